# Optimizing an MI355X kernel written in HIP

```python
import math
import jax, jax.numpy as jnp
from jax import lax
import numpy as np

D_MODEL = 1024
BATCH = 8
SEQ = 2048
DEPTH = 1
DEC_BATCH = 128
DEC_SEQ = 1
PAST_LEN = 16384
PAGE_SIZE = 128

D_MIX = D_MODEL
R_WIDTH = D_MIX // 2
R_HEAD = 64
R_HEADS = R_WIDTH // R_HEAD
D_DECAY_LORA = 64
D_AAA_LORA = 64
D_GATE_LORA = 128
M_WIDTH = D_MIX - R_WIDTH
M_HEADDIM = 64
M_HEADS = M_WIDTH // M_HEADDIM
M_GROUPS = 2
M_HPG = M_HEADS // M_GROUPS
D_STATE = 128
CONV_K = 4
CONV_DIM = M_WIDTH + 2 * M_GROUPS * D_STATE
SSD_CHUNK = 256
D_FF = 4 * D_MODEL
RWKV_PROJ = 3 * R_WIDTH + D_DECAY_LORA + D_AAA_LORA + D_GATE_LORA
PROJ = RWKV_PROJ + M_WIDTH + CONV_DIM + M_HEADS
ALPHA = (2 * DEPTH) ** 0.25
BETA = (8 * DEPTH) ** -0.25
LN_EPS = 1e-5
LNX_EPS = 64e-5
RMS_EPS = 1e-5

kernel_name = 'rwkv7_mamba2_hybrid_step'


def layer_norm(x, g, b, eps):
    xf = x.astype(jnp.float32)
    mu = jnp.mean(xf, -1, keepdims=True)
    var = jnp.mean(jnp.square(xf - mu), -1, keepdims=True)
    return (xf - mu) * lax.rsqrt(var + eps) * g.astype(jnp.float32) + b.astype(jnp.float32)


def rwkv7_mix(u, wkv0, w0, w_up, a0, a_up, g_up, k_k, k_a, r_k, lnx_w, lnx_b):
    b, L, _ = u.shape
    cuts = [R_WIDTH, 2 * R_WIDTH, 3 * R_WIDTH, 3 * R_WIDTH + D_DECAY_LORA,
            3 * R_WIDTH + D_DECAY_LORA + D_AAA_LORA]
    r, k, v, uw, ua, ug = jnp.split(u, cuts, axis=-1)
    w_log = -jax.nn.softplus(-(w0 + jnp.tanh(uw) @ w_up)) - 0.5
    decay = jnp.exp(-jnp.exp(w_log))
    a = jax.nn.sigmoid(a0 + ua @ a_up)
    g = jax.nn.sigmoid(ug) @ g_up
    heads = lambda t: t.reshape(b, L, R_HEADS, R_HEAD)
    kk = heads(k * k_k)
    kk = kk * lax.rsqrt(jnp.maximum(jnp.sum(jnp.square(kk), -1, keepdims=True), 1e-24))
    k = heads(k * (1.0 + (a - 1.0) * k_a))
    r, v, decay, a = heads(r), heads(v), heads(decay), heads(a)

    def step(S, inp):
        r_t, w_t, k_t, v_t, ka_t, kb_t = inp
        Sa = jnp.einsum('bhvk,bhk->bhv', S, ka_t)
        S = (S * w_t[:, :, None, :] + Sa[..., None] * kb_t[:, :, None, :]
             + v_t[..., None] * k_t[:, :, None, :])
        return S, jnp.einsum('bhvk,bhk->bhv', S, r_t)

    seq = tuple(jnp.swapaxes(t, 0, 1) for t in (r, decay, k, v, -kk, kk * a))
    S_fin, y = lax.scan(step, wkv0, seq)
    y = jnp.swapaxes(y, 0, 1)
    y = layer_norm(y, lnx_w.reshape(R_HEADS, R_HEAD), lnx_b.reshape(R_HEADS, R_HEAD), LNX_EPS)
    y = y + jnp.sum(r * k * r_k, -1, keepdims=True) * v
    return y.reshape(b, L, R_WIDTH) * g, S_fin


def segsum(a):
    q = a.shape[-1]
    cs = jnp.cumsum(a, -1)
    diff = cs[..., :, None] - cs[..., None, :]
    mask = jnp.tril(jnp.ones((q, q), dtype=bool))
    return jnp.where(mask, diff, -jnp.inf)


def ssd_scan(X, Adt, Bm, Cm, h0):
    b, L = X.shape[:2]
    q = min(SSD_CHUNK, L)
    pad = (-L) % q
    if pad:
        padw = lambda t: jnp.pad(t, [(0, 0), (0, pad)] + [(0, 0)] * (t.ndim - 2))
        X, Adt, Bm, Cm = padw(X), padw(Adt), padw(Bm), padw(Cm)
    nc = (L + pad) // q
    X = X.reshape(b, nc, q, M_GROUPS, M_HPG, M_HEADDIM)
    Adt = Adt.reshape(b, nc, q, M_GROUPS, M_HPG).transpose(0, 3, 4, 1, 2)
    Bm = Bm.reshape(b, nc, q, M_GROUPS, D_STATE)
    Cm = Cm.reshape(b, nc, q, M_GROUPS, D_STATE)
    A_cs = jnp.cumsum(Adt, -1)
    Lmat = jnp.exp(segsum(Adt))
    CB = jnp.einsum('bclgn,bcsgn->bcgls', Cm, Bm)
    y_diag = jnp.einsum('bcgls,bgecls,bcsgep->bclgep', CB, Lmat, X)
    decay_states = jnp.exp(A_cs[..., -1:] - A_cs)
    states = jnp.einsum('bclgn,bgecl,bclgep->bcgepn', Bm, decay_states, X)
    states = jnp.concatenate([h0[:, None], states], axis=1)
    chunk_decay = jnp.exp(segsum(jnp.pad(A_cs[..., -1], ((0, 0), (0, 0), (0, 0), (1, 0)))))
    states = jnp.einsum('bgezc,bcgepn->bzgepn', chunk_decay, states)
    h_in, h_fin = states[:, :-1], states[:, -1]
    y_off = jnp.einsum('bclgn,bcgepn,bgecl->bclgep', Cm, h_in, jnp.exp(A_cs))
    y = (y_diag + y_off).reshape(b, nc * q, M_GROUPS, M_HPG, M_HEADDIM)[:, :L]
    return y, h_fin


def mamba2_mix(z, xbc, dt, conv_prev, ssm0, conv_w, conv_b, dt_bias, a_log, d_skip, gnorm_w):
    b, L, _ = xbc.shape
    xpad = jnp.concatenate([conv_prev, xbc], axis=1)
    conv = conv_b + sum(xpad[:, i:i + L] * conv_w[i] for i in range(CONV_K))
    new_conv = xpad[:, L:]
    xbc = jax.nn.silu(conv)
    xs, Bm, Cm = jnp.split(xbc, [M_WIDTH, M_WIDTH + M_GROUPS * D_STATE], axis=-1)
    xs = xs.reshape(b, L, M_GROUPS, M_HPG, M_HEADDIM)
    Bm = Bm.reshape(b, L, M_GROUPS, D_STATE)
    Cm = Cm.reshape(b, L, M_GROUPS, D_STATE)
    dt = jax.nn.softplus(dt + dt_bias).reshape(b, L, M_GROUPS, M_HPG)
    A = -jnp.exp(a_log).reshape(M_GROUPS, M_HPG)
    y, h_fin = ssd_scan(xs * dt[..., None], dt * A, Bm, Cm,
                        ssm0.reshape(b, M_GROUPS, M_HPG, M_HEADDIM, D_STATE))
    y = y + d_skip.reshape(M_GROUPS, M_HPG)[:, :, None] * xs
    gw = M_WIDTH // M_GROUPS
    y = y.reshape(b, L, M_GROUPS, gw) * jax.nn.silu(z).reshape(b, L, M_GROUPS, gw)
    y = y * lax.rsqrt(jnp.mean(jnp.square(y), -1, keepdims=True) + RMS_EPS)
    return (y.reshape(b, L, M_WIDTH) * gnorm_w, new_conv,
            h_fin.reshape(b, M_HEADS, M_HEADDIM, D_STATE))


def decoder_layer(x, shift_prev, wkv0, conv_prev, ssm0, w_in, mu_shift, w0, w_up, a0, a_up,
                  g_up, k_k, k_a, r_k, lnx_w, lnx_b, conv_w, conv_b, dt_bias, a_log, d_skip,
                  gnorm_w, w_out, ln1_g, ln1_b, w_ff1, w_ff2, ln2_g, ln2_b):
    L = x.shape[1]
    proj = (x @ w_in).astype(jnp.float32)
    pr = proj[..., :RWKV_PROJ]
    prev = jnp.concatenate([shift_prev[:, None].astype(jnp.float32), pr[:, :L - 1]], axis=1)
    u = pr + (prev - pr) * mu_shift
    o_r, wkv_fin = rwkv7_mix(u, wkv0.astype(jnp.float32), w0, w_up, a0, a_up, g_up,
                             k_k, k_a, r_k, lnx_w, lnx_b)
    m0 = RWKV_PROJ
    z = proj[..., m0:m0 + M_WIDTH]
    xbc = proj[..., m0 + M_WIDTH:m0 + M_WIDTH + CONV_DIM]
    dt = proj[..., m0 + M_WIDTH + CONV_DIM:]
    o_m, conv_new, ssm_fin = mamba2_mix(z, xbc, dt, conv_prev.astype(jnp.float32),
                                        ssm0.astype(jnp.float32), conv_w, conv_b,
                                        dt_bias, a_log, d_skip, gnorm_w)
    mix = jnp.concatenate([o_r, o_m], axis=-1).astype(x.dtype) @ w_out
    h = layer_norm(ALPHA * x + mix, ln1_g, ln1_b, LN_EPS).astype(x.dtype)
    ff = jnp.square(jax.nn.relu(h @ w_ff1)) @ w_ff2
    y = layer_norm(ALPHA * h + ff, ln2_g, ln2_b, LN_EPS).astype(x.dtype)
    return y, pr[:, -1], wkv_fin, conv_new, ssm_fin


def setup_inputs(seed: int = 0) -> dict:
    key = jax.random.key(seed)
    ks = jax.random.split(key, 32)
    nrm = lambda k, shape, s: jax.random.normal(k, shape, jnp.float32) * s
    dt = jnp.exp(jax.random.uniform(ks[20], (DEPTH, M_HEADS), jnp.float32,
                                    minval=math.log(1e-3), maxval=math.log(1e-1)))
    return {
        'x_prompt': nrm(ks[0], (BATCH, SEQ, D_MODEL), 1.0),
        'x_sample': nrm(ks[1], (DEC_BATCH, DEC_SEQ, D_MODEL), 1.0),
        'state_shift': nrm(ks[2], (DEPTH, DEC_BATCH, RWKV_PROJ), 1.0),
        'state_wkv': nrm(ks[3], (DEPTH, DEC_BATCH, R_HEADS, R_HEAD, R_HEAD), 0.3),
        'state_conv': nrm(ks[4], (DEPTH, DEC_BATCH, CONV_K - 1, CONV_DIM), 1.0),
        'state_ssm': nrm(ks[5], (DEPTH, DEC_BATCH, M_HEADS, M_HEADDIM, D_STATE), 0.3),
        'w_in': nrm(ks[6], (DEPTH, D_MODEL, PROJ), D_MODEL ** -0.5),
        'mu_shift': jax.random.uniform(ks[7], (DEPTH, RWKV_PROJ), jnp.float32),
        'w0': nrm(ks[8], (DEPTH, R_WIDTH), 0.5) - 1.0,
        'w_up': nrm(ks[9], (DEPTH, D_DECAY_LORA, R_WIDTH), 0.1),
        'a0': nrm(ks[10], (DEPTH, R_WIDTH), 0.1),
        'a_up': nrm(ks[11], (DEPTH, D_AAA_LORA, R_WIDTH), 0.1),
        'g_up': nrm(ks[12], (DEPTH, D_GATE_LORA, R_WIDTH), D_GATE_LORA ** -0.5),
        'k_k': 0.85 + nrm(ks[13], (DEPTH, R_WIDTH), 0.05),
        'k_a': 1.0 + nrm(ks[14], (DEPTH, R_WIDTH), 0.05),
        'r_k': nrm(ks[15], (DEPTH, R_HEADS, R_HEAD), 0.1),
        'lnx_w': 1.0 + nrm(ks[16], (DEPTH, R_WIDTH), 0.02),
        'lnx_b': nrm(ks[17], (DEPTH, R_WIDTH), 0.02),
        'conv_w': nrm(ks[18], (DEPTH, CONV_K, CONV_DIM), CONV_K ** -0.5),
        'conv_b': nrm(ks[19], (DEPTH, CONV_DIM), 0.02),
        'dt_bias': dt + jnp.log(-jnp.expm1(-dt)),
        'a_log': jnp.log(jax.random.uniform(ks[21], (DEPTH, M_HEADS), jnp.float32, minval=1.0, maxval=16.0)),
        'd_skip': 1.0 + nrm(ks[22], (DEPTH, M_HEADS), 0.1),
        'gnorm_w': 1.0 + nrm(ks[23], (DEPTH, M_WIDTH), 0.02),
        'w_out': nrm(ks[24], (DEPTH, D_MIX, D_MODEL), BETA * D_MIX ** -0.5),
        'ln1_g': 1.0 + nrm(ks[25], (DEPTH, D_MODEL), 0.02),
        'ln1_b': nrm(ks[26], (DEPTH, D_MODEL), 0.02),
        'w_ff1': nrm(ks[27], (DEPTH, D_MODEL, D_FF), D_MODEL ** -0.5),
        'w_ff2': nrm(ks[28], (DEPTH, D_FF, D_MODEL), BETA * D_FF ** -0.5),
        'ln2_g': 1.0 + nrm(ks[29], (DEPTH, D_MODEL), 0.02),
        'ln2_b': nrm(ks[30], (DEPTH, D_MODEL), 0.02),
    }


def reference(x_prompt, x_sample, state_shift, state_wkv, state_conv, state_ssm, w_in, mu_shift,
              w0, w_up, a0, a_up, g_up, k_k, k_a, r_k, lnx_w, lnx_b, conv_w, conv_b, dt_bias,
              a_log, d_skip, gnorm_w, w_out, ln1_g, ln1_b, w_ff1, w_ff2, ln2_g, ln2_b):
    h_p, h_s = x_prompt, x_sample
    nb = x_prompt.shape[0]
    new_p, new_s = [], []
    for l in range(DEPTH):
        lp = (w_in[l], mu_shift[l], w0[l], w_up[l], a0[l], a_up[l], g_up[l], k_k[l], k_a[l],
              r_k[l], lnx_w[l], lnx_b[l], conv_w[l], conv_b[l], dt_bias[l], a_log[l], d_skip[l],
              gnorm_w[l], w_out[l], ln1_g[l], ln1_b[l], w_ff1[l], w_ff2[l], ln2_g[l], ln2_b[l])
        h_p, *sp = decoder_layer(
            h_p,
            jnp.zeros((nb, RWKV_PROJ), jnp.float32),
            jnp.zeros((nb, R_HEADS, R_HEAD, R_HEAD), jnp.float32),
            jnp.zeros((nb, CONV_K - 1, CONV_DIM), jnp.float32),
            jnp.zeros((nb, M_HEADS, M_HEADDIM, D_STATE), jnp.float32),
            *lp)
        h_s, *ss = decoder_layer(h_s, state_shift[l], state_wkv[l], state_conv[l], state_ssm[l], *lp)
        new_p.append(sp)
        new_s.append(ss)
    st = lambda outs, i, ref: jnp.stack([o[i] for o in outs]).astype(ref.dtype)
    return (h_p, h_s,
            st(new_p, 0, state_shift), st(new_p, 1, state_wkv), st(new_p, 2, state_conv), st(new_p, 3, state_ssm),
            st(new_s, 0, state_shift), st(new_s, 1, state_wkv), st(new_s, 2, state_conv), st(new_s, 3, state_ssm))
```

```cpp
#include <hip/hip_runtime.h>
#include <hip/hip_cooperative_groups.h>
#include <cstdio>
#include <cstdint>
namespace cg = cooperative_groups;
#define LAS __attribute__((address_space(3)))

typedef unsigned short bf16;
typedef short bf16x8 __attribute__((ext_vector_type(8)));
typedef float f32x4 __attribute__((ext_vector_type(4)));
typedef unsigned u32x4 __attribute__((ext_vector_type(4)));

constexpr int DM = 1024, SEQ = 2048, MPR = 8 * SEQ, MSM = 128, MTOT = MPR + MSM;
constexpr int RPJ = 1792, PLD = 3328, PROJN = 3336, DFF = 4096;
constexpr float ALPHA = 1.189207115f;
constexpr size_t O_Y = 0, O_YS = 16777216, O_SHP = 16908288, O_WKVP = 16922624, O_CONVP = 17184768, O_SSMP = 17209344,
                 O_SHS = 17733632, O_WKVS = 17963008, O_CONVS = 22157312, O_SSMS = 22550528;
constexpr size_t OS_WD = 0, OS_GG = 8454144;
constexpr size_t WS_WIN = 0, WS_WOUT = 7340032, WS_WFF1 = 9437184, WS_WFF2 = 17825792, WS_LORA = 26214400, WS_XB = 26476544,
                 WS_PROJ = 60293120, WS_DT = 170196992, WS_KP = 170725376, WS_KK = 187633664, WS_KB = 204541952, WS_XBC = 221450240,
                 WS_CTL = 255004672, WS_YS = WS_CTL + 65536, WS_HID = WS_PROJ, WS_MIX = WS_KK;
constexpr int LDS_BYTES = 147456, MISC_OFF = LDS_BYTES - 64;

struct P { const float* in[31]; float* out; unsigned char* ws; int never; int pad; };

__device__ __forceinline__ float bf2f(unsigned short b) { return __uint_as_float(((unsigned)b) << 16); }
__device__ __forceinline__ float bflo(unsigned u) { return __uint_as_float(u << 16); }
__device__ __forceinline__ float bfhi(unsigned u) { return __uint_as_float(u & 0xffff0000u); }
typedef float f32x2_t __attribute__((ext_vector_type(2)));
typedef __bf16 bf16x2_t __attribute__((ext_vector_type(2)));
__device__ __forceinline__ unsigned pkbf(float lo, float hi) { const f32x2_t v = {lo, hi}; const bf16x2_t b = __builtin_convertvector(v, bf16x2_t); return __builtin_bit_cast(unsigned, b); }
__device__ __forceinline__ unsigned short f2bf(float f) { return (unsigned short)(pkbf(f, f) & 0xffffu); }
__device__ __forceinline__ void unpack8(u32x4 v, float* o) { o[0] = bflo(v.x); o[1] = bfhi(v.x); o[2] = bflo(v.y); o[3] = bfhi(v.y); o[4] = bflo(v.z); o[5] = bfhi(v.z); o[6] = bflo(v.w); o[7] = bfhi(v.w); }
__device__ __forceinline__ u32x4 pack8(const float* o) { u32x4 v; v.x = pkbf(o[0], o[1]); v.y = pkbf(o[2], o[3]); v.z = pkbf(o[4], o[5]); v.w = pkbf(o[6], o[7]); return v; }
__device__ __forceinline__ float sigm(float x) { return __builtin_amdgcn_rcpf(1.f + __expf(-x)); }
__device__ __forceinline__ float silu(float x) { return x * __builtin_amdgcn_rcpf(1.f + __expf(-x)); }
__device__ __forceinline__ float softplus(float x) { return fmaxf(x, 0.f) + __logf(1.f + __expf(-fabsf(x))); }
__device__ __forceinline__ float tanh_(float x) { const float e = __expf(2.f * x); return 1.f - 2.f * __builtin_amdgcn_rcpf(e + 1.f); }
template <int CTRL> __device__ __forceinline__ float dppf(float x) { return __int_as_float(__builtin_amdgcn_update_dpp(0, __float_as_int(x), CTRL, 0xf, 0xf, true)); }
template <int CTRL> __device__ __forceinline__ float dppo(float x) { return __int_as_float(__builtin_amdgcn_update_dpp(0x3f800000, __float_as_int(x), CTRL, 0xf, 0xf, false)); }
__device__ __forceinline__ float sum16(float x) { x += dppf<0xB1>(x); x += dppf<0x4E>(x); x += dppf<0x141>(x); x += dppf<0x140>(x); return x; }
__device__ __forceinline__ f32x4 mfma16(bf16x8 a, bf16x8 b, f32x4 c) { return __builtin_amdgcn_mfma_f32_16x16x32_bf16(a, b, c, 0, 0, 0); }
typedef short s16x4 __attribute__((ext_vector_type(4)));
__device__ __forceinline__ f32x4 mf16(s16x4 a, s16x4 b, f32x4 c) { return __builtin_amdgcn_mfma_f32_16x16x16bf16_1k(a, b, c, 0, 0, 0); }
__device__ __forceinline__ s16x4 cvt4(f32x4 v) { struct { unsigned a, b; } t = {pkbf(v[0], v[1]), pkbf(v[2], v[3])}; return __builtin_bit_cast(s16x4, t); }
#define LDS_FENCE() asm volatile("s_waitcnt lgkmcnt(0)" ::: "memory")

#define PHASE_PROLOGUE P p = p_in; { size_t z_ = 0; asm volatile("" : "+s"(z_)); p.ws += z_; p.out += z_; } int tid = threadIdx.x; asm volatile("" : "+v"(tid))
namespace pg8 {
#define PG8_LAS __attribute__((address_space(3)))
typedef unsigned short bf16_t;
typedef short bf16x8 __attribute__((ext_vector_type(8)));
typedef float f32x4 __attribute__((ext_vector_type(4)));
typedef unsigned u32x4 __attribute__((ext_vector_type(4)));
constexpr int BM = 256, BK = 64, HALF = 128, HTB = HALF * BK * 2  , STAGE_BYTES = 8 * HTB, NXCD = 8, WGM = 8;

__host__ __device__ __forceinline__ int lds_byte(int r, int c) { const int st = (r >> 4) * 2 + (c >> 5), rr = r & 15, cc = c & 31, ob = rr * 64 + cc * 2; return st * 1024 + (ob ^ (((ob >> 9) & 1) << 5)); }
__host__ __device__ __forceinline__ void stage_rc(int b, int& R, int& C) { const int st = b / 1024, sb = b % 1024, swz = sb ^ (((sb >> 9) & 1) << 5); R = (st >> 1) * 16 + swz / 64; C = (st & 1) * 32 + (swz % 64) / 2; }
__host__ __device__ __forceinline__ int perm32(int rho) { const int n = rho >> 4, i = rho & 15; return 8 * (i >> 2) + 4 * n + (i & 3); }

struct Unit { int pm, pn; };
struct Gemm { const bf16_t* A; const bf16_t* Bt; int M, N, K; };

struct StaticOrder {
    int nM, nN, nwg, G, c;
    __host__ __device__ void init(int M, int N, int G_, int c_) { nM = M / BM; nN = N / BM; nwg = nM * nN; G = G_; c = c_; }
    __host__ __device__ bool next(int i, Unit& u) const {
        const long L = (long)i * G + c; if (L >= nwg) return false;
        int wgid = (int)L; { const int q = nwg / NXCD, r = nwg % NXCD, xcd = wgid % NXCD, off = wgid / NXCD; wgid = (xcd < r ? xcd * (q + 1) : r * (q + 1) + (xcd - r) * q) + off; }
        const int nig = WGM * nN, gid = wgid / nig, fm = gid * WGM, gsz = (nM - fm) < WGM ? (nM - fm) : WGM;
        u.pm = fm + ((wgid % nig) % gsz); u.pn = (wgid % nig) / gsz; return true;
    }
    __device__ __forceinline__ void a_ready(const Unit&) const {}
    __device__ __forceinline__ void done(const Unit&) const {}
};

__device__ __forceinline__ unsigned cvt_pk_bf16(float lo, float hi) { return ::pkbf(lo, hi); }
typedef float f32x2 __attribute__((ext_vector_type(2)));
struct EpiProj {
    static constexpr bool PERM = true, AFTER_DRAIN = false;
    bf16_t* PROJ; float* DT; const float* dt_bias; float* out;
    __device__ __forceinline__ void operator()(const f32x4 (&acc)[2][2][4][2], const Unit& u, int wr, int wc, int fr, int fq) const {
        const int row0 = u.pm * BM + wr * 64 + fr;
#pragma unroll
        for (int bj = 0; bj < 2; ++bj) {
            const int c0 = u.pn * BM + bj * HALF + wc * 32 + 8 * fq;
            if (c0 >= 3336) continue;
#pragma unroll
            for (int ai = 0; ai < 2; ++ai)
#pragma unroll
                for (int m = 0; m < 4; ++m) {
                    const int row = row0 + ai * HALF + m * 16; const f32x4 v0 = acc[ai][bj][m][0], v1 = acc[ai][bj][m][1];
                    if (c0 < 3328) { u32x4 w; w.x = cvt_pk_bf16(v0[0], v0[1]); w.y = cvt_pk_bf16(v0[2], v0[3]); w.z = cvt_pk_bf16(v1[0], v1[1]); w.w = cvt_pk_bf16(v1[2], v1[3]);
                        *(u32x4*)(PROJ + (size_t)row * 3328 + c0) = w; }
                    else { f32x4 a, b;
#pragma unroll
                        for (int i = 0; i < 4; ++i) { float x = v0[i] + dt_bias[i]; a[i] = x > 20.f ? x : log1pf(__expf(x)); float y = v1[i] + dt_bias[4 + i]; b[i] = y > 20.f ? y : log1pf(__expf(y)); }
                        *(f32x4*)(DT + (size_t)row * 8) = a; *(f32x4*)(DT + (size_t)row * 8 + 4) = b; }
                    const int t = row & 2047, b_ = row >> 11;
                    if (t == 2047 && c0 < 1792) { float* o = out + 16908288 + (size_t)b_ * 1792 + c0; *(f32x4*)o = v0; *(f32x4*)(o + 4) = v1; }
                    if (t >= 2045 && c0 >= 2304 && c0 < 3328) { float* o = out + 17184768 + ((size_t)b_ * 3 + (t - 2045)) * 1024 + (c0 - 2304); *(f32x4*)o = v0; *(f32x4*)(o + 4) = v1; }
                }
        }
    }
};
struct EpiResF32 {
    static constexpr bool PERM = true, AFTER_DRAIN = false;
    const float* resf; const bf16_t* resb; bf16_t* ob; int ld; float alpha;
    __device__ __forceinline__ void operator()(const f32x4 (&acc)[2][2][4][2], const Unit& u, int wr, int wc, int fr, int fq) const {
        const int row0 = u.pm * BM + wr * 64 + fr;
#pragma unroll
        for (int ai = 0; ai < 2; ++ai)
#pragma unroll
            for (int m = 0; m < 4; ++m)
#pragma unroll
                for (int bj = 0; bj < 2; ++bj) {
                    const int row = row0 + ai * HALF + m * 16, c0 = u.pn * BM + bj * HALF + wc * 32 + 8 * fq; const size_t o = (size_t)row * 1024 + c0;
                    f32x4 r0, r1;
                    if (resf) { r0 = *(const f32x4*)(resf + o); r1 = *(const f32x4*)(resf + o + 4); }
                    else { const u32x4 w = *(const u32x4*)(resb + o); r0[0] = __uint_as_float(w.x << 16); r0[1] = __uint_as_float(w.x & 0xffff0000u); r0[2] = __uint_as_float(w.y << 16); r0[3] = __uint_as_float(w.y & 0xffff0000u);
                        r1[0] = __uint_as_float(w.z << 16); r1[1] = __uint_as_float(w.z & 0xffff0000u); r1[2] = __uint_as_float(w.w << 16); r1[3] = __uint_as_float(w.w & 0xffff0000u); }
                    const f32x4 v0 = r0 * alpha + acc[ai][bj][m][0], v1 = r1 * alpha + acc[ai][bj][m][1];
                    u32x4 w8; w8.x = cvt_pk_bf16(v0[0], v0[1]); w8.y = cvt_pk_bf16(v0[2], v0[3]); w8.z = cvt_pk_bf16(v1[0], v1[1]); w8.w = cvt_pk_bf16(v1[2], v1[3]);
                    *(u32x4*)(ob + (size_t)row * ld + c0) = w8;
                }
    }
};
struct EpiRelu2 {
    static constexpr bool PERM = true, AFTER_DRAIN = false;
    bf16_t* O; int ldc;
    __device__ __forceinline__ void operator()(const f32x4 (&acc)[2][2][4][2], const Unit& u, int wr, int wc, int fr, int fq) const {
        const int row0 = u.pm * BM + wr * 64 + fr;
#pragma unroll
        for (int ai = 0; ai < 2; ++ai)
#pragma unroll
            for (int m = 0; m < 4; ++m)
#pragma unroll
                for (int bj = 0; bj < 2; ++bj) {
                    const int row = row0 + ai * HALF + m * 16, c0 = u.pn * BM + bj * HALF + wc * 32 + 8 * fq;
                    f32x4 v0 = acc[ai][bj][m][0], v1 = acc[ai][bj][m][1];
#pragma unroll
                    for (int i = 0; i < 4; ++i) { float a = fmaxf(v0[i], 0.f); v0[i] = a * a; float b = fmaxf(v1[i], 0.f); v1[i] = b * b; }
                    u32x4 w; w.x = cvt_pk_bf16(v0[0], v0[1]); w.y = cvt_pk_bf16(v0[2], v0[3]); w.z = cvt_pk_bf16(v1[0], v1[1]); w.w = cvt_pk_bf16(v1[2], v1[3]);
                    *(u32x4*)(O + (size_t)row * ldc + c0) = w;
                }
    }
};
template <class Epi, class Sched, bool ALIGN_EPI = false, bool SP2 = false>
__device__ __forceinline__ void gemm_phase(PG8_LAS unsigned char* lds, const Gemm g, const Sched& S, const Epi& E) {
    int tid = threadIdx.x; asm volatile("" : "+v"(tid)); const int wid = __builtin_amdgcn_readfirstlane(tid >> 6), lane = tid & 63, wr = wid >> 2, wc = wid & 3, fr = lane & 15, fq = lane >> 4;
    const int K = g.K, nt = K / BK;
    unsigned voffA[2], voffB[2];
#pragma unroll
    for (int i = 0; i < 2; ++i) { int R, C; stage_rc(tid * 16 + i * 8192, R, C); const int Rb = Epi::PERM ? ((R & ~31) + perm32(R & 31)) : R;
        voffA[i] = (unsigned)(R * K + C) * 2u; voffB[i] = (unsigned)(Rb * K + C) * 2u; }
    const size_t kstep = (size_t)(BK * 2);
    const size_t hstep = (size_t)HALF * K * 2;
    const size_t tstep = 2 * hstep;
    const unsigned ldsw = (unsigned)wid * 1024u;
    const int aoff = lds_byte(wr * 64 + fr, fq * 8), boff = lds_byte(wc * 32 + fr, fq * 8);
#define PG8_SA(b, h) (((b) * 2 + (h)) * HTB)
#define PG8_SB(b, h) ((4 + (b) * 2 + (h)) * HTB)
#define PG8_STAGE(bufoff, gbase, voff) do { _Pragma("unroll") for (int _i = 0; _i < 2; ++_i) \
        __builtin_amdgcn_global_load_lds((const unsigned*)((const char*)(gbase) + (voff)[_i]), (PG8_LAS unsigned*)(lds + (bufoff) + ldsw + _i * 8192), 16, 0, 0); } while (0)
#define PG8_LDA(dst, b, h) do { _Pragma("unroll") for (int m = 0; m < 4; ++m) _Pragma("unroll") for (int k = 0; k < 2; ++k) dst[m][k] = *(const PG8_LAS bf16x8*)(lds + PG8_SA(b, h) + aoff + m * 2048 + k * 1024); } while (0)
#define PG8_LDB(dst, b, h) do { _Pragma("unroll") for (int n = 0; n < 2; ++n) _Pragma("unroll") for (int k = 0; k < 2; ++k) dst[n][k] = *(const PG8_LAS bf16x8*)(lds + PG8_SB(b, h) + boff + n * 2048 + k * 1024); } while (0)
#define PG8_MMA(ai, bj, At, Bt) do { __builtin_amdgcn_s_setprio(1); _Pragma("unroll") for (int m = 0; m < 4; ++m) _Pragma("unroll") for (int n = 0; n < 2; ++n) _Pragma("unroll") for (int k = 0; k < 2; ++k) \
        acc[ai][bj][m][n] = __builtin_amdgcn_mfma_f32_16x16x32_bf16(Bt[n][k], At[m][k], acc[ai][bj][m][n], 0, 0, 0); __builtin_amdgcn_s_setprio(0); } while (0)
#define PG8_WAIT_V(n) asm volatile("s_waitcnt vmcnt(" #n ")" ::: "memory")
#define PG8_WAIT_L(n) asm volatile("s_waitcnt lgkmcnt(" #n ")" ::: "memory")
#define PG8_BAR __builtin_amdgcn_s_barrier()
#define PG8_SCHED __builtin_amdgcn_sched_barrier(0)
    Unit cur, nxt; int ui = 0;
    if (!S.next(0, cur)) return;
    f32x4 acc[2][2][4][2];
#pragma unroll
    for (int a = 0; a < 2; ++a)
#pragma unroll
        for (int b = 0; b < 2; ++b)
#pragma unroll
            for (int m = 0; m < 4; ++m)
#pragma unroll
                for (int n = 0; n < 2; ++n) acc[a][b][m][n] = (f32x4){0.f, 0.f, 0.f, 0.f};
    bf16x8 At[4][2], B0[2][2], B1[2][2];
    const char* cA = (const char*)g.A + (size_t)cur.pm * tstep; const char* cB = (const char*)g.Bt + (size_t)cur.pn * tstep;
    S.a_ready(cur);
    if constexpr (SP2) {
        PG8_STAGE(PG8_SB(0, 0), cB, voffB); PG8_STAGE(PG8_SB(0, 1), cB + hstep, voffB); PG8_STAGE(PG8_SA(0, 0), cA, voffA); PG8_STAGE(PG8_SA(0, 1), cA + hstep, voffA);
        if (wr == 1) PG8_BAR;
        PG8_WAIT_V(2); PG8_BAR;
        PG8_STAGE(PG8_SB(1, 0), cB + kstep, voffB); PG8_STAGE(PG8_SA(1, 0), cA + kstep, voffA); PG8_STAGE(PG8_SB(1, 1), cB + hstep + kstep, voffB);
        PG8_WAIT_V(6); PG8_BAR;
    } else {
        PG8_STAGE(PG8_SB(0, 0), cB, voffB); PG8_STAGE(PG8_SA(0, 0), cA, voffA); PG8_STAGE(PG8_SB(0, 1), cB + hstep, voffB); PG8_STAGE(PG8_SA(0, 1), cA + hstep, voffA);
        if (wr == 1) PG8_BAR;
        PG8_WAIT_V(4); PG8_BAR;
        PG8_STAGE(PG8_SB(1, 0), cB + kstep, voffB); PG8_STAGE(PG8_SA(1, 0), cA + kstep, voffA); PG8_STAGE(PG8_SB(1, 1), cB + hstep + kstep, voffB);
        PG8_WAIT_V(6); PG8_BAR;
    }
    for (;;) {
        const bool has_next = S.next(ui + 1, nxt);
        const char* nA = has_next ? (const char*)g.A + (size_t)nxt.pm * tstep : cA; const char* nB = has_next ? (const char*)g.Bt + (size_t)nxt.pn * tstep : cB;
        for (int t = 0; t < nt; t += 2) {
            const bool last = (t == nt - 2);
            const char* a1 = cA + (size_t)(t + 1) * kstep;
            const char* a2 = last ? nA : cA + (size_t)(t + 2) * kstep; const char* b2 = last ? nB : cB + (size_t)(t + 2) * kstep;
            const char* a3 = a2 + kstep; const char* b3 = b2 + kstep;
            if (last && has_next) S.a_ready(nxt);
            if constexpr (SP2) {
            PG8_LDB(B0, 0, 0); PG8_LDB(B1, 0, 1); PG8_SCHED; PG8_LDA(At, 0, 0); PG8_STAGE(PG8_SA(1, 1), a1 + hstep, voffA);
            PG8_WAIT_V(8); PG8_WAIT_L(0); PG8_BAR; PG8_MMA(0, 0, At, B0); PG8_MMA(0, 1, At, B1); PG8_BAR; PG8_SCHED;
            PG8_LDA(At, 0, 1); PG8_STAGE(PG8_SB(0, 0), b2, voffB); PG8_STAGE(PG8_SB(0, 1), b2 + hstep, voffB); PG8_STAGE(PG8_SA(0, 0), a2, voffA);
            PG8_WAIT_V(8); PG8_WAIT_L(0); PG8_BAR; PG8_MMA(1, 0, At, B0); PG8_MMA(1, 1, At, B1); PG8_BAR; PG8_SCHED;
            PG8_LDB(B0, 1, 0); PG8_LDB(B1, 1, 1); PG8_SCHED; PG8_LDA(At, 1, 0); PG8_STAGE(PG8_SA(0, 1), a2 + hstep, voffA);
            PG8_WAIT_V(8); PG8_WAIT_L(0); PG8_BAR; PG8_MMA(0, 0, At, B0); PG8_MMA(0, 1, At, B1); PG8_BAR; PG8_SCHED;
            PG8_LDA(At, 1, 1); PG8_STAGE(PG8_SB(1, 0), b3, voffB); PG8_STAGE(PG8_SB(1, 1), b3 + hstep, voffB); PG8_STAGE(PG8_SA(1, 0), a3, voffA);
            PG8_WAIT_V(8); PG8_WAIT_L(0); PG8_BAR; PG8_MMA(1, 0, At, B0); PG8_MMA(1, 1, At, B1); PG8_BAR; PG8_SCHED;
            } else {
            PG8_LDB(B0, 0, 0); PG8_SCHED; PG8_LDA(At, 0, 0); PG8_STAGE(PG8_SA(1, 1), a1 + hstep, voffA);
            PG8_WAIT_L(8); PG8_BAR; PG8_WAIT_L(0); PG8_MMA(0, 0, At, B0); PG8_BAR; PG8_SCHED;
            PG8_LDB(B1, 0, 1); PG8_STAGE(PG8_SB(0, 0), b2, voffB);
            PG8_BAR; PG8_WAIT_L(0); PG8_MMA(0, 1, At, B1); PG8_BAR;
            PG8_LDA(At, 0, 1); PG8_STAGE(PG8_SA(0, 0), a2, voffA);
            PG8_BAR; PG8_WAIT_L(0); PG8_MMA(1, 0, At, B0); PG8_BAR; PG8_SCHED;
            PG8_STAGE(PG8_SB(0, 1), b2 + hstep, voffB);
            PG8_WAIT_V(6); PG8_BAR; PG8_MMA(1, 1, At, B1); PG8_BAR;
            PG8_LDB(B0, 1, 0); PG8_SCHED; PG8_LDA(At, 1, 0); PG8_STAGE(PG8_SA(0, 1), a2 + hstep, voffA);
            PG8_WAIT_L(8); PG8_BAR; PG8_WAIT_L(0); PG8_MMA(0, 0, At, B0); PG8_BAR; PG8_SCHED;
            PG8_LDB(B1, 1, 1); PG8_STAGE(PG8_SB(1, 0), b3, voffB);
            PG8_BAR; PG8_WAIT_L(0); PG8_MMA(0, 1, At, B1); PG8_BAR;
            PG8_LDA(At, 1, 1); PG8_STAGE(PG8_SA(1, 0), a3, voffA);
            PG8_BAR; PG8_WAIT_L(0); PG8_MMA(1, 0, At, B0); PG8_BAR; PG8_SCHED;
            PG8_STAGE(PG8_SB(1, 1), b3 + hstep, voffB);
            PG8_WAIT_V(6); PG8_BAR; PG8_MMA(1, 1, At, B1); PG8_BAR;
            }
        }
        if constexpr (ALIGN_EPI) { if (wr == 0) PG8_BAR; }
        if constexpr (!Epi::AFTER_DRAIN) { E(acc, cur, wr, wc, fr, fq); S.done(cur); }
        if (!has_next) break;
#pragma unroll
        for (int a = 0; a < 2; ++a)
#pragma unroll
            for (int b = 0; b < 2; ++b)
#pragma unroll
                for (int m = 0; m < 4; ++m)
#pragma unroll
                    for (int n = 0; n < 2; ++n) acc[a][b][m][n] = (f32x4){0.f, 0.f, 0.f, 0.f};
        cur = nxt; cA = nA; cB = nB; ++ui;
        if constexpr (ALIGN_EPI) { if (wr == 1) PG8_BAR; }
    }
    PG8_WAIT_V(0);
    if constexpr (!ALIGN_EPI) { if (wr == 0) PG8_BAR; }
    PG8_BAR;
    if constexpr (Epi::AFTER_DRAIN) { E.fused(acc, cur, wr, wc, fr, fq, lds, wid, lane); S.done(cur); }
#undef PG8_SA
#undef PG8_SB
#undef PG8_STAGE
#undef PG8_LDA
#undef PG8_LDB
#undef PG8_MMA
#undef PG8_WAIT_V
#undef PG8_WAIT_L
#undef PG8_BAR
#undef PG8_SCHED
}
}

#define XB_TMO      128
#define XB_XCNT(j)  (256  + 64 * (j))
#define XB_XSUB(j)  (1280 + 64 * (j))
#define XB_XGEN(j)  (2304 + 64 * (j))
#define XB_TOP      3328
#define XB_TOPGEN   3392
#define XCD_BAR_WORDS 3456
#define XB_SPIN_CAP (1u << 18)

__device__ __forceinline__ unsigned xb_ld(unsigned* p)              { return __hip_atomic_load(p, __ATOMIC_RELAXED, __HIP_MEMORY_SCOPE_AGENT); }
__device__ __forceinline__ unsigned xb_add(unsigned* p, unsigned v) { return __hip_atomic_fetch_add(p, v, __ATOMIC_RELAXED, __HIP_MEMORY_SCOPE_AGENT); }
__device__ __forceinline__ unsigned xb_xcc_id() { return (unsigned)__builtin_amdgcn_s_getreg((3 << 11) | 20) & 0xFu; }
#define XB_SPIN(cond, bar) do { unsigned _sp = 0; while (cond) { __builtin_amdgcn_s_sleep(1); \
    if ((++_sp & 255u) == 0u) { if (xb_ld(&(bar)[XB_TMO])) break; if (_sp > XB_SPIN_CAP) { atomicAdd(&(bar)[XB_TMO], 1u); break; } } } } while (0)

struct XcdBarrier {
    unsigned* bar; unsigned x;
    volatile LAS unsigned* st;
};

__device__ __forceinline__ XcdBarrier xcd_barrier_post(unsigned* bar, volatile LAS unsigned* st) {
    XcdBarrier b; b.bar = bar; b.x = xb_xcc_id(); b.st = st;
    if (threadIdx.x == 0) (void)xb_add(&bar[XB_XCNT(b.x)], 1u);
    return b;
}
__device__ __forceinline__ void xcd_barrier_complete(unsigned* bar, unsigned x, unsigned& nloc, unsigned& nx) {
    const unsigned G = gridDim.x * gridDim.y * gridDim.z;
    unsigned sum, cnt, mine, sp = 0u;
    for (;;) {
        sum = 0u; cnt = 0u; mine = 0u;
#pragma unroll
        for (unsigned j = 0; j < 16; ++j) { const unsigned c = xb_ld(&bar[XB_XCNT(j)]); sum += c; cnt += (c > 0u) ? 1u : 0u; mine = (j == x) ? c : mine; }
        if (sum == G) break;
        __builtin_amdgcn_s_sleep(1);
        if ((++sp & 255u) == 0u) { if (xb_ld(&bar[XB_TMO])) break; if (sp > XB_SPIN_CAP) { atomicAdd(&bar[XB_TMO], 1u); break; } }
    }
    nloc = mine > 0u ? mine : 1u; nx = cnt > 0u ? cnt : 1u;
}

__device__ __forceinline__ void xcd_barrier(const XcdBarrier& b) {
    asm volatile("s_waitcnt vmcnt(0)" ::: "memory");
    __syncthreads();
    if (threadIdx.x == 0) {
        unsigned* bar = b.bar;
        __builtin_amdgcn_s_waitcnt(0);
        unsigned nloc = b.st[0], nx = b.st[1];
        if (nloc == 0u) { xcd_barrier_complete(bar, b.x, nloc, nx); b.st[0] = nloc; b.st[1] = nx; }
        const unsigned old = xb_add(&bar[XB_XSUB(b.x)], 1u);
        const unsigned gen = old / nloc;
        if (old + 1u == (gen + 1u) * nloc) {
            __builtin_amdgcn_fence(__ATOMIC_RELEASE, "agent");
            asm volatile("s_waitcnt vmcnt(0)" ::: "memory");
            const unsigned og = xb_add(&bar[XB_TOP], 1u);
            const unsigned tg = og / nx;
            if (og + 1u == (tg + 1u) * nx) xb_add(&bar[XB_TOPGEN], 1u);
            else XB_SPIN(xb_ld(&bar[XB_TOPGEN]) == tg, bar);
            __builtin_amdgcn_fence(__ATOMIC_ACQUIRE, "agent");
            xb_add(&bar[XB_XGEN(b.x)], 1u);
            asm volatile("s_waitcnt vmcnt(0)" ::: "memory");
        } else {
            XB_SPIN(xb_ld(&bar[XB_XGEN(b.x)]) == gen, bar);
            __builtin_amdgcn_fence(__ATOMIC_ACQUIRE, "agent");
            asm volatile("s_waitcnt vmcnt(0)" ::: "memory");
        }
    }
    __syncthreads();
}

__device__ __forceinline__ void lerp8(const P& p, int row, int col, float* o) {
    const bf16* PROJ = (const bf16*)(p.ws + WS_PROJ);
    float cur[8], prv[8];
    unpack8(*(const u32x4*)(PROJ + (size_t)row * PLD + col), cur);
    if (row >= MPR) { const float* s = p.in[2] + (size_t)(row - MPR) * RPJ + col; const f32x4 a = *(const f32x4*)s, b = *(const f32x4*)(s + 4);
        prv[0] = a[0]; prv[1] = a[1]; prv[2] = a[2]; prv[3] = a[3]; prv[4] = b[0]; prv[5] = b[1]; prv[6] = b[2]; prv[7] = b[3]; }
    else if ((row & (SEQ - 1)) == 0) {
#pragma unroll
        for (int i = 0; i < 8; ++i) prv[i] = 0.f; }
    else unpack8(*(const u32x4*)(PROJ + (size_t)(row - 1) * PLD + col), prv);
    const float* mu = p.in[7] + col; const f32x4 m0 = *(const f32x4*)mu, m1 = *(const f32x4*)(mu + 4);
#pragma unroll
    for (int i = 0; i < 4; ++i) { o[i] = cur[i] + (prv[i] - cur[i]) * m0[i]; o[4 + i] = cur[4 + i] + (prv[4 + i] - cur[4 + i]) * m1[i]; }
}
__device__ __forceinline__ float lerp1(const P& p, int row, int col) {
    const bf16* PROJ = (const bf16*)(p.ws + WS_PROJ);
    const float cur = bf2f(PROJ[(size_t)row * PLD + col]); float prv;
    if (row >= MPR) prv = p.in[2][(size_t)(row - MPR) * RPJ + col];
    else if ((row & (SEQ - 1)) == 0) prv = 0.f;
    else prv = bf2f(PROJ[(size_t)(row - 1) * PLD + col]);
    return cur + (prv - cur) * p.in[7][col];
}

__device__ __forceinline__ void transpose_item(const float* W, int K, int N, bf16* WT, float* scr, int item, int lane) {
    const int nblk = (N + 31) / 32, kb = item / nblk, nb = item % nblk, k0 = 64 * kb, n0 = 32 * nb;
#pragma unroll 8
    for (int i = 0; i < 32; ++i) { const int kk = 2 * i + (lane >> 5), n = n0 + (lane & 31); scr[kk * 33 + (lane & 31)] = (n < N) ? W[(size_t)(k0 + kk) * N + n] : 0.f; }
    LDS_FENCE();
    const int c = lane & 7;
#pragma unroll
    for (int j = 0; j < 4; ++j) { const int n = (lane >> 3) + 8 * j; const float* s = scr + (8 * c) * 33 + n;
        u32x4 o; o.x = pkbf(s[0 * 33], s[1 * 33]); o.y = pkbf(s[2 * 33], s[3 * 33]); o.z = pkbf(s[4 * 33], s[5 * 33]); o.w = pkbf(s[6 * 33], s[7 * 33]);
        *(u32x4*)(WT + (size_t)(n0 + n) * K + k0 + 8 * c) = o; }
    LDS_FENCE();
}

__device__ __forceinline__ void phase0(const P& p_in, unsigned char* smem) {
    PHASE_PROLOGUE;
    const int lane = tid & 63, wave = tid >> 6, G = gridDim.x, bid = blockIdx.x;
    const int gw = bid * 8 + wave, NGW = G * 8; const size_t gt = (size_t)bid * 512 + tid, NGT = (size_t)G * 512;
    bf16* XB = (bf16*)(p.ws + WS_XB);
    for (size_t i = gt; i < (size_t)MTOT * DM / 8; i += NGT) { const size_t e = i * 8; const float* src = e < (size_t)MPR * DM ? p.in[0] + e : p.in[1] + (e - (size_t)MPR * DM);
        const f32x4 a = *(const f32x4*)src, b = *(const f32x4*)(src + 4); u32x4 o; o.x = pkbf(a[0], a[1]); o.y = pkbf(a[2], a[3]); o.z = pkbf(b[0], b[1]); o.w = pkbf(b[2], b[3]); *(u32x4*)(XB + e) = o; }
    float* scr = (float*)(smem + wave * 8448);
    constexpr int I_IN = 16 * 105, I_WU = 16, I_AU = 16, I_GU = 32;
    constexpr int NIT = I_IN + I_WU + I_AU + I_GU;
    for (int it = gw; it < NIT; it += NGW) {
        int r = it;
        if (r < I_IN) { transpose_item(p.in[6], 1024, PROJN, (bf16*)(p.ws + WS_WIN), scr, r, lane); continue; } r -= I_IN;
        if (r < I_WU) { transpose_item(p.in[9], 64, 512, (bf16*)(p.ws + WS_LORA), scr, r, lane); continue; } r -= I_WU;
        if (r < I_AU) { transpose_item(p.in[11], 64, 512, (bf16*)(p.ws + WS_LORA + 65536), scr, r, lane); continue; } r -= I_AU;
        transpose_item(p.in[12], 128, 512, (bf16*)(p.ws + WS_LORA + 131072), scr, r, lane);
    }
    for (size_t i = gt; i < (size_t)MSM * 2048 / 4; i += NGT) { const size_t idx = i * 4, b = idx >> 11, rem = idx & 2047;
        *(f32x4*)(p.out + O_CONVS + b * 3072 + rem) = *(const f32x4*)(p.in[4] + b * 3072 + 1024 + rem); }
}

__device__ __forceinline__ void phase0_late(const P& p_in, unsigned char* smem, int first, int which) {
    PHASE_PROLOGUE;
    const int lane = tid & 63, wave = tid >> 6, G = gridDim.x, bid = blockIdx.x;
    if (bid < first) return;
    const int gw = (bid - first) * 8 + wave, NGW = (G - first) * 8;
    float* scr = (float*)(smem + wave * 8448);
    constexpr int I_OUT = 16 * 32, I_F1 = 16 * 128, I_F2 = 64 * 32;
    const int lo = which ? I_OUT + I_F1 : 0, hi = which ? I_OUT + I_F1 + I_F2 : I_OUT + I_F1;
    for (int it = lo + gw; it < hi; it += NGW) {
        int r = it;
        if (r < I_OUT) { transpose_item(p.in[24], 1024, 1024, (bf16*)(p.ws + WS_WOUT), scr, r, lane); continue; } r -= I_OUT;
        if (r < I_F1) { transpose_item(p.in[27], 1024, 4096, (bf16*)(p.ws + WS_WFF1), scr, r, lane); continue; } r -= I_F1;
        transpose_item(p.in[28], 4096, 1024, (bf16*)(p.ws + WS_WFF2), scr, r, lane);
    }
}

template <int RG, int K, class F> __device__ __forceinline__ void small_gemm(const bf16* A, const bf16* Bt, int N, unsigned char* smem, const F& epi, int first = 0) {
    int tid = threadIdx.x; asm volatile("" : "+v"(tid));
    const int lane = tid & 63, wave = tid >> 6, r = lane & 15, q = lane >> 4;
    constexpr int KS = K / 8, NST = KS / 32, RGN = 8 / RG;
    const int nunits = ((N + 15) / 16) * RGN;
    float* part = (float*)smem;
    for (int u = (int)gridDim.x - 1 - (int)blockIdx.x; u < nunits && (int)blockIdx.x >= first; u += (int)gridDim.x - first) {
        const int ct = u / RGN, rg = u - ct * RGN, n0 = ct * 16;
        f32x4 acc[RG];
#pragma unroll
        for (int t = 0; t < RG; ++t) acc[t] = (f32x4){0.f, 0.f, 0.f, 0.f};
        const bf16* ap = A + (size_t)(rg * RG * 16 + r) * K + wave * KS + q * 8;
        const bf16* bp = Bt + (size_t)(n0 + r) * K + wave * KS + q * 8;
#pragma unroll 8
        for (int ks = 0; ks < NST; ++ks) {
            const bf16x8 b = *(const bf16x8*)(bp + ks * 32);
#pragma unroll
            for (int t = 0; t < RG; ++t) acc[t] = mfma16(*(const bf16x8*)(ap + (size_t)t * 16 * K + ks * 32), b, acc[t]);
        }
#pragma unroll
        for (int t = 0; t < RG; ++t)
#pragma unroll
            for (int j = 0; j < 4; ++j) part[(wave * RG + t) * 256 + (q * 4 + j) * 16 + r] = acc[t][j];
        __syncthreads();
        for (int e = tid; e < RG * 256; e += 512) { const int t = e >> 8, idx = e & 255; float v = 0.f;
#pragma unroll
            for (int w = 0; w < 8; ++w) v += part[(w * RG + t) * 256 + idx];
            const int col = n0 + (idx & 15);
            if (col < N) epi((rg * RG + t) * 16 + (idx >> 4), col, v); }
        __syncthreads();
    }
}

__device__ __forceinline__ void phase_prep(const P& p_in, unsigned char* smem) {
    PHASE_PROLOGUE;
    const int lane = tid & 63, wave = tid >> 6, G = gridDim.x, bid = blockIdx.x, r = lane & 15, q = lane >> 4;
    const bf16* WUPT = (const bf16*)(p.ws + WS_LORA); const bf16* AUPT = (const bf16*)(p.ws + WS_LORA + 65536); const bf16* GUPT = (const bf16*)(p.ws + WS_LORA + 131072);
    const bf16* PROJ = (const bf16*)(p.ws + WS_PROJ);
    float* WD = p.out + OS_WD; bf16* GG = (bf16*)(p.out + OS_GG);
    bf16* KP = (bf16*)(p.ws + WS_KP); bf16* KK = (bf16*)(p.ws + WS_KK); bf16* KB = (bf16*)(p.ws + WS_KB);
    bf16* WU = (bf16*)smem; bf16* AU = WU + 64 * 72; bf16* GU = AU + 64 * 72;
    bf16* kcur = (bf16*)(smem + 35840 + wave * 4608); bf16* kprv = kcur + 16 * 72;
#pragma unroll 1
    for (int tile = bid; tile < MTOT / 128; tile += G) {
        const int item = tile * 8 + wave, rowa = item * 16 + r;
        bf16x8 aw[2], aa[2], ag[4];
        float u[8];
#pragma unroll
        for (int ks = 0; ks < 2; ++ks) { lerp8(p, rowa, 1536 + ks * 32 + q * 8, u);
#pragma unroll
            for (int i = 0; i < 8; ++i) u[i] = tanh_(u[i]);
            aw[ks] = __builtin_bit_cast(bf16x8, pack8(u)); }
#pragma unroll
        for (int ks = 0; ks < 2; ++ks) { lerp8(p, rowa, 1600 + ks * 32 + q * 8, u); aa[ks] = __builtin_bit_cast(bf16x8, pack8(u)); }
#pragma unroll
        for (int ks = 0; ks < 4; ++ks) { lerp8(p, rowa, 1664 + ks * 32 + q * 8, u);
#pragma unroll
            for (int i = 0; i < 8; ++i) u[i] = sigm(u[i]);
            ag[ks] = __builtin_bit_cast(bf16x8, pack8(u)); }
        u32x4 pw, pa, pg[2];
#define PREP_LOAD(hh_) do { const int c_ = tid >> 3, k8_ = (tid & 7) * 8; \
            pw = *(const u32x4*)(WUPT + (size_t)((hh_) * 64 + c_) * 64 + k8_); pa = *(const u32x4*)(AUPT + (size_t)((hh_) * 64 + c_) * 64 + k8_); \
            _Pragma("unroll") for (int i = 0; i < 2; ++i) { const int pc_ = tid + i * 512, c2_ = pc_ >> 4, k82_ = (pc_ & 15) * 8; pg[i] = *(const u32x4*)(GUPT + (size_t)((hh_) * 64 + c2_) * 128 + k82_); } } while (0)
        PREP_LOAD(0);
#pragma unroll 1
        for (int h = 0; h < 8; ++h) {
            __syncthreads();
            { const int c = tid >> 3, k8 = (tid & 7) * 8;
              *(u32x4*)(WU + c * 72 + k8) = pw; *(u32x4*)(AU + c * 72 + k8) = pa;
#pragma unroll
              for (int i = 0; i < 2; ++i) { const int pc = tid + i * 512, c2 = pc >> 4, k82 = (pc & 15) * 8; *(u32x4*)(GU + c2 * 136 + k82) = pg[i]; } }
#pragma unroll
            for (int i = 0; i < 2; ++i) { const int pc = lane + i * 64, rr = pc >> 3, c8 = (pc & 7) * 8, row = item * 16 + rr, col = 512 + h * 64 + c8;
                *(u32x4*)(kcur + rr * 72 + c8) = *(const u32x4*)(PROJ + (size_t)row * PLD + col);
                u32x4 pv = {0u, 0u, 0u, 0u};
                if (row >= MPR) { const float* sp = p.in[2] + (size_t)(row - MPR) * RPJ + col; const f32x4 a = *(const f32x4*)sp, b = *(const f32x4*)(sp + 4); pv.x = pkbf(a[0], a[1]); pv.y = pkbf(a[2], a[3]); pv.z = pkbf(b[0], b[1]); pv.w = pkbf(b[2], b[3]); }
                else if ((row & (SEQ - 1)) != 0) pv = *(const u32x4*)(PROJ + (size_t)(row - 1) * PLD + col);
                *(u32x4*)(kprv + rr * 72 + c8) = pv; }
            if (h + 1 < 8) PREP_LOAD(h + 1);
            __syncthreads();
            float ss[4] = {0.f, 0.f, 0.f, 0.f};
#pragma unroll
            for (int ctl = 0; ctl < 4; ++ctl) { const int cl = ctl * 16 + r, col = h * 64 + cl; const float kkc = p.in[13][col], muc = p.in[7][512 + col];
#pragma unroll
                for (int j = 0; j < 4; ++j) { const float kc = bf2f(kcur[(q * 4 + j) * 72 + cl]), kv = bf2f(kprv[(q * 4 + j) * 72 + cl]); const float kr = (kc + (kv - kc) * muc) * kkc; ss[j] += kr * kr; } }
#pragma unroll
            for (int j = 0; j < 4; ++j) { ss[j] = sum16(ss[j]); ss[j] = rsqrtf(fmaxf(ss[j], 1e-24f)); }
#pragma unroll 1
            for (int ctl = 0; ctl < 4; ++ctl) {
                const int cl = ctl * 16 + r, col = h * 64 + cl;
                f32x4 cw = {0.f, 0.f, 0.f, 0.f}, ca = cw, cgt = cw;
#pragma unroll
                for (int ks = 0; ks < 2; ++ks) { cw = mfma16(aw[ks], *(const bf16x8*)(WU + cl * 72 + ks * 32 + q * 8), cw); ca = mfma16(aa[ks], *(const bf16x8*)(AU + cl * 72 + ks * 32 + q * 8), ca); }
#pragma unroll
                for (int ks = 0; ks < 4; ++ks) cgt = mfma16(ag[ks], *(const bf16x8*)(GU + cl * 136 + ks * 32 + q * 8), cgt);
                const float w0c = p.in[8][col], a0c = p.in[10][col], kkc = p.in[13][col], kac = p.in[14][col], muc = p.in[7][512 + col];
#pragma unroll
                for (int j = 0; j < 4; ++j) {
                    const int row = item * 16 + q * 4 + j; const size_t o = (size_t)row * 512 + col;
                    const float wl = -softplus(-(w0c + cw[j])) - 0.5f;
                    WD[o] = __expf(-__expf(wl));
                    const float a = sigm(a0c + ca[j]);
                    GG[o] = f2bf(cgt[j]);
                    const float kc = bf2f(kcur[(q * 4 + j) * 72 + cl]), kv = bf2f(kprv[(q * 4 + j) * 72 + cl]); const float k = kc + (kv - kc) * muc;
                    KP[o] = f2bf(k * (1.f + (a - 1.f) * kac));
                    const float kk = k * kkc * ss[j];
                    KK[o] = f2bf(kk); KB[o] = f2bf(kk * a);
                }
            }
        }
    }
    __syncthreads();
#undef PREP_LOAD
    bf16* XBC = (bf16*)(p.ws + WS_XBC);
    const int ntl = MTOT / 128, cb = (G > ntl + 32) ? ntl : 0;
    if (bid < cb) return;
    const size_t gt = (size_t)(bid - cb) * 512 + tid, NGT = (size_t)(G - cb) * 512;
    for (size_t idx = gt; idx < (size_t)MPR * 128; idx += NGT) {
        const int row = (int)(idx >> 7), c0 = (int)(idx & 127) * 8, t = row & (SEQ - 1);
        float acc[8], x[8];
        { const f32x4 b0 = *(const f32x4*)(p.in[19] + c0), b1 = *(const f32x4*)(p.in[19] + c0 + 4);
#pragma unroll
          for (int i = 0; i < 4; ++i) { acc[i] = b0[i]; acc[4 + i] = b1[i]; } }
#pragma unroll
        for (int d = 0; d < 4; ++d) { if (t - 3 + d < 0) continue;
            unpack8(*(const u32x4*)(PROJ + (size_t)(row - 3 + d) * PLD + 2304 + c0), x);
            const f32x4 w0 = *(const f32x4*)(p.in[18] + d * 1024 + c0), w1 = *(const f32x4*)(p.in[18] + d * 1024 + c0 + 4);
#pragma unroll
            for (int i = 0; i < 4; ++i) { acc[i] += w0[i] * x[i]; acc[4 + i] += w1[i] * x[4 + i]; } }
#pragma unroll
        for (int i = 0; i < 8; ++i) acc[i] = silu(acc[i]);
        *(u32x4*)(XBC + (size_t)row * 1024 + c0) = pack8(acc);
    }
}

constexpr int TC = 32, SBUF = 5 * TC * 64 + TC * 16 + TC * 2;
struct StageRegs { f32x4 w0, w1; u32x4 kp, kk, kb, rc, rp, vc, vp; };
__device__ __forceinline__ void scan_issue(const P& p, StageRegs& R, int row0, int h, int vq, int st) {
    const float* WD = p.out + OS_WD; const bf16* KP = (const bf16*)(p.ws + WS_KP); const bf16* KK = (const bf16*)(p.ws + WS_KK); const bf16* KB = (const bf16*)(p.ws + WS_KB); const bf16* PROJ = (const bf16*)(p.ws + WS_PROJ);
    const int tt = st >> 3, k8 = (st & 7) * 8, row = row0 + tt, prow = (row & (SEQ - 1)) ? row - 1 : row; const size_t o = (size_t)row * 512 + h * 64 + k8;
    R.w0 = *(const f32x4*)(WD + o); R.w1 = *(const f32x4*)(WD + o + 4); R.kp = *(const u32x4*)(KP + o); R.kk = *(const u32x4*)(KK + o); R.kb = *(const u32x4*)(KB + o);
    R.rc = *(const u32x4*)(PROJ + (size_t)row * PLD + h * 64 + k8); R.rp = *(const u32x4*)(PROJ + (size_t)prow * PLD + h * 64 + k8);
    if (st < 64) { const int t2 = st >> 1, v8 = (st & 1) * 8, row2 = row0 + t2, prow2 = (row2 & (SEQ - 1)) ? row2 - 1 : row2;
        R.vc = *(const u32x4*)(PROJ + (size_t)row2 * PLD + 1024 + h * 64 + vq * 16 + v8); R.vp = *(const u32x4*)(PROJ + (size_t)prow2 * PLD + 1024 + h * 64 + vq * 16 + v8); }
}
__device__ __forceinline__ void scan_commit(const StageRegs& R, float* B, int row0, int st, const float* mur, const float* muv) {
    const int tt = st >> 3, k8 = (st & 7) * 8; float kp[8], kb[8], v[8], rc[8], rp[8];
    *(f32x4*)(B + tt * 64 + k8) = R.w0; *(f32x4*)(B + tt * 64 + k8 + 4) = R.w1;
    unpack8(R.kp, kp); *(f32x4*)(B + TC * 64 + tt * 64 + k8) = (f32x4){kp[0], kp[1], kp[2], kp[3]}; *(f32x4*)(B + TC * 64 + tt * 64 + k8 + 4) = (f32x4){kp[4], kp[5], kp[6], kp[7]};
    unpack8(R.kk, v); *(f32x4*)(B + 2 * TC * 64 + tt * 64 + k8) = (f32x4){-v[0], -v[1], -v[2], -v[3]}; *(f32x4*)(B + 2 * TC * 64 + tt * 64 + k8 + 4) = (f32x4){-v[4], -v[5], -v[6], -v[7]};
    unpack8(R.kb, kb); *(f32x4*)(B + 3 * TC * 64 + tt * 64 + k8) = (f32x4){kb[0], kb[1], kb[2], kb[3]}; *(f32x4*)(B + 3 * TC * 64 + tt * 64 + k8 + 4) = (f32x4){kb[4], kb[5], kb[6], kb[7]};
    unpack8(R.rc, rc); unpack8(R.rp, rp); const float pz = ((row0 + tt) & (SEQ - 1)) ? 1.f : 0.f;
    float c1 = 0.f, c2 = 0.f;
#pragma unroll
    for (int j = 0; j < 8; ++j) { v[j] = rc[j] + (rp[j] * pz - rc[j]) * mur[j]; c1 += kb[j] * v[j]; c2 += kp[j] * v[j]; }
    *(f32x4*)(B + 4 * TC * 64 + tt * 64 + k8) = (f32x4){R.w0[0] * v[0], R.w0[1] * v[1], R.w0[2] * v[2], R.w0[3] * v[3]}; *(f32x4*)(B + 4 * TC * 64 + tt * 64 + k8 + 4) = (f32x4){R.w1[0] * v[4], R.w1[1] * v[5], R.w1[2] * v[6], R.w1[3] * v[7]};
    c1 += __shfl_xor(c1, 1); c2 += __shfl_xor(c2, 1); c1 += __shfl_xor(c1, 2); c2 += __shfl_xor(c2, 2); c1 += __shfl_xor(c1, 4); c2 += __shfl_xor(c2, 4);
    if ((st & 7) == 0) { B[5 * TC * 64 + TC * 16 + tt * 2] = c1; B[5 * TC * 64 + TC * 16 + tt * 2 + 1] = c2; }
    if (st < 64) { const int t2 = st >> 1, v8 = (st & 1) * 8; unpack8(R.vc, rc); unpack8(R.vp, rp); const float pz2 = ((row0 + t2) & (SEQ - 1)) ? 1.f : 0.f;
#pragma unroll
        for (int j = 0; j < 8; ++j) v[j] = rc[j] + (rp[j] * pz2 - rc[j]) * muv[j];
        *(f32x4*)(B + 5 * TC * 64 + t2 * 16 + v8) = (f32x4){v[0], v[1], v[2], v[3]}; *(f32x4*)(B + 5 * TC * 64 + t2 * 16 + v8 + 4) = (f32x4){v[4], v[5], v[6], v[7]}; }
}
struct ScanIn { f32x4 w, kp, ka, kb, wr; float vv, c1, c2; };
__device__ __forceinline__ ScanIn scan_load(const float* B, int tt, int kg, int rloc) {
    ScanIn s; s.w = *(const f32x4*)(B + tt * 64 + kg * 4); s.kp = *(const f32x4*)(B + TC * 64 + tt * 64 + kg * 4); s.ka = *(const f32x4*)(B + 2 * TC * 64 + tt * 64 + kg * 4);
    s.kb = *(const f32x4*)(B + 3 * TC * 64 + tt * 64 + kg * 4); s.wr = *(const f32x4*)(B + 4 * TC * 64 + tt * 64 + kg * 4);
    s.vv = B[5 * TC * 64 + tt * 16 + rloc]; s.c1 = B[5 * TC * 64 + TC * 16 + tt * 2]; s.c2 = B[5 * TC * 64 + TC * 16 + tt * 2 + 1]; return s;
}
__device__ __forceinline__ void phase_scan(const P& p_in, unsigned char* smem) {
    PHASE_PROLOGUE;
    const int lane = tid & 63, wave = tid >> 6;
    float* buf0 = (float*)smem; float* ybuf = buf0 + 2 * SBUF;
    bf16* YR = (bf16*)(p.ws + WS_XB);
    constexpr int NCH = SEQ / TC;
    for (int unit = blockIdx.x; unit < 256; unit += gridDim.x) {
        const int xcd = unit & 7, slot = unit >> 3, bh = xcd * 8 + (slot >> 2), vq = slot & 3, b = bh >> 3, h = bh & 7, rowbase = b * SEQ;
        bf16* yu = YR + (size_t)(bh * 4 + vq) * SEQ * 16;
        const int st = tid - 256;
        StageRegs R; float mur[8], muv[8];
        if (wave >= 4) {
#pragma unroll
            for (int j = 0; j < 8; ++j) { mur[j] = p.in[7][h * 64 + (st & 7) * 8 + j]; muv[j] = p.in[7][1024 + h * 64 + vq * 16 + (st & 1) * 8 + j]; }
            scan_issue(p, R, rowbase, h, vq, st); scan_commit(R, buf0, rowbase, st, mur, muv); scan_issue(p, R, rowbase + TC, h, vq, st);
        }
        __syncthreads();
        float S0 = 0.f, S1 = 0.f, S2 = 0.f, S3 = 0.f;
        const int rl = lane >> 4, kg = lane & 15, rloc = (wave & 3) * 4 + rl;
        for (int c = 0; c < NCH; ++c) {
            if (wave < 4) {
                const float* B = buf0 + (c & 1) * SBUF; float* yb = ybuf + (c & 1) * (TC * 16);
                ScanIn cur = scan_load(B, 0, kg, rloc);
#pragma unroll 4
                for (int tt = 0; tt < TC; ++tt) {
                    const ScanIn nxt = scan_load(B, (tt + 1) & (TC - 1), kg, rloc);
                    float sa = (S0 * cur.ka[0] + S1 * cur.ka[1]) + (S2 * cur.ka[2] + S3 * cur.ka[3]);
                    float y1 = (S0 * cur.wr[0] + S1 * cur.wr[1]) + (S2 * cur.wr[2] + S3 * cur.wr[3]);
                    sa += dppf<0xB1>(sa); y1 += dppf<0xB1>(y1); sa += dppf<0x4E>(sa); y1 += dppf<0x4E>(y1);
                    sa += dppf<0x141>(sa); y1 += dppf<0x141>(y1); sa += dppf<0x140>(sa); y1 += dppf<0x140>(y1);
                    S0 = S0 * cur.w[0] + (sa * cur.kb[0] + cur.vv * cur.kp[0]); S1 = S1 * cur.w[1] + (sa * cur.kb[1] + cur.vv * cur.kp[1]);
                    S2 = S2 * cur.w[2] + (sa * cur.kb[2] + cur.vv * cur.kp[2]); S3 = S3 * cur.w[3] + (sa * cur.kb[3] + cur.vv * cur.kp[3]);
                    if (kg == 0) yb[tt * 16 + rloc] = y1 + sa * cur.c1 + cur.vv * cur.c2;
                    cur = nxt;
                }
            } else {
                if (c + 1 < NCH) scan_commit(R, buf0 + ((c + 1) & 1) * SBUF, rowbase + (c + 1) * TC, st, mur, muv);
                if (c + 2 < NCH) scan_issue(p, R, rowbase + (c + 2) * TC, h, vq, st);
                if (c > 0) { const float* yp = ybuf + ((c - 1) & 1) * (TC * 16); const int i2 = st * 2;
                    *(unsigned*)(yu + (size_t)(c - 1) * TC * 16 + i2) = pkbf(yp[i2], yp[i2 + 1]); }
            }
            __syncthreads();
        }
        if (wave >= 4) { const float* yp = ybuf + ((NCH - 1) & 1) * (TC * 16); const int i2 = st * 2;
            *(unsigned*)(yu + (size_t)(NCH - 1) * TC * 16 + i2) = pkbf(yp[i2], yp[i2 + 1]); }
        else *(f32x4*)(p.out + O_WKVP + ((size_t)(bh * 64 + vq * 16 + rloc)) * 64 + kg * 4) = (f32x4){S0, S1, S2, S3};
        __syncthreads();
    }
}


constexpr int CK = 16, NCHAIN = 2, NHELP = 8 - NCHAIN, SLOTB = 22912, NCHK = SEQ / CK, SCAN_WGS = 256 / NCHAIN;
constexpr int SO_AT = 0, SO_RT = 2304, SO_BT = 4608, SO_KT = 6912, SO_BH = 9216, SO_KH = 12288, SO_NAK = 15360, SO_NBR = 16128, SO_NKR = 16896, SO_TT = 17664, SO_VT = 18432, SO_DC = 21504, SO_NAB = 21760;
constexpr int CR_SB = NHELP * SLOTB, FL_OFF = CR_SB + NCHAIN * 3072;
static_assert(FL_OFF + 256 <= MISC_OFF, "scan LDS map");
struct HelpRegs { f32x4 w0, w1; u32x4 kp, kk, kb, rc, rp, vc, vp; };
__device__ __forceinline__ void help_issue(const P& p, HelpRegs (&R)[2], int row0, int h, int lane) {
    const float* WD = p.out + OS_WD; const bf16* KP = (const bf16*)(p.ws + WS_KP); const bf16* KK = (const bf16*)(p.ws + WS_KK); const bf16* KB = (const bf16*)(p.ws + WS_KB); const bf16* PROJ = (const bf16*)(p.ws + WS_PROJ);
#pragma unroll
    for (int i = 0; i < 2; ++i) { const int pc = lane + i * 64, tt = pc & 15, k8 = (pc >> 4) * 8, row = row0 + tt, prow = (row & (SEQ - 1)) ? row - 1 : row; const size_t o = (size_t)row * 512 + h * 64 + k8;
        R[i].w0 = *(const f32x4*)(WD + o); R[i].w1 = *(const f32x4*)(WD + o + 4); R[i].kp = *(const u32x4*)(KP + o); R[i].kk = *(const u32x4*)(KK + o); R[i].kb = *(const u32x4*)(KB + o);
        R[i].rc = *(const u32x4*)(PROJ + (size_t)row * PLD + h * 64 + k8); R[i].rp = *(const u32x4*)(PROJ + (size_t)prow * PLD + h * 64 + k8);
        R[i].vc = *(const u32x4*)(PROJ + (size_t)row * PLD + 1024 + h * 64 + k8); R[i].vp = *(const u32x4*)(PROJ + (size_t)prow * PLD + 1024 + h * 64 + k8); }
}
__device__ __forceinline__ void phase_scan2(const P& p_in, unsigned char* smem) {
    PHASE_PROLOGUE;
    const int lane = tid & 63, wave = tid >> 6, r = lane & 15, q = lane >> 4;
    bf16* YR = (bf16*)(p.ws + WS_XB);
    volatile unsigned* flags = (volatile unsigned*)(smem + FL_OFF);
    const bf16x8 zero8 = {0, 0, 0, 0, 0, 0, 0, 0};
    for (int unit = blockIdx.x; unit < SCAN_WGS; unit += SCAN_WGS) {
        const int ub = unit / (4 / NCHAIN), part = unit % (4 / NCHAIN), bh = (ub & 7) * 8 + (ub >> 3), vq = part * NCHAIN + (wave % NCHAIN), b = bh >> 3, h = bh & 7, rowbase = b * SEQ;
        if (tid < 64) flags[tid] = 0u;
        __syncthreads();
        if (wave < NCHAIN) {
            __builtin_amdgcn_s_setprio(3);
            bf16* yu = YR + (size_t)(bh * 4 + vq) * SEQ * 16;
            f32x4 ST[4];
#pragma unroll
            for (int mt = 0; mt < 4; ++mt) ST[mt] = (f32x4){0.f, 0.f, 0.f, 0.f};
            for (int c = 0; c < NCHK; ++c) {
                const int slot = c % NHELP; unsigned char* sb = smem + slot * SLOTB;
                const bf16* AT = (const bf16*)(sb + SO_AT); const bf16* RT = (const bf16*)(sb + SO_RT); const bf16* BH = (const bf16*)(sb + SO_BH); const bf16* KH = (const bf16*)(sb + SO_KH);
                const bf16* NAK = (const bf16*)(sb + SO_NAK); const bf16* NBR = (const bf16*)(sb + SO_NBR); const bf16* NKR = (const bf16*)(sb + SO_NKR); const bf16* TT = (const bf16*)(sb + SO_TT);
                const bf16* VT = (const bf16*)(sb + SO_VT) + vq * 16 * 24; const float* DC = (const float*)(sb + SO_DC);
                s16x4 sb4[4];
#pragma unroll
                for (int mt = 0; mt < 4; ++mt) sb4[mt] = cvt4(ST[mt]);
                { unsigned sp = 0; while (flags[slot] != (unsigned)(c + 1)) { __builtin_amdgcn_s_sleep(1); if (++sp > (1u << 22)) break; } }
                asm volatile("" ::: "memory");
                s16x4 fa[4], fr[4], fbh[4], fkh[4]; f32x4 dcv[4];
#pragma unroll
                for (int mt = 0; mt < 4; ++mt) { fa[mt] = *(const s16x4*)(AT + r * 72 + mt * 16 + q * 4); fr[mt] = *(const s16x4*)(RT + r * 72 + mt * 16 + q * 4);
                    fbh[mt] = *(const s16x4*)(BH + (mt * 16 + r) * 24 + q * 4); fkh[mt] = *(const s16x4*)(KH + (mt * 16 + r) * 24 + q * 4); dcv[mt] = *(const f32x4*)(DC + mt * 16 + q * 4); }
                const s16x4 fnak = *(const s16x4*)(NAK + lane * 4), ftt = *(const s16x4*)(TT + lane * 4), fnbr = *(const s16x4*)(NBR + lane * 4), fnkr = *(const s16x4*)(NKR + lane * 4);
                const s16x4 fvt = *(const s16x4*)(VT + r * 24 + q * 4);
                LDS_FENCE();
                if (lane == 0) flags[8 + slot * NCHAIN + wave] = (unsigned)(c + 1);
                f32x4 Wt = {0.f, 0.f, 0.f, 0.f};
#pragma unroll
                for (int mt = 0; mt < 4; ++mt) Wt = mf16(fa[mt], sb4[mt], Wt);
                Wt = mf16(fnak, fvt, Wt);
                f32x4 Ut = {0.f, 0.f, 0.f, 0.f};
                Ut = mf16(ftt, cvt4(Wt), Ut);
                const s16x4 ub = cvt4(Ut);
#pragma unroll
                for (int mt = 0; mt < 4; ++mt) { ST[mt] = ST[mt] * dcv[mt]; ST[mt] = mf16(fbh[mt], ub, ST[mt]); ST[mt] = mf16(fkh[mt], fvt, ST[mt]); }
                f32x4 Yt = {0.f, 0.f, 0.f, 0.f};
#pragma unroll
                for (int mt = 0; mt < 4; ++mt) Yt = mf16(fr[mt], sb4[mt], Yt);
                Yt = mf16(fnbr, ub, Yt); Yt = mf16(fnkr, fvt, Yt);
#pragma unroll
                for (int j = 0; j < 4; ++j) yu[(size_t)(c * CK + q * 4 + j) * 16 + r] = f2bf(Yt[j]);
            }
#pragma unroll
            for (int mt = 0; mt < 4; ++mt) *(f32x4*)(p.out + O_WKVP + ((size_t)(bh * 64 + vq * 16 + r)) * 64 + mt * 16 + q * 4) = ST[mt];
            __builtin_amdgcn_s_setprio(0);
        } else {
            const int hw = wave - NCHAIN; unsigned char* sb = smem + hw * SLOTB;
            bf16* AT = (bf16*)(sb + SO_AT); bf16* RT = (bf16*)(sb + SO_RT); bf16* BT = (bf16*)(sb + SO_BT); bf16* KT = (bf16*)(sb + SO_KT); bf16* BH = (bf16*)(sb + SO_BH); bf16* KH = (bf16*)(sb + SO_KH);
            bf16* NAK = (bf16*)(sb + SO_NAK); bf16* NBR = (bf16*)(sb + SO_NBR); bf16* NKR = (bf16*)(sb + SO_NKR); bf16* TT = (bf16*)(sb + SO_TT); bf16* VT = (bf16*)(sb + SO_VT);
            float* DC = (float*)(sb + SO_DC); float* NAB = (float*)(sb + SO_NAB); float* WR = (float*)(sb + SO_BH);
            float mur[2][8], muv[2][8];
#pragma unroll
            for (int i = 0; i < 2; ++i)
#pragma unroll
                for (int j = 0; j < 8; ++j) { mur[i][j] = p.in[7][h * 64 + ((lane + i * 64) >> 4) * 8 + j]; muv[i][j] = p.in[7][1024 + h * 64 + ((lane + i * 64) >> 4) * 8 + j]; }
            HelpRegs R[2];
            help_issue(p, R, rowbase + hw * CK, h, lane);
            for (int c = hw; c < NCHK; c += NHELP) {
                if (c >= NHELP) { const unsigned want = (unsigned)(c - NHELP + 1); unsigned sp = 0;
                    for (;;) { bool ok = true;
#pragma unroll
                        for (int w = 0; w < NCHAIN; ++w) ok = ok && (flags[8 + hw * NCHAIN + w] == want);
                        if (ok) break; __builtin_amdgcn_s_sleep(2); if (++sp > (1u << 22)) break; } }
                asm volatile("" ::: "memory");
                const int row0 = rowbase + c * CK;
#pragma unroll
                for (int i = 0; i < 2; ++i) { const int k8 = ((lane >> 4) + 4 * i) * 8, tt = lane & 15; float w[8], pre[8], suf[8], x[8], y[8], rc[8], rp[8];
#pragma unroll
                    for (int j = 0; j < 4; ++j) { w[j] = R[i].w0[j]; w[4 + j] = R[i].w1[j]; }
#pragma unroll
                    for (int j = 0; j < 8; ++j) { float a = w[j], z = w[j];
                        a *= dppo<0x111>(a); a *= dppo<0x112>(a); a *= dppo<0x114>(a); a *= dppo<0x118>(a);
                        z *= dppo<0x101>(z); z *= dppo<0x102>(z); z *= dppo<0x104>(z); z *= dppo<0x108>(z);
                        pre[j] = a; suf[j] = z * __builtin_amdgcn_rcpf(w[j]); }
                    if (tt == 15) { *(f32x4*)(DC + k8) = (f32x4){pre[0], pre[1], pre[2], pre[3]}; *(f32x4*)(DC + k8 + 4) = (f32x4){pre[4], pre[5], pre[6], pre[7]}; }
                    unpack8(R[i].kk, x);
#pragma unroll
                    for (int j = 0; j < 8; ++j) y[j] = -x[j] * dppo<0x111>(pre[j]);
                    *(u32x4*)(AT + tt * 72 + k8) = pack8(y);
                    unpack8(R[i].kb, x);
#pragma unroll
                    for (int j = 0; j < 8; ++j) { const float inv = __builtin_amdgcn_rcpf(pre[j]); rp[j] = inv; y[j] = x[j] * inv; x[j] *= suf[j]; }
                    *(u32x4*)(BT + tt * 72 + k8) = pack8(y);
#pragma unroll
                    for (int j = 0; j < 8; ++j) BH[(k8 + j) * 24 + tt] = f2bf(x[j]);
                    unpack8(R[i].kp, x);
#pragma unroll
                    for (int j = 0; j < 8; ++j) { y[j] = x[j] * rp[j]; x[j] *= suf[j]; }
                    *(u32x4*)(KT + tt * 72 + k8) = pack8(y);
#pragma unroll
                    for (int j = 0; j < 8; ++j) KH[(k8 + j) * 24 + tt] = f2bf(x[j]);
                    unpack8(R[i].rc, rc); unpack8(R[i].rp, rp); const float pz = ((row0 + tt) & (SEQ - 1)) ? 1.f : 0.f;
#pragma unroll
                    for (int j = 0; j < 8; ++j) y[j] = (rc[j] + (rp[j] * pz - rc[j]) * mur[i][j]) * pre[j];
                    *(u32x4*)(RT + tt * 72 + k8) = pack8(y);
                    unpack8(R[i].vc, rc); unpack8(R[i].vp, rp);
#pragma unroll
                    for (int j = 0; j < 8; ++j) VT[(k8 + j) * 24 + tt] = f2bf(rc[j] + (rp[j] * pz - rc[j]) * muv[i][j]); }
                if (c + NHELP < NCHK) help_issue(p, R, rowbase + (c + NHELP) * CK, h, lane);
                LDS_FENCE();
                { f32x4 nab = {0.f, 0.f, 0.f, 0.f}, nabT = nab, nak = nab, nbr = nab, nkr = nab;
#pragma unroll
                  for (int ks = 0; ks < 2; ++ks) { const bf16x8 fb = *(const bf16x8*)(BT + r * 72 + ks * 32 + q * 8), fk = *(const bf16x8*)(KT + r * 72 + ks * 32 + q * 8), fa = *(const bf16x8*)(AT + r * 72 + ks * 32 + q * 8), fr = *(const bf16x8*)(RT + r * 72 + ks * 32 + q * 8);
                      nab = mfma16(fb, fa, nab); nabT = mfma16(fa, fb, nabT); nak = mfma16(fk, fa, nak); nbr = mfma16(fb, fr, nbr); nkr = mfma16(fk, fr, nkr); }
#pragma unroll
                  for (int j = 0; j < 4; ++j) { const int i = q * 4 + j, t = r;
                      nab[j] = (i < t) ? nab[j] : 0.f; nabT[j] = (r < i) ? nabT[j] : 0.f; nak[j] = (i < t) ? nak[j] : 0.f; nbr[j] = (i <= t) ? nbr[j] : 0.f; nkr[j] = (i <= t) ? nkr[j] : 0.f; }
                  *(s16x4*)(NAK + lane * 4) = cvt4(nak); *(s16x4*)(NBR + lane * 4) = cvt4(nbr); *(s16x4*)(NKR + lane * 4) = cvt4(nkr);
                  const f32x4 z4 = {0.f, 0.f, 0.f, 0.f};
                  const s16x4 bN = cvt4(nab), bNT = cvt4(nabT);
                  const f32x4 n2 = mf16(bNT, bN, z4), n2T = mf16(bN, bNT, z4);
                  const s16x4 b2 = cvt4(n2), b2T = cvt4(n2T);
                  const f32x4 n4 = mf16(b2T, b2, z4), n4T = mf16(b2, b2T, z4);
                  const s16x4 b4 = cvt4(n4), b4T = cvt4(n4T);
                  f32x4 X = mf16(b4T, b4, z4);
#pragma unroll
                  for (int j = 0; j < 4; ++j) X[j] += (q * 4 + j == r) ? 1.f : 0.f;
                  X = mf16(b4T, cvt4(X), X);
                  X = mf16(b2T, cvt4(X), X);
                  X = mf16(bNT, cvt4(X), X);
                  *(s16x4*)(TT + lane * 4) = cvt4(X); }
                LDS_FENCE();
                if (lane == 0) flags[hw] = (unsigned)(c + 1);
            }
        }
        __syncthreads();
    }
}

__device__ __forceinline__ bf16x8 ldfrag(const bf16* base, int ld, int row0, int k0, int r, int q) { return *(const bf16x8*)(base + (row0 + r) * ld + k0 + q * 8); }
__device__ __forceinline__ void phase_ssd(const P& p_in, unsigned char* smem) {
    PHASE_PROLOGUE;
    const int lane = tid & 63, wave = tid >> 6, r = lane & 15, q = lane >> 4;
    bf16* XT = (bf16*)(smem + 53248); bf16* XdT = (bf16*)(smem + 57856); bf16* Gs = (bf16*)(smem + 62464); bf16* Hb = (bf16*)(smem + 71680); float* xsn = (float*)(smem + 80384);
    const bf16* XBC = (const bf16*)(p.ws + WS_XBC); const float* DT = (const float*)(p.ws + WS_DT); bf16* YM = (bf16*)(p.ws + WS_XB) + (size_t)MPR * 512;
    for (int unit = (int)blockIdx.x - SCAN_WGS; unit >= 0 && unit < 128; unit += 128) {
        const int bg = unit >> 3, e = (unit >> 1) & 3, ph = unit & 1, b = bg >> 1, g = bg & 1, h = g * 4 + e;
        const float A = -__expf(p.in[21][h]), Dh = p.in[22][h];
        f32x4 hacc[2] = {{0.f, 0.f, 0.f, 0.f}, {0.f, 0.f, 0.f, 0.f}};
        for (int i = tid; i < 32 * 136; i += 512) Hb[i] = 0;
        u32x4 rc[2], rb[2]; unsigned rx0, rx1; float rdt = 0.f;
#define SSD_LOAD(c_) do { const int row0_ = b * SEQ + (c_) * 64; \
            _Pragma("unroll") for (int i = 0; i < 2; ++i) { const int pc = tid + i * 512, s_ = pc >> 4, n8 = (pc & 15) * 8; \
                rc[i] = *(const u32x4*)(XBC + (size_t)(row0_ + s_) * 1024 + 768 + g * 128 + n8); rb[i] = *(const u32x4*)(XBC + (size_t)(row0_ + s_) * 1024 + 512 + g * 128 + n8); } \
            { const unsigned* xp_ = (const unsigned*)(XBC + (size_t)(row0_ + (tid >> 3)) * 1024 + h * 64 + ph * 32 + (tid & 7) * 4); rx0 = xp_[0]; rx1 = xp_[1]; } \
            if (tid < 64) rdt = DT[(size_t)(row0_ + tid) * 8 + h]; } while (0)
        SSD_LOAD(0);
        for (int c = 0; c < SEQ / 64; ++c) {
            unsigned char* sb = smem + (c & 1) * 89088; bf16* Cs = (bf16*)sb; bf16* Bs = (bf16*)(sb + 17408); bf16* BT = (bf16*)(sb + 34816);
            float* cs = (float*)(smem + ((c & 1) ? 142336 : 88576)); float* dtv = cs + 64;
#pragma unroll
            for (int i = 0; i < 2; ++i) { const int pc = tid + i * 512, s_ = pc >> 4, n8 = (pc & 15) * 8;
                *(u32x4*)(Cs + s_ * 136 + n8) = rc[i]; *(u32x4*)(Bs + s_ * 136 + n8) = rb[i];
                const unsigned w[4] = {rb[i].x, rb[i].y, rb[i].z, rb[i].w};
                const int sp = ((((s_ >> 3) ^ (pc & 7)) << 3) | (s_ & 7));
#pragma unroll
                for (int j = 0; j < 4; ++j) { BT[(n8 + 2 * j) * 72 + sp] = (bf16)(w[j] & 0xffffu); BT[(n8 + 2 * j + 1) * 72 + sp] = (bf16)(w[j] >> 16); } }
            if (wave == 0) { float v = A * rdt;
                v += dppf<0x111>(v); v += dppf<0x112>(v); v += dppf<0x114>(v); v += dppf<0x118>(v);
                v += __int_as_float(__builtin_amdgcn_update_dpp(0, __float_as_int(v), 0x142, 0xa, 0xf, false));
                v += __int_as_float(__builtin_amdgcn_update_dpp(0, __float_as_int(v), 0x143, 0xc, 0xf, false));
                cs[lane] = v; dtv[lane] = rdt; }
            __syncthreads();
            { const int s_ = tid >> 3, p4 = (tid & 7) * 4; const float dts = dtv[s_], dec = __expf(cs[63] - cs[s_]);
              const float x[4] = {bflo(rx0), bfhi(rx0), bflo(rx1), bfhi(rx1)};
#pragma unroll
              for (int j = 0; j < 4; ++j) { const float X = x[j] * dts; XT[(p4 + j) * 72 + s_] = f2bf(X); XdT[(p4 + j) * 72 + s_] = f2bf(X * dec); }
              *(f32x4*)(xsn + s_ * 32 + p4) = (f32x4){x[0], x[1], x[2], x[3]}; }
            if (c + 1 < SEQ / 64) SSD_LOAD(c + 1);
#pragma unroll
            for (int i = 0; i < 2; ++i) { const int tile = wave * 2 + i, mt = tile >> 2, nt = tile & 3; f32x4 acc = {0.f, 0.f, 0.f, 0.f};
#pragma unroll
                for (int ks = 0; ks < 4; ++ks) acc = mfma16(ldfrag(Cs, 136, mt * 16, ks * 32, r, q), ldfrag(Bs, 136, nt * 16, ks * 32, r, q), acc);
                const int s_ = nt * 16 + r; const float css = cs[s_];
#pragma unroll
                for (int j = 0; j < 4; ++j) { const int l = mt * 16 + q * 4 + j; const float gv = (s_ <= l) ? acc[j] * __expf(cs[l] - css) : 0.f; Gs[l * 72 + s_] = f2bf(gv); } }
            const int mt = wave >> 1, pt = wave & 1;
            f32x4 yacc = {0.f, 0.f, 0.f, 0.f};
#pragma unroll
            for (int ks = 0; ks < 4; ++ks) yacc = mfma16(ldfrag(Cs, 136, mt * 16, ks * 32, r, q), ldfrag(Hb, 136, pt * 16, ks * 32, r, q), yacc);
#pragma unroll
            for (int j = 0; j < 4; ++j) yacc[j] *= __expf(cs[mt * 16 + q * 4 + j]);
            __syncthreads();
#pragma unroll
            for (int ks = 0; ks < 2; ++ks) yacc = mfma16(ldfrag(Gs, 72, mt * 16, ks * 32, r, q), ldfrag(XT, 72, pt * 16, ks * 32, r, q), yacc);
#pragma unroll
            for (int j = 0; j < 4; ++j) { const int l = mt * 16 + q * 4 + j; YM[((size_t)((b * 8 + h) * 4 + ph * 2 + pt) * SEQ + c * 64 + l) * 16 + r] = f2bf(yacc[j] + Dh * xsn[l * 32 + pt * 16 + r]); }
            { const float dl = __expf(cs[63]);
#pragma unroll
              for (int t2 = 0; t2 < 2; ++t2) { hacc[t2] = hacc[t2] * dl;
#pragma unroll
                  for (int ks = 0; ks < 2; ++ks) hacc[t2] = mfma16(ldfrag(XdT, 72, t2 * 16, ks * 32, r, q), *(const bf16x8*)(BT + (wave * 16 + r) * 72 + (((ks * 4 + q) ^ ((wave * 2 + (r >> 3)) & 7)) << 3)), hacc[t2]);
#pragma unroll
                  for (int j = 0; j < 4; ++j) Hb[(t2 * 16 + q * 4 + j) * 136 + wave * 16 + r] = f2bf(hacc[t2][j]); } }
        }
#undef SSD_LOAD
#pragma unroll
        for (int t2 = 0; t2 < 2; ++t2)
#pragma unroll
            for (int j = 0; j < 4; ++j) p.out[O_SSMP + ((size_t)((b * 8 + h) * 64 + ph * 32 + t2 * 16 + q * 4 + j)) * 128 + wave * 16 + r] = hacc[t2][j];
        __syncthreads();
    }
}

__device__ __forceinline__ float conv_act_s(const P& p, int bs, int c) {
    const bf16* PROJ = (const bf16*)(p.ws + WS_PROJ); const float* sc = p.in[4] + (size_t)bs * 3072 + c; const float* cw = p.in[18] + c;
    const float v = p.in[19][c] + cw[0] * sc[0] + cw[1024] * sc[1024] + cw[2048] * sc[2048] + cw[3072] * bf2f(PROJ[(size_t)(MPR + bs) * PLD + 2304 + c]);
    return silu(v);
}
__device__ __forceinline__ void phase_sample_step(const P& p_in, unsigned char* smem) {
    PHASE_PROLOGUE;
    const int lane = tid & 63, wave = tid >> 6, G = gridDim.x, bid = blockIdx.x;
    const int first = SCAN_WGS;
    const int gw = (bid - first) * 8 + wave, NGW = (G - first) * 8;
    if (bid < first) return;
    float* sv = (float*)(smem + wave * 2048);
    const float* WD = p.out + OS_WD; const bf16* KP = (const bf16*)(p.ws + WS_KP); const bf16* KK = (const bf16*)(p.ws + WS_KK); const bf16* KB = (const bf16*)(p.ws + WS_KB);
    bf16* YS = (bf16*)(p.ws + WS_YS); const float* DT = (const float*)(p.ws + WS_DT);
    const int kq = lane & 15, rr = lane >> 4;
    for (int unit = gw; unit < 2048; unit += NGW) {
        const int bs = (unit & 1023) >> 3, h = unit & 7, row = MPR + bs;
        if (unit < 1024) {
            const size_t o = (size_t)row * 512 + h * 64 + lane;
            sv[lane] = WD[o]; sv[64 + lane] = bf2f(KP[o]); sv[128 + lane] = -bf2f(KK[o]); sv[192 + lane] = bf2f(KB[o]); sv[256 + lane] = lerp1(p, row, h * 64 + lane); sv[320 + lane] = lerp1(p, row, 1024 + h * 64 + lane);
            LDS_FENCE();
            const f32x4 w4 = *(const f32x4*)(sv + kq * 4), kp4 = *(const f32x4*)(sv + 64 + kq * 4), ka4 = *(const f32x4*)(sv + 128 + kq * 4), kb4 = *(const f32x4*)(sv + 192 + kq * 4), r4 = *(const f32x4*)(sv + 256 + kq * 4);
            const size_t so = (size_t)(bs * 8 + h) * 4096 + rr * 64 + kq * 4;
            const float* Sb = p.in[3] + so; float* Ob = p.out + O_WKVS + so;
            f32x4 S[16]; float sa[16];
#pragma unroll
            for (int i = 0; i < 16; ++i) S[i] = *(const f32x4*)(Sb + i * 256);
#pragma unroll
            for (int i = 0; i < 16; ++i) sa[i] = sum16((S[i][0] * ka4[0] + S[i][1] * ka4[1]) + (S[i][2] * ka4[2] + S[i][3] * ka4[3]));
#pragma unroll
            for (int i = 0; i < 16; ++i) { const float vv = sv[320 + 4 * i + rr]; f32x4 n;
#pragma unroll
                for (int j = 0; j < 4; ++j) n[j] = S[i][j] * w4[j] + (sa[i] * kb4[j] + vv * kp4[j]);
                *(f32x4*)(Ob + i * 256) = n;
                const float y = sum16((n[0] * r4[0] + n[1] * r4[1]) + (n[2] * r4[2] + n[3] * r4[3]));
                if (kq == 0) YS[(size_t)bs * 1024 + h * 64 + 4 * i + rr] = f2bf(y); }
            LDS_FENCE();
        } else {
            const int g = h >> 2;
            sv[lane] = conv_act_s(p, bs, 512 + g * 128 + lane); sv[64 + lane] = conv_act_s(p, bs, 512 + g * 128 + 64 + lane);
            sv[128 + lane] = conv_act_s(p, bs, 768 + g * 128 + lane); sv[192 + lane] = conv_act_s(p, bs, 768 + g * 128 + 64 + lane);
            sv[256 + lane] = conv_act_s(p, bs, h * 64 + lane);
            LDS_FENCE();
            const float dt = DT[(size_t)row * 8 + h], A = -__expf(p.in[21][h]), dA = __expf(A * dt), Dh = p.in[22][h];
            const f32x4 Bl = *(const f32x4*)(sv + kq * 4), Bh = *(const f32x4*)(sv + 64 + kq * 4), Cl = *(const f32x4*)(sv + 128 + kq * 4), Ch = *(const f32x4*)(sv + 192 + kq * 4);
            const size_t so = (size_t)(bs * 8 + h) * 8192 + rr * 128 + kq * 4;
            const float* Hb_ = p.in[5] + so; float* Ob = p.out + O_SSMS + so;
#pragma unroll
            for (int half = 0; half < 2; ++half) { f32x4 hl[8], hh[8];
#pragma unroll
                for (int i = 0; i < 8; ++i) { hl[i] = *(const f32x4*)(Hb_ + (half * 8 + i) * 512); hh[i] = *(const f32x4*)(Hb_ + (half * 8 + i) * 512 + 64); }
#pragma unroll
                for (int i = 0; i < 8; ++i) { const int pp = 4 * (half * 8 + i) + rr; const float x = sv[256 + pp], dtx = dt * x; f32x4 nl, nh; float y = 0.f;
#pragma unroll
                    for (int j = 0; j < 4; ++j) { nl[j] = hl[i][j] * dA + dtx * Bl[j]; nh[j] = hh[i][j] * dA + dtx * Bh[j]; y += nl[j] * Cl[j] + nh[j] * Ch[j]; }
                    *(f32x4*)(Ob + (half * 8 + i) * 512) = nl; *(f32x4*)(Ob + (half * 8 + i) * 512 + 64) = nh;
                    y = sum16(y) + Dh * x;
                    if (kq == 0) YS[(size_t)bs * 1024 + 512 + h * 64 + pp] = f2bf(y); } }
            LDS_FENCE();
        }
    }
}

__device__ __forceinline__ void phase_post(const P& p_in) {
    PHASE_PROLOGUE;
    const int lane = tid & 63, wave = tid >> 6, G = gridDim.x, bid = blockIdx.x;
    const int gw = bid * 8 + wave, NGW = G * 8;
    bf16* MIX = (bf16*)(p.ws + WS_MIX); const bf16* YR = (const bf16*)(p.ws + WS_XB); const bf16* YM = YR + (size_t)MPR * 512; const bf16* YS = (const bf16*)(p.ws + WS_YS);
    const bf16* PROJ = (const bf16*)(p.ws + WS_PROJ); const bf16* KP = (const bf16*)(p.ws + WS_KP); const bf16* GG = (const bf16*)(p.out + OS_GG);
    for (int row = gw; row < MTOT; row += NGW) {
        const int c0 = lane * 8;
        const size_t yo = ((size_t)(((row >> 11) * 8 + (lane >> 3)) * 4 + ((lane & 7) >> 1)) * SEQ + (row & (SEQ - 1))) * 16 + (lane & 1) * 8;
        {
            float y[8], rr[8], kp[8], vv[8], gg[8];
            unpack8(row < MPR ? *(const u32x4*)(YR + yo) : *(const u32x4*)(YS + (size_t)(row - MPR) * 1024 + c0), y);
            float s = 0.f;
#pragma unroll
            for (int i = 0; i < 8; ++i) s += y[i];
            s += __shfl_xor(s, 1); s += __shfl_xor(s, 2); s += __shfl_xor(s, 4);
            const float mean = s * (1.f / 64.f); float s2 = 0.f;
#pragma unroll
            for (int i = 0; i < 8; ++i) { y[i] -= mean; s2 += y[i] * y[i]; }
            s2 += __shfl_xor(s2, 1); s2 += __shfl_xor(s2, 2); s2 += __shfl_xor(s2, 4);
            const float rstd = rsqrtf(s2 * (1.f / 64.f) + 64e-5f);
            lerp8(p, row, c0, rr); lerp8(p, row, 1024 + c0, vv);
            unpack8(*(const u32x4*)(KP + (size_t)row * 512 + c0), kp); unpack8(*(const u32x4*)(GG + (size_t)row * 512 + c0), gg);
            float bo = 0.f;
#pragma unroll
            for (int i = 0; i < 8; ++i) bo += rr[i] * kp[i] * p.in[15][c0 + i];
            bo += __shfl_xor(bo, 1); bo += __shfl_xor(bo, 2); bo += __shfl_xor(bo, 4);
#pragma unroll
            for (int i = 0; i < 8; ++i) y[i] = (y[i] * rstd * p.in[16][c0 + i] + p.in[17][c0 + i] + bo * vv[i]) * gg[i];
            *(u32x4*)(MIX + (size_t)row * 1024 + c0) = pack8(y);
        }
        {
            float y[8], z[8];
            unpack8(row < MPR ? *(const u32x4*)(YM + yo) : *(const u32x4*)(YS + (size_t)(row - MPR) * 1024 + 512 + c0), y); unpack8(*(const u32x4*)(PROJ + (size_t)row * PLD + 1792 + c0), z);
            float ss = 0.f;
#pragma unroll
            for (int i = 0; i < 8; ++i) { y[i] *= silu(z[i]); ss += y[i] * y[i]; }
            ss += __shfl_xor(ss, 1); ss += __shfl_xor(ss, 2); ss += __shfl_xor(ss, 4); ss += __shfl_xor(ss, 8); ss += __shfl_xor(ss, 16);
            const float sc = rsqrtf(ss * (1.f / 256.f) + 1e-5f);
#pragma unroll
            for (int i = 0; i < 8; ++i) y[i] = y[i] * sc * p.in[23][c0 + i];
            *(u32x4*)(MIX + (size_t)row * 1024 + 512 + c0) = pack8(y);
        }
    }
}

template <bool TO_BF16> __device__ __forceinline__ void phase_ln(const P& p_in, const float* gam, const float* bet, bf16* ob, size_t src_off, int sld) {
    PHASE_PROLOGUE;
    const int lane = tid & 63, wave = tid >> 6, G = gridDim.x, bid = blockIdx.x;
    const int gw = bid * 8 + wave, NGW = G * 8;
    const bf16* src = (const bf16*)p.out + src_off;
    for (int row = gw; row < MTOT; row += NGW) {
        float* xr = p.out + (size_t)row * 1024 + lane * 4;
        f32x4 v[4]; float s = 0.f;
#pragma unroll
        for (int j = 0; j < 4; ++j) { const unsigned long long w = *(const unsigned long long*)(src + (size_t)row * sld + lane * 4 + 256 * j); const unsigned lo = (unsigned)w, hi = (unsigned)(w >> 32);
            v[j] = (f32x4){bflo(lo), bfhi(lo), bflo(hi), bfhi(hi)}; s += (v[j][0] + v[j][1]) + (v[j][2] + v[j][3]); }
#pragma unroll
        for (int o = 1; o < 64; o <<= 1) s += __shfl_xor(s, o);
        const float mean = s * (1.f / 1024.f); float s2 = 0.f;
#pragma unroll
        for (int j = 0; j < 4; ++j) { v[j] = v[j] - mean; s2 += (v[j][0] * v[j][0] + v[j][1] * v[j][1]) + (v[j][2] * v[j][2] + v[j][3] * v[j][3]); }
#pragma unroll
        for (int o = 1; o < 64; o <<= 1) s2 += __shfl_xor(s2, o);
        const float rstd = rsqrtf(s2 * (1.f / 1024.f) + 1e-5f);
#pragma unroll
        for (int j = 0; j < 4; ++j) { const f32x4 gv = *(const f32x4*)(gam + lane * 4 + 256 * j), bv = *(const f32x4*)(bet + lane * 4 + 256 * j); const f32x4 o = v[j] * rstd * gv + bv;
            if (TO_BF16) { unsigned long long w = (unsigned long long)pkbf(o[0], o[1]) | ((unsigned long long)pkbf(o[2], o[3]) << 32); *(unsigned long long*)(ob + (size_t)row * 1024 + lane * 4 + 256 * j) = w; }
            else *(f32x4*)(xr + 256 * j) = o; }
    }
}

#ifndef USE_CHUNKED
#define USE_CHUNKED 1
#endif
#ifndef REPEAT_SEL
#define REPEAT_SEL 0
#endif
#ifndef DUMP_SEL
#define DUMP_SEL 0
#endif
#ifndef STOP_AFTER
#define STOP_AFTER 99
#endif
__global__ void __launch_bounds__(512, 2) mega(P p) {
    extern __shared__ __attribute__((aligned(16))) unsigned char smem[];
    LAS unsigned char* lds = (LAS unsigned char*)smem;
    volatile LAS unsigned* MISC = (volatile LAS unsigned*)(lds + MISC_OFF);
    if (threadIdx.x < 16) MISC[threadIdx.x] = 0u;
    __syncthreads();
    XcdBarrier bar = xcd_barrier_post((unsigned*)(p.ws + WS_CTL), MISC);
    if (p.never) cg::this_grid().sync();
#define GRID_BAR() xcd_barrier(bar)
    const int G = gridDim.x, bid = blockIdx.x;
    bf16* XB = (bf16*)(p.ws + WS_XB); bf16* PROJ = (bf16*)(p.ws + WS_PROJ); float* DT = (float*)(p.ws + WS_DT); bf16* HID = (bf16*)(p.ws + WS_HID);

#if STOP_AFTER != 99
    { const size_t gt = (size_t)blockIdx.x * 512 + threadIdx.x, NGT = (size_t)gridDim.x * 512; for (size_t i = O_SHP + gt; i < 30939136; i += NGT) p.out[i] = 0.f; }
    GRID_BAR();
#endif
    phase0(p, smem);
    GRID_BAR();
    {
        pg8::Gemm g{XB, (const bf16*)(p.ws + WS_WIN), MPR, 3584, 1024}; pg8::StaticOrder S; S.init(MPR, 3584, G, bid);
        pg8::EpiProj E{PROJ, DT, p.in[20], p.out};
        pg8::gemm_phase<pg8::EpiProj, pg8::StaticOrder, true, true>(lds, g, S, E);
        const float* dtb = p.in[20]; float* out = p.out;
        small_gemm<4, 1024>(XB + (size_t)MPR * 1024, (const bf16*)(p.ws + WS_WIN), PROJN, smem, [=](int rs, int c, float v) {
            if (c < 3328) PROJ[(size_t)(MPR + rs) * PLD + c] = f2bf(v); else DT[(size_t)(MPR + rs) * 8 + (c - 3328)] = softplus(v + dtb[c - 3328]);
            if (c < 1792) out[O_SHS + (size_t)rs * 1792 + c] = v;
            if (c >= 2304 && c < 3328) out[O_CONVS + ((size_t)rs * 3 + 2) * 1024 + (c - 2304)] = v; }, (G == 256) ? 128 : 0);
        phase0_late(p, smem, (G == 256) ? 128 : 0, 0);
    }
    GRID_BAR();
    phase_prep(p, smem);
    phase0_late(p, smem, (G > MTOT / 128 + 32) ? MTOT / 128 : 0, 1);
#if REPEAT_SEL == 2
    phase_prep(p, smem);
#endif
    GRID_BAR();
#if STOP_AFTER == 2
    { const size_t gt = (size_t)blockIdx.x * 512 + threadIdx.x, NGT = (size_t)gridDim.x * 512; const bf16* KPd = (const bf16*)(p.ws + WS_KP); const bf16* XBCd = (const bf16*)(p.ws + WS_XBC);
      for (size_t i = gt; i < 8454144; i += NGT) { p.out[i] = bf2f(KPd[i]); p.out[8454144 + i] = bf2f(XBCd[i]); } }
    return;
#endif
#if USE_CHUNKED
    phase_scan2(p, smem);
#else
    phase_scan(p, smem);
#endif
    phase_ssd(p, smem);
    phase_sample_step(p, smem);
#if REPEAT_SEL == 3
    phase_scan2(p, smem);
    phase_ssd(p, smem);
    phase_sample_step(p, smem);
#endif
#if REPEAT_SEL == 5
    phase_sample_step(p, smem);
    phase_sample_step(p, smem);
#endif
#if REPEAT_SEL == 6
    phase_ssd(p, smem);
#endif
#if REPEAT_SEL == 4
    phase_ssd(p, smem);
    phase_sample_step(p, smem);
#endif
    GRID_BAR();
#if STOP_AFTER == 4
    { const size_t gt = (size_t)blockIdx.x * 512 + threadIdx.x, NGT = (size_t)gridDim.x * 512; const bf16* Yd = (const bf16*)(p.ws + WS_XB);
      for (size_t i = gt; i < 8388608; i += NGT) { p.out[i] = (DUMP_SEL & 1) ? bf2f(Yd[i]) : 0.f; p.out[8388608 + i] = (DUMP_SEL & 2) ? bf2f(Yd[8388608 + i]) : 0.f; }
      for (size_t i = gt; i < 131072; i += NGT) p.out[16777216 + i] = (DUMP_SEL & 4) ? bf2f(((const bf16*)(p.ws + WS_YS))[i]) : 0.f; }
    return;
#endif
    phase_post(p);
    GRID_BAR();
#if STOP_AFTER == 5
    { const size_t gt = (size_t)blockIdx.x * 512 + threadIdx.x, NGT = (size_t)gridDim.x * 512; for (size_t i = gt; i < (size_t)MTOT * 1024; i += NGT) p.out[i] = bf2f(((const bf16*)(p.ws + WS_MIX))[i]); }
    return;
#endif
    {
        pg8::Gemm g{(const bf16*)(p.ws + WS_MIX), (const bf16*)(p.ws + WS_WOUT), MPR, 1024, 1024}; pg8::StaticOrder S; S.init(MPR, 1024, G, bid);
        pg8::EpiResF32 E{p.in[0], nullptr, (bf16*)p.out, 1024, ALPHA};
        pg8::gemm_phase<pg8::EpiResF32, pg8::StaticOrder, true, true>(lds, g, S, E);
        const float* xs = p.in[1]; float* out = p.out;
        small_gemm<2, 1024>((const bf16*)(p.ws + WS_MIX) + (size_t)MPR * 1024, (const bf16*)(p.ws + WS_WOUT), 1024, smem, [=](int rs, int c, float v) { ((bf16*)out)[(size_t)(MPR + rs) * 1024 + c] = f2bf(ALPHA * xs[(size_t)rs * 1024 + c] + v); });
    }
    GRID_BAR();
    phase_ln<true>(p, p.in[25], p.in[26], XB, 0, 1024);
    GRID_BAR();
    {
        pg8::Gemm g{XB, (const bf16*)(p.ws + WS_WFF1), MPR, 4096, 1024}; pg8::StaticOrder S; S.init(MPR, 4096, G, bid);
        pg8::EpiRelu2 E{HID, 4096};
        pg8::gemm_phase<pg8::EpiRelu2, pg8::StaticOrder, true, true>(lds, g, S, E);
        small_gemm<4, 1024>(XB + (size_t)MPR * 1024, (const bf16*)(p.ws + WS_WFF1), 4096, smem, [=](int rs, int c, float v) { const float a = fmaxf(v, 0.f); HID[(size_t)(MPR + rs) * 4096 + c] = f2bf(a * a); });
    }
    GRID_BAR();
    {
        pg8::Gemm g{HID, (const bf16*)(p.ws + WS_WFF2), MPR, 1024, 4096}; pg8::StaticOrder S; S.init(MPR, 1024, G, bid);
        pg8::EpiResF32 E{nullptr, XB, (bf16*)p.out + 1024, 2048, ALPHA};
        pg8::gemm_phase<pg8::EpiResF32, pg8::StaticOrder, true, true>(lds, g, S, E);
        float* out = p.out;
        small_gemm<2, 4096>(HID + (size_t)MPR * 4096, (const bf16*)(p.ws + WS_WFF2), 1024, smem, [=](int rs, int c, float v) { ((bf16*)out)[(size_t)(MPR + rs) * 2048 + 1024 + c] = f2bf(ALPHA * bf2f(XB[(size_t)(MPR + rs) * 1024 + c]) + v); });
    }
    GRID_BAR();
    phase_ln<false>(p, p.in[29], p.in[30], nullptr, 1024, 2048);
}

extern "C" void kernel_launch(void* const* d_in, const int* in_sizes, int n_in, void* d_out, int out_size, void* d_ws, size_t ws_size, hipStream_t stream) {
    static int grid = 0;
    if (grid == 0) {
        int dev = 0, cus = 0, per_cu = 0;
        (void)hipGetDevice(&dev);
        (void)hipDeviceGetAttribute(&cus, hipDeviceAttributeMultiprocessorCount, dev);
        if (hipFuncSetAttribute((const void*)mega, hipFuncAttributeMaxDynamicSharedMemorySize, LDS_BYTES) != hipSuccess) fprintf(stderr, "kernel_launch: hipFuncSetAttribute failed\n");
        if (hipOccupancyMaxActiveBlocksPerMultiprocessor(&per_cu, (const void*)mega, 512, LDS_BYTES) != hipSuccess || per_cu < 1) { fprintf(stderr, "kernel_launch: occupancy query says %d\n", per_cu); per_cu = 1; }
        (void)hipGetLastError();
        grid = cus * 1;
        if (n_in != 31 || out_size != 30939136 || ws_size < WS_CTL + 16384) fprintf(stderr, "kernel_launch: unexpected sizes n_in %d out %d ws %zu\n", n_in, out_size, ws_size);
    }
    (void)hipMemsetAsync((char*)d_ws + WS_CTL, 0, 16384, stream);
    P a{};
    for (int i = 0; i < 31; ++i) a.in[i] = (const float*)d_in[i];
    a.out = (float*)d_out; a.ws = (unsigned char*)d_ws; a.never = 0; a.pad = 0;
    void* args[] = {&a};
    hipError_t e = hipLaunchCooperativeKernel((const void*)mega, dim3(grid), dim3(512), args, LDS_BYTES, stream);
    if (e != hipSuccess) fprintf(stderr, "kernel_launch: cooperative launch failed: %s (grid %d)\n", hipGetErrorString(e), grid);
}
```

```cpp
#include <hip/hip_runtime.h>
#include <hip/hip_cooperative_groups.h>
#include <cstdio>
#include <cstdint>
namespace cg = cooperative_groups;
#define LAS __attribute__((address_space(3)))

typedef unsigned short bf16;
typedef short bf16x8 __attribute__((ext_vector_type(8)));
typedef float f32x4 __attribute__((ext_vector_type(4)));
typedef unsigned u32x4 __attribute__((ext_vector_type(4)));

constexpr int DM = 1024, SEQ = 2048, MPR = 8 * SEQ, MSM = 128, MTOT = MPR + MSM;
constexpr int RPJ = 1792, PLD = 3328, PROJN = 3336, DFF = 4096;
constexpr float ALPHA = 1.189207115f;
constexpr size_t O_Y = 0, O_YS = 16777216, O_SHP = 16908288, O_WKVP = 16922624, O_CONVP = 17184768, O_SSMP = 17209344,
                 O_SHS = 17733632, O_WKVS = 17963008, O_CONVS = 22157312, O_SSMS = 22550528;
constexpr size_t OS_WD = 0, OS_GG = 8454144;
constexpr size_t WS_WIN = 0, WS_WOUT = 7340032, WS_WFF1 = 9437184, WS_WFF2 = 17825792, WS_LORA = 26214400, WS_XB = 26476544,
                 WS_PROJ = 60293120, WS_DT = 170196992, WS_KP = 170725376, WS_KK = 187633664, WS_KB = 204541952, WS_XBC = 221450240,
                 WS_CTL = 255004672, WS_YS = WS_CTL + 65536, WS_HID = WS_PROJ, WS_MIX = WS_KK;
constexpr int LDS_BYTES = 147456, MISC_OFF = LDS_BYTES - 64;

struct P { const float* in[31]; float* out; unsigned char* ws; int never; int pad; };

__device__ __forceinline__ float bf2f(unsigned short b) { return __uint_as_float(((unsigned)b) << 16); }
__device__ __forceinline__ float bflo(unsigned u) { return __uint_as_float(u << 16); }
__device__ __forceinline__ float bfhi(unsigned u) { return __uint_as_float(u & 0xffff0000u); }
typedef float f32x2_t __attribute__((ext_vector_type(2)));
typedef __bf16 bf16x2_t __attribute__((ext_vector_type(2)));
__device__ __forceinline__ unsigned pkbf(float lo, float hi) { const f32x2_t v = {lo, hi}; const bf16x2_t b = __builtin_convertvector(v, bf16x2_t); return __builtin_bit_cast(unsigned, b); }
__device__ __forceinline__ unsigned short f2bf(float f) { return (unsigned short)(pkbf(f, f) & 0xffffu); }
__device__ __forceinline__ void unpack8(u32x4 v, float* o) { o[0] = bflo(v.x); o[1] = bfhi(v.x); o[2] = bflo(v.y); o[3] = bfhi(v.y); o[4] = bflo(v.z); o[5] = bfhi(v.z); o[6] = bflo(v.w); o[7] = bfhi(v.w); }
__device__ __forceinline__ u32x4 pack8(const float* o) { u32x4 v; v.x = pkbf(o[0], o[1]); v.y = pkbf(o[2], o[3]); v.z = pkbf(o[4], o[5]); v.w = pkbf(o[6], o[7]); return v; }
__device__ __forceinline__ float sigm(float x) { return __builtin_amdgcn_rcpf(1.f + __expf(-x)); }
__device__ __forceinline__ float silu(float x) { return x * __builtin_amdgcn_rcpf(1.f + __expf(-x)); }
__device__ __forceinline__ float softplus(float x) { return fmaxf(x, 0.f) + __logf(1.f + __expf(-fabsf(x))); }
__device__ __forceinline__ float tanh_(float x) { const float e = __expf(2.f * x); return 1.f - 2.f * __builtin_amdgcn_rcpf(e + 1.f); }
template <int CTRL> __device__ __forceinline__ float dppf(float x) { return __int_as_float(__builtin_amdgcn_update_dpp(0, __float_as_int(x), CTRL, 0xf, 0xf, true)); }
template <int CTRL> __device__ __forceinline__ float dppo(float x) { return __int_as_float(__builtin_amdgcn_update_dpp(0x3f800000, __float_as_int(x), CTRL, 0xf, 0xf, false)); }
__device__ __forceinline__ float sum16(float x) { x += dppf<0xB1>(x); x += dppf<0x4E>(x); x += dppf<0x141>(x); x += dppf<0x140>(x); return x; }
__device__ __forceinline__ float sum8(float x) { x += dppf<0xB1>(x); x += dppf<0x4E>(x); x += dppf<0x141>(x); return x; }
__device__ __forceinline__ float rdl(float x, int l) { return __int_as_float(__builtin_amdgcn_readlane(__float_as_int(x), l)); }
__device__ __forceinline__ float sum64(float x) { x = sum16(x); return (rdl(x, 0) + rdl(x, 16)) + (rdl(x, 32) + rdl(x, 48)); }
__device__ __forceinline__ float sum32(float x, bool hi) { x = sum16(x); const float a = rdl(x, 0) + rdl(x, 16), b = rdl(x, 32) + rdl(x, 48); return hi ? b : a; }
__device__ __forceinline__ f32x4 mfma16(bf16x8 a, bf16x8 b, f32x4 c) { return __builtin_amdgcn_mfma_f32_16x16x32_bf16(a, b, c, 0, 0, 0); }
typedef short s16x4 __attribute__((ext_vector_type(4)));
__device__ __forceinline__ f32x4 mf16(s16x4 a, s16x4 b, f32x4 c) { return __builtin_amdgcn_mfma_f32_16x16x16bf16_1k(a, b, c, 0, 0, 0); }
__device__ __forceinline__ s16x4 cvt4(f32x4 v) { struct { unsigned a, b; } t = {pkbf(v[0], v[1]), pkbf(v[2], v[3])}; return __builtin_bit_cast(s16x4, t); }
#define LDS_FENCE() asm volatile("s_waitcnt lgkmcnt(0)" ::: "memory")

#define PHASE_PROLOGUE P p = p_in; { size_t z_ = 0; asm volatile("" : "+s"(z_)); p.ws += z_; p.out += z_; } int tid = threadIdx.x; asm volatile("" : "+v"(tid))
namespace pg8 {
#define PG8_LAS __attribute__((address_space(3)))
typedef unsigned short bf16_t;
typedef short bf16x8 __attribute__((ext_vector_type(8)));
typedef float f32x4 __attribute__((ext_vector_type(4)));
typedef unsigned u32x4 __attribute__((ext_vector_type(4)));
constexpr int BM = 256, BK = 64, HALF = 128, HTB = HALF * BK * 2  , STAGE_BYTES = 8 * HTB, NXCD = 8, WGM = 8;

__host__ __device__ __forceinline__ int lds_byte(int r, int c) { const int st = (r >> 4) * 2 + (c >> 5), rr = r & 15, cc = c & 31, ob = rr * 64 + cc * 2; return st * 1024 + (ob ^ (((ob >> 9) & 1) << 5)); }
__host__ __device__ __forceinline__ void stage_rc(int b, int& R, int& C) { const int st = b / 1024, sb = b % 1024, swz = sb ^ (((sb >> 9) & 1) << 5); R = (st >> 1) * 16 + swz / 64; C = (st & 1) * 32 + (swz % 64) / 2; }
__host__ __device__ __forceinline__ int perm32(int rho) { const int n = rho >> 4, i = rho & 15; return 8 * (i >> 2) + 4 * n + (i & 3); }

struct Unit { int pm, pn; };
struct Gemm { const bf16_t* A; const bf16_t* Bt; int M, N, K; };

struct StaticOrder {
    int nM, nN, nwg, G, c;
    __host__ __device__ void init(int M, int N, int G_, int c_) { nM = M / BM; nN = N / BM; nwg = nM * nN; G = G_; c = c_; }
    __host__ __device__ bool next(int i, Unit& u) const {
        const long L = (long)i * G + c; if (L >= nwg) return false;
        int wgid = (int)L; { const int q = nwg / NXCD, r = nwg % NXCD, xcd = wgid % NXCD, off = wgid / NXCD; wgid = (xcd < r ? xcd * (q + 1) : r * (q + 1) + (xcd - r) * q) + off; }
        const int nig = WGM * nN, gid = wgid / nig, fm = gid * WGM, gsz = (nM - fm) < WGM ? (nM - fm) : WGM;
        u.pm = fm + ((wgid % nig) % gsz); u.pn = (wgid % nig) / gsz; return true;
    }
    __device__ __forceinline__ void a_ready(const Unit&) const {}
    __device__ __forceinline__ void done(const Unit&) const {}
};

__device__ __forceinline__ unsigned cvt_pk_bf16(float lo, float hi) { return ::pkbf(lo, hi); }
typedef float f32x2 __attribute__((ext_vector_type(2)));
struct EpiProj {
    static constexpr bool PERM = true, AFTER_DRAIN = false;
    bf16_t* PROJ; float* DT; const float* dt_bias; float* out;
    __device__ __forceinline__ void operator()(const f32x4 (&acc)[2][2][4][2], const Unit& u, int wr, int wc, int fr, int fq) const {
        const int row0 = u.pm * BM + wr * 64 + fr;
#pragma unroll
        for (int bj = 0; bj < 2; ++bj) {
            const int c0 = u.pn * BM + bj * HALF + wc * 32 + 8 * fq;
            if (c0 >= 3336) continue;
#pragma unroll
            for (int ai = 0; ai < 2; ++ai)
#pragma unroll
                for (int m = 0; m < 4; ++m) {
                    const int row = row0 + ai * HALF + m * 16; const f32x4 v0 = acc[ai][bj][m][0], v1 = acc[ai][bj][m][1];
                    if (c0 < 3328) { u32x4 w; w.x = cvt_pk_bf16(v0[0], v0[1]); w.y = cvt_pk_bf16(v0[2], v0[3]); w.z = cvt_pk_bf16(v1[0], v1[1]); w.w = cvt_pk_bf16(v1[2], v1[3]);
                        *(u32x4*)(PROJ + (size_t)row * 3328 + c0) = w; }
                    else { f32x4 a, b;
#pragma unroll
                        for (int i = 0; i < 4; ++i) { float x = v0[i] + dt_bias[i]; a[i] = x > 20.f ? x : log1pf(__expf(x)); float y = v1[i] + dt_bias[4 + i]; b[i] = y > 20.f ? y : log1pf(__expf(y)); }
                        *(f32x4*)(DT + (size_t)row * 8) = a; *(f32x4*)(DT + (size_t)row * 8 + 4) = b; }
                    const int t = row & 2047, b_ = row >> 11;
                    if (t == 2047 && c0 < 1792) { float* o = out + 16908288 + (size_t)b_ * 1792 + c0; *(f32x4*)o = v0; *(f32x4*)(o + 4) = v1; }
                    if (t >= 2045 && c0 >= 2304 && c0 < 3328) { float* o = out + 17184768 + ((size_t)b_ * 3 + (t - 2045)) * 1024 + (c0 - 2304); *(f32x4*)o = v0; *(f32x4*)(o + 4) = v1; }
                }
        }
    }
};
struct EpiResF32 {
    static constexpr bool PERM = true, AFTER_DRAIN = false;
    const float* resf; const bf16_t* resb; bf16_t* ob; int ld; float alpha;
    __device__ __forceinline__ void operator()(const f32x4 (&acc)[2][2][4][2], const Unit& u, int wr, int wc, int fr, int fq) const {
        const int row0 = u.pm * BM + wr * 64 + fr;
#pragma unroll
        for (int ai = 0; ai < 2; ++ai)
#pragma unroll
            for (int m = 0; m < 4; ++m)
#pragma unroll
                for (int bj = 0; bj < 2; ++bj) {
                    const int row = row0 + ai * HALF + m * 16, c0 = u.pn * BM + bj * HALF + wc * 32 + 8 * fq; const size_t o = (size_t)row * 1024 + c0;
                    f32x4 r0, r1;
                    if (resf) { r0 = *(const f32x4*)(resf + o); r1 = *(const f32x4*)(resf + o + 4); }
                    else { const u32x4 w = *(const u32x4*)(resb + o); r0[0] = __uint_as_float(w.x << 16); r0[1] = __uint_as_float(w.x & 0xffff0000u); r0[2] = __uint_as_float(w.y << 16); r0[3] = __uint_as_float(w.y & 0xffff0000u);
                        r1[0] = __uint_as_float(w.z << 16); r1[1] = __uint_as_float(w.z & 0xffff0000u); r1[2] = __uint_as_float(w.w << 16); r1[3] = __uint_as_float(w.w & 0xffff0000u); }
                    const f32x4 v0 = r0 * alpha + acc[ai][bj][m][0], v1 = r1 * alpha + acc[ai][bj][m][1];
                    u32x4 w8; w8.x = cvt_pk_bf16(v0[0], v0[1]); w8.y = cvt_pk_bf16(v0[2], v0[3]); w8.z = cvt_pk_bf16(v1[0], v1[1]); w8.w = cvt_pk_bf16(v1[2], v1[3]);
                    *(u32x4*)(ob + (size_t)row * ld + c0) = w8;
                }
    }
};
struct EpiRelu2 {
    static constexpr bool PERM = true, AFTER_DRAIN = false;
    bf16_t* O; int ldc;
    __device__ __forceinline__ void operator()(const f32x4 (&acc)[2][2][4][2], const Unit& u, int wr, int wc, int fr, int fq) const {
        const int row0 = u.pm * BM + wr * 64 + fr;
#pragma unroll
        for (int ai = 0; ai < 2; ++ai)
#pragma unroll
            for (int m = 0; m < 4; ++m)
#pragma unroll
                for (int bj = 0; bj < 2; ++bj) {
                    const int row = row0 + ai * HALF + m * 16, c0 = u.pn * BM + bj * HALF + wc * 32 + 8 * fq;
                    f32x4 v0 = acc[ai][bj][m][0], v1 = acc[ai][bj][m][1];
#pragma unroll
                    for (int i = 0; i < 4; ++i) { float a = fmaxf(v0[i], 0.f); v0[i] = a * a; float b = fmaxf(v1[i], 0.f); v1[i] = b * b; }
                    u32x4 w; w.x = cvt_pk_bf16(v0[0], v0[1]); w.y = cvt_pk_bf16(v0[2], v0[3]); w.z = cvt_pk_bf16(v1[0], v1[1]); w.w = cvt_pk_bf16(v1[2], v1[3]);
                    *(u32x4*)(O + (size_t)row * ldc + c0) = w;
                }
    }
};
template <class Epi, class Sched, bool ALIGN_EPI = false, bool SP2 = false>
__device__ __forceinline__ void gemm_phase(PG8_LAS unsigned char* lds, const Gemm g, const Sched& S, const Epi& E) {
    int tid = threadIdx.x; asm volatile("" : "+v"(tid)); const int wid = __builtin_amdgcn_readfirstlane(tid >> 6), lane = tid & 63, wr = wid >> 2, wc = wid & 3, fr = lane & 15, fq = lane >> 4;
    const int K = g.K, nt = K / BK;
    unsigned voffA[2], voffB[2];
#pragma unroll
    for (int i = 0; i < 2; ++i) { int R, C; stage_rc(tid * 16 + i * 8192, R, C); const int Rb = Epi::PERM ? ((R & ~31) + perm32(R & 31)) : R;
        voffA[i] = (unsigned)(R * K + C) * 2u; voffB[i] = (unsigned)(Rb * K + C) * 2u; }
    const size_t kstep = (size_t)(BK * 2);
    const size_t hstep = (size_t)HALF * K * 2;
    const size_t tstep = 2 * hstep;
    const unsigned ldsw = (unsigned)wid * 1024u;
    const int aoff = lds_byte(wr * 64 + fr, fq * 8), boff = lds_byte(wc * 32 + fr, fq * 8);
#define PG8_SA(b, h) (((b) * 2 + (h)) * HTB)
#define PG8_SB(b, h) ((4 + (b) * 2 + (h)) * HTB)
#define PG8_STAGE(bufoff, gbase, voff) do { _Pragma("unroll") for (int _i = 0; _i < 2; ++_i) \
        __builtin_amdgcn_global_load_lds((const unsigned*)((const char*)(gbase) + (voff)[_i]), (PG8_LAS unsigned*)(lds + (bufoff) + ldsw + _i * 8192), 16, 0, 0); } while (0)
#define PG8_LDA(dst, b, h) do { _Pragma("unroll") for (int m = 0; m < 4; ++m) _Pragma("unroll") for (int k = 0; k < 2; ++k) dst[m][k] = *(const PG8_LAS bf16x8*)(lds + PG8_SA(b, h) + aoff + m * 2048 + k * 1024); } while (0)
#define PG8_LDB(dst, b, h) do { _Pragma("unroll") for (int n = 0; n < 2; ++n) _Pragma("unroll") for (int k = 0; k < 2; ++k) dst[n][k] = *(const PG8_LAS bf16x8*)(lds + PG8_SB(b, h) + boff + n * 2048 + k * 1024); } while (0)
#define PG8_MMA(ai, bj, At, Bt) do { __builtin_amdgcn_s_setprio(1); _Pragma("unroll") for (int m = 0; m < 4; ++m) _Pragma("unroll") for (int n = 0; n < 2; ++n) _Pragma("unroll") for (int k = 0; k < 2; ++k) \
        acc[ai][bj][m][n] = __builtin_amdgcn_mfma_f32_16x16x32_bf16(Bt[n][k], At[m][k], acc[ai][bj][m][n], 0, 0, 0); __builtin_amdgcn_s_setprio(0); } while (0)
#define PG8_WAIT_V(n) asm volatile("s_waitcnt vmcnt(" #n ")" ::: "memory")
#define PG8_WAIT_L(n) asm volatile("s_waitcnt lgkmcnt(" #n ")" ::: "memory")
#define PG8_BAR __builtin_amdgcn_s_barrier()
#define PG8_SCHED __builtin_amdgcn_sched_barrier(0)
    Unit cur, nxt; int ui = 0;
    if (!S.next(0, cur)) return;
    f32x4 acc[2][2][4][2];
#pragma unroll
    for (int a = 0; a < 2; ++a)
#pragma unroll
        for (int b = 0; b < 2; ++b)
#pragma unroll
            for (int m = 0; m < 4; ++m)
#pragma unroll
                for (int n = 0; n < 2; ++n) acc[a][b][m][n] = (f32x4){0.f, 0.f, 0.f, 0.f};
    bf16x8 At[4][2], B0[2][2], B1[2][2];
    const char* cA = (const char*)g.A + (size_t)cur.pm * tstep; const char* cB = (const char*)g.Bt + (size_t)cur.pn * tstep;
    S.a_ready(cur);
    if constexpr (SP2) {
        PG8_STAGE(PG8_SB(0, 0), cB, voffB); PG8_STAGE(PG8_SB(0, 1), cB + hstep, voffB); PG8_STAGE(PG8_SA(0, 0), cA, voffA); PG8_STAGE(PG8_SA(0, 1), cA + hstep, voffA);
        if (wr == 1) PG8_BAR;
        PG8_WAIT_V(2); PG8_BAR;
        PG8_STAGE(PG8_SB(1, 0), cB + kstep, voffB); PG8_STAGE(PG8_SA(1, 0), cA + kstep, voffA); PG8_STAGE(PG8_SB(1, 1), cB + hstep + kstep, voffB);
        PG8_WAIT_V(6); PG8_BAR;
    } else {
        PG8_STAGE(PG8_SB(0, 0), cB, voffB); PG8_STAGE(PG8_SA(0, 0), cA, voffA); PG8_STAGE(PG8_SB(0, 1), cB + hstep, voffB); PG8_STAGE(PG8_SA(0, 1), cA + hstep, voffA);
        if (wr == 1) PG8_BAR;
        PG8_WAIT_V(4); PG8_BAR;
        PG8_STAGE(PG8_SB(1, 0), cB + kstep, voffB); PG8_STAGE(PG8_SA(1, 0), cA + kstep, voffA); PG8_STAGE(PG8_SB(1, 1), cB + hstep + kstep, voffB);
        PG8_WAIT_V(6); PG8_BAR;
    }
    for (;;) {
        const bool has_next = S.next(ui + 1, nxt);
        const char* nA = has_next ? (const char*)g.A + (size_t)nxt.pm * tstep : cA; const char* nB = has_next ? (const char*)g.Bt + (size_t)nxt.pn * tstep : cB;
        for (int t = 0; t < nt; t += 2) {
            const bool last = (t == nt - 2);
            const char* a1 = cA + (size_t)(t + 1) * kstep;
            const char* a2 = last ? nA : cA + (size_t)(t + 2) * kstep; const char* b2 = last ? nB : cB + (size_t)(t + 2) * kstep;
            const char* a3 = a2 + kstep; const char* b3 = b2 + kstep;
            if (last && has_next) S.a_ready(nxt);
            if constexpr (SP2) {
            PG8_LDB(B0, 0, 0); PG8_LDB(B1, 0, 1); PG8_SCHED; PG8_LDA(At, 0, 0); PG8_STAGE(PG8_SA(1, 1), a1 + hstep, voffA);
            PG8_WAIT_V(8); PG8_WAIT_L(0); PG8_BAR; PG8_MMA(0, 0, At, B0); PG8_MMA(0, 1, At, B1); PG8_BAR; PG8_SCHED;
            PG8_LDA(At, 0, 1); PG8_STAGE(PG8_SB(0, 0), b2, voffB); PG8_STAGE(PG8_SB(0, 1), b2 + hstep, voffB); PG8_STAGE(PG8_SA(0, 0), a2, voffA);
            PG8_WAIT_V(8); PG8_WAIT_L(0); PG8_BAR; PG8_MMA(1, 0, At, B0); PG8_MMA(1, 1, At, B1); PG8_BAR; PG8_SCHED;
            PG8_LDB(B0, 1, 0); PG8_LDB(B1, 1, 1); PG8_SCHED; PG8_LDA(At, 1, 0); PG8_STAGE(PG8_SA(0, 1), a2 + hstep, voffA);
            PG8_WAIT_V(8); PG8_WAIT_L(0); PG8_BAR; PG8_MMA(0, 0, At, B0); PG8_MMA(0, 1, At, B1); PG8_BAR; PG8_SCHED;
            PG8_LDA(At, 1, 1); PG8_STAGE(PG8_SB(1, 0), b3, voffB); PG8_STAGE(PG8_SB(1, 1), b3 + hstep, voffB); PG8_STAGE(PG8_SA(1, 0), a3, voffA);
            PG8_WAIT_V(8); PG8_WAIT_L(0); PG8_BAR; PG8_MMA(1, 0, At, B0); PG8_MMA(1, 1, At, B1); PG8_BAR; PG8_SCHED;
            } else {
            PG8_LDB(B0, 0, 0); PG8_SCHED; PG8_LDA(At, 0, 0); PG8_STAGE(PG8_SA(1, 1), a1 + hstep, voffA);
            PG8_WAIT_L(8); PG8_BAR; PG8_WAIT_L(0); PG8_MMA(0, 0, At, B0); PG8_BAR; PG8_SCHED;
            PG8_LDB(B1, 0, 1); PG8_STAGE(PG8_SB(0, 0), b2, voffB);
            PG8_BAR; PG8_WAIT_L(0); PG8_MMA(0, 1, At, B1); PG8_BAR;
            PG8_LDA(At, 0, 1); PG8_STAGE(PG8_SA(0, 0), a2, voffA);
            PG8_BAR; PG8_WAIT_L(0); PG8_MMA(1, 0, At, B0); PG8_BAR; PG8_SCHED;
            PG8_STAGE(PG8_SB(0, 1), b2 + hstep, voffB);
            PG8_WAIT_V(6); PG8_BAR; PG8_MMA(1, 1, At, B1); PG8_BAR;
            PG8_LDB(B0, 1, 0); PG8_SCHED; PG8_LDA(At, 1, 0); PG8_STAGE(PG8_SA(0, 1), a2 + hstep, voffA);
            PG8_WAIT_L(8); PG8_BAR; PG8_WAIT_L(0); PG8_MMA(0, 0, At, B0); PG8_BAR; PG8_SCHED;
            PG8_LDB(B1, 1, 1); PG8_STAGE(PG8_SB(1, 0), b3, voffB);
            PG8_BAR; PG8_WAIT_L(0); PG8_MMA(0, 1, At, B1); PG8_BAR;
            PG8_LDA(At, 1, 1); PG8_STAGE(PG8_SA(1, 0), a3, voffA);
            PG8_BAR; PG8_WAIT_L(0); PG8_MMA(1, 0, At, B0); PG8_BAR; PG8_SCHED;
            PG8_STAGE(PG8_SB(1, 1), b3 + hstep, voffB);
            PG8_WAIT_V(6); PG8_BAR; PG8_MMA(1, 1, At, B1); PG8_BAR;
            }
        }
        if constexpr (ALIGN_EPI) { if (wr == 0) PG8_BAR; }
        if constexpr (!Epi::AFTER_DRAIN) { E(acc, cur, wr, wc, fr, fq); S.done(cur); }
        if (!has_next) break;
#pragma unroll
        for (int a = 0; a < 2; ++a)
#pragma unroll
            for (int b = 0; b < 2; ++b)
#pragma unroll
                for (int m = 0; m < 4; ++m)
#pragma unroll
                    for (int n = 0; n < 2; ++n) acc[a][b][m][n] = (f32x4){0.f, 0.f, 0.f, 0.f};
        cur = nxt; cA = nA; cB = nB; ++ui;
        if constexpr (ALIGN_EPI) { if (wr == 1) PG8_BAR; }
    }
    PG8_WAIT_V(0);
    if constexpr (!ALIGN_EPI) { if (wr == 0) PG8_BAR; }
    PG8_BAR;
    if constexpr (Epi::AFTER_DRAIN) { E.fused(acc, cur, wr, wc, fr, fq, lds, wid, lane); S.done(cur); }
#undef PG8_SA
#undef PG8_SB
#undef PG8_STAGE
#undef PG8_LDA
#undef PG8_LDB
#undef PG8_MMA
#undef PG8_WAIT_V
#undef PG8_WAIT_L
#undef PG8_BAR
#undef PG8_SCHED
}
}

#define XB_TMO      128
#define XB_XCNT(j)  (256  + 64 * (j))
#define XB_XSUB(j)  (1280 + 64 * (j))
#define XB_XGEN(j)  (2304 + 64 * (j))
#define XB_TOP      3328
#define XB_TOPGEN   3392
#define XCD_BAR_WORDS 3456
#define XB_SPIN_CAP (1u << 18)

__device__ __forceinline__ unsigned xb_ld(unsigned* p)              { return __hip_atomic_load(p, __ATOMIC_RELAXED, __HIP_MEMORY_SCOPE_AGENT); }
__device__ __forceinline__ unsigned xb_add(unsigned* p, unsigned v) { return __hip_atomic_fetch_add(p, v, __ATOMIC_RELAXED, __HIP_MEMORY_SCOPE_AGENT); }
__device__ __forceinline__ unsigned xb_xcc_id() { return (unsigned)__builtin_amdgcn_s_getreg((3 << 11) | 20) & 0xFu; }
#define XB_SPIN(cond, bar) do { unsigned _sp = 0; while (cond) { __builtin_amdgcn_s_sleep(1); \
    if ((++_sp & 255u) == 0u) { if (xb_ld(&(bar)[XB_TMO])) break; if (_sp > XB_SPIN_CAP) { atomicAdd(&(bar)[XB_TMO], 1u); break; } } } } while (0)

struct XcdBarrier {
    unsigned* bar; unsigned x;
    volatile LAS unsigned* st;
};

__device__ __forceinline__ XcdBarrier xcd_barrier_post(unsigned* bar, volatile LAS unsigned* st) {
    XcdBarrier b; b.bar = bar; b.x = xb_xcc_id(); b.st = st;
    if (threadIdx.x == 0) (void)xb_add(&bar[XB_XCNT(b.x)], 1u);
    return b;
}
__device__ __forceinline__ void xcd_barrier_complete(unsigned* bar, unsigned x, unsigned& nloc, unsigned& nx) {
    const unsigned G = gridDim.x * gridDim.y * gridDim.z;
    unsigned sum, cnt, mine, sp = 0u;
    for (;;) {
        sum = 0u; cnt = 0u; mine = 0u;
#pragma unroll
        for (unsigned j = 0; j < 16; ++j) { const unsigned c = xb_ld(&bar[XB_XCNT(j)]); sum += c; cnt += (c > 0u) ? 1u : 0u; mine = (j == x) ? c : mine; }
        if (sum == G) break;
        __builtin_amdgcn_s_sleep(1);
        if ((++sp & 255u) == 0u) { if (xb_ld(&bar[XB_TMO])) break; if (sp > XB_SPIN_CAP) { atomicAdd(&bar[XB_TMO], 1u); break; } }
    }
    nloc = mine > 0u ? mine : 1u; nx = cnt > 0u ? cnt : 1u;
}

__device__ __forceinline__ void xcd_barrier(const XcdBarrier& b) {
    asm volatile("s_waitcnt vmcnt(0)" ::: "memory");
    __syncthreads();
    if (threadIdx.x == 0) {
        unsigned* bar = b.bar;
        __builtin_amdgcn_s_waitcnt(0);
        unsigned nloc = b.st[0], nx = b.st[1];
        if (nloc == 0u) { xcd_barrier_complete(bar, b.x, nloc, nx); b.st[0] = nloc; b.st[1] = nx; }
        const unsigned old = xb_add(&bar[XB_XSUB(b.x)], 1u);
        const unsigned gen = old / nloc;
        if (old + 1u == (gen + 1u) * nloc) {
            __builtin_amdgcn_fence(__ATOMIC_RELEASE, "agent");
            asm volatile("s_waitcnt vmcnt(0)" ::: "memory");
            const unsigned og = xb_add(&bar[XB_TOP], 1u);
            const unsigned tg = og / nx;
            if (og + 1u == (tg + 1u) * nx) xb_add(&bar[XB_TOPGEN], 1u);
            else XB_SPIN(xb_ld(&bar[XB_TOPGEN]) == tg, bar);
            __builtin_amdgcn_fence(__ATOMIC_ACQUIRE, "agent");
            xb_add(&bar[XB_XGEN(b.x)], 1u);
            asm volatile("s_waitcnt vmcnt(0)" ::: "memory");
        } else {
            XB_SPIN(xb_ld(&bar[XB_XGEN(b.x)]) == gen, bar);
            __builtin_amdgcn_fence(__ATOMIC_ACQUIRE, "agent");
            asm volatile("s_waitcnt vmcnt(0)" ::: "memory");
        }
    }
    __syncthreads();
}

__device__ __forceinline__ void lerp8(const P& p, int row, int col, float* o) {
    const bf16* PROJ = (const bf16*)(p.ws + WS_PROJ);
    float cur[8], prv[8];
    unpack8(*(const u32x4*)(PROJ + (size_t)row * PLD + col), cur);
    if (row >= MPR) { const float* s = p.in[2] + (size_t)(row - MPR) * RPJ + col; const f32x4 a = *(const f32x4*)s, b = *(const f32x4*)(s + 4);
        prv[0] = a[0]; prv[1] = a[1]; prv[2] = a[2]; prv[3] = a[3]; prv[4] = b[0]; prv[5] = b[1]; prv[6] = b[2]; prv[7] = b[3]; }
    else if ((row & (SEQ - 1)) == 0) {
#pragma unroll
        for (int i = 0; i < 8; ++i) prv[i] = 0.f; }
    else unpack8(*(const u32x4*)(PROJ + (size_t)(row - 1) * PLD + col), prv);
    const float* mu = p.in[7] + col; const f32x4 m0 = *(const f32x4*)mu, m1 = *(const f32x4*)(mu + 4);
#pragma unroll
    for (int i = 0; i < 4; ++i) { o[i] = cur[i] + (prv[i] - cur[i]) * m0[i]; o[4 + i] = cur[4 + i] + (prv[4 + i] - cur[4 + i]) * m1[i]; }
}
__device__ __forceinline__ float lerp1(const P& p, int row, int col) {
    const bf16* PROJ = (const bf16*)(p.ws + WS_PROJ);
    const float cur = bf2f(PROJ[(size_t)row * PLD + col]); float prv;
    if (row >= MPR) prv = p.in[2][(size_t)(row - MPR) * RPJ + col];
    else if ((row & (SEQ - 1)) == 0) prv = 0.f;
    else prv = bf2f(PROJ[(size_t)(row - 1) * PLD + col]);
    return cur + (prv - cur) * p.in[7][col];
}

__device__ __forceinline__ void transpose_item(const float* W, int K, int N, bf16* WT, float* scr, int item, int lane) {
    const int nblk = (N + 31) / 32, kb = item / nblk, nb = item % nblk, k0 = 64 * kb, n0 = 32 * nb;
#pragma unroll 8
    for (int i = 0; i < 32; ++i) { const int kk = 2 * i + (lane >> 5), n = n0 + (lane & 31); scr[kk * 33 + (lane & 31)] = (n < N) ? W[(size_t)(k0 + kk) * N + n] : 0.f; }
    LDS_FENCE();
    const int c = lane & 7;
#pragma unroll
    for (int j = 0; j < 4; ++j) { const int n = (lane >> 3) + 8 * j; const float* s = scr + (8 * c) * 33 + n;
        u32x4 o; o.x = pkbf(s[0 * 33], s[1 * 33]); o.y = pkbf(s[2 * 33], s[3 * 33]); o.z = pkbf(s[4 * 33], s[5 * 33]); o.w = pkbf(s[6 * 33], s[7 * 33]);
        *(u32x4*)(WT + (size_t)(n0 + n) * K + k0 + 8 * c) = o; }
    LDS_FENCE();
}

__device__ __forceinline__ void phase0(const P& p_in, unsigned char* smem) {
    PHASE_PROLOGUE;
    const int lane = tid & 63, wave = tid >> 6, G = gridDim.x, bid = blockIdx.x;
    const int gw = bid * 8 + wave, NGW = G * 8; const size_t gt = (size_t)bid * 512 + tid, NGT = (size_t)G * 512;
    bf16* XB = (bf16*)(p.ws + WS_XB);
    for (size_t i = gt; i < (size_t)MTOT * DM / 8; i += NGT) { const size_t e = i * 8; const float* src = e < (size_t)MPR * DM ? p.in[0] + e : p.in[1] + (e - (size_t)MPR * DM);
        const f32x4 a = *(const f32x4*)src, b = *(const f32x4*)(src + 4); u32x4 o; o.x = pkbf(a[0], a[1]); o.y = pkbf(a[2], a[3]); o.z = pkbf(b[0], b[1]); o.w = pkbf(b[2], b[3]); *(u32x4*)(XB + e) = o; }
    float* scr = (float*)(smem + wave * 8448);
    constexpr int I_IN = 16 * 105, I_WU = 16, I_AU = 16, I_GU = 32;
    constexpr int NIT = I_IN + I_WU + I_AU + I_GU;
    for (int it = gw; it < NIT; it += NGW) {
        int r = it;
        if (r < I_IN) { transpose_item(p.in[6], 1024, PROJN, (bf16*)(p.ws + WS_WIN), scr, r, lane); continue; } r -= I_IN;
        if (r < I_WU) { transpose_item(p.in[9], 64, 512, (bf16*)(p.ws + WS_LORA), scr, r, lane); continue; } r -= I_WU;
        if (r < I_AU) { transpose_item(p.in[11], 64, 512, (bf16*)(p.ws + WS_LORA + 65536), scr, r, lane); continue; } r -= I_AU;
        transpose_item(p.in[12], 128, 512, (bf16*)(p.ws + WS_LORA + 131072), scr, r, lane);
    }
    for (size_t i = gt; i < (size_t)MSM * 2048 / 4; i += NGT) { const size_t idx = i * 4, b = idx >> 11, rem = idx & 2047;
        *(f32x4*)(p.out + O_CONVS + b * 3072 + rem) = *(const f32x4*)(p.in[4] + b * 3072 + 1024 + rem); }
}

__device__ __forceinline__ void phase0_late(const P& p_in, unsigned char* smem, int first, int which) {
    PHASE_PROLOGUE;
    const int lane = tid & 63, wave = tid >> 6, G = gridDim.x, bid = blockIdx.x;
    if (bid < first) return;
    const int gw = (bid - first) * 8 + wave, NGW = (G - first) * 8;
    float* scr = (float*)(smem + wave * 8448);
    constexpr int I_OUT = 16 * 32, I_F1 = 16 * 128, I_F2 = 64 * 32;
    const int lo = which ? I_OUT + I_F1 : 0, hi = which ? I_OUT + I_F1 + I_F2 : I_OUT + I_F1;
    for (int it = lo + gw; it < hi; it += NGW) {
        int r = it;
        if (r < I_OUT) { transpose_item(p.in[24], 1024, 1024, (bf16*)(p.ws + WS_WOUT), scr, r, lane); continue; } r -= I_OUT;
        if (r < I_F1) { transpose_item(p.in[27], 1024, 4096, (bf16*)(p.ws + WS_WFF1), scr, r, lane); continue; } r -= I_F1;
        transpose_item(p.in[28], 4096, 1024, (bf16*)(p.ws + WS_WFF2), scr, r, lane);
    }
}

template <int RG, int K, class F> __device__ __forceinline__ void small_gemm(const bf16* A, const bf16* Bt, int N, unsigned char* smem, const F& epi, int first = 0) {
    int tid = threadIdx.x; asm volatile("" : "+v"(tid));
    const int lane = tid & 63, wave = tid >> 6, r = lane & 15, q = lane >> 4;
    constexpr int KS = K / 8, NST = KS / 32, RGN = 8 / RG;
    const int nunits = ((N + 15) / 16) * RGN;
    float* part = (float*)smem;
    for (int u = (int)gridDim.x - 1 - (int)blockIdx.x; u < nunits && (int)blockIdx.x >= first; u += (int)gridDim.x - first) {
        const int ct = u / RGN, rg = u - ct * RGN, n0 = ct * 16;
        f32x4 acc[RG];
#pragma unroll
        for (int t = 0; t < RG; ++t) acc[t] = (f32x4){0.f, 0.f, 0.f, 0.f};
        const bf16* ap = A + (size_t)(rg * RG * 16 + r) * K + wave * KS + q * 8;
        const bf16* bp = Bt + (size_t)(n0 + r) * K + wave * KS + q * 8;
#pragma unroll 8
        for (int ks = 0; ks < NST; ++ks) {
            const bf16x8 b = *(const bf16x8*)(bp + ks * 32);
#pragma unroll
            for (int t = 0; t < RG; ++t) acc[t] = mfma16(*(const bf16x8*)(ap + (size_t)t * 16 * K + ks * 32), b, acc[t]);
        }
#pragma unroll
        for (int t = 0; t < RG; ++t)
#pragma unroll
            for (int j = 0; j < 4; ++j) part[(wave * RG + t) * 256 + (q * 4 + j) * 16 + r] = acc[t][j];
        __syncthreads();
        for (int e = tid; e < RG * 256; e += 512) { const int t = e >> 8, idx = e & 255; float v = 0.f;
#pragma unroll
            for (int w = 0; w < 8; ++w) v += part[(w * RG + t) * 256 + idx];
            const int col = n0 + (idx & 15);
            if (col < N) epi((rg * RG + t) * 16 + (idx >> 4), col, v); }
        __syncthreads();
    }
}

__device__ __forceinline__ void phase_prep(const P& p_in, unsigned char* smem) {
    PHASE_PROLOGUE;
    const int lane = tid & 63, wave = tid >> 6, G = gridDim.x, bid = blockIdx.x, r = lane & 15, q = lane >> 4;
    const bf16* WUPT = (const bf16*)(p.ws + WS_LORA); const bf16* AUPT = (const bf16*)(p.ws + WS_LORA + 65536); const bf16* GUPT = (const bf16*)(p.ws + WS_LORA + 131072);
    const bf16* PROJ = (const bf16*)(p.ws + WS_PROJ);
    float* WD = p.out + OS_WD; bf16* GG = (bf16*)(p.out + OS_GG);
    bf16* KP = (bf16*)(p.ws + WS_KP); bf16* KK = (bf16*)(p.ws + WS_KK); bf16* KB = (bf16*)(p.ws + WS_KB);
    bf16* WU = (bf16*)smem; bf16* AU = WU + 64 * 72; bf16* GU = AU + 64 * 72;
    bf16* kcur = (bf16*)(smem + 35840 + wave * 4608); bf16* kprv = kcur + 16 * 72;
#pragma unroll 1
    for (int tile = bid; tile < MTOT / 128; tile += G) {
        const int item = tile * 8 + wave, rowa = item * 16 + r;
        bf16x8 aw[2], aa[2], ag[4];
        float u[8];
#pragma unroll
        for (int ks = 0; ks < 2; ++ks) { lerp8(p, rowa, 1536 + ks * 32 + q * 8, u);
#pragma unroll
            for (int i = 0; i < 8; ++i) u[i] = tanh_(u[i]);
            aw[ks] = __builtin_bit_cast(bf16x8, pack8(u)); }
#pragma unroll
        for (int ks = 0; ks < 2; ++ks) { lerp8(p, rowa, 1600 + ks * 32 + q * 8, u); aa[ks] = __builtin_bit_cast(bf16x8, pack8(u)); }
#pragma unroll
        for (int ks = 0; ks < 4; ++ks) { lerp8(p, rowa, 1664 + ks * 32 + q * 8, u);
#pragma unroll
            for (int i = 0; i < 8; ++i) u[i] = sigm(u[i]);
            ag[ks] = __builtin_bit_cast(bf16x8, pack8(u)); }
        u32x4 pw, pa, pg[2];
#define PREP_LOAD(hh_) do { const int c_ = tid >> 3, k8_ = (tid & 7) * 8; \
            pw = *(const u32x4*)(WUPT + (size_t)((hh_) * 64 + c_) * 64 + k8_); pa = *(const u32x4*)(AUPT + (size_t)((hh_) * 64 + c_) * 64 + k8_); \
            _Pragma("unroll") for (int i = 0; i < 2; ++i) { const int pc_ = tid + i * 512, c2_ = pc_ >> 4, k82_ = (pc_ & 15) * 8; pg[i] = *(const u32x4*)(GUPT + (size_t)((hh_) * 64 + c2_) * 128 + k82_); } } while (0)
        PREP_LOAD(0);
#pragma unroll 1
        for (int h = 0; h < 8; ++h) {
            __syncthreads();
            { const int c = tid >> 3, k8 = (tid & 7) * 8;
              *(u32x4*)(WU + c * 72 + k8) = pw; *(u32x4*)(AU + c * 72 + k8) = pa;
#pragma unroll
              for (int i = 0; i < 2; ++i) { const int pc = tid + i * 512, c2 = pc >> 4, k82 = (pc & 15) * 8; *(u32x4*)(GU + c2 * 136 + k82) = pg[i]; } }
#pragma unroll
            for (int i = 0; i < 2; ++i) { const int pc = lane + i * 64, rr = pc >> 3, c8 = (pc & 7) * 8, row = item * 16 + rr, col = 512 + h * 64 + c8;
                *(u32x4*)(kcur + rr * 72 + c8) = *(const u32x4*)(PROJ + (size_t)row * PLD + col);
                u32x4 pv = {0u, 0u, 0u, 0u};
                if (row >= MPR) { const float* sp = p.in[2] + (size_t)(row - MPR) * RPJ + col; const f32x4 a = *(const f32x4*)sp, b = *(const f32x4*)(sp + 4); pv.x = pkbf(a[0], a[1]); pv.y = pkbf(a[2], a[3]); pv.z = pkbf(b[0], b[1]); pv.w = pkbf(b[2], b[3]); }
                else if ((row & (SEQ - 1)) != 0) pv = *(const u32x4*)(PROJ + (size_t)(row - 1) * PLD + col);
                *(u32x4*)(kprv + rr * 72 + c8) = pv; }
            if (h + 1 < 8) PREP_LOAD(h + 1);
            __syncthreads();
            float ss[4] = {0.f, 0.f, 0.f, 0.f};
#pragma unroll
            for (int ctl = 0; ctl < 4; ++ctl) { const int cl = ctl * 16 + r, col = h * 64 + cl; const float kkc = p.in[13][col], muc = p.in[7][512 + col];
#pragma unroll
                for (int j = 0; j < 4; ++j) { const float kc = bf2f(kcur[(q * 4 + j) * 72 + cl]), kv = bf2f(kprv[(q * 4 + j) * 72 + cl]); const float kr = (kc + (kv - kc) * muc) * kkc; ss[j] += kr * kr; } }
#pragma unroll
            for (int j = 0; j < 4; ++j) { ss[j] = sum16(ss[j]); ss[j] = rsqrtf(fmaxf(ss[j], 1e-24f)); }
#pragma unroll 1
            for (int ctl = 0; ctl < 4; ++ctl) {
                const int cl = ctl * 16 + r, col = h * 64 + cl;
                f32x4 cw = {0.f, 0.f, 0.f, 0.f}, ca = cw, cgt = cw;
#pragma unroll
                for (int ks = 0; ks < 2; ++ks) { cw = mfma16(aw[ks], *(const bf16x8*)(WU + cl * 72 + ks * 32 + q * 8), cw); ca = mfma16(aa[ks], *(const bf16x8*)(AU + cl * 72 + ks * 32 + q * 8), ca); }
#pragma unroll
                for (int ks = 0; ks < 4; ++ks) cgt = mfma16(ag[ks], *(const bf16x8*)(GU + cl * 136 + ks * 32 + q * 8), cgt);
                const float w0c = p.in[8][col], a0c = p.in[10][col], kkc = p.in[13][col], kac = p.in[14][col], muc = p.in[7][512 + col];
#pragma unroll
                for (int j = 0; j < 4; ++j) {
                    const int row = item * 16 + q * 4 + j; const size_t o = (size_t)row * 512 + col;
                    const float wl = -softplus(-(w0c + cw[j])) - 0.5f;
                    WD[o] = __expf(-__expf(wl));
                    const float a = sigm(a0c + ca[j]);
                    GG[o] = f2bf(cgt[j]);
                    const float kc = bf2f(kcur[(q * 4 + j) * 72 + cl]), kv = bf2f(kprv[(q * 4 + j) * 72 + cl]); const float k = kc + (kv - kc) * muc;
                    KP[o] = f2bf(k * (1.f + (a - 1.f) * kac));
                    const float kk = k * kkc * ss[j];
                    KK[o] = f2bf(kk); KB[o] = f2bf(kk * a);
                }
            }
        }
    }
    __syncthreads();
#undef PREP_LOAD
    bf16* XBC = (bf16*)(p.ws + WS_XBC);
    const int ntl = MTOT / 128, cb = (G > ntl + 32) ? ntl : 0;
    if (bid < cb) return;
    const size_t gt = (size_t)(bid - cb) * 512 + tid, NGT = (size_t)(G - cb) * 512;
    for (size_t idx = gt; idx < (size_t)MPR * 128; idx += NGT) {
        const int row = (int)(idx >> 7), c0 = (int)(idx & 127) * 8, t = row & (SEQ - 1);
        float acc[8], x[8];
        { const f32x4 b0 = *(const f32x4*)(p.in[19] + c0), b1 = *(const f32x4*)(p.in[19] + c0 + 4);
#pragma unroll
          for (int i = 0; i < 4; ++i) { acc[i] = b0[i]; acc[4 + i] = b1[i]; } }
#pragma unroll
        for (int d = 0; d < 4; ++d) { if (t - 3 + d < 0) continue;
            unpack8(*(const u32x4*)(PROJ + (size_t)(row - 3 + d) * PLD + 2304 + c0), x);
            const f32x4 w0 = *(const f32x4*)(p.in[18] + d * 1024 + c0), w1 = *(const f32x4*)(p.in[18] + d * 1024 + c0 + 4);
#pragma unroll
            for (int i = 0; i < 4; ++i) { acc[i] += w0[i] * x[i]; acc[4 + i] += w1[i] * x[4 + i]; } }
#pragma unroll
        for (int i = 0; i < 8; ++i) acc[i] = silu(acc[i]);
        *(u32x4*)(XBC + (size_t)row * 1024 + c0) = pack8(acc);
    }
}

constexpr int TC = 32, SBUF = 5 * TC * 64 + TC * 16 + TC * 2;
struct StageRegs { f32x4 w0, w1; u32x4 kp, kk, kb, rc, rp, vc, vp; };
__device__ __forceinline__ void scan_issue(const P& p, StageRegs& R, int row0, int h, int vq, int st) {
    const float* WD = p.out + OS_WD; const bf16* KP = (const bf16*)(p.ws + WS_KP); const bf16* KK = (const bf16*)(p.ws + WS_KK); const bf16* KB = (const bf16*)(p.ws + WS_KB); const bf16* PROJ = (const bf16*)(p.ws + WS_PROJ);
    const int tt = st >> 3, k8 = (st & 7) * 8, row = row0 + tt, prow = (row & (SEQ - 1)) ? row - 1 : row; const size_t o = (size_t)row * 512 + h * 64 + k8;
    R.w0 = *(const f32x4*)(WD + o); R.w1 = *(const f32x4*)(WD + o + 4); R.kp = *(const u32x4*)(KP + o); R.kk = *(const u32x4*)(KK + o); R.kb = *(const u32x4*)(KB + o);
    R.rc = *(const u32x4*)(PROJ + (size_t)row * PLD + h * 64 + k8); R.rp = *(const u32x4*)(PROJ + (size_t)prow * PLD + h * 64 + k8);
    if (st < 64) { const int t2 = st >> 1, v8 = (st & 1) * 8, row2 = row0 + t2, prow2 = (row2 & (SEQ - 1)) ? row2 - 1 : row2;
        R.vc = *(const u32x4*)(PROJ + (size_t)row2 * PLD + 1024 + h * 64 + vq * 16 + v8); R.vp = *(const u32x4*)(PROJ + (size_t)prow2 * PLD + 1024 + h * 64 + vq * 16 + v8); }
}
__device__ __forceinline__ void scan_commit(const StageRegs& R, float* B, int row0, int st, const float* mur, const float* muv) {
    const int tt = st >> 3, k8 = (st & 7) * 8; float kp[8], kb[8], v[8], rc[8], rp[8];
    *(f32x4*)(B + tt * 64 + k8) = R.w0; *(f32x4*)(B + tt * 64 + k8 + 4) = R.w1;
    unpack8(R.kp, kp); *(f32x4*)(B + TC * 64 + tt * 64 + k8) = (f32x4){kp[0], kp[1], kp[2], kp[3]}; *(f32x4*)(B + TC * 64 + tt * 64 + k8 + 4) = (f32x4){kp[4], kp[5], kp[6], kp[7]};
    unpack8(R.kk, v); *(f32x4*)(B + 2 * TC * 64 + tt * 64 + k8) = (f32x4){-v[0], -v[1], -v[2], -v[3]}; *(f32x4*)(B + 2 * TC * 64 + tt * 64 + k8 + 4) = (f32x4){-v[4], -v[5], -v[6], -v[7]};
    unpack8(R.kb, kb); *(f32x4*)(B + 3 * TC * 64 + tt * 64 + k8) = (f32x4){kb[0], kb[1], kb[2], kb[3]}; *(f32x4*)(B + 3 * TC * 64 + tt * 64 + k8 + 4) = (f32x4){kb[4], kb[5], kb[6], kb[7]};
    unpack8(R.rc, rc); unpack8(R.rp, rp); const float pz = ((row0 + tt) & (SEQ - 1)) ? 1.f : 0.f;
    float c1 = 0.f, c2 = 0.f;
#pragma unroll
    for (int j = 0; j < 8; ++j) { v[j] = rc[j] + (rp[j] * pz - rc[j]) * mur[j]; c1 += kb[j] * v[j]; c2 += kp[j] * v[j]; }
    *(f32x4*)(B + 4 * TC * 64 + tt * 64 + k8) = (f32x4){R.w0[0] * v[0], R.w0[1] * v[1], R.w0[2] * v[2], R.w0[3] * v[3]}; *(f32x4*)(B + 4 * TC * 64 + tt * 64 + k8 + 4) = (f32x4){R.w1[0] * v[4], R.w1[1] * v[5], R.w1[2] * v[6], R.w1[3] * v[7]};
    c1 += __shfl_xor(c1, 1); c2 += __shfl_xor(c2, 1); c1 += __shfl_xor(c1, 2); c2 += __shfl_xor(c2, 2); c1 += __shfl_xor(c1, 4); c2 += __shfl_xor(c2, 4);
    if ((st & 7) == 0) { B[5 * TC * 64 + TC * 16 + tt * 2] = c1; B[5 * TC * 64 + TC * 16 + tt * 2 + 1] = c2; }
    if (st < 64) { const int t2 = st >> 1, v8 = (st & 1) * 8; unpack8(R.vc, rc); unpack8(R.vp, rp); const float pz2 = ((row0 + t2) & (SEQ - 1)) ? 1.f : 0.f;
#pragma unroll
        for (int j = 0; j < 8; ++j) v[j] = rc[j] + (rp[j] * pz2 - rc[j]) * muv[j];
        *(f32x4*)(B + 5 * TC * 64 + t2 * 16 + v8) = (f32x4){v[0], v[1], v[2], v[3]}; *(f32x4*)(B + 5 * TC * 64 + t2 * 16 + v8 + 4) = (f32x4){v[4], v[5], v[6], v[7]}; }
}
struct ScanIn { f32x4 w, kp, ka, kb, wr; float vv, c1, c2; };
__device__ __forceinline__ ScanIn scan_load(const float* B, int tt, int kg, int rloc) {
    ScanIn s; s.w = *(const f32x4*)(B + tt * 64 + kg * 4); s.kp = *(const f32x4*)(B + TC * 64 + tt * 64 + kg * 4); s.ka = *(const f32x4*)(B + 2 * TC * 64 + tt * 64 + kg * 4);
    s.kb = *(const f32x4*)(B + 3 * TC * 64 + tt * 64 + kg * 4); s.wr = *(const f32x4*)(B + 4 * TC * 64 + tt * 64 + kg * 4);
    s.vv = B[5 * TC * 64 + tt * 16 + rloc]; s.c1 = B[5 * TC * 64 + TC * 16 + tt * 2]; s.c2 = B[5 * TC * 64 + TC * 16 + tt * 2 + 1]; return s;
}
__device__ __forceinline__ void phase_scan(const P& p_in, unsigned char* smem) {
    PHASE_PROLOGUE;
    const int lane = tid & 63, wave = tid >> 6;
    float* buf0 = (float*)smem; float* ybuf = buf0 + 2 * SBUF;
    bf16* YR = (bf16*)(p.ws + WS_XB);
    constexpr int NCH = SEQ / TC;
    for (int unit = blockIdx.x; unit < 256; unit += gridDim.x) {
        const int xcd = unit & 7, slot = unit >> 3, bh = xcd * 8 + (slot >> 2), vq = slot & 3, b = bh >> 3, h = bh & 7, rowbase = b * SEQ;
        bf16* yu = YR + (size_t)(bh * 4 + vq) * SEQ * 16;
        const int st = tid - 256;
        StageRegs R; float mur[8], muv[8];
        if (wave >= 4) {
#pragma unroll
            for (int j = 0; j < 8; ++j) { mur[j] = p.in[7][h * 64 + (st & 7) * 8 + j]; muv[j] = p.in[7][1024 + h * 64 + vq * 16 + (st & 1) * 8 + j]; }
            scan_issue(p, R, rowbase, h, vq, st); scan_commit(R, buf0, rowbase, st, mur, muv); scan_issue(p, R, rowbase + TC, h, vq, st);
        }
        __syncthreads();
        float S0 = 0.f, S1 = 0.f, S2 = 0.f, S3 = 0.f;
        const int rl = lane >> 4, kg = lane & 15, rloc = (wave & 3) * 4 + rl;
        for (int c = 0; c < NCH; ++c) {
            if (wave < 4) {
                const float* B = buf0 + (c & 1) * SBUF; float* yb = ybuf + (c & 1) * (TC * 16);
                ScanIn cur = scan_load(B, 0, kg, rloc);
#pragma unroll 4
                for (int tt = 0; tt < TC; ++tt) {
                    const ScanIn nxt = scan_load(B, (tt + 1) & (TC - 1), kg, rloc);
                    float sa = (S0 * cur.ka[0] + S1 * cur.ka[1]) + (S2 * cur.ka[2] + S3 * cur.ka[3]);
                    float y1 = (S0 * cur.wr[0] + S1 * cur.wr[1]) + (S2 * cur.wr[2] + S3 * cur.wr[3]);
                    sa += dppf<0xB1>(sa); y1 += dppf<0xB1>(y1); sa += dppf<0x4E>(sa); y1 += dppf<0x4E>(y1);
                    sa += dppf<0x141>(sa); y1 += dppf<0x141>(y1); sa += dppf<0x140>(sa); y1 += dppf<0x140>(y1);
                    S0 = S0 * cur.w[0] + (sa * cur.kb[0] + cur.vv * cur.kp[0]); S1 = S1 * cur.w[1] + (sa * cur.kb[1] + cur.vv * cur.kp[1]);
                    S2 = S2 * cur.w[2] + (sa * cur.kb[2] + cur.vv * cur.kp[2]); S3 = S3 * cur.w[3] + (sa * cur.kb[3] + cur.vv * cur.kp[3]);
                    if (kg == 0) yb[tt * 16 + rloc] = y1 + sa * cur.c1 + cur.vv * cur.c2;
                    cur = nxt;
                }
            } else {
                if (c + 1 < NCH) scan_commit(R, buf0 + ((c + 1) & 1) * SBUF, rowbase + (c + 1) * TC, st, mur, muv);
                if (c + 2 < NCH) scan_issue(p, R, rowbase + (c + 2) * TC, h, vq, st);
                if (c > 0) { const float* yp = ybuf + ((c - 1) & 1) * (TC * 16); const int i2 = st * 2;
                    *(unsigned*)(yu + (size_t)(c - 1) * TC * 16 + i2) = pkbf(yp[i2], yp[i2 + 1]); }
            }
            __syncthreads();
        }
        if (wave >= 4) { const float* yp = ybuf + ((NCH - 1) & 1) * (TC * 16); const int i2 = st * 2;
            *(unsigned*)(yu + (size_t)(NCH - 1) * TC * 16 + i2) = pkbf(yp[i2], yp[i2 + 1]); }
        else *(f32x4*)(p.out + O_WKVP + ((size_t)(bh * 64 + vq * 16 + rloc)) * 64 + kg * 4) = (f32x4){S0, S1, S2, S3};
        __syncthreads();
    }
}


constexpr int CK = 16, NCHAIN = 2, NHELP = 8 - NCHAIN, SLOTB = 22912, NCHK = SEQ / CK, SCAN_WGS = 256 / NCHAIN;
constexpr int SO_AT = 0, SO_RT = 2304, SO_BT = 4608, SO_KT = 6912, SO_BH = 9216, SO_KH = 12288, SO_NAK = 15360, SO_NBR = 16128, SO_NKR = 16896, SO_TT = 17664, SO_VT = 18432, SO_DC = 21504, SO_NAB = 21760;
constexpr int CR_SB = NHELP * SLOTB, FL_OFF = CR_SB + NCHAIN * 3072;
static_assert(FL_OFF + 256 <= MISC_OFF, "scan LDS map");
struct HelpRegs { f32x4 w0, w1; u32x4 kp, kk, kb, rc, rp, vc, vp; };
__device__ __forceinline__ void help_issue(const P& p, HelpRegs (&R)[2], int row0, int h, int lane) {
    const float* WD = p.out + OS_WD; const bf16* KP = (const bf16*)(p.ws + WS_KP); const bf16* KK = (const bf16*)(p.ws + WS_KK); const bf16* KB = (const bf16*)(p.ws + WS_KB); const bf16* PROJ = (const bf16*)(p.ws + WS_PROJ);
#pragma unroll
    for (int i = 0; i < 2; ++i) { const int pc = lane + i * 64, tt = pc & 15, k8 = (pc >> 4) * 8, row = row0 + tt, prow = (row & (SEQ - 1)) ? row - 1 : row; const size_t o = (size_t)row * 512 + h * 64 + k8;
        R[i].w0 = *(const f32x4*)(WD + o); R[i].w1 = *(const f32x4*)(WD + o + 4); R[i].kp = *(const u32x4*)(KP + o); R[i].kk = *(const u32x4*)(KK + o); R[i].kb = *(const u32x4*)(KB + o);
        R[i].rc = *(const u32x4*)(PROJ + (size_t)row * PLD + h * 64 + k8); R[i].rp = *(const u32x4*)(PROJ + (size_t)prow * PLD + h * 64 + k8);
        R[i].vc = *(const u32x4*)(PROJ + (size_t)row * PLD + 1024 + h * 64 + k8); R[i].vp = *(const u32x4*)(PROJ + (size_t)prow * PLD + 1024 + h * 64 + k8); }
}
__device__ __forceinline__ void phase_scan2(const P& p_in, unsigned char* smem) {
    PHASE_PROLOGUE;
    const int lane = tid & 63, wave = tid >> 6, r = lane & 15, q = lane >> 4;
    bf16* YR = (bf16*)(p.ws + WS_XB);
    volatile unsigned* flags = (volatile unsigned*)(smem + FL_OFF);
    const bf16x8 zero8 = {0, 0, 0, 0, 0, 0, 0, 0};
    for (int unit = blockIdx.x; unit < SCAN_WGS; unit += SCAN_WGS) {
        const int ub = unit / (4 / NCHAIN), part = unit % (4 / NCHAIN), bh = (ub & 7) * 8 + (ub >> 3), vq = part * NCHAIN + (wave % NCHAIN), b = bh >> 3, h = bh & 7, rowbase = b * SEQ;
        if (tid < 64) flags[tid] = 0u;
        __syncthreads();
        if (wave < NCHAIN) {
            __builtin_amdgcn_s_setprio(3);
            bf16* yu = YR + (size_t)(bh * 4 + vq) * SEQ * 16;
            f32x4 ST[4];
#pragma unroll
            for (int mt = 0; mt < 4; ++mt) ST[mt] = (f32x4){0.f, 0.f, 0.f, 0.f};
            for (int c = 0; c < NCHK; ++c) {
                const int slot = c % NHELP; unsigned char* sb = smem + slot * SLOTB;
                const bf16* AT = (const bf16*)(sb + SO_AT); const bf16* RT = (const bf16*)(sb + SO_RT); const bf16* BH = (const bf16*)(sb + SO_BH); const bf16* KH = (const bf16*)(sb + SO_KH);
                const bf16* NAK = (const bf16*)(sb + SO_NAK); const bf16* NBR = (const bf16*)(sb + SO_NBR); const bf16* NKR = (const bf16*)(sb + SO_NKR); const bf16* TT = (const bf16*)(sb + SO_TT);
                const bf16* VT = (const bf16*)(sb + SO_VT) + vq * 16 * 24; const float* DC = (const float*)(sb + SO_DC);
                s16x4 sb4[4];
#pragma unroll
                for (int mt = 0; mt < 4; ++mt) sb4[mt] = cvt4(ST[mt]);
                { unsigned sp = 0; while (flags[slot] != (unsigned)(c + 1)) { __builtin_amdgcn_s_sleep(1); if (++sp > (1u << 22)) break; } }
                asm volatile("" ::: "memory");
                s16x4 fa[4], fr[4], fbh[4], fkh[4]; f32x4 dcv[4];
#pragma unroll
                for (int mt = 0; mt < 4; ++mt) { fa[mt] = *(const s16x4*)(AT + r * 72 + mt * 16 + q * 4); fr[mt] = *(const s16x4*)(RT + r * 72 + mt * 16 + q * 4);
                    fbh[mt] = *(const s16x4*)(BH + (mt * 16 + r) * 24 + q * 4); fkh[mt] = *(const s16x4*)(KH + (mt * 16 + r) * 24 + q * 4); dcv[mt] = *(const f32x4*)(DC + mt * 16 + q * 4); }
                const s16x4 fnak = *(const s16x4*)(NAK + lane * 4), ftt = *(const s16x4*)(TT + lane * 4), fnbr = *(const s16x4*)(NBR + lane * 4), fnkr = *(const s16x4*)(NKR + lane * 4);
                const s16x4 fvt = *(const s16x4*)(VT + r * 24 + q * 4);
                LDS_FENCE();
                if (lane == 0) flags[8 + slot * NCHAIN + wave] = (unsigned)(c + 1);
                f32x4 Wt = {0.f, 0.f, 0.f, 0.f};
#pragma unroll
                for (int mt = 0; mt < 4; ++mt) Wt = mf16(fa[mt], sb4[mt], Wt);
                Wt = mf16(fnak, fvt, Wt);
                f32x4 Ut = {0.f, 0.f, 0.f, 0.f};
                Ut = mf16(ftt, cvt4(Wt), Ut);
                const s16x4 ub = cvt4(Ut);
#pragma unroll
                for (int mt = 0; mt < 4; ++mt) { ST[mt] = ST[mt] * dcv[mt]; ST[mt] = mf16(fbh[mt], ub, ST[mt]); ST[mt] = mf16(fkh[mt], fvt, ST[mt]); }
                f32x4 Yt = {0.f, 0.f, 0.f, 0.f};
#pragma unroll
                for (int mt = 0; mt < 4; ++mt) Yt = mf16(fr[mt], sb4[mt], Yt);
                Yt = mf16(fnbr, ub, Yt); Yt = mf16(fnkr, fvt, Yt);
#pragma unroll
                for (int j = 0; j < 4; ++j) yu[(size_t)(c * CK + q * 4 + j) * 16 + r] = f2bf(Yt[j]);
            }
#pragma unroll
            for (int mt = 0; mt < 4; ++mt) *(f32x4*)(p.out + O_WKVP + ((size_t)(bh * 64 + vq * 16 + r)) * 64 + mt * 16 + q * 4) = ST[mt];
            __builtin_amdgcn_s_setprio(0);
        } else {
            const int hw = wave - NCHAIN; unsigned char* sb = smem + hw * SLOTB;
            bf16* AT = (bf16*)(sb + SO_AT); bf16* RT = (bf16*)(sb + SO_RT); bf16* BT = (bf16*)(sb + SO_BT); bf16* KT = (bf16*)(sb + SO_KT); bf16* BH = (bf16*)(sb + SO_BH); bf16* KH = (bf16*)(sb + SO_KH);
            bf16* NAK = (bf16*)(sb + SO_NAK); bf16* NBR = (bf16*)(sb + SO_NBR); bf16* NKR = (bf16*)(sb + SO_NKR); bf16* TT = (bf16*)(sb + SO_TT); bf16* VT = (bf16*)(sb + SO_VT);
            float* DC = (float*)(sb + SO_DC); float* NAB = (float*)(sb + SO_NAB); float* WR = (float*)(sb + SO_BH);
            float mur[2][8], muv[2][8];
#pragma unroll
            for (int i = 0; i < 2; ++i)
#pragma unroll
                for (int j = 0; j < 8; ++j) { mur[i][j] = p.in[7][h * 64 + ((lane + i * 64) >> 4) * 8 + j]; muv[i][j] = p.in[7][1024 + h * 64 + ((lane + i * 64) >> 4) * 8 + j]; }
            HelpRegs R[2];
            help_issue(p, R, rowbase + hw * CK, h, lane);
            for (int c = hw; c < NCHK; c += NHELP) {
                if (c >= NHELP) { const unsigned want = (unsigned)(c - NHELP + 1); unsigned sp = 0;
                    for (;;) { bool ok = true;
#pragma unroll
                        for (int w = 0; w < NCHAIN; ++w) ok = ok && (flags[8 + hw * NCHAIN + w] == want);
                        if (ok) break; __builtin_amdgcn_s_sleep(2); if (++sp > (1u << 22)) break; } }
                asm volatile("" ::: "memory");
                const int row0 = rowbase + c * CK;
#pragma unroll
                for (int i = 0; i < 2; ++i) { const int k8 = ((lane >> 4) + 4 * i) * 8, tt = lane & 15; float w[8], pre[8], suf[8], x[8], y[8], rc[8], rp[8];
#pragma unroll
                    for (int j = 0; j < 4; ++j) { w[j] = R[i].w0[j]; w[4 + j] = R[i].w1[j]; }
#pragma unroll
                    for (int j = 0; j < 8; ++j) { float a = w[j], z = w[j];
                        a *= dppo<0x111>(a); a *= dppo<0x112>(a); a *= dppo<0x114>(a); a *= dppo<0x118>(a);
                        z *= dppo<0x101>(z); z *= dppo<0x102>(z); z *= dppo<0x104>(z); z *= dppo<0x108>(z);
                        pre[j] = a; suf[j] = z * __builtin_amdgcn_rcpf(w[j]); }
                    if (tt == 15) { *(f32x4*)(DC + k8) = (f32x4){pre[0], pre[1], pre[2], pre[3]}; *(f32x4*)(DC + k8 + 4) = (f32x4){pre[4], pre[5], pre[6], pre[7]}; }
                    unpack8(R[i].kk, x);
#pragma unroll
                    for (int j = 0; j < 8; ++j) y[j] = -x[j] * dppo<0x111>(pre[j]);
                    *(u32x4*)(AT + tt * 72 + k8) = pack8(y);
                    unpack8(R[i].kb, x);
#pragma unroll
                    for (int j = 0; j < 8; ++j) { const float inv = __builtin_amdgcn_rcpf(pre[j]); rp[j] = inv; y[j] = x[j] * inv; x[j] *= suf[j]; }
                    *(u32x4*)(BT + tt * 72 + k8) = pack8(y);
#pragma unroll
                    for (int j = 0; j < 8; ++j) BH[(k8 + j) * 24 + tt] = f2bf(x[j]);
                    unpack8(R[i].kp, x);
#pragma unroll
                    for (int j = 0; j < 8; ++j) { y[j] = x[j] * rp[j]; x[j] *= suf[j]; }
                    *(u32x4*)(KT + tt * 72 + k8) = pack8(y);
#pragma unroll
                    for (int j = 0; j < 8; ++j) KH[(k8 + j) * 24 + tt] = f2bf(x[j]);
                    unpack8(R[i].rc, rc); unpack8(R[i].rp, rp); const float pz = ((row0 + tt) & (SEQ - 1)) ? 1.f : 0.f;
#pragma unroll
                    for (int j = 0; j < 8; ++j) y[j] = (rc[j] + (rp[j] * pz - rc[j]) * mur[i][j]) * pre[j];
                    *(u32x4*)(RT + tt * 72 + k8) = pack8(y);
                    unpack8(R[i].vc, rc); unpack8(R[i].vp, rp);
#pragma unroll
                    for (int j = 0; j < 8; ++j) VT[(k8 + j) * 24 + tt] = f2bf(rc[j] + (rp[j] * pz - rc[j]) * muv[i][j]); }
                if (c + NHELP < NCHK) help_issue(p, R, rowbase + (c + NHELP) * CK, h, lane);
                LDS_FENCE();
                { f32x4 nab = {0.f, 0.f, 0.f, 0.f}, nabT = nab, nak = nab, nbr = nab, nkr = nab;
#pragma unroll
                  for (int ks = 0; ks < 2; ++ks) { const bf16x8 fb = *(const bf16x8*)(BT + r * 72 + ks * 32 + q * 8), fk = *(const bf16x8*)(KT + r * 72 + ks * 32 + q * 8), fa = *(const bf16x8*)(AT + r * 72 + ks * 32 + q * 8), fr = *(const bf16x8*)(RT + r * 72 + ks * 32 + q * 8);
                      nab = mfma16(fb, fa, nab); nabT = mfma16(fa, fb, nabT); nak = mfma16(fk, fa, nak); nbr = mfma16(fb, fr, nbr); nkr = mfma16(fk, fr, nkr); }
#pragma unroll
                  for (int j = 0; j < 4; ++j) { const int i = q * 4 + j, t = r;
                      nab[j] = (i < t) ? nab[j] : 0.f; nabT[j] = (r < i) ? nabT[j] : 0.f; nak[j] = (i < t) ? nak[j] : 0.f; nbr[j] = (i <= t) ? nbr[j] : 0.f; nkr[j] = (i <= t) ? nkr[j] : 0.f; }
                  *(s16x4*)(NAK + lane * 4) = cvt4(nak); *(s16x4*)(NBR + lane * 4) = cvt4(nbr); *(s16x4*)(NKR + lane * 4) = cvt4(nkr);
                  const f32x4 z4 = {0.f, 0.f, 0.f, 0.f};
                  const s16x4 bN = cvt4(nab), bNT = cvt4(nabT);
                  const f32x4 n2 = mf16(bNT, bN, z4), n2T = mf16(bN, bNT, z4);
                  const s16x4 b2 = cvt4(n2), b2T = cvt4(n2T);
                  const f32x4 n4 = mf16(b2T, b2, z4), n4T = mf16(b2, b2T, z4);
                  const s16x4 b4 = cvt4(n4), b4T = cvt4(n4T);
                  f32x4 X = mf16(b4T, b4, z4);
#pragma unroll
                  for (int j = 0; j < 4; ++j) X[j] += (q * 4 + j == r) ? 1.f : 0.f;
                  X = mf16(b4T, cvt4(X), X);
                  X = mf16(b2T, cvt4(X), X);
                  X = mf16(bNT, cvt4(X), X);
                  *(s16x4*)(TT + lane * 4) = cvt4(X); }
                LDS_FENCE();
                if (lane == 0) flags[hw] = (unsigned)(c + 1);
            }
        }
        __syncthreads();
    }
}

__device__ __forceinline__ bf16x8 ldfrag(const bf16* base, int ld, int row0, int k0, int r, int q) { return *(const bf16x8*)(base + (row0 + r) * ld + k0 + q * 8); }
__device__ __forceinline__ void phase_ssd(const P& p_in, unsigned char* smem) {
    PHASE_PROLOGUE;
    const int lane = tid & 63, wave = tid >> 6, r = lane & 15, q = lane >> 4;
    bf16* XT = (bf16*)(smem + 53248); bf16* XdT = (bf16*)(smem + 57856); bf16* Gs = (bf16*)(smem + 62464); bf16* Hb = (bf16*)(smem + 71680); float* xsn = (float*)(smem + 80384);
    const bf16* XBC = (const bf16*)(p.ws + WS_XBC); const float* DT = (const float*)(p.ws + WS_DT); bf16* YM = (bf16*)(p.ws + WS_XB) + (size_t)MPR * 512;
    for (int unit = (int)blockIdx.x - SCAN_WGS; unit >= 0 && unit < 128; unit += 128) {
        const int bg = unit >> 3, e = (unit >> 1) & 3, ph = unit & 1, b = bg >> 1, g = bg & 1, h = g * 4 + e;
        const float A = -__expf(p.in[21][h]), Dh = p.in[22][h];
        f32x4 hacc[2] = {{0.f, 0.f, 0.f, 0.f}, {0.f, 0.f, 0.f, 0.f}};
        for (int i = tid; i < 32 * 136; i += 512) Hb[i] = 0;
        u32x4 rc[2], rb[2]; unsigned rx0, rx1; float rdt = 0.f;
#define SSD_LOAD(c_) do { const int row0_ = b * SEQ + (c_) * 64; \
            _Pragma("unroll") for (int i = 0; i < 2; ++i) { const int pc = tid + i * 512, s_ = pc >> 4, n8 = (pc & 15) * 8; \
                rc[i] = *(const u32x4*)(XBC + (size_t)(row0_ + s_) * 1024 + 768 + g * 128 + n8); rb[i] = *(const u32x4*)(XBC + (size_t)(row0_ + s_) * 1024 + 512 + g * 128 + n8); } \
            { const unsigned* xp_ = (const unsigned*)(XBC + (size_t)(row0_ + (tid >> 3)) * 1024 + h * 64 + ph * 32 + (tid & 7) * 4); rx0 = xp_[0]; rx1 = xp_[1]; } \
            if (tid < 64) rdt = DT[(size_t)(row0_ + tid) * 8 + h]; } while (0)
        SSD_LOAD(0);
        for (int c = 0; c < SEQ / 64; ++c) {
            unsigned char* sb = smem + (c & 1) * 89088; bf16* Cs = (bf16*)sb; bf16* Bs = (bf16*)(sb + 17408); bf16* BT = (bf16*)(sb + 34816);
            float* cs = (float*)(smem + ((c & 1) ? 142336 : 88576)); float* dtv = cs + 64;
#pragma unroll
            for (int i = 0; i < 2; ++i) { const int pc = tid + i * 512, s_ = pc >> 4, n8 = (pc & 15) * 8;
                *(u32x4*)(Cs + s_ * 136 + n8) = rc[i]; *(u32x4*)(Bs + s_ * 136 + n8) = rb[i];
                const unsigned w[4] = {rb[i].x, rb[i].y, rb[i].z, rb[i].w};
                const int sp = ((((s_ >> 3) ^ (pc & 7)) << 3) | (s_ & 7));
#pragma unroll
                for (int j = 0; j < 4; ++j) { BT[(n8 + 2 * j) * 72 + sp] = (bf16)(w[j] & 0xffffu); BT[(n8 + 2 * j + 1) * 72 + sp] = (bf16)(w[j] >> 16); } }
            if (wave == 0) { float v = A * rdt;
                v += dppf<0x111>(v); v += dppf<0x112>(v); v += dppf<0x114>(v); v += dppf<0x118>(v);
                v += __int_as_float(__builtin_amdgcn_update_dpp(0, __float_as_int(v), 0x142, 0xa, 0xf, false));
                v += __int_as_float(__builtin_amdgcn_update_dpp(0, __float_as_int(v), 0x143, 0xc, 0xf, false));
                cs[lane] = v; dtv[lane] = rdt; }
            __syncthreads();
            { const int s_ = tid >> 3, p4 = (tid & 7) * 4; const float dts = dtv[s_], dec = __expf(cs[63] - cs[s_]);
              const float x[4] = {bflo(rx0), bfhi(rx0), bflo(rx1), bfhi(rx1)};
#pragma unroll
              for (int j = 0; j < 4; ++j) { const float X = x[j] * dts; XT[(p4 + j) * 72 + s_] = f2bf(X); XdT[(p4 + j) * 72 + s_] = f2bf(X * dec); }
              *(f32x4*)(xsn + s_ * 32 + p4) = (f32x4){x[0], x[1], x[2], x[3]}; }
            if (c + 1 < SEQ / 64) SSD_LOAD(c + 1);
#pragma unroll
            for (int i = 0; i < 2; ++i) { const int tile = wave * 2 + i, mt = tile >> 2, nt = tile & 3; f32x4 acc = {0.f, 0.f, 0.f, 0.f};
#pragma unroll
                for (int ks = 0; ks < 4; ++ks) acc = mfma16(ldfrag(Cs, 136, mt * 16, ks * 32, r, q), ldfrag(Bs, 136, nt * 16, ks * 32, r, q), acc);
                const int s_ = nt * 16 + r; const float css = cs[s_];
#pragma unroll
                for (int j = 0; j < 4; ++j) { const int l = mt * 16 + q * 4 + j; const float gv = (s_ <= l) ? acc[j] * __expf(cs[l] - css) : 0.f; Gs[l * 72 + s_] = f2bf(gv); } }
            const int mt = wave >> 1, pt = wave & 1;
            f32x4 yacc = {0.f, 0.f, 0.f, 0.f};
#pragma unroll
            for (int ks = 0; ks < 4; ++ks) yacc = mfma16(ldfrag(Cs, 136, mt * 16, ks * 32, r, q), ldfrag(Hb, 136, pt * 16, ks * 32, r, q), yacc);
#pragma unroll
            for (int j = 0; j < 4; ++j) yacc[j] *= __expf(cs[mt * 16 + q * 4 + j]);
            __syncthreads();
#pragma unroll
            for (int ks = 0; ks < 2; ++ks) yacc = mfma16(ldfrag(Gs, 72, mt * 16, ks * 32, r, q), ldfrag(XT, 72, pt * 16, ks * 32, r, q), yacc);
#pragma unroll
            for (int j = 0; j < 4; ++j) { const int l = mt * 16 + q * 4 + j; YM[((size_t)((b * 8 + h) * 4 + ph * 2 + pt) * SEQ + c * 64 + l) * 16 + r] = f2bf(yacc[j] + Dh * xsn[l * 32 + pt * 16 + r]); }
            { const float dl = __expf(cs[63]);
#pragma unroll
              for (int t2 = 0; t2 < 2; ++t2) { hacc[t2] = hacc[t2] * dl;
#pragma unroll
                  for (int ks = 0; ks < 2; ++ks) hacc[t2] = mfma16(ldfrag(XdT, 72, t2 * 16, ks * 32, r, q), *(const bf16x8*)(BT + (wave * 16 + r) * 72 + (((ks * 4 + q) ^ ((wave * 2 + (r >> 3)) & 7)) << 3)), hacc[t2]);
#pragma unroll
                  for (int j = 0; j < 4; ++j) Hb[(t2 * 16 + q * 4 + j) * 136 + wave * 16 + r] = f2bf(hacc[t2][j]); } }
        }
#undef SSD_LOAD
#pragma unroll
        for (int t2 = 0; t2 < 2; ++t2)
#pragma unroll
            for (int j = 0; j < 4; ++j) p.out[O_SSMP + ((size_t)((b * 8 + h) * 64 + ph * 32 + t2 * 16 + q * 4 + j)) * 128 + wave * 16 + r] = hacc[t2][j];
        __syncthreads();
    }
}

__device__ __forceinline__ float conv_act_s(const P& p, int bs, int c) {
    const bf16* PROJ = (const bf16*)(p.ws + WS_PROJ); const float* sc = p.in[4] + (size_t)bs * 3072 + c; const float* cw = p.in[18] + c;
    const float v = p.in[19][c] + cw[0] * sc[0] + cw[1024] * sc[1024] + cw[2048] * sc[2048] + cw[3072] * bf2f(PROJ[(size_t)(MPR + bs) * PLD + 2304 + c]);
    return silu(v);
}
__device__ __forceinline__ void phase_sample_step(const P& p_in, unsigned char* smem) {
    PHASE_PROLOGUE;
    const int lane = tid & 63, wave = tid >> 6, G = gridDim.x, bid = blockIdx.x;
    const int first = SCAN_WGS;
    const int gw = (bid - first) * 8 + wave, NGW = (G - first) * 8;
    if (bid < first) return;
    float* sv = (float*)(smem + wave * 2048);
    const float* WD = p.out + OS_WD; const bf16* KP = (const bf16*)(p.ws + WS_KP); const bf16* KK = (const bf16*)(p.ws + WS_KK); const bf16* KB = (const bf16*)(p.ws + WS_KB);
    bf16* YS = (bf16*)(p.ws + WS_YS); const float* DT = (const float*)(p.ws + WS_DT);
    const int kq = lane & 15, rr = lane >> 4;
    for (int unit = gw; unit < 2048; unit += NGW) {
        const int bs = (unit & 1023) >> 3, h = unit & 7, row = MPR + bs;
        if (unit < 1024) {
            const size_t o = (size_t)row * 512 + h * 64 + lane;
            sv[lane] = WD[o]; sv[64 + lane] = bf2f(KP[o]); sv[128 + lane] = -bf2f(KK[o]); sv[192 + lane] = bf2f(KB[o]); sv[256 + lane] = lerp1(p, row, h * 64 + lane); sv[320 + lane] = lerp1(p, row, 1024 + h * 64 + lane);
            LDS_FENCE();
            const f32x4 w4 = *(const f32x4*)(sv + kq * 4), kp4 = *(const f32x4*)(sv + 64 + kq * 4), ka4 = *(const f32x4*)(sv + 128 + kq * 4), kb4 = *(const f32x4*)(sv + 192 + kq * 4), r4 = *(const f32x4*)(sv + 256 + kq * 4);
            const size_t so = (size_t)(bs * 8 + h) * 4096 + rr * 64 + kq * 4;
            const float* Sb = p.in[3] + so; float* Ob = p.out + O_WKVS + so;
            f32x4 S[16]; float sa[16];
#pragma unroll
            for (int i = 0; i < 16; ++i) S[i] = *(const f32x4*)(Sb + i * 256);
#pragma unroll
            for (int i = 0; i < 16; ++i) sa[i] = sum16((S[i][0] * ka4[0] + S[i][1] * ka4[1]) + (S[i][2] * ka4[2] + S[i][3] * ka4[3]));
#pragma unroll
            for (int i = 0; i < 16; ++i) { const float vv = sv[320 + 4 * i + rr]; f32x4 n;
#pragma unroll
                for (int j = 0; j < 4; ++j) n[j] = S[i][j] * w4[j] + (sa[i] * kb4[j] + vv * kp4[j]);
                *(f32x4*)(Ob + i * 256) = n;
                const float y = sum16((n[0] * r4[0] + n[1] * r4[1]) + (n[2] * r4[2] + n[3] * r4[3]));
                if (kq == 0) YS[(size_t)bs * 1024 + h * 64 + 4 * i + rr] = f2bf(y); }
            LDS_FENCE();
        } else {
            const int g = h >> 2;
            sv[lane] = conv_act_s(p, bs, 512 + g * 128 + lane); sv[64 + lane] = conv_act_s(p, bs, 512 + g * 128 + 64 + lane);
            sv[128 + lane] = conv_act_s(p, bs, 768 + g * 128 + lane); sv[192 + lane] = conv_act_s(p, bs, 768 + g * 128 + 64 + lane);
            sv[256 + lane] = conv_act_s(p, bs, h * 64 + lane);
            LDS_FENCE();
            const float dt = DT[(size_t)row * 8 + h], A = -__expf(p.in[21][h]), dA = __expf(A * dt), Dh = p.in[22][h];
            const f32x4 Bl = *(const f32x4*)(sv + kq * 4), Bh = *(const f32x4*)(sv + 64 + kq * 4), Cl = *(const f32x4*)(sv + 128 + kq * 4), Ch = *(const f32x4*)(sv + 192 + kq * 4);
            const size_t so = (size_t)(bs * 8 + h) * 8192 + rr * 128 + kq * 4;
            const float* Hb_ = p.in[5] + so; float* Ob = p.out + O_SSMS + so;
#pragma unroll
            for (int half = 0; half < 2; ++half) { f32x4 hl[8], hh[8];
#pragma unroll
                for (int i = 0; i < 8; ++i) { hl[i] = *(const f32x4*)(Hb_ + (half * 8 + i) * 512); hh[i] = *(const f32x4*)(Hb_ + (half * 8 + i) * 512 + 64); }
#pragma unroll
                for (int i = 0; i < 8; ++i) { const int pp = 4 * (half * 8 + i) + rr; const float x = sv[256 + pp], dtx = dt * x; f32x4 nl, nh; float y = 0.f;
#pragma unroll
                    for (int j = 0; j < 4; ++j) { nl[j] = hl[i][j] * dA + dtx * Bl[j]; nh[j] = hh[i][j] * dA + dtx * Bh[j]; y += nl[j] * Cl[j] + nh[j] * Ch[j]; }
                    *(f32x4*)(Ob + (half * 8 + i) * 512) = nl; *(f32x4*)(Ob + (half * 8 + i) * 512 + 64) = nh;
                    y = sum16(y) + Dh * x;
                    if (kq == 0) YS[(size_t)bs * 1024 + 512 + h * 64 + pp] = f2bf(y); } }
            LDS_FENCE();
        }
    }
}

__device__ __forceinline__ void phase_post(const P& p_in) {
    PHASE_PROLOGUE;
    const int lane = tid & 63, wave = tid >> 6, G = gridDim.x, bid = blockIdx.x;
    const int gw = bid * 8 + wave, NGW = G * 8;
    bf16* MIX = (bf16*)(p.ws + WS_MIX); const bf16* YR = (const bf16*)(p.ws + WS_XB); const bf16* YM = YR + (size_t)MPR * 512; const bf16* YS = (const bf16*)(p.ws + WS_YS);
    const bf16* PROJ = (const bf16*)(p.ws + WS_PROJ); const bf16* KP = (const bf16*)(p.ws + WS_KP); const bf16* GG = (const bf16*)(p.out + OS_GG);
    for (int row = gw; row < MTOT; row += NGW) {
        const int c0 = lane * 8;
        const size_t yo = ((size_t)(((row >> 11) * 8 + (lane >> 3)) * 4 + ((lane & 7) >> 1)) * SEQ + (row & (SEQ - 1))) * 16 + (lane & 1) * 8;
        {
            float y[8], rr[8], kp[8], vv[8], gg[8];
            unpack8(row < MPR ? *(const u32x4*)(YR + yo) : *(const u32x4*)(YS + (size_t)(row - MPR) * 1024 + c0), y);
            float s = 0.f;
#pragma unroll
            for (int i = 0; i < 8; ++i) s += y[i];
            s = sum8(s);
            const float mean = s * (1.f / 64.f); float s2 = 0.f;
#pragma unroll
            for (int i = 0; i < 8; ++i) { y[i] -= mean; s2 += y[i] * y[i]; }
            s2 = sum8(s2);
            const float rstd = rsqrtf(s2 * (1.f / 64.f) + 64e-5f);
            lerp8(p, row, c0, rr); lerp8(p, row, 1024 + c0, vv);
            unpack8(*(const u32x4*)(KP + (size_t)row * 512 + c0), kp); unpack8(*(const u32x4*)(GG + (size_t)row * 512 + c0), gg);
            float bo = 0.f;
#pragma unroll
            for (int i = 0; i < 8; ++i) bo += rr[i] * kp[i] * p.in[15][c0 + i];
            bo = sum8(bo);
#pragma unroll
            for (int i = 0; i < 8; ++i) y[i] = (y[i] * rstd * p.in[16][c0 + i] + p.in[17][c0 + i] + bo * vv[i]) * gg[i];
            *(u32x4*)(MIX + (size_t)row * 1024 + c0) = pack8(y);
        }
        {
            float y[8], z[8];
            unpack8(row < MPR ? *(const u32x4*)(YM + yo) : *(const u32x4*)(YS + (size_t)(row - MPR) * 1024 + 512 + c0), y); unpack8(*(const u32x4*)(PROJ + (size_t)row * PLD + 1792 + c0), z);
            float ss = 0.f;
#pragma unroll
            for (int i = 0; i < 8; ++i) { y[i] *= silu(z[i]); ss += y[i] * y[i]; }
            ss = sum32(ss, lane >= 32);
            const float sc = rsqrtf(ss * (1.f / 256.f) + 1e-5f);
#pragma unroll
            for (int i = 0; i < 8; ++i) y[i] = y[i] * sc * p.in[23][c0 + i];
            *(u32x4*)(MIX + (size_t)row * 1024 + 512 + c0) = pack8(y);
        }
    }
}

template <bool TO_BF16> __device__ __forceinline__ void phase_ln(const P& p_in, const float* gam, const float* bet, bf16* ob, size_t src_off, int sld) {
    PHASE_PROLOGUE;
    const int lane = tid & 63, wave = tid >> 6, G = gridDim.x, bid = blockIdx.x;
    const int gw = bid * 8 + wave, NGW = G * 8;
    const bf16* src = (const bf16*)p.out + src_off;
    for (int row = gw; row < MTOT; row += NGW) {
        float* xr = p.out + (size_t)row * 1024 + lane * 4;
        f32x4 v[4]; float s = 0.f;
#pragma unroll
        for (int j = 0; j < 4; ++j) { const unsigned long long w = *(const unsigned long long*)(src + (size_t)row * sld + lane * 4 + 256 * j); const unsigned lo = (unsigned)w, hi = (unsigned)(w >> 32);
            v[j] = (f32x4){bflo(lo), bfhi(lo), bflo(hi), bfhi(hi)}; s += (v[j][0] + v[j][1]) + (v[j][2] + v[j][3]); }
        s = sum64(s);
        const float mean = s * (1.f / 1024.f); float s2 = 0.f;
#pragma unroll
        for (int j = 0; j < 4; ++j) { v[j] = v[j] - mean; s2 += (v[j][0] * v[j][0] + v[j][1] * v[j][1]) + (v[j][2] * v[j][2] + v[j][3] * v[j][3]); }
        s2 = sum64(s2);
        const float rstd = rsqrtf(s2 * (1.f / 1024.f) + 1e-5f);
#pragma unroll
        for (int j = 0; j < 4; ++j) { const f32x4 gv = *(const f32x4*)(gam + lane * 4 + 256 * j), bv = *(const f32x4*)(bet + lane * 4 + 256 * j); const f32x4 o = v[j] * rstd * gv + bv;
            if (TO_BF16) { unsigned long long w = (unsigned long long)pkbf(o[0], o[1]) | ((unsigned long long)pkbf(o[2], o[3]) << 32); *(unsigned long long*)(ob + (size_t)row * 1024 + lane * 4 + 256 * j) = w; }
            else *(f32x4*)(xr + 256 * j) = o; }
    }
}

#ifndef USE_CHUNKED
#define USE_CHUNKED 1
#endif
#ifndef REPEAT_SEL
#define REPEAT_SEL 0
#endif
#ifndef DUMP_SEL
#define DUMP_SEL 0
#endif
#ifndef STOP_AFTER
#define STOP_AFTER 99
#endif
__global__ void __launch_bounds__(512, 2) mega(P p) {
    extern __shared__ __attribute__((aligned(16))) unsigned char smem[];
    LAS unsigned char* lds = (LAS unsigned char*)smem;
    volatile LAS unsigned* MISC = (volatile LAS unsigned*)(lds + MISC_OFF);
    if (threadIdx.x < 16) MISC[threadIdx.x] = 0u;
    __syncthreads();
    XcdBarrier bar = xcd_barrier_post((unsigned*)(p.ws + WS_CTL), MISC);
    if (p.never) cg::this_grid().sync();
#define GRID_BAR() xcd_barrier(bar)
    const int G = gridDim.x, bid = blockIdx.x;
    bf16* XB = (bf16*)(p.ws + WS_XB); bf16* PROJ = (bf16*)(p.ws + WS_PROJ); float* DT = (float*)(p.ws + WS_DT); bf16* HID = (bf16*)(p.ws + WS_HID);

#if STOP_AFTER != 99
    { const size_t gt = (size_t)blockIdx.x * 512 + threadIdx.x, NGT = (size_t)gridDim.x * 512; for (size_t i = O_SHP + gt; i < 30939136; i += NGT) p.out[i] = 0.f; }
    GRID_BAR();
#endif
    phase0(p, smem);
    GRID_BAR();
    {
        pg8::Gemm g{XB, (const bf16*)(p.ws + WS_WIN), MPR, 3584, 1024}; pg8::StaticOrder S; S.init(MPR, 3584, G, bid);
        pg8::EpiProj E{PROJ, DT, p.in[20], p.out};
        pg8::gemm_phase<pg8::EpiProj, pg8::StaticOrder, true, true>(lds, g, S, E);
        const float* dtb = p.in[20]; float* out = p.out;
        small_gemm<4, 1024>(XB + (size_t)MPR * 1024, (const bf16*)(p.ws + WS_WIN), PROJN, smem, [=](int rs, int c, float v) {
            if (c < 3328) PROJ[(size_t)(MPR + rs) * PLD + c] = f2bf(v); else DT[(size_t)(MPR + rs) * 8 + (c - 3328)] = softplus(v + dtb[c - 3328]);
            if (c < 1792) out[O_SHS + (size_t)rs * 1792 + c] = v;
            if (c >= 2304 && c < 3328) out[O_CONVS + ((size_t)rs * 3 + 2) * 1024 + (c - 2304)] = v; }, (G == 256) ? 128 : 0);
        phase0_late(p, smem, (G == 256) ? 128 : 0, 0);
    }
    GRID_BAR();
    phase_prep(p, smem);
#if REPEAT_SEL == 2
    phase_prep(p, smem);
#endif
    GRID_BAR();
#if STOP_AFTER == 2
    { const size_t gt = (size_t)blockIdx.x * 512 + threadIdx.x, NGT = (size_t)gridDim.x * 512; const bf16* KPd = (const bf16*)(p.ws + WS_KP); const bf16* XBCd = (const bf16*)(p.ws + WS_XBC);
      for (size_t i = gt; i < 8454144; i += NGT) { p.out[i] = bf2f(KPd[i]); p.out[8454144 + i] = bf2f(XBCd[i]); } }
    return;
#endif
#if USE_CHUNKED
    phase_scan2(p, smem);
#else
    phase_scan(p, smem);
#endif
    phase_ssd(p, smem);
    phase_sample_step(p, smem);
#if REPEAT_SEL == 3
    phase_scan2(p, smem);
    phase_ssd(p, smem);
    phase_sample_step(p, smem);
#endif
#if REPEAT_SEL == 5
    phase_sample_step(p, smem);
    phase_sample_step(p, smem);
#endif
#if REPEAT_SEL == 6
    phase_ssd(p, smem);
#endif
#if REPEAT_SEL == 4
    phase_ssd(p, smem);
    phase_sample_step(p, smem);
#endif
    GRID_BAR();
#if STOP_AFTER == 4
    { const size_t gt = (size_t)blockIdx.x * 512 + threadIdx.x, NGT = (size_t)gridDim.x * 512; const bf16* Yd = (const bf16*)(p.ws + WS_XB);
      for (size_t i = gt; i < 8388608; i += NGT) { p.out[i] = (DUMP_SEL & 1) ? bf2f(Yd[i]) : 0.f; p.out[8388608 + i] = (DUMP_SEL & 2) ? bf2f(Yd[8388608 + i]) : 0.f; }
      for (size_t i = gt; i < 131072; i += NGT) p.out[16777216 + i] = (DUMP_SEL & 4) ? bf2f(((const bf16*)(p.ws + WS_YS))[i]) : 0.f; }
    return;
#endif
    phase_post(p);
    GRID_BAR();
#if STOP_AFTER == 5
    { const size_t gt = (size_t)blockIdx.x * 512 + threadIdx.x, NGT = (size_t)gridDim.x * 512; for (size_t i = gt; i < (size_t)MTOT * 1024; i += NGT) p.out[i] = bf2f(((const bf16*)(p.ws + WS_MIX))[i]); }
    return;
#endif
    {
        pg8::Gemm g{(const bf16*)(p.ws + WS_MIX), (const bf16*)(p.ws + WS_WOUT), MPR, 1024, 1024}; pg8::StaticOrder S; S.init(MPR, 1024, G, bid);
        pg8::EpiResF32 E{p.in[0], nullptr, (bf16*)p.out, 1024, ALPHA};
        pg8::gemm_phase<pg8::EpiResF32, pg8::StaticOrder, true, true>(lds, g, S, E);
        const float* xs = p.in[1]; float* out = p.out;
        small_gemm<2, 1024>((const bf16*)(p.ws + WS_MIX) + (size_t)MPR * 1024, (const bf16*)(p.ws + WS_WOUT), 1024, smem, [=](int rs, int c, float v) { ((bf16*)out)[(size_t)(MPR + rs) * 1024 + c] = f2bf(ALPHA * xs[(size_t)rs * 1024 + c] + v); });
    }
    GRID_BAR();
    phase_ln<true>(p, p.in[25], p.in[26], XB, 0, 1024);
    phase0_late(p, smem, 0, 1);
    GRID_BAR();
    {
        pg8::Gemm g{XB, (const bf16*)(p.ws + WS_WFF1), MPR, 4096, 1024}; pg8::StaticOrder S; S.init(MPR, 4096, G, bid);
        pg8::EpiRelu2 E{HID, 4096};
        pg8::gemm_phase<pg8::EpiRelu2, pg8::StaticOrder, true, true>(lds, g, S, E);
        small_gemm<4, 1024>(XB + (size_t)MPR * 1024, (const bf16*)(p.ws + WS_WFF1), 4096, smem, [=](int rs, int c, float v) { const float a = fmaxf(v, 0.f); HID[(size_t)(MPR + rs) * 4096 + c] = f2bf(a * a); });
    }
    GRID_BAR();
    {
        pg8::Gemm g{HID, (const bf16*)(p.ws + WS_WFF2), MPR, 1024, 4096}; pg8::StaticOrder S; S.init(MPR, 1024, G, bid);
        pg8::EpiResF32 E{nullptr, XB, (bf16*)p.out + 1024, 2048, ALPHA};
        pg8::gemm_phase<pg8::EpiResF32, pg8::StaticOrder, true, true>(lds, g, S, E);
        float* out = p.out;
        small_gemm<2, 4096>(HID + (size_t)MPR * 4096, (const bf16*)(p.ws + WS_WFF2), 1024, smem, [=](int rs, int c, float v) { ((bf16*)out)[(size_t)(MPR + rs) * 2048 + 1024 + c] = f2bf(ALPHA * bf2f(XB[(size_t)(MPR + rs) * 1024 + c]) + v); });
    }
    GRID_BAR();
    phase_ln<false>(p, p.in[29], p.in[30], nullptr, 1024, 2048);
}

extern "C" void kernel_launch(void* const* d_in, const int* in_sizes, int n_in, void* d_out, int out_size, void* d_ws, size_t ws_size, hipStream_t stream) {
    static int grid = 0;
    if (grid == 0) {
        int dev = 0, cus = 0, per_cu = 0;
        (void)hipGetDevice(&dev);
        (void)hipDeviceGetAttribute(&cus, hipDeviceAttributeMultiprocessorCount, dev);
        if (hipFuncSetAttribute((const void*)mega, hipFuncAttributeMaxDynamicSharedMemorySize, LDS_BYTES) != hipSuccess) fprintf(stderr, "kernel_launch: hipFuncSetAttribute failed\n");
        if (hipOccupancyMaxActiveBlocksPerMultiprocessor(&per_cu, (const void*)mega, 512, LDS_BYTES) != hipSuccess || per_cu < 1) { fprintf(stderr, "kernel_launch: occupancy query says %d\n", per_cu); per_cu = 1; }
        (void)hipGetLastError();
        grid = cus * 1;
        if (n_in != 31 || out_size != 30939136 || ws_size < WS_CTL + 16384) fprintf(stderr, "kernel_launch: unexpected sizes n_in %d out %d ws %zu\n", n_in, out_size, ws_size);
    }
    (void)hipMemsetAsync((char*)d_ws + WS_CTL, 0, 16384, stream);
    P a{};
    for (int i = 0; i < 31; ++i) a.in[i] = (const float*)d_in[i];
    a.out = (float*)d_out; a.ws = (unsigned char*)d_ws; a.never = 0; a.pad = 0;
    void* args[] = {&a};
    hipError_t e = hipLaunchCooperativeKernel((const void*)mega, dim3(grid), dim3(512), args, LDS_BYTES, stream);
    if (e != hipSuccess) fprintf(stderr, "kernel_launch: cooperative launch failed: %s (grid %d)\n", hipGetErrorString(e), grid);
}
```

```cpp
#include <hip/hip_runtime.h>
#include <hip/hip_cooperative_groups.h>
#include <cstdio>
#include <cstdint>
namespace cg = cooperative_groups;
#define LAS __attribute__((address_space(3)))

typedef unsigned short bf16;
typedef short bf16x8 __attribute__((ext_vector_type(8)));
typedef float f32x4 __attribute__((ext_vector_type(4)));
typedef unsigned u32x4 __attribute__((ext_vector_type(4)));

constexpr int DM = 1024, SEQ = 2048, MPR = 8 * SEQ, MSM = 128, MTOT = MPR + MSM;
constexpr int RPJ = 1792, PLD = 3328, PROJN = 3336, DFF = 4096;
constexpr float ALPHA = 1.189207115f;
constexpr size_t O_Y = 0, O_YS = 16777216, O_SHP = 16908288, O_WKVP = 16922624, O_CONVP = 17184768, O_SSMP = 17209344,
                 O_SHS = 17733632, O_WKVS = 17963008, O_CONVS = 22157312, O_SSMS = 22550528;
constexpr size_t OS_WD = 0, OS_GG = 8454144;
constexpr size_t WS_WIN = 0, WS_WOUT = 7340032, WS_WFF1 = 9437184, WS_WFF2 = 17825792, WS_LORA = 26214400, WS_XB = 26476544,
                 WS_PROJ = 60293120, WS_DT = 170196992, WS_KP = 170725376, WS_KK = 187633664, WS_KB = 204541952, WS_XBC = 221450240,
                 WS_CTL = 255004672, WS_YS = WS_CTL + 65536, WS_HID = WS_PROJ, WS_MIX = WS_KK;
constexpr int LDS_BYTES = 147456, MISC_OFF = LDS_BYTES - 64;

struct P { const float* in[31]; float* out; unsigned char* ws; int never; int pad; };

__device__ __forceinline__ float bf2f(unsigned short b) { return __uint_as_float(((unsigned)b) << 16); }
__device__ __forceinline__ float bflo(unsigned u) { return __uint_as_float(u << 16); }
__device__ __forceinline__ float bfhi(unsigned u) { return __uint_as_float(u & 0xffff0000u); }
typedef float f32x2_t __attribute__((ext_vector_type(2)));
typedef __bf16 bf16x2_t __attribute__((ext_vector_type(2)));
__device__ __forceinline__ unsigned pkbf(float lo, float hi) { const f32x2_t v = {lo, hi}; const bf16x2_t b = __builtin_convertvector(v, bf16x2_t); return __builtin_bit_cast(unsigned, b); }
__device__ __forceinline__ unsigned short f2bf(float f) { return (unsigned short)(pkbf(f, f) & 0xffffu); }
__device__ __forceinline__ void unpack8(u32x4 v, float* o) { o[0] = bflo(v.x); o[1] = bfhi(v.x); o[2] = bflo(v.y); o[3] = bfhi(v.y); o[4] = bflo(v.z); o[5] = bfhi(v.z); o[6] = bflo(v.w); o[7] = bfhi(v.w); }
__device__ __forceinline__ u32x4 pack8(const float* o) { u32x4 v; v.x = pkbf(o[0], o[1]); v.y = pkbf(o[2], o[3]); v.z = pkbf(o[4], o[5]); v.w = pkbf(o[6], o[7]); return v; }
__device__ __forceinline__ float sigm(float x) { return __builtin_amdgcn_rcpf(1.f + __expf(-x)); }
__device__ __forceinline__ float silu(float x) { return x * __builtin_amdgcn_rcpf(1.f + __expf(-x)); }
__device__ __forceinline__ float softplus(float x) { return fmaxf(x, 0.f) + __logf(1.f + __expf(-fabsf(x))); }
__device__ __forceinline__ float tanh_(float x) { const float e = __expf(2.f * x); return 1.f - 2.f * __builtin_amdgcn_rcpf(e + 1.f); }
template <int CTRL> __device__ __forceinline__ float dppf(float x) { return __int_as_float(__builtin_amdgcn_update_dpp(0, __float_as_int(x), CTRL, 0xf, 0xf, true)); }
template <int CTRL> __device__ __forceinline__ float dppo(float x) { return __int_as_float(__builtin_amdgcn_update_dpp(0x3f800000, __float_as_int(x), CTRL, 0xf, 0xf, false)); }
__device__ __forceinline__ float sum16(float x) { x += dppf<0xB1>(x); x += dppf<0x4E>(x); x += dppf<0x141>(x); x += dppf<0x140>(x); return x; }
__device__ __forceinline__ float sum8(float x) { x += dppf<0xB1>(x); x += dppf<0x4E>(x); x += dppf<0x141>(x); return x; }
__device__ __forceinline__ float rdl(float x, int l) { return __int_as_float(__builtin_amdgcn_readlane(__float_as_int(x), l)); }
__device__ __forceinline__ float sum64(float x) { x = sum16(x); return (rdl(x, 0) + rdl(x, 16)) + (rdl(x, 32) + rdl(x, 48)); }
__device__ __forceinline__ float sum32(float x, bool hi) { x = sum16(x); const float a = rdl(x, 0) + rdl(x, 16), b = rdl(x, 32) + rdl(x, 48); return hi ? b : a; }
__device__ __forceinline__ f32x4 mfma16(bf16x8 a, bf16x8 b, f32x4 c) { return __builtin_amdgcn_mfma_f32_16x16x32_bf16(a, b, c, 0, 0, 0); }
typedef short s16x4 __attribute__((ext_vector_type(4)));
__device__ __forceinline__ f32x4 mf16(s16x4 a, s16x4 b, f32x4 c) { return __builtin_amdgcn_mfma_f32_16x16x16bf16_1k(a, b, c, 0, 0, 0); }
__device__ __forceinline__ s16x4 cvt4(f32x4 v) { struct { unsigned a, b; } t = {pkbf(v[0], v[1]), pkbf(v[2], v[3])}; return __builtin_bit_cast(s16x4, t); }
#define LDS_FENCE() asm volatile("s_waitcnt lgkmcnt(0)" ::: "memory")

#define PHASE_PROLOGUE P p = p_in; { size_t z_ = 0; asm volatile("" : "+s"(z_)); p.ws += z_; p.out += z_; } int tid = threadIdx.x; asm volatile("" : "+v"(tid))
namespace pg8 {
#define PG8_LAS __attribute__((address_space(3)))
typedef unsigned short bf16_t;
typedef short bf16x8 __attribute__((ext_vector_type(8)));
typedef float f32x4 __attribute__((ext_vector_type(4)));
typedef unsigned u32x4 __attribute__((ext_vector_type(4)));
constexpr int BM = 256, BK = 64, HALF = 128, HTB = HALF * BK * 2  , STAGE_BYTES = 8 * HTB, NXCD = 8, WGM = 8;

__host__ __device__ __forceinline__ int lds_byte(int r, int c) { const int st = (r >> 4) * 2 + (c >> 5), rr = r & 15, cc = c & 31, ob = rr * 64 + cc * 2; return st * 1024 + (ob ^ (((ob >> 9) & 1) << 5)); }
__host__ __device__ __forceinline__ void stage_rc(int b, int& R, int& C) { const int st = b / 1024, sb = b % 1024, swz = sb ^ (((sb >> 9) & 1) << 5); R = (st >> 1) * 16 + swz / 64; C = (st & 1) * 32 + (swz % 64) / 2; }
__host__ __device__ __forceinline__ int perm32(int rho) { const int n = rho >> 4, i = rho & 15; return 8 * (i >> 2) + 4 * n + (i & 3); }

struct Unit { int pm, pn; };
struct Gemm { const bf16_t* A; const bf16_t* Bt; int M, N, K; };

struct StaticOrder {
    int nM, nN, nwg, G, c;
    __host__ __device__ void init(int M, int N, int G_, int c_) { nM = M / BM; nN = N / BM; nwg = nM * nN; G = G_; c = c_; }
    __host__ __device__ bool next(int i, Unit& u) const {
        const long L = (long)i * G + c; if (L >= nwg) return false;
        int wgid = (int)L; { const int q = nwg / NXCD, r = nwg % NXCD, xcd = wgid % NXCD, off = wgid / NXCD; wgid = (xcd < r ? xcd * (q + 1) : r * (q + 1) + (xcd - r) * q) + off; }
        const int nig = WGM * nN, gid = wgid / nig, fm = gid * WGM, gsz = (nM - fm) < WGM ? (nM - fm) : WGM;
        u.pm = fm + ((wgid % nig) % gsz); u.pn = (wgid % nig) / gsz; return true;
    }
    __device__ __forceinline__ void a_ready(const Unit&) const {}
    __device__ __forceinline__ void done(const Unit&) const {}
};

__device__ __forceinline__ unsigned cvt_pk_bf16(float lo, float hi) { return ::pkbf(lo, hi); }
typedef float f32x2 __attribute__((ext_vector_type(2)));
struct EpiProj {
    static constexpr bool PERM = true, AFTER_DRAIN = false;
    bf16_t* PROJ; float* DT; const float* dt_bias; float* out;
    __device__ __forceinline__ void operator()(const f32x4 (&acc)[2][2][4][2], const Unit& u, int wr, int wc, int fr, int fq) const {
        const int row0 = u.pm * BM + wr * 64 + fr;
#pragma unroll
        for (int bj = 0; bj < 2; ++bj) {
            const int c0 = u.pn * BM + bj * HALF + wc * 32 + 8 * fq;
            if (c0 >= 3336) continue;
#pragma unroll
            for (int ai = 0; ai < 2; ++ai)
#pragma unroll
                for (int m = 0; m < 4; ++m) {
                    const int row = row0 + ai * HALF + m * 16; const f32x4 v0 = acc[ai][bj][m][0], v1 = acc[ai][bj][m][1];
                    if (c0 < 3328) { u32x4 w; w.x = cvt_pk_bf16(v0[0], v0[1]); w.y = cvt_pk_bf16(v0[2], v0[3]); w.z = cvt_pk_bf16(v1[0], v1[1]); w.w = cvt_pk_bf16(v1[2], v1[3]);
                        *(u32x4*)(PROJ + (size_t)row * 3328 + c0) = w; }
                    else { f32x4 a, b;
#pragma unroll
                        for (int i = 0; i < 4; ++i) { float x = v0[i] + dt_bias[i]; a[i] = x > 20.f ? x : log1pf(__expf(x)); float y = v1[i] + dt_bias[4 + i]; b[i] = y > 20.f ? y : log1pf(__expf(y)); }
                        *(f32x4*)(DT + (size_t)row * 8) = a; *(f32x4*)(DT + (size_t)row * 8 + 4) = b; }
                    const int t = row & 2047, b_ = row >> 11;
                    if (t == 2047 && c0 < 1792) { float* o = out + 16908288 + (size_t)b_ * 1792 + c0; *(f32x4*)o = v0; *(f32x4*)(o + 4) = v1; }
                    if (t >= 2045 && c0 >= 2304 && c0 < 3328) { float* o = out + 17184768 + ((size_t)b_ * 3 + (t - 2045)) * 1024 + (c0 - 2304); *(f32x4*)o = v0; *(f32x4*)(o + 4) = v1; }
                }
        }
    }
};
struct EpiResF32 {
    static constexpr bool PERM = true, AFTER_DRAIN = false;
    const float* resf; const bf16_t* resb; bf16_t* ob; int ld; float alpha;
    __device__ __forceinline__ void operator()(const f32x4 (&acc)[2][2][4][2], const Unit& u, int wr, int wc, int fr, int fq) const {
        const int row0 = u.pm * BM + wr * 64 + fr;
#pragma unroll
        for (int ai = 0; ai < 2; ++ai)
#pragma unroll
            for (int m = 0; m < 4; ++m)
#pragma unroll
                for (int bj = 0; bj < 2; ++bj) {
                    const int row = row0 + ai * HALF + m * 16, c0 = u.pn * BM + bj * HALF + wc * 32 + 8 * fq; const size_t o = (size_t)row * 1024 + c0;
                    f32x4 r0, r1;
                    if (resf) { r0 = *(const f32x4*)(resf + o); r1 = *(const f32x4*)(resf + o + 4); }
                    else { const u32x4 w = *(const u32x4*)(resb + o); r0[0] = __uint_as_float(w.x << 16); r0[1] = __uint_as_float(w.x & 0xffff0000u); r0[2] = __uint_as_float(w.y << 16); r0[3] = __uint_as_float(w.y & 0xffff0000u);
                        r1[0] = __uint_as_float(w.z << 16); r1[1] = __uint_as_float(w.z & 0xffff0000u); r1[2] = __uint_as_float(w.w << 16); r1[3] = __uint_as_float(w.w & 0xffff0000u); }
                    const f32x4 v0 = r0 * alpha + acc[ai][bj][m][0], v1 = r1 * alpha + acc[ai][bj][m][1];
                    u32x4 w8; w8.x = cvt_pk_bf16(v0[0], v0[1]); w8.y = cvt_pk_bf16(v0[2], v0[3]); w8.z = cvt_pk_bf16(v1[0], v1[1]); w8.w = cvt_pk_bf16(v1[2], v1[3]);
                    *(u32x4*)(ob + (size_t)row * ld + c0) = w8;
                }
    }
};
struct EpiRelu2 {
    static constexpr bool PERM = true, AFTER_DRAIN = false;
    bf16_t* O; int ldc;
    __device__ __forceinline__ void operator()(const f32x4 (&acc)[2][2][4][2], const Unit& u, int wr, int wc, int fr, int fq) const {
        const int row0 = u.pm * BM + wr * 64 + fr;
#pragma unroll
        for (int ai = 0; ai < 2; ++ai)
#pragma unroll
            for (int m = 0; m < 4; ++m)
#pragma unroll
                for (int bj = 0; bj < 2; ++bj) {
                    const int row = row0 + ai * HALF + m * 16, c0 = u.pn * BM + bj * HALF + wc * 32 + 8 * fq;
                    f32x4 v0 = acc[ai][bj][m][0], v1 = acc[ai][bj][m][1];
#pragma unroll
                    for (int i = 0; i < 4; ++i) { float a = fmaxf(v0[i], 0.f); v0[i] = a * a; float b = fmaxf(v1[i], 0.f); v1[i] = b * b; }
                    u32x4 w; w.x = cvt_pk_bf16(v0[0], v0[1]); w.y = cvt_pk_bf16(v0[2], v0[3]); w.z = cvt_pk_bf16(v1[0], v1[1]); w.w = cvt_pk_bf16(v1[2], v1[3]);
                    *(u32x4*)(O + (size_t)row * ldc + c0) = w;
                }
    }
};
template <class Epi, class Sched, bool ALIGN_EPI = false, bool SP2 = false>
__device__ __forceinline__ void gemm_phase(PG8_LAS unsigned char* lds, const Gemm g, const Sched& S, const Epi& E) {
    int tid = threadIdx.x; asm volatile("" : "+v"(tid)); const int wid = __builtin_amdgcn_readfirstlane(tid >> 6), lane = tid & 63, wr = wid >> 2, wc = wid & 3, fr = lane & 15, fq = lane >> 4;
    const int K = g.K, nt = K / BK;
    unsigned voffA[2], voffB[2];
#pragma unroll
    for (int i = 0; i < 2; ++i) { int R, C; stage_rc(tid * 16 + i * 8192, R, C); const int Rb = Epi::PERM ? ((R & ~31) + perm32(R & 31)) : R;
        voffA[i] = (unsigned)(R * K + C) * 2u; voffB[i] = (unsigned)(Rb * K + C) * 2u; }
    const size_t kstep = (size_t)(BK * 2);
    const size_t hstep = (size_t)HALF * K * 2;
    const size_t tstep = 2 * hstep;
    const unsigned ldsw = (unsigned)wid * 1024u;
    const int aoff = lds_byte(wr * 64 + fr, fq * 8), boff = lds_byte(wc * 32 + fr, fq * 8);
#define PG8_SA(b, h) (((b) * 2 + (h)) * HTB)
#define PG8_SB(b, h) ((4 + (b) * 2 + (h)) * HTB)
#define PG8_STAGE(bufoff, gbase, voff) do { _Pragma("unroll") for (int _i = 0; _i < 2; ++_i) \
        __builtin_amdgcn_global_load_lds((const unsigned*)((const char*)(gbase) + (voff)[_i]), (PG8_LAS unsigned*)(lds + (bufoff) + ldsw + _i * 8192), 16, 0, 0); } while (0)
#define PG8_LDA(dst, b, h) do { _Pragma("unroll") for (int m = 0; m < 4; ++m) _Pragma("unroll") for (int k = 0; k < 2; ++k) dst[m][k] = *(const PG8_LAS bf16x8*)(lds + PG8_SA(b, h) + aoff + m * 2048 + k * 1024); } while (0)
#define PG8_LDB(dst, b, h) do { _Pragma("unroll") for (int n = 0; n < 2; ++n) _Pragma("unroll") for (int k = 0; k < 2; ++k) dst[n][k] = *(const PG8_LAS bf16x8*)(lds + PG8_SB(b, h) + boff + n * 2048 + k * 1024); } while (0)
#define PG8_MMA(ai, bj, At, Bt) do { __builtin_amdgcn_s_setprio(1); _Pragma("unroll") for (int m = 0; m < 4; ++m) _Pragma("unroll") for (int n = 0; n < 2; ++n) _Pragma("unroll") for (int k = 0; k < 2; ++k) \
        acc[ai][bj][m][n] = __builtin_amdgcn_mfma_f32_16x16x32_bf16(Bt[n][k], At[m][k], acc[ai][bj][m][n], 0, 0, 0); __builtin_amdgcn_s_setprio(0); } while (0)
#define PG8_WAIT_V(n) asm volatile("s_waitcnt vmcnt(" #n ")" ::: "memory")
#define PG8_WAIT_L(n) asm volatile("s_waitcnt lgkmcnt(" #n ")" ::: "memory")
#define PG8_BAR __builtin_amdgcn_s_barrier()
#define PG8_SCHED __builtin_amdgcn_sched_barrier(0)
    Unit cur, nxt; int ui = 0;
    if (!S.next(0, cur)) return;
    f32x4 acc[2][2][4][2];
#pragma unroll
    for (int a = 0; a < 2; ++a)
#pragma unroll
        for (int b = 0; b < 2; ++b)
#pragma unroll
            for (int m = 0; m < 4; ++m)
#pragma unroll
                for (int n = 0; n < 2; ++n) acc[a][b][m][n] = (f32x4){0.f, 0.f, 0.f, 0.f};
    bf16x8 At[4][2], B0[2][2], B1[2][2];
    const char* cA = (const char*)g.A + (size_t)cur.pm * tstep; const char* cB = (const char*)g.Bt + (size_t)cur.pn * tstep;
    S.a_ready(cur);
    if constexpr (SP2) {
        PG8_STAGE(PG8_SB(0, 0), cB, voffB); PG8_STAGE(PG8_SB(0, 1), cB + hstep, voffB); PG8_STAGE(PG8_SA(0, 0), cA, voffA); PG8_STAGE(PG8_SA(0, 1), cA + hstep, voffA);
        if (wr == 1) PG8_BAR;
        PG8_WAIT_V(2); PG8_BAR;
        PG8_STAGE(PG8_SB(1, 0), cB + kstep, voffB); PG8_STAGE(PG8_SA(1, 0), cA + kstep, voffA); PG8_STAGE(PG8_SB(1, 1), cB + hstep + kstep, voffB);
        PG8_WAIT_V(6); PG8_BAR;
    } else {
        PG8_STAGE(PG8_SB(0, 0), cB, voffB); PG8_STAGE(PG8_SA(0, 0), cA, voffA); PG8_STAGE(PG8_SB(0, 1), cB + hstep, voffB); PG8_STAGE(PG8_SA(0, 1), cA + hstep, voffA);
        if (wr == 1) PG8_BAR;
        PG8_WAIT_V(4); PG8_BAR;
        PG8_STAGE(PG8_SB(1, 0), cB + kstep, voffB); PG8_STAGE(PG8_SA(1, 0), cA + kstep, voffA); PG8_STAGE(PG8_SB(1, 1), cB + hstep + kstep, voffB);
        PG8_WAIT_V(6); PG8_BAR;
    }
    for (;;) {
        const bool has_next = S.next(ui + 1, nxt);
        const char* nA = has_next ? (const char*)g.A + (size_t)nxt.pm * tstep : cA; const char* nB = has_next ? (const char*)g.Bt + (size_t)nxt.pn * tstep : cB;
        for (int t = 0; t < nt; t += 2) {
            const bool last = (t == nt - 2);
            const char* a1 = cA + (size_t)(t + 1) * kstep;
            const char* a2 = last ? nA : cA + (size_t)(t + 2) * kstep; const char* b2 = last ? nB : cB + (size_t)(t + 2) * kstep;
            const char* a3 = a2 + kstep; const char* b3 = b2 + kstep;
            if (last && has_next) S.a_ready(nxt);
            if constexpr (SP2) {
            PG8_LDB(B0, 0, 0); PG8_LDB(B1, 0, 1); PG8_SCHED; PG8_LDA(At, 0, 0); PG8_STAGE(PG8_SA(1, 1), a1 + hstep, voffA);
            PG8_WAIT_V(8); PG8_WAIT_L(0); PG8_BAR; PG8_MMA(0, 0, At, B0); PG8_MMA(0, 1, At, B1); PG8_BAR; PG8_SCHED;
            PG8_LDA(At, 0, 1); PG8_STAGE(PG8_SB(0, 0), b2, voffB); PG8_STAGE(PG8_SB(0, 1), b2 + hstep, voffB); PG8_STAGE(PG8_SA(0, 0), a2, voffA);
            PG8_WAIT_V(8); PG8_WAIT_L(0); PG8_BAR; PG8_MMA(1, 0, At, B0); PG8_MMA(1, 1, At, B1); PG8_BAR; PG8_SCHED;
            PG8_LDB(B0, 1, 0); PG8_LDB(B1, 1, 1); PG8_SCHED; PG8_LDA(At, 1, 0); PG8_STAGE(PG8_SA(0, 1), a2 + hstep, voffA);
            PG8_WAIT_V(8); PG8_WAIT_L(0); PG8_BAR; PG8_MMA(0, 0, At, B0); PG8_MMA(0, 1, At, B1); PG8_BAR; PG8_SCHED;
            PG8_LDA(At, 1, 1); PG8_STAGE(PG8_SB(1, 0), b3, voffB); PG8_STAGE(PG8_SB(1, 1), b3 + hstep, voffB); PG8_STAGE(PG8_SA(1, 0), a3, voffA);
            PG8_WAIT_V(8); PG8_WAIT_L(0); PG8_BAR; PG8_MMA(1, 0, At, B0); PG8_MMA(1, 1, At, B1); PG8_BAR; PG8_SCHED;
            } else {
            PG8_LDB(B0, 0, 0); PG8_SCHED; PG8_LDA(At, 0, 0); PG8_STAGE(PG8_SA(1, 1), a1 + hstep, voffA);
            PG8_WAIT_L(8); PG8_BAR; PG8_WAIT_L(0); PG8_MMA(0, 0, At, B0); PG8_BAR; PG8_SCHED;
            PG8_LDB(B1, 0, 1); PG8_STAGE(PG8_SB(0, 0), b2, voffB);
            PG8_BAR; PG8_WAIT_L(0); PG8_MMA(0, 1, At, B1); PG8_BAR;
            PG8_LDA(At, 0, 1); PG8_STAGE(PG8_SA(0, 0), a2, voffA);
            PG8_BAR; PG8_WAIT_L(0); PG8_MMA(1, 0, At, B0); PG8_BAR; PG8_SCHED;
            PG8_STAGE(PG8_SB(0, 1), b2 + hstep, voffB);
            PG8_WAIT_V(6); PG8_BAR; PG8_MMA(1, 1, At, B1); PG8_BAR;
            PG8_LDB(B0, 1, 0); PG8_SCHED; PG8_LDA(At, 1, 0); PG8_STAGE(PG8_SA(0, 1), a2 + hstep, voffA);
            PG8_WAIT_L(8); PG8_BAR; PG8_WAIT_L(0); PG8_MMA(0, 0, At, B0); PG8_BAR; PG8_SCHED;
            PG8_LDB(B1, 1, 1); PG8_STAGE(PG8_SB(1, 0), b3, voffB);
            PG8_BAR; PG8_WAIT_L(0); PG8_MMA(0, 1, At, B1); PG8_BAR;
            PG8_LDA(At, 1, 1); PG8_STAGE(PG8_SA(1, 0), a3, voffA);
            PG8_BAR; PG8_WAIT_L(0); PG8_MMA(1, 0, At, B0); PG8_BAR; PG8_SCHED;
            PG8_STAGE(PG8_SB(1, 1), b3 + hstep, voffB);
            PG8_WAIT_V(6); PG8_BAR; PG8_MMA(1, 1, At, B1); PG8_BAR;
            }
        }
        if constexpr (ALIGN_EPI) { if (wr == 0) PG8_BAR; }
        if constexpr (!Epi::AFTER_DRAIN) { E(acc, cur, wr, wc, fr, fq); S.done(cur); }
        if (!has_next) break;
#pragma unroll
        for (int a = 0; a < 2; ++a)
#pragma unroll
            for (int b = 0; b < 2; ++b)
#pragma unroll
                for (int m = 0; m < 4; ++m)
#pragma unroll
                    for (int n = 0; n < 2; ++n) acc[a][b][m][n] = (f32x4){0.f, 0.f, 0.f, 0.f};
        cur = nxt; cA = nA; cB = nB; ++ui;
        if constexpr (ALIGN_EPI) { if (wr == 1) PG8_BAR; }
    }
    PG8_WAIT_V(0);
    if constexpr (!ALIGN_EPI) { if (wr == 0) PG8_BAR; }
    PG8_BAR;
    if constexpr (Epi::AFTER_DRAIN) { E.fused(acc, cur, wr, wc, fr, fq, lds, wid, lane); S.done(cur); }
#undef PG8_SA
#undef PG8_SB
#undef PG8_STAGE
#undef PG8_LDA
#undef PG8_LDB
#undef PG8_MMA
#undef PG8_WAIT_V
#undef PG8_WAIT_L
#undef PG8_BAR
#undef PG8_SCHED
}
}

#define XB_TMO      128
#define XB_XCNT(j)  (256  + 64 * (j))
#define XB_XSUB(j)  (1280 + 64 * (j))
#define XB_XGEN(j)  (2304 + 64 * (j))
#define XB_TOP      3328
#define XB_TOPGEN   3392
#define XCD_BAR_WORDS 3456
#define XB_SPIN_CAP (1u << 18)

__device__ __forceinline__ unsigned xb_ld(unsigned* p)              { return __hip_atomic_load(p, __ATOMIC_RELAXED, __HIP_MEMORY_SCOPE_AGENT); }
__device__ __forceinline__ unsigned xb_add(unsigned* p, unsigned v) { return __hip_atomic_fetch_add(p, v, __ATOMIC_RELAXED, __HIP_MEMORY_SCOPE_AGENT); }
__device__ __forceinline__ unsigned xb_xcc_id() { return (unsigned)__builtin_amdgcn_s_getreg((3 << 11) | 20) & 0xFu; }
#define XB_SPIN(cond, bar) do { unsigned _sp = 0; while (cond) { __builtin_amdgcn_s_sleep(1); \
    if ((++_sp & 255u) == 0u) { if (xb_ld(&(bar)[XB_TMO])) break; if (_sp > XB_SPIN_CAP) { atomicAdd(&(bar)[XB_TMO], 1u); break; } } } } while (0)

struct XcdBarrier {
    unsigned* bar; unsigned x;
    volatile LAS unsigned* st;
};

__device__ __forceinline__ XcdBarrier xcd_barrier_post(unsigned* bar, volatile LAS unsigned* st) {
    XcdBarrier b; b.bar = bar; b.x = xb_xcc_id(); b.st = st;
    if (threadIdx.x == 0) (void)xb_add(&bar[XB_XCNT(b.x)], 1u);
    return b;
}
__device__ __forceinline__ void xcd_barrier_complete(unsigned* bar, unsigned x, unsigned& nloc, unsigned& nx) {
    const unsigned G = gridDim.x * gridDim.y * gridDim.z;
    unsigned sum, cnt, mine, sp = 0u;
    for (;;) {
        sum = 0u; cnt = 0u; mine = 0u;
#pragma unroll
        for (unsigned j = 0; j < 16; ++j) { const unsigned c = xb_ld(&bar[XB_XCNT(j)]); sum += c; cnt += (c > 0u) ? 1u : 0u; mine = (j == x) ? c : mine; }
        if (sum == G) break;
        __builtin_amdgcn_s_sleep(1);
        if ((++sp & 255u) == 0u) { if (xb_ld(&bar[XB_TMO])) break; if (sp > XB_SPIN_CAP) { atomicAdd(&bar[XB_TMO], 1u); break; } }
    }
    nloc = mine > 0u ? mine : 1u; nx = cnt > 0u ? cnt : 1u;
}

__device__ __forceinline__ void xcd_barrier(const XcdBarrier& b) {
    asm volatile("s_waitcnt vmcnt(0)" ::: "memory");
    __syncthreads();
    if (threadIdx.x == 0) {
        unsigned* bar = b.bar;
        __builtin_amdgcn_s_waitcnt(0);
        unsigned nloc = b.st[0], nx = b.st[1];
        if (nloc == 0u) { xcd_barrier_complete(bar, b.x, nloc, nx); b.st[0] = nloc; b.st[1] = nx; }
        const unsigned old = xb_add(&bar[XB_XSUB(b.x)], 1u);
        const unsigned gen = old / nloc;
        if (old + 1u == (gen + 1u) * nloc) {
            __builtin_amdgcn_fence(__ATOMIC_RELEASE, "agent");
            asm volatile("s_waitcnt vmcnt(0)" ::: "memory");
            const unsigned og = xb_add(&bar[XB_TOP], 1u);
            const unsigned tg = og / nx;
            if (og + 1u == (tg + 1u) * nx) xb_add(&bar[XB_TOPGEN], 1u);
            else XB_SPIN(xb_ld(&bar[XB_TOPGEN]) == tg, bar);
            __builtin_amdgcn_fence(__ATOMIC_ACQUIRE, "agent");
            xb_add(&bar[XB_XGEN(b.x)], 1u);
            asm volatile("s_waitcnt vmcnt(0)" ::: "memory");
        } else {
            XB_SPIN(xb_ld(&bar[XB_XGEN(b.x)]) == gen, bar);
            __builtin_amdgcn_fence(__ATOMIC_ACQUIRE, "agent");
            asm volatile("s_waitcnt vmcnt(0)" ::: "memory");
        }
    }
    __syncthreads();
}

__device__ __forceinline__ void lerp8(const P& p, int row, int col, float* o) {
    const bf16* PROJ = (const bf16*)(p.ws + WS_PROJ);
    float cur[8], prv[8];
    unpack8(*(const u32x4*)(PROJ + (size_t)row * PLD + col), cur);
    if (row >= MPR) { const float* s = p.in[2] + (size_t)(row - MPR) * RPJ + col; const f32x4 a = *(const f32x4*)s, b = *(const f32x4*)(s + 4);
        prv[0] = a[0]; prv[1] = a[1]; prv[2] = a[2]; prv[3] = a[3]; prv[4] = b[0]; prv[5] = b[1]; prv[6] = b[2]; prv[7] = b[3]; }
    else if ((row & (SEQ - 1)) == 0) {
#pragma unroll
        for (int i = 0; i < 8; ++i) prv[i] = 0.f; }
    else unpack8(*(const u32x4*)(PROJ + (size_t)(row - 1) * PLD + col), prv);
    const float* mu = p.in[7] + col; const f32x4 m0 = *(const f32x4*)mu, m1 = *(const f32x4*)(mu + 4);
#pragma unroll
    for (int i = 0; i < 4; ++i) { o[i] = cur[i] + (prv[i] - cur[i]) * m0[i]; o[4 + i] = cur[4 + i] + (prv[4 + i] - cur[4 + i]) * m1[i]; }
}
__device__ __forceinline__ float lerp1(const P& p, int row, int col) {
    const bf16* PROJ = (const bf16*)(p.ws + WS_PROJ);
    const float cur = bf2f(PROJ[(size_t)row * PLD + col]); float prv;
    if (row >= MPR) prv = p.in[2][(size_t)(row - MPR) * RPJ + col];
    else if ((row & (SEQ - 1)) == 0) prv = 0.f;
    else prv = bf2f(PROJ[(size_t)(row - 1) * PLD + col]);
    return cur + (prv - cur) * p.in[7][col];
}

__device__ __forceinline__ void transpose_item(const float* W, int K, int N, bf16* WT, float* scr, int item, int lane) {
    const int nblk = (N + 31) / 32, kb = item / nblk, nb = item % nblk, k0 = 64 * kb, n0 = 32 * nb;
#pragma unroll 8
    for (int i = 0; i < 32; ++i) { const int kk = 2 * i + (lane >> 5), n = n0 + (lane & 31); scr[kk * 33 + (lane & 31)] = (n < N) ? W[(size_t)(k0 + kk) * N + n] : 0.f; }
    LDS_FENCE();
    const int c = lane & 7;
#pragma unroll
    for (int j = 0; j < 4; ++j) { const int n = (lane >> 3) + 8 * j; const float* s = scr + (8 * c) * 33 + n;
        u32x4 o; o.x = pkbf(s[0 * 33], s[1 * 33]); o.y = pkbf(s[2 * 33], s[3 * 33]); o.z = pkbf(s[4 * 33], s[5 * 33]); o.w = pkbf(s[6 * 33], s[7 * 33]);
        *(u32x4*)(WT + (size_t)(n0 + n) * K + k0 + 8 * c) = o; }
    LDS_FENCE();
}

__device__ __forceinline__ void phase0(const P& p_in, unsigned char* smem) {
    PHASE_PROLOGUE;
    const int lane = tid & 63, wave = tid >> 6, G = gridDim.x, bid = blockIdx.x;
    const int gw = bid * 8 + wave, NGW = G * 8; const size_t gt = (size_t)bid * 512 + tid, NGT = (size_t)G * 512;
    bf16* XB = (bf16*)(p.ws + WS_XB);
    for (size_t i = gt; i < (size_t)MTOT * DM / 8; i += NGT) { const size_t e = i * 8; const float* src = e < (size_t)MPR * DM ? p.in[0] + e : p.in[1] + (e - (size_t)MPR * DM);
        const f32x4 a = *(const f32x4*)src, b = *(const f32x4*)(src + 4); u32x4 o; o.x = pkbf(a[0], a[1]); o.y = pkbf(a[2], a[3]); o.z = pkbf(b[0], b[1]); o.w = pkbf(b[2], b[3]); *(u32x4*)(XB + e) = o; }
    float* scr = (float*)(smem + wave * 8448);
    constexpr int I_IN = 16 * 105, I_WU = 16, I_AU = 16, I_GU = 32;
    constexpr int NIT = I_IN + I_WU + I_AU + I_GU;
    for (int it = gw; it < NIT; it += NGW) {
        int r = it;
        if (r < I_IN) { transpose_item(p.in[6], 1024, PROJN, (bf16*)(p.ws + WS_WIN), scr, r, lane); continue; } r -= I_IN;
        if (r < I_WU) { transpose_item(p.in[9], 64, 512, (bf16*)(p.ws + WS_LORA), scr, r, lane); continue; } r -= I_WU;
        if (r < I_AU) { transpose_item(p.in[11], 64, 512, (bf16*)(p.ws + WS_LORA + 65536), scr, r, lane); continue; } r -= I_AU;
        transpose_item(p.in[12], 128, 512, (bf16*)(p.ws + WS_LORA + 131072), scr, r, lane);
    }
    for (size_t i = gt; i < (size_t)MSM * 2048 / 4; i += NGT) { const size_t idx = i * 4, b = idx >> 11, rem = idx & 2047;
        *(f32x4*)(p.out + O_CONVS + b * 3072 + rem) = *(const f32x4*)(p.in[4] + b * 3072 + 1024 + rem); }
}

__device__ __forceinline__ void phase0_late(const P& p_in, unsigned char* smem, int first, int which) {
    PHASE_PROLOGUE;
    const int lane = tid & 63, wave = tid >> 6, G = gridDim.x, bid = blockIdx.x;
    if (bid < first) return;
    const int gw = (bid - first) * 8 + wave, NGW = (G - first) * 8;
    float* scr = (float*)(smem + wave * 8448);
    constexpr int I_OUT = 16 * 32, I_F1 = 16 * 128, I_F2 = 64 * 32;
    const int lo = which ? I_OUT + I_F1 : 0, hi = which ? I_OUT + I_F1 + I_F2 : I_OUT + I_F1;
    for (int it = lo + gw; it < hi; it += NGW) {
        int r = it;
        if (r < I_OUT) { transpose_item(p.in[24], 1024, 1024, (bf16*)(p.ws + WS_WOUT), scr, r, lane); continue; } r -= I_OUT;
        if (r < I_F1) { transpose_item(p.in[27], 1024, 4096, (bf16*)(p.ws + WS_WFF1), scr, r, lane); continue; } r -= I_F1;
        transpose_item(p.in[28], 4096, 1024, (bf16*)(p.ws + WS_WFF2), scr, r, lane);
    }
}

template <int RG, int K, class F> __device__ __forceinline__ void small_gemm(const bf16* A, const bf16* Bt, int N, unsigned char* smem, const F& epi, int first = 0) {
    int tid = threadIdx.x; asm volatile("" : "+v"(tid));
    const int lane = tid & 63, wave = tid >> 6, r = lane & 15, q = lane >> 4;
    constexpr int KS = K / 8, NST = KS / 32, RGN = 8 / RG;
    const int nunits = ((N + 15) / 16) * RGN;
    float* part = (float*)smem;
    for (int u = (int)gridDim.x - 1 - (int)blockIdx.x; u < nunits && (int)blockIdx.x >= first; u += (int)gridDim.x - first) {
        const int ct = u / RGN, rg = u - ct * RGN, n0 = ct * 16;
        f32x4 acc[RG];
#pragma unroll
        for (int t = 0; t < RG; ++t) acc[t] = (f32x4){0.f, 0.f, 0.f, 0.f};
        const bf16* ap = A + (size_t)(rg * RG * 16 + r) * K + wave * KS + q * 8;
        const bf16* bp = Bt + (size_t)(n0 + r) * K + wave * KS + q * 8;
#pragma unroll 8
        for (int ks = 0; ks < NST; ++ks) {
            const bf16x8 b = *(const bf16x8*)(bp + ks * 32);
#pragma unroll
            for (int t = 0; t < RG; ++t) acc[t] = mfma16(*(const bf16x8*)(ap + (size_t)t * 16 * K + ks * 32), b, acc[t]);
        }
#pragma unroll
        for (int t = 0; t < RG; ++t)
#pragma unroll
            for (int j = 0; j < 4; ++j) part[(wave * RG + t) * 256 + (q * 4 + j) * 16 + r] = acc[t][j];
        __syncthreads();
        for (int e = tid; e < RG * 256; e += 512) { const int t = e >> 8, idx = e & 255; float v = 0.f;
#pragma unroll
            for (int w = 0; w < 8; ++w) v += part[(w * RG + t) * 256 + idx];
            const int col = n0 + (idx & 15);
            if (col < N) epi((rg * RG + t) * 16 + (idx >> 4), col, v); }
        __syncthreads();
    }
}

__device__ __forceinline__ void phase_prep(const P& p_in, unsigned char* smem) {
    PHASE_PROLOGUE;
    const int lane = tid & 63, wave = tid >> 6, G = gridDim.x, bid = blockIdx.x, r = lane & 15, q = lane >> 4;
    const bf16* WUPT = (const bf16*)(p.ws + WS_LORA); const bf16* AUPT = (const bf16*)(p.ws + WS_LORA + 65536); const bf16* GUPT = (const bf16*)(p.ws + WS_LORA + 131072);
    const bf16* PROJ = (const bf16*)(p.ws + WS_PROJ);
    float* WD = p.out + OS_WD; bf16* GG = (bf16*)(p.out + OS_GG);
    bf16* KP = (bf16*)(p.ws + WS_KP); bf16* KK = (bf16*)(p.ws + WS_KK); bf16* KB = (bf16*)(p.ws + WS_KB);
    bf16* WU = (bf16*)smem; bf16* AU = WU + 64 * 72; bf16* GU = AU + 64 * 72;
    bf16* kcur = (bf16*)(smem + 35840 + wave * 4608); bf16* kprv = kcur + 16 * 72;
#pragma unroll 1
    for (int tile = bid; tile < MTOT / 128; tile += G) {
        const int item = tile * 8 + wave, rowa = item * 16 + r;
        bf16x8 aw[2], aa[2], ag[4];
        float u[8];
#pragma unroll
        for (int ks = 0; ks < 2; ++ks) { lerp8(p, rowa, 1536 + ks * 32 + q * 8, u);
#pragma unroll
            for (int i = 0; i < 8; ++i) u[i] = tanh_(u[i]);
            aw[ks] = __builtin_bit_cast(bf16x8, pack8(u)); }
#pragma unroll
        for (int ks = 0; ks < 2; ++ks) { lerp8(p, rowa, 1600 + ks * 32 + q * 8, u); aa[ks] = __builtin_bit_cast(bf16x8, pack8(u)); }
#pragma unroll
        for (int ks = 0; ks < 4; ++ks) { lerp8(p, rowa, 1664 + ks * 32 + q * 8, u);
#pragma unroll
            for (int i = 0; i < 8; ++i) u[i] = sigm(u[i]);
            ag[ks] = __builtin_bit_cast(bf16x8, pack8(u)); }
        u32x4 pw, pa, pg[2];
#define PREP_LOAD(hh_) do { const int c_ = tid >> 3, k8_ = (tid & 7) * 8; \
            pw = *(const u32x4*)(WUPT + (size_t)((hh_) * 64 + c_) * 64 + k8_); pa = *(const u32x4*)(AUPT + (size_t)((hh_) * 64 + c_) * 64 + k8_); \
            _Pragma("unroll") for (int i = 0; i < 2; ++i) { const int pc_ = tid + i * 512, c2_ = pc_ >> 4, k82_ = (pc_ & 15) * 8; pg[i] = *(const u32x4*)(GUPT + (size_t)((hh_) * 64 + c2_) * 128 + k82_); } } while (0)
        PREP_LOAD(0);
#pragma unroll 1
        for (int h = 0; h < 8; ++h) {
            __syncthreads();
            { const int c = tid >> 3, k8 = (tid & 7) * 8;
              *(u32x4*)(WU + c * 72 + k8) = pw; *(u32x4*)(AU + c * 72 + k8) = pa;
#pragma unroll
              for (int i = 0; i < 2; ++i) { const int pc = tid + i * 512, c2 = pc >> 4, k82 = (pc & 15) * 8; *(u32x4*)(GU + c2 * 136 + k82) = pg[i]; } }
#pragma unroll
            for (int i = 0; i < 2; ++i) { const int pc = lane + i * 64, rr = pc >> 3, c8 = (pc & 7) * 8, row = item * 16 + rr, col = 512 + h * 64 + c8;
                *(u32x4*)(kcur + rr * 72 + c8) = *(const u32x4*)(PROJ + (size_t)row * PLD + col);
                u32x4 pv = {0u, 0u, 0u, 0u};
                if (row >= MPR) { const float* sp = p.in[2] + (size_t)(row - MPR) * RPJ + col; const f32x4 a = *(const f32x4*)sp, b = *(const f32x4*)(sp + 4); pv.x = pkbf(a[0], a[1]); pv.y = pkbf(a[2], a[3]); pv.z = pkbf(b[0], b[1]); pv.w = pkbf(b[2], b[3]); }
                else if ((row & (SEQ - 1)) != 0) pv = *(const u32x4*)(PROJ + (size_t)(row - 1) * PLD + col);
                *(u32x4*)(kprv + rr * 72 + c8) = pv; }
            if (h + 1 < 8) PREP_LOAD(h + 1);
            __syncthreads();
            float ss[4] = {0.f, 0.f, 0.f, 0.f};
#pragma unroll
            for (int ctl = 0; ctl < 4; ++ctl) { const int cl = ctl * 16 + r, col = h * 64 + cl; const float kkc = p.in[13][col], muc = p.in[7][512 + col];
#pragma unroll
                for (int j = 0; j < 4; ++j) { const float kc = bf2f(kcur[(q * 4 + j) * 72 + cl]), kv = bf2f(kprv[(q * 4 + j) * 72 + cl]); const float kr = (kc + (kv - kc) * muc) * kkc; ss[j] += kr * kr; } }
#pragma unroll
            for (int j = 0; j < 4; ++j) { ss[j] = sum16(ss[j]); ss[j] = rsqrtf(fmaxf(ss[j], 1e-24f)); }
#pragma unroll 1
            for (int ctl = 0; ctl < 4; ++ctl) {
                const int cl = ctl * 16 + r, col = h * 64 + cl;
                f32x4 cw = {0.f, 0.f, 0.f, 0.f}, ca = cw, cgt = cw;
#pragma unroll
                for (int ks = 0; ks < 2; ++ks) { cw = mfma16(aw[ks], *(const bf16x8*)(WU + cl * 72 + ks * 32 + q * 8), cw); ca = mfma16(aa[ks], *(const bf16x8*)(AU + cl * 72 + ks * 32 + q * 8), ca); }
#pragma unroll
                for (int ks = 0; ks < 4; ++ks) cgt = mfma16(ag[ks], *(const bf16x8*)(GU + cl * 136 + ks * 32 + q * 8), cgt);
                const float w0c = p.in[8][col], a0c = p.in[10][col], kkc = p.in[13][col], kac = p.in[14][col], muc = p.in[7][512 + col];
#pragma unroll
                for (int j = 0; j < 4; ++j) {
                    const int row = item * 16 + q * 4 + j; const size_t o = (size_t)row * 512 + col;
                    const float wl = -softplus(-(w0c + cw[j])) - 0.5f;
                    WD[o] = __expf(-__expf(wl));
                    const float a = sigm(a0c + ca[j]);
                    GG[o] = f2bf(cgt[j]);
                    const float kc = bf2f(kcur[(q * 4 + j) * 72 + cl]), kv = bf2f(kprv[(q * 4 + j) * 72 + cl]); const float k = kc + (kv - kc) * muc;
                    KP[o] = f2bf(k * (1.f + (a - 1.f) * kac));
                    const float kk = k * kkc * ss[j];
                    KK[o] = f2bf(kk); KB[o] = f2bf(kk * a);
                }
            }
        }
    }
    __syncthreads();
#undef PREP_LOAD
    bf16* XBC = (bf16*)(p.ws + WS_XBC);
    const int ntl = MTOT / 128, cb = (G > ntl + 32) ? ntl : 0;
    if (bid < cb) return;
    const size_t gt = (size_t)(bid - cb) * 512 + tid, NGT = (size_t)(G - cb) * 512;
    for (size_t idx = gt; idx < (size_t)MPR * 128; idx += NGT) {
        const int row = (int)(idx >> 7), c0 = (int)(idx & 127) * 8, t = row & (SEQ - 1);
        float acc[8], x[8];
        { const f32x4 b0 = *(const f32x4*)(p.in[19] + c0), b1 = *(const f32x4*)(p.in[19] + c0 + 4);
#pragma unroll
          for (int i = 0; i < 4; ++i) { acc[i] = b0[i]; acc[4 + i] = b1[i]; } }
#pragma unroll
        for (int d = 0; d < 4; ++d) { if (t - 3 + d < 0) continue;
            unpack8(*(const u32x4*)(PROJ + (size_t)(row - 3 + d) * PLD + 2304 + c0), x);
            const f32x4 w0 = *(const f32x4*)(p.in[18] + d * 1024 + c0), w1 = *(const f32x4*)(p.in[18] + d * 1024 + c0 + 4);
#pragma unroll
            for (int i = 0; i < 4; ++i) { acc[i] += w0[i] * x[i]; acc[4 + i] += w1[i] * x[4 + i]; } }
#pragma unroll
        for (int i = 0; i < 8; ++i) acc[i] = silu(acc[i]);
        *(u32x4*)(XBC + (size_t)row * 1024 + c0) = pack8(acc);
    }
}

constexpr int TC = 32, SBUF = 5 * TC * 64 + TC * 16 + TC * 2;
struct StageRegs { f32x4 w0, w1; u32x4 kp, kk, kb, rc, rp, vc, vp; };
__device__ __forceinline__ void scan_issue(const P& p, StageRegs& R, int row0, int h, int vq, int st) {
    const float* WD = p.out + OS_WD; const bf16* KP = (const bf16*)(p.ws + WS_KP); const bf16* KK = (const bf16*)(p.ws + WS_KK); const bf16* KB = (const bf16*)(p.ws + WS_KB); const bf16* PROJ = (const bf16*)(p.ws + WS_PROJ);
    const int tt = st >> 3, k8 = (st & 7) * 8, row = row0 + tt, prow = (row & (SEQ - 1)) ? row - 1 : row; const size_t o = (size_t)row * 512 + h * 64 + k8;
    R.w0 = *(const f32x4*)(WD + o); R.w1 = *(const f32x4*)(WD + o + 4); R.kp = *(const u32x4*)(KP + o); R.kk = *(const u32x4*)(KK + o); R.kb = *(const u32x4*)(KB + o);
    R.rc = *(const u32x4*)(PROJ + (size_t)row * PLD + h * 64 + k8); R.rp = *(const u32x4*)(PROJ + (size_t)prow * PLD + h * 64 + k8);
    if (st < 64) { const int t2 = st >> 1, v8 = (st & 1) * 8, row2 = row0 + t2, prow2 = (row2 & (SEQ - 1)) ? row2 - 1 : row2;
        R.vc = *(const u32x4*)(PROJ + (size_t)row2 * PLD + 1024 + h * 64 + vq * 16 + v8); R.vp = *(const u32x4*)(PROJ + (size_t)prow2 * PLD + 1024 + h * 64 + vq * 16 + v8); }
}
__device__ __forceinline__ void scan_commit(const StageRegs& R, float* B, int row0, int st, const float* mur, const float* muv) {
    const int tt = st >> 3, k8 = (st & 7) * 8; float kp[8], kb[8], v[8], rc[8], rp[8];
    *(f32x4*)(B + tt * 64 + k8) = R.w0; *(f32x4*)(B + tt * 64 + k8 + 4) = R.w1;
    unpack8(R.kp, kp); *(f32x4*)(B + TC * 64 + tt * 64 + k8) = (f32x4){kp[0], kp[1], kp[2], kp[3]}; *(f32x4*)(B + TC * 64 + tt * 64 + k8 + 4) = (f32x4){kp[4], kp[5], kp[6], kp[7]};
    unpack8(R.kk, v); *(f32x4*)(B + 2 * TC * 64 + tt * 64 + k8) = (f32x4){-v[0], -v[1], -v[2], -v[3]}; *(f32x4*)(B + 2 * TC * 64 + tt * 64 + k8 + 4) = (f32x4){-v[4], -v[5], -v[6], -v[7]};
    unpack8(R.kb, kb); *(f32x4*)(B + 3 * TC * 64 + tt * 64 + k8) = (f32x4){kb[0], kb[1], kb[2], kb[3]}; *(f32x4*)(B + 3 * TC * 64 + tt * 64 + k8 + 4) = (f32x4){kb[4], kb[5], kb[6], kb[7]};
    unpack8(R.rc, rc); unpack8(R.rp, rp); const float pz = ((row0 + tt) & (SEQ - 1)) ? 1.f : 0.f;
    float c1 = 0.f, c2 = 0.f;
#pragma unroll
    for (int j = 0; j < 8; ++j) { v[j] = rc[j] + (rp[j] * pz - rc[j]) * mur[j]; c1 += kb[j] * v[j]; c2 += kp[j] * v[j]; }
    *(f32x4*)(B + 4 * TC * 64 + tt * 64 + k8) = (f32x4){R.w0[0] * v[0], R.w0[1] * v[1], R.w0[2] * v[2], R.w0[3] * v[3]}; *(f32x4*)(B + 4 * TC * 64 + tt * 64 + k8 + 4) = (f32x4){R.w1[0] * v[4], R.w1[1] * v[5], R.w1[2] * v[6], R.w1[3] * v[7]};
    c1 += __shfl_xor(c1, 1); c2 += __shfl_xor(c2, 1); c1 += __shfl_xor(c1, 2); c2 += __shfl_xor(c2, 2); c1 += __shfl_xor(c1, 4); c2 += __shfl_xor(c2, 4);
    if ((st & 7) == 0) { B[5 * TC * 64 + TC * 16 + tt * 2] = c1; B[5 * TC * 64 + TC * 16 + tt * 2 + 1] = c2; }
    if (st < 64) { const int t2 = st >> 1, v8 = (st & 1) * 8; unpack8(R.vc, rc); unpack8(R.vp, rp); const float pz2 = ((row0 + t2) & (SEQ - 1)) ? 1.f : 0.f;
#pragma unroll
        for (int j = 0; j < 8; ++j) v[j] = rc[j] + (rp[j] * pz2 - rc[j]) * muv[j];
        *(f32x4*)(B + 5 * TC * 64 + t2 * 16 + v8) = (f32x4){v[0], v[1], v[2], v[3]}; *(f32x4*)(B + 5 * TC * 64 + t2 * 16 + v8 + 4) = (f32x4){v[4], v[5], v[6], v[7]}; }
}
struct ScanIn { f32x4 w, kp, ka, kb, wr; float vv, c1, c2; };
__device__ __forceinline__ ScanIn scan_load(const float* B, int tt, int kg, int rloc) {
    ScanIn s; s.w = *(const f32x4*)(B + tt * 64 + kg * 4); s.kp = *(const f32x4*)(B + TC * 64 + tt * 64 + kg * 4); s.ka = *(const f32x4*)(B + 2 * TC * 64 + tt * 64 + kg * 4);
    s.kb = *(const f32x4*)(B + 3 * TC * 64 + tt * 64 + kg * 4); s.wr = *(const f32x4*)(B + 4 * TC * 64 + tt * 64 + kg * 4);
    s.vv = B[5 * TC * 64 + tt * 16 + rloc]; s.c1 = B[5 * TC * 64 + TC * 16 + tt * 2]; s.c2 = B[5 * TC * 64 + TC * 16 + tt * 2 + 1]; return s;
}
__device__ __forceinline__ void phase_scan(const P& p_in, unsigned char* smem) {
    PHASE_PROLOGUE;
    const int lane = tid & 63, wave = tid >> 6;
    float* buf0 = (float*)smem; float* ybuf = buf0 + 2 * SBUF;
    bf16* YR = (bf16*)(p.ws + WS_XB);
    constexpr int NCH = SEQ / TC;
    for (int unit = blockIdx.x; unit < 256; unit += gridDim.x) {
        const int xcd = unit & 7, slot = unit >> 3, bh = xcd * 8 + (slot >> 2), vq = slot & 3, b = bh >> 3, h = bh & 7, rowbase = b * SEQ;
        bf16* yu = YR + (size_t)(bh * 4 + vq) * SEQ * 16;
        const int st = tid - 256;
        StageRegs R; float mur[8], muv[8];
        if (wave >= 4) {
#pragma unroll
            for (int j = 0; j < 8; ++j) { mur[j] = p.in[7][h * 64 + (st & 7) * 8 + j]; muv[j] = p.in[7][1024 + h * 64 + vq * 16 + (st & 1) * 8 + j]; }
            scan_issue(p, R, rowbase, h, vq, st); scan_commit(R, buf0, rowbase, st, mur, muv); scan_issue(p, R, rowbase + TC, h, vq, st);
        }
        __syncthreads();
        float S0 = 0.f, S1 = 0.f, S2 = 0.f, S3 = 0.f;
        const int rl = lane >> 4, kg = lane & 15, rloc = (wave & 3) * 4 + rl;
        for (int c = 0; c < NCH; ++c) {
            if (wave < 4) {
                const float* B = buf0 + (c & 1) * SBUF; float* yb = ybuf + (c & 1) * (TC * 16);
                ScanIn cur = scan_load(B, 0, kg, rloc);
#pragma unroll 4
                for (int tt = 0; tt < TC; ++tt) {
                    const ScanIn nxt = scan_load(B, (tt + 1) & (TC - 1), kg, rloc);
                    float sa = (S0 * cur.ka[0] + S1 * cur.ka[1]) + (S2 * cur.ka[2] + S3 * cur.ka[3]);
                    float y1 = (S0 * cur.wr[0] + S1 * cur.wr[1]) + (S2 * cur.wr[2] + S3 * cur.wr[3]);
                    sa += dppf<0xB1>(sa); y1 += dppf<0xB1>(y1); sa += dppf<0x4E>(sa); y1 += dppf<0x4E>(y1);
                    sa += dppf<0x141>(sa); y1 += dppf<0x141>(y1); sa += dppf<0x140>(sa); y1 += dppf<0x140>(y1);
                    S0 = S0 * cur.w[0] + (sa * cur.kb[0] + cur.vv * cur.kp[0]); S1 = S1 * cur.w[1] + (sa * cur.kb[1] + cur.vv * cur.kp[1]);
                    S2 = S2 * cur.w[2] + (sa * cur.kb[2] + cur.vv * cur.kp[2]); S3 = S3 * cur.w[3] + (sa * cur.kb[3] + cur.vv * cur.kp[3]);
                    if (kg == 0) yb[tt * 16 + rloc] = y1 + sa * cur.c1 + cur.vv * cur.c2;
                    cur = nxt;
                }
            } else {
                if (c + 1 < NCH) scan_commit(R, buf0 + ((c + 1) & 1) * SBUF, rowbase + (c + 1) * TC, st, mur, muv);
                if (c + 2 < NCH) scan_issue(p, R, rowbase + (c + 2) * TC, h, vq, st);
                if (c > 0) { const float* yp = ybuf + ((c - 1) & 1) * (TC * 16); const int i2 = st * 2;
                    *(unsigned*)(yu + (size_t)(c - 1) * TC * 16 + i2) = pkbf(yp[i2], yp[i2 + 1]); }
            }
            __syncthreads();
        }
        if (wave >= 4) { const float* yp = ybuf + ((NCH - 1) & 1) * (TC * 16); const int i2 = st * 2;
            *(unsigned*)(yu + (size_t)(NCH - 1) * TC * 16 + i2) = pkbf(yp[i2], yp[i2 + 1]); }
        else *(f32x4*)(p.out + O_WKVP + ((size_t)(bh * 64 + vq * 16 + rloc)) * 64 + kg * 4) = (f32x4){S0, S1, S2, S3};
        __syncthreads();
    }
}


constexpr int CK = 16, NCHAIN = 2, NHELP = 8 - NCHAIN, SLOTB = 22912, NCHK = SEQ / CK, SCAN_WGS = 256 / NCHAIN;
constexpr int SO_AT = 0, SO_RT = 2304, SO_BT = 4608, SO_KT = 6912, SO_BH = 9216, SO_KH = 12288, SO_NAK = 15360, SO_NBR = 16128, SO_NKR = 16896, SO_TT = 17664, SO_VT = 18432, SO_DC = 21504, SO_NAB = 21760;
constexpr int CR_SB = NHELP * SLOTB, FL_OFF = CR_SB + NCHAIN * 3072;
static_assert(FL_OFF + 256 <= MISC_OFF, "scan LDS map");
struct HelpRegs { f32x4 w0, w1; u32x4 kp, kk, kb, rc, rp, vc, vp; };
__device__ __forceinline__ void help_issue(const P& p, HelpRegs (&R)[2], int row0, int h, int lane) {
    const float* WD = p.out + OS_WD; const bf16* KP = (const bf16*)(p.ws + WS_KP); const bf16* KK = (const bf16*)(p.ws + WS_KK); const bf16* KB = (const bf16*)(p.ws + WS_KB); const bf16* PROJ = (const bf16*)(p.ws + WS_PROJ);
#pragma unroll
    for (int i = 0; i < 2; ++i) { const int pc = lane + i * 64, tt = pc & 15, k8 = (pc >> 4) * 8, row = row0 + tt, prow = (row & (SEQ - 1)) ? row - 1 : row; const size_t o = (size_t)row * 512 + h * 64 + k8;
        R[i].w0 = *(const f32x4*)(WD + o); R[i].w1 = *(const f32x4*)(WD + o + 4); R[i].kp = *(const u32x4*)(KP + o); R[i].kk = *(const u32x4*)(KK + o); R[i].kb = *(const u32x4*)(KB + o);
        R[i].rc = *(const u32x4*)(PROJ + (size_t)row * PLD + h * 64 + k8); R[i].rp = *(const u32x4*)(PROJ + (size_t)prow * PLD + h * 64 + k8);
        R[i].vc = *(const u32x4*)(PROJ + (size_t)row * PLD + 1024 + h * 64 + k8); R[i].vp = *(const u32x4*)(PROJ + (size_t)prow * PLD + 1024 + h * 64 + k8); }
}
__device__ __forceinline__ void phase_scan2(const P& p_in, unsigned char* smem) {
    PHASE_PROLOGUE;
    const int lane = tid & 63, wave = tid >> 6, r = lane & 15, q = lane >> 4;
    bf16* YR = (bf16*)(p.ws + WS_XB);
    volatile unsigned* flags = (volatile unsigned*)(smem + FL_OFF);
    const bf16x8 zero8 = {0, 0, 0, 0, 0, 0, 0, 0};
    for (int unit = blockIdx.x; unit < SCAN_WGS; unit += SCAN_WGS) {
        const int ub = unit / (4 / NCHAIN), part = unit % (4 / NCHAIN), bh = (ub & 7) * 8 + (ub >> 3), vq = part * NCHAIN + (wave % NCHAIN), b = bh >> 3, h = bh & 7, rowbase = b * SEQ;
        if (tid < 64) flags[tid] = 0u;
        __syncthreads();
        if (wave < NCHAIN) {
            __builtin_amdgcn_s_setprio(3);
            bf16* yu = YR + (size_t)(bh * 4 + vq) * SEQ * 16;
            f32x4 ST[4];
#pragma unroll
            for (int mt = 0; mt < 4; ++mt) ST[mt] = (f32x4){0.f, 0.f, 0.f, 0.f};
            for (int c = 0; c < NCHK; ++c) {
                const int slot = c % NHELP; unsigned char* sb = smem + slot * SLOTB;
                const bf16* AT = (const bf16*)(sb + SO_AT); const bf16* RT = (const bf16*)(sb + SO_RT); const bf16* BH = (const bf16*)(sb + SO_BH); const bf16* KH = (const bf16*)(sb + SO_KH);
                const bf16* NAK = (const bf16*)(sb + SO_NAK); const bf16* NBR = (const bf16*)(sb + SO_NBR); const bf16* NKR = (const bf16*)(sb + SO_NKR); const bf16* TT = (const bf16*)(sb + SO_TT);
                const bf16* VT = (const bf16*)(sb + SO_VT) + vq * 16 * 24; const float* DC = (const float*)(sb + SO_DC);
                s16x4 sb4[4];
#pragma unroll
                for (int mt = 0; mt < 4; ++mt) sb4[mt] = cvt4(ST[mt]);
                { unsigned sp = 0; while (flags[slot] != (unsigned)(c + 1)) { __builtin_amdgcn_s_sleep(1); if (++sp > (1u << 22)) break; } }
                asm volatile("" ::: "memory");
                s16x4 fa[4], fr[4], fbh[4], fkh[4]; f32x4 dcv[4];
#pragma unroll
                for (int mt = 0; mt < 4; ++mt) { fa[mt] = *(const s16x4*)(AT + r * 72 + mt * 16 + q * 4); fr[mt] = *(const s16x4*)(RT + r * 72 + mt * 16 + q * 4);
                    fbh[mt] = *(const s16x4*)(BH + (mt * 16 + r) * 24 + q * 4); fkh[mt] = *(const s16x4*)(KH + (mt * 16 + r) * 24 + q * 4); dcv[mt] = *(const f32x4*)(DC + mt * 16 + q * 4); }
                const s16x4 fnak = *(const s16x4*)(NAK + lane * 4), ftt = *(const s16x4*)(TT + lane * 4), fnbr = *(const s16x4*)(NBR + lane * 4), fnkr = *(const s16x4*)(NKR + lane * 4);
                const s16x4 fvt = *(const s16x4*)(VT + r * 24 + q * 4);
                LDS_FENCE();
                if (lane == 0) flags[8 + slot * NCHAIN + wave] = (unsigned)(c + 1);
                f32x4 Wt = {0.f, 0.f, 0.f, 0.f};
#pragma unroll
                for (int mt = 0; mt < 4; ++mt) Wt = mf16(fa[mt], sb4[mt], Wt);
                Wt = mf16(fnak, fvt, Wt);
                f32x4 Ut = {0.f, 0.f, 0.f, 0.f};
                Ut = mf16(ftt, cvt4(Wt), Ut);
                const s16x4 ub = cvt4(Ut);
#pragma unroll
                for (int mt = 0; mt < 4; ++mt) { ST[mt] = ST[mt] * dcv[mt]; ST[mt] = mf16(fbh[mt], ub, ST[mt]); ST[mt] = mf16(fkh[mt], fvt, ST[mt]); }
                f32x4 Yt = {0.f, 0.f, 0.f, 0.f};
#pragma unroll
                for (int mt = 0; mt < 4; ++mt) Yt = mf16(fr[mt], sb4[mt], Yt);
                Yt = mf16(fnbr, ub, Yt); Yt = mf16(fnkr, fvt, Yt);
#pragma unroll
                for (int j = 0; j < 4; ++j) yu[(size_t)(c * CK + q * 4 + j) * 16 + r] = f2bf(Yt[j]);
            }
#pragma unroll
            for (int mt = 0; mt < 4; ++mt) *(f32x4*)(p.out + O_WKVP + ((size_t)(bh * 64 + vq * 16 + r)) * 64 + mt * 16 + q * 4) = ST[mt];
            __builtin_amdgcn_s_setprio(0);
        } else {
            const int hw = wave - NCHAIN; unsigned char* sb = smem + hw * SLOTB;
            bf16* AT = (bf16*)(sb + SO_AT); bf16* RT = (bf16*)(sb + SO_RT); bf16* BT = (bf16*)(sb + SO_BT); bf16* KT = (bf16*)(sb + SO_KT); bf16* BH = (bf16*)(sb + SO_BH); bf16* KH = (bf16*)(sb + SO_KH);
            bf16* NAK = (bf16*)(sb + SO_NAK); bf16* NBR = (bf16*)(sb + SO_NBR); bf16* NKR = (bf16*)(sb + SO_NKR); bf16* TT = (bf16*)(sb + SO_TT); bf16* VT = (bf16*)(sb + SO_VT);
            float* DC = (float*)(sb + SO_DC); float* NAB = (float*)(sb + SO_NAB); float* WR = (float*)(sb + SO_BH);
            float mur[2][8], muv[2][8];
#pragma unroll
            for (int i = 0; i < 2; ++i)
#pragma unroll
                for (int j = 0; j < 8; ++j) { mur[i][j] = p.in[7][h * 64 + ((lane + i * 64) >> 4) * 8 + j]; muv[i][j] = p.in[7][1024 + h * 64 + ((lane + i * 64) >> 4) * 8 + j]; }
            HelpRegs R[2];
            help_issue(p, R, rowbase + hw * CK, h, lane);
            for (int c = hw; c < NCHK; c += NHELP) {
                if (c >= NHELP) { const unsigned want = (unsigned)(c - NHELP + 1); unsigned sp = 0;
                    for (;;) { bool ok = true;
#pragma unroll
                        for (int w = 0; w < NCHAIN; ++w) ok = ok && (flags[8 + hw * NCHAIN + w] == want);
                        if (ok) break; __builtin_amdgcn_s_sleep(2); if (++sp > (1u << 22)) break; } }
                asm volatile("" ::: "memory");
                const int row0 = rowbase + c * CK;
#pragma unroll
                for (int i = 0; i < 2; ++i) { const int k8 = ((lane >> 4) + 4 * i) * 8, tt = lane & 15; float w[8], pre[8], suf[8], x[8], y[8], rc[8], rp[8];
#pragma unroll
                    for (int j = 0; j < 4; ++j) { w[j] = R[i].w0[j]; w[4 + j] = R[i].w1[j]; }
#pragma unroll
                    for (int j = 0; j < 8; ++j) { float a = w[j], z = w[j];
                        a *= dppo<0x111>(a); a *= dppo<0x112>(a); a *= dppo<0x114>(a); a *= dppo<0x118>(a);
                        z *= dppo<0x101>(z); z *= dppo<0x102>(z); z *= dppo<0x104>(z); z *= dppo<0x108>(z);
                        pre[j] = a; suf[j] = z * __builtin_amdgcn_rcpf(w[j]); }
                    if (tt == 15) { *(f32x4*)(DC + k8) = (f32x4){pre[0], pre[1], pre[2], pre[3]}; *(f32x4*)(DC + k8 + 4) = (f32x4){pre[4], pre[5], pre[6], pre[7]}; }
                    unpack8(R[i].kk, x);
#pragma unroll
                    for (int j = 0; j < 8; ++j) y[j] = -x[j] * dppo<0x111>(pre[j]);
                    *(u32x4*)(AT + tt * 72 + k8) = pack8(y);
                    unpack8(R[i].kb, x);
#pragma unroll
                    for (int j = 0; j < 8; ++j) { const float inv = __builtin_amdgcn_rcpf(pre[j]); rp[j] = inv; y[j] = x[j] * inv; x[j] *= suf[j]; }
                    *(u32x4*)(BT + tt * 72 + k8) = pack8(y);
#pragma unroll
                    for (int j = 0; j < 8; ++j) BH[(k8 + j) * 24 + tt] = f2bf(x[j]);
                    unpack8(R[i].kp, x);
#pragma unroll
                    for (int j = 0; j < 8; ++j) { y[j] = x[j] * rp[j]; x[j] *= suf[j]; }
                    *(u32x4*)(KT + tt * 72 + k8) = pack8(y);
#pragma unroll
                    for (int j = 0; j < 8; ++j) KH[(k8 + j) * 24 + tt] = f2bf(x[j]);
                    unpack8(R[i].rc, rc); unpack8(R[i].rp, rp); const float pz = ((row0 + tt) & (SEQ - 1)) ? 1.f : 0.f;
#pragma unroll
                    for (int j = 0; j < 8; ++j) y[j] = (rc[j] + (rp[j] * pz - rc[j]) * mur[i][j]) * pre[j];
                    *(u32x4*)(RT + tt * 72 + k8) = pack8(y);
                    unpack8(R[i].vc, rc); unpack8(R[i].vp, rp);
#pragma unroll
                    for (int j = 0; j < 8; ++j) VT[(k8 + j) * 24 + tt] = f2bf(rc[j] + (rp[j] * pz - rc[j]) * muv[i][j]); }
                if (c + NHELP < NCHK) help_issue(p, R, rowbase + (c + NHELP) * CK, h, lane);
                LDS_FENCE();
                { f32x4 nab = {0.f, 0.f, 0.f, 0.f}, nabT = nab, nak = nab, nbr = nab, nkr = nab;
#pragma unroll
                  for (int ks = 0; ks < 2; ++ks) { const bf16x8 fb = *(const bf16x8*)(BT + r * 72 + ks * 32 + q * 8), fk = *(const bf16x8*)(KT + r * 72 + ks * 32 + q * 8), fa = *(const bf16x8*)(AT + r * 72 + ks * 32 + q * 8), fr = *(const bf16x8*)(RT + r * 72 + ks * 32 + q * 8);
                      nab = mfma16(fb, fa, nab); nabT = mfma16(fa, fb, nabT); nak = mfma16(fk, fa, nak); nbr = mfma16(fb, fr, nbr); nkr = mfma16(fk, fr, nkr); }
#pragma unroll
                  for (int j = 0; j < 4; ++j) { const int i = q * 4 + j, t = r;
                      nab[j] = (i < t) ? nab[j] : 0.f; nabT[j] = (r < i) ? nabT[j] : 0.f; nak[j] = (i < t) ? nak[j] : 0.f; nbr[j] = (i <= t) ? nbr[j] : 0.f; nkr[j] = (i <= t) ? nkr[j] : 0.f; }
                  *(s16x4*)(NAK + lane * 4) = cvt4(nak); *(s16x4*)(NBR + lane * 4) = cvt4(nbr); *(s16x4*)(NKR + lane * 4) = cvt4(nkr);
                  const f32x4 z4 = {0.f, 0.f, 0.f, 0.f};
                  const s16x4 bN = cvt4(nab), bNT = cvt4(nabT);
                  const f32x4 n2 = mf16(bNT, bN, z4), n2T = mf16(bN, bNT, z4);
                  const s16x4 b2 = cvt4(n2), b2T = cvt4(n2T);
                  const f32x4 n4 = mf16(b2T, b2, z4), n4T = mf16(b2, b2T, z4);
                  const s16x4 b4 = cvt4(n4), b4T = cvt4(n4T);
                  f32x4 X = mf16(b4T, b4, z4);
#pragma unroll
                  for (int j = 0; j < 4; ++j) X[j] += (q * 4 + j == r) ? 1.f : 0.f;
                  X = mf16(b4T, cvt4(X), X);
                  X = mf16(b2T, cvt4(X), X);
                  X = mf16(bNT, cvt4(X), X);
                  *(s16x4*)(TT + lane * 4) = cvt4(X); }
                LDS_FENCE();
                if (lane == 0) flags[hw] = (unsigned)(c + 1);
            }
        }
        __syncthreads();
    }
}

__device__ __forceinline__ bf16x8 ldfrag(const bf16* base, int ld, int row0, int k0, int r, int q) { return *(const bf16x8*)(base + (row0 + r) * ld + k0 + q * 8); }
__device__ __forceinline__ void phase_ssd(const P& p_in, unsigned char* smem) {
    PHASE_PROLOGUE;
    const int lane = tid & 63, wave = tid >> 6, r = lane & 15, q = lane >> 4;
    bf16* XT = (bf16*)(smem + 53248); bf16* XdT = (bf16*)(smem + 57856); bf16* Gs = (bf16*)(smem + 62464); bf16* Hb = (bf16*)(smem + 71680); float* xsn = (float*)(smem + 80384);
    const bf16* XBC = (const bf16*)(p.ws + WS_XBC); const float* DT = (const float*)(p.ws + WS_DT); bf16* YM = (bf16*)(p.ws + WS_XB) + (size_t)MPR * 512;
    for (int unit = (int)blockIdx.x - SCAN_WGS; unit >= 0 && unit < 128; unit += 128) {
        const int bg = unit >> 3, e = (unit >> 1) & 3, ph = unit & 1, b = bg >> 1, g = bg & 1, h = g * 4 + e;
        const float A = -__expf(p.in[21][h]), Dh = p.in[22][h];
        f32x4 hacc[2] = {{0.f, 0.f, 0.f, 0.f}, {0.f, 0.f, 0.f, 0.f}};
        for (int i = tid; i < 32 * 136; i += 512) Hb[i] = 0;
        u32x4 rc[2], rb[2]; unsigned rx0, rx1; float rdt = 0.f;
#define SSD_LOAD(c_) do { const int row0_ = b * SEQ + (c_) * 64; \
            _Pragma("unroll") for (int i = 0; i < 2; ++i) { const int pc = tid + i * 512, s_ = pc >> 4, n8 = (pc & 15) * 8; \
                rc[i] = *(const u32x4*)(XBC + (size_t)(row0_ + s_) * 1024 + 768 + g * 128 + n8); rb[i] = *(const u32x4*)(XBC + (size_t)(row0_ + s_) * 1024 + 512 + g * 128 + n8); } \
            { const unsigned* xp_ = (const unsigned*)(XBC + (size_t)(row0_ + (tid >> 3)) * 1024 + h * 64 + ph * 32 + (tid & 7) * 4); rx0 = xp_[0]; rx1 = xp_[1]; } \
            if (tid < 64) rdt = DT[(size_t)(row0_ + tid) * 8 + h]; } while (0)
        SSD_LOAD(0);
        for (int c = 0; c < SEQ / 64; ++c) {
            unsigned char* sb = smem + (c & 1) * 89088; bf16* Cs = (bf16*)sb; bf16* Bs = (bf16*)(sb + 17408); bf16* BT = (bf16*)(sb + 34816);
            float* cs = (float*)(smem + ((c & 1) ? 142336 : 88576)); float* dtv = cs + 64;
#pragma unroll
            for (int i = 0; i < 2; ++i) { const int pc = tid + i * 512, s_ = pc >> 4, n8 = (pc & 15) * 8;
                *(u32x4*)(Cs + s_ * 136 + n8) = rc[i]; *(u32x4*)(Bs + s_ * 136 + n8) = rb[i];
                const unsigned w[4] = {rb[i].x, rb[i].y, rb[i].z, rb[i].w};
                const int sp = ((((s_ >> 3) ^ (pc & 7)) << 3) | (s_ & 7));
#pragma unroll
                for (int j = 0; j < 4; ++j) { BT[(n8 + 2 * j) * 72 + sp] = (bf16)(w[j] & 0xffffu); BT[(n8 + 2 * j + 1) * 72 + sp] = (bf16)(w[j] >> 16); } }
            if (wave == 0) { float v = A * rdt;
                v += dppf<0x111>(v); v += dppf<0x112>(v); v += dppf<0x114>(v); v += dppf<0x118>(v);
                v += __int_as_float(__builtin_amdgcn_update_dpp(0, __float_as_int(v), 0x142, 0xa, 0xf, false));
                v += __int_as_float(__builtin_amdgcn_update_dpp(0, __float_as_int(v), 0x143, 0xc, 0xf, false));
                cs[lane] = v; dtv[lane] = rdt; }
            __syncthreads();
            { const int s_ = tid >> 3, p4 = (tid & 7) * 4; const float dts = dtv[s_], dec = __expf(cs[63] - cs[s_]);
              const float x[4] = {bflo(rx0), bfhi(rx0), bflo(rx1), bfhi(rx1)};
#pragma unroll
              for (int j = 0; j < 4; ++j) { const float X = x[j] * dts; XT[(p4 + j) * 72 + s_] = f2bf(X); XdT[(p4 + j) * 72 + s_] = f2bf(X * dec); }
              *(f32x4*)(xsn + s_ * 32 + p4) = (f32x4){x[0], x[1], x[2], x[3]}; }
            if (c + 1 < SEQ / 64) SSD_LOAD(c + 1);
#pragma unroll
            for (int i = 0; i < 2; ++i) { const int tile = wave * 2 + i, mt = tile >> 2, nt = tile & 3; f32x4 acc = {0.f, 0.f, 0.f, 0.f};
#pragma unroll
                for (int ks = 0; ks < 4; ++ks) acc = mfma16(ldfrag(Cs, 136, mt * 16, ks * 32, r, q), ldfrag(Bs, 136, nt * 16, ks * 32, r, q), acc);
                const int s_ = nt * 16 + r; const float css = cs[s_];
#pragma unroll
                for (int j = 0; j < 4; ++j) { const int l = mt * 16 + q * 4 + j; const float gv = (s_ <= l) ? acc[j] * __expf(cs[l] - css) : 0.f; Gs[l * 72 + s_] = f2bf(gv); } }
            const int mt = wave >> 1, pt = wave & 1;
            f32x4 yacc = {0.f, 0.f, 0.f, 0.f};
#pragma unroll
            for (int ks = 0; ks < 4; ++ks) yacc = mfma16(ldfrag(Cs, 136, mt * 16, ks * 32, r, q), ldfrag(Hb, 136, pt * 16, ks * 32, r, q), yacc);
#pragma unroll
            for (int j = 0; j < 4; ++j) yacc[j] *= __expf(cs[mt * 16 + q * 4 + j]);
            __syncthreads();
#pragma unroll
            for (int ks = 0; ks < 2; ++ks) yacc = mfma16(ldfrag(Gs, 72, mt * 16, ks * 32, r, q), ldfrag(XT, 72, pt * 16, ks * 32, r, q), yacc);
#pragma unroll
            for (int j = 0; j < 4; ++j) { const int l = mt * 16 + q * 4 + j; YM[((size_t)((b * 8 + h) * 4 + ph * 2 + pt) * SEQ + c * 64 + l) * 16 + r] = f2bf(yacc[j] + Dh * xsn[l * 32 + pt * 16 + r]); }
            { const float dl = __expf(cs[63]);
#pragma unroll
              for (int t2 = 0; t2 < 2; ++t2) { hacc[t2] = hacc[t2] * dl;
#pragma unroll
                  for (int ks = 0; ks < 2; ++ks) hacc[t2] = mfma16(ldfrag(XdT, 72, t2 * 16, ks * 32, r, q), *(const bf16x8*)(BT + (wave * 16 + r) * 72 + (((ks * 4 + q) ^ ((wave * 2 + (r >> 3)) & 7)) << 3)), hacc[t2]);
#pragma unroll
                  for (int j = 0; j < 4; ++j) Hb[(t2 * 16 + q * 4 + j) * 136 + wave * 16 + r] = f2bf(hacc[t2][j]); } }
        }
#undef SSD_LOAD
#pragma unroll
        for (int t2 = 0; t2 < 2; ++t2)
#pragma unroll
            for (int j = 0; j < 4; ++j) p.out[O_SSMP + ((size_t)((b * 8 + h) * 64 + ph * 32 + t2 * 16 + q * 4 + j)) * 128 + wave * 16 + r] = hacc[t2][j];
        __syncthreads();
    }
}

__device__ __forceinline__ float conv_act_s(const P& p, int bs, int c) {
    const bf16* PROJ = (const bf16*)(p.ws + WS_PROJ); const float* sc = p.in[4] + (size_t)bs * 3072 + c; const float* cw = p.in[18] + c;
    const float v = p.in[19][c] + cw[0] * sc[0] + cw[1024] * sc[1024] + cw[2048] * sc[2048] + cw[3072] * bf2f(PROJ[(size_t)(MPR + bs) * PLD + 2304 + c]);
    return silu(v);
}
__device__ __forceinline__ void phase_sample_step(const P& p_in, unsigned char* smem) {
    PHASE_PROLOGUE;
    const int lane = tid & 63, wave = tid >> 6, G = gridDim.x, bid = blockIdx.x;
    const int first = SCAN_WGS;
    const int gw = (bid - first) * 8 + wave, NGW = (G - first) * 8;
    if (bid < first) return;
    float* sv = (float*)(smem + wave * 2048);
    const float* WD = p.out + OS_WD; const bf16* KP = (const bf16*)(p.ws + WS_KP); const bf16* KK = (const bf16*)(p.ws + WS_KK); const bf16* KB = (const bf16*)(p.ws + WS_KB);
    bf16* YS = (bf16*)(p.ws + WS_YS); const float* DT = (const float*)(p.ws + WS_DT);
    const int kq = lane & 15, rr = lane >> 4;
    for (int unit = gw; unit < 2048; unit += NGW) {
        const int bs = (unit & 1023) >> 3, h = unit & 7, row = MPR + bs;
        if (unit < 1024) {
            const size_t o = (size_t)row * 512 + h * 64 + lane;
            sv[lane] = WD[o]; sv[64 + lane] = bf2f(KP[o]); sv[128 + lane] = -bf2f(KK[o]); sv[192 + lane] = bf2f(KB[o]); sv[256 + lane] = lerp1(p, row, h * 64 + lane); sv[320 + lane] = lerp1(p, row, 1024 + h * 64 + lane);
            LDS_FENCE();
            const f32x4 w4 = *(const f32x4*)(sv + kq * 4), kp4 = *(const f32x4*)(sv + 64 + kq * 4), ka4 = *(const f32x4*)(sv + 128 + kq * 4), kb4 = *(const f32x4*)(sv + 192 + kq * 4), r4 = *(const f32x4*)(sv + 256 + kq * 4);
            const size_t so = (size_t)(bs * 8 + h) * 4096 + rr * 64 + kq * 4;
            const float* Sb = p.in[3] + so; float* Ob = p.out + O_WKVS + so;
            f32x4 S[16]; float sa[16];
#pragma unroll
            for (int i = 0; i < 16; ++i) S[i] = *(const f32x4*)(Sb + i * 256);
#pragma unroll
            for (int i = 0; i < 16; ++i) sa[i] = sum16((S[i][0] * ka4[0] + S[i][1] * ka4[1]) + (S[i][2] * ka4[2] + S[i][3] * ka4[3]));
#pragma unroll
            for (int i = 0; i < 16; ++i) { const float vv = sv[320 + 4 * i + rr]; f32x4 n;
#pragma unroll
                for (int j = 0; j < 4; ++j) n[j] = S[i][j] * w4[j] + (sa[i] * kb4[j] + vv * kp4[j]);
                *(f32x4*)(Ob + i * 256) = n;
                const float y = sum16((n[0] * r4[0] + n[1] * r4[1]) + (n[2] * r4[2] + n[3] * r4[3]));
                if (kq == 0) YS[(size_t)bs * 1024 + h * 64 + 4 * i + rr] = f2bf(y); }
            LDS_FENCE();
        } else {
            const int g = h >> 2;
            sv[lane] = conv_act_s(p, bs, 512 + g * 128 + lane); sv[64 + lane] = conv_act_s(p, bs, 512 + g * 128 + 64 + lane);
            sv[128 + lane] = conv_act_s(p, bs, 768 + g * 128 + lane); sv[192 + lane] = conv_act_s(p, bs, 768 + g * 128 + 64 + lane);
            sv[256 + lane] = conv_act_s(p, bs, h * 64 + lane);
            LDS_FENCE();
            const float dt = DT[(size_t)row * 8 + h], A = -__expf(p.in[21][h]), dA = __expf(A * dt), Dh = p.in[22][h];
            const f32x4 Bl = *(const f32x4*)(sv + kq * 4), Bh = *(const f32x4*)(sv + 64 + kq * 4), Cl = *(const f32x4*)(sv + 128 + kq * 4), Ch = *(const f32x4*)(sv + 192 + kq * 4);
            const size_t so = (size_t)(bs * 8 + h) * 8192 + rr * 128 + kq * 4;
            const float* Hb_ = p.in[5] + so; float* Ob = p.out + O_SSMS + so;
#pragma unroll
            for (int half = 0; half < 2; ++half) { f32x4 hl[8], hh[8];
#pragma unroll
                for (int i = 0; i < 8; ++i) { hl[i] = *(const f32x4*)(Hb_ + (half * 8 + i) * 512); hh[i] = *(const f32x4*)(Hb_ + (half * 8 + i) * 512 + 64); }
#pragma unroll
                for (int i = 0; i < 8; ++i) { const int pp = 4 * (half * 8 + i) + rr; const float x = sv[256 + pp], dtx = dt * x; f32x4 nl, nh; float y = 0.f;
#pragma unroll
                    for (int j = 0; j < 4; ++j) { nl[j] = hl[i][j] * dA + dtx * Bl[j]; nh[j] = hh[i][j] * dA + dtx * Bh[j]; y += nl[j] * Cl[j] + nh[j] * Ch[j]; }
                    *(f32x4*)(Ob + (half * 8 + i) * 512) = nl; *(f32x4*)(Ob + (half * 8 + i) * 512 + 64) = nh;
                    y = sum16(y) + Dh * x;
                    if (kq == 0) YS[(size_t)bs * 1024 + 512 + h * 64 + pp] = f2bf(y); } }
            LDS_FENCE();
        }
    }
}

__device__ __forceinline__ void phase_post(const P& p_in) {
    PHASE_PROLOGUE;
    const int lane = tid & 63, wave = tid >> 6, G = gridDim.x, bid = blockIdx.x;
    const int gw = bid * 8 + wave, NGW = G * 8;
    bf16* MIX = (bf16*)(p.ws + WS_MIX); const bf16* YR = (const bf16*)(p.ws + WS_XB); const bf16* YM = YR + (size_t)MPR * 512; const bf16* YS = (const bf16*)(p.ws + WS_YS);
    const bf16* PROJ = (const bf16*)(p.ws + WS_PROJ); const bf16* KP = (const bf16*)(p.ws + WS_KP); const bf16* GG = (const bf16*)(p.out + OS_GG);
    for (int row = gw; row < MTOT; row += NGW) {
        const int c0 = lane * 8;
        const size_t yo = ((size_t)(((row >> 11) * 8 + (lane >> 3)) * 4 + ((lane & 7) >> 1)) * SEQ + (row & (SEQ - 1))) * 16 + (lane & 1) * 8;
        {
            float y[8], rr[8], kp[8], vv[8], gg[8];
            unpack8(row < MPR ? *(const u32x4*)(YR + yo) : *(const u32x4*)(YS + (size_t)(row - MPR) * 1024 + c0), y);
            float s = 0.f;
#pragma unroll
            for (int i = 0; i < 8; ++i) s += y[i];
            s = sum8(s);
            const float mean = s * (1.f / 64.f); float s2 = 0.f;
#pragma unroll
            for (int i = 0; i < 8; ++i) { y[i] -= mean; s2 += y[i] * y[i]; }
            s2 = sum8(s2);
            const float rstd = rsqrtf(s2 * (1.f / 64.f) + 64e-5f);
            lerp8(p, row, c0, rr); lerp8(p, row, 1024 + c0, vv);
            unpack8(*(const u32x4*)(KP + (size_t)row * 512 + c0), kp); unpack8(*(const u32x4*)(GG + (size_t)row * 512 + c0), gg);
            float bo = 0.f;
#pragma unroll
            for (int i = 0; i < 8; ++i) bo += rr[i] * kp[i] * p.in[15][c0 + i];
            bo = sum8(bo);
#pragma unroll
            for (int i = 0; i < 8; ++i) y[i] = (y[i] * rstd * p.in[16][c0 + i] + p.in[17][c0 + i] + bo * vv[i]) * gg[i];
            *(u32x4*)(MIX + (size_t)row * 1024 + c0) = pack8(y);
        }
        {
            float y[8], z[8];
            unpack8(row < MPR ? *(const u32x4*)(YM + yo) : *(const u32x4*)(YS + (size_t)(row - MPR) * 1024 + 512 + c0), y); unpack8(*(const u32x4*)(PROJ + (size_t)row * PLD + 1792 + c0), z);
            float ss = 0.f;
#pragma unroll
            for (int i = 0; i < 8; ++i) { y[i] *= silu(z[i]); ss += y[i] * y[i]; }
            ss = sum32(ss, lane >= 32);
            const float sc = rsqrtf(ss * (1.f / 256.f) + 1e-5f);
#pragma unroll
            for (int i = 0; i < 8; ++i) y[i] = y[i] * sc * p.in[23][c0 + i];
            *(u32x4*)(MIX + (size_t)row * 1024 + 512 + c0) = pack8(y);
        }
    }
}

template <bool TO_BF16> __device__ __forceinline__ void phase_ln(const P& p_in, const float* gam, const float* bet, bf16* ob, size_t src_off, int sld) {
    PHASE_PROLOGUE;
    const int lane = tid & 63, wave = tid >> 6, G = gridDim.x, bid = blockIdx.x;
    const int gw = bid * 8 + wave, NGW = G * 8;
    const bf16* src = (const bf16*)p.out + src_off;
    f32x4 gv[4], bv[4];
#pragma unroll
    for (int j = 0; j < 4; ++j) { gv[j] = *(const f32x4*)(gam + lane * 4 + 256 * j); bv[j] = *(const f32x4*)(bet + lane * 4 + 256 * j); }
    unsigned long long nx[4] = {0ull, 0ull, 0ull, 0ull};
    if (gw < MTOT) {
#pragma unroll
        for (int j = 0; j < 4; ++j) nx[j] = *(const unsigned long long*)(src + (size_t)gw * sld + lane * 4 + 256 * j); }
    for (int row = gw; row < MTOT; row += NGW) {
        float* xr = p.out + (size_t)row * 1024 + lane * 4;
        f32x4 v[4]; float s = 0.f;
#pragma unroll
        for (int j = 0; j < 4; ++j) { const unsigned lo = (unsigned)nx[j], hi = (unsigned)(nx[j] >> 32);
            v[j] = (f32x4){bflo(lo), bfhi(lo), bflo(hi), bfhi(hi)}; s += (v[j][0] + v[j][1]) + (v[j][2] + v[j][3]); }
        if (row + NGW < MTOT) {
#pragma unroll
            for (int j = 0; j < 4; ++j) nx[j] = *(const unsigned long long*)(src + (size_t)(row + NGW) * sld + lane * 4 + 256 * j); }
        s = sum64(s);
        const float mean = s * (1.f / 1024.f); float s2 = 0.f;
#pragma unroll
        for (int j = 0; j < 4; ++j) { v[j] = v[j] - mean; s2 += (v[j][0] * v[j][0] + v[j][1] * v[j][1]) + (v[j][2] * v[j][2] + v[j][3] * v[j][3]); }
        s2 = sum64(s2);
        const float rstd = rsqrtf(s2 * (1.f / 1024.f) + 1e-5f);
#pragma unroll
        for (int j = 0; j < 4; ++j) { const f32x4 o = v[j] * rstd * gv[j] + bv[j];
            if (TO_BF16) { unsigned long long w = (unsigned long long)pkbf(o[0], o[1]) | ((unsigned long long)pkbf(o[2], o[3]) << 32); *(unsigned long long*)(ob + (size_t)row * 1024 + lane * 4 + 256 * j) = w; }
            else *(f32x4*)(xr + 256 * j) = o; }
    }
}

#ifndef USE_CHUNKED
#define USE_CHUNKED 1
#endif
#ifndef REPEAT_SEL
#define REPEAT_SEL 0
#endif
#ifndef DUMP_SEL
#define DUMP_SEL 0
#endif
#ifndef STOP_AFTER
#define STOP_AFTER 99
#endif
__global__ void __launch_bounds__(512, 2) mega(P p) {
    extern __shared__ __attribute__((aligned(16))) unsigned char smem[];
    LAS unsigned char* lds = (LAS unsigned char*)smem;
    volatile LAS unsigned* MISC = (volatile LAS unsigned*)(lds + MISC_OFF);
    if (threadIdx.x < 16) MISC[threadIdx.x] = 0u;
    __syncthreads();
    XcdBarrier bar = xcd_barrier_post((unsigned*)(p.ws + WS_CTL), MISC);
    if (p.never) cg::this_grid().sync();
#define GRID_BAR() xcd_barrier(bar)
    const int G = gridDim.x, bid = blockIdx.x;
    bf16* XB = (bf16*)(p.ws + WS_XB); bf16* PROJ = (bf16*)(p.ws + WS_PROJ); float* DT = (float*)(p.ws + WS_DT); bf16* HID = (bf16*)(p.ws + WS_HID);

#if STOP_AFTER != 99
    { const size_t gt = (size_t)blockIdx.x * 512 + threadIdx.x, NGT = (size_t)gridDim.x * 512; for (size_t i = O_SHP + gt; i < 30939136; i += NGT) p.out[i] = 0.f; }
    GRID_BAR();
#endif
    phase0(p, smem);
    GRID_BAR();
    {
        pg8::Gemm g{XB, (const bf16*)(p.ws + WS_WIN), MPR, 3584, 1024}; pg8::StaticOrder S; S.init(MPR, 3584, G, bid);
        pg8::EpiProj E{PROJ, DT, p.in[20], p.out};
        pg8::gemm_phase<pg8::EpiProj, pg8::StaticOrder, true, true>(lds, g, S, E);
        const float* dtb = p.in[20]; float* out = p.out;
        small_gemm<4, 1024>(XB + (size_t)MPR * 1024, (const bf16*)(p.ws + WS_WIN), PROJN, smem, [=](int rs, int c, float v) {
            if (c < 3328) PROJ[(size_t)(MPR + rs) * PLD + c] = f2bf(v); else DT[(size_t)(MPR + rs) * 8 + (c - 3328)] = softplus(v + dtb[c - 3328]);
            if (c < 1792) out[O_SHS + (size_t)rs * 1792 + c] = v;
            if (c >= 2304 && c < 3328) out[O_CONVS + ((size_t)rs * 3 + 2) * 1024 + (c - 2304)] = v; }, (G == 256) ? 128 : 0);
        phase0_late(p, smem, (G == 256) ? 128 : 0, 0);
    }
    GRID_BAR();
    phase_prep(p, smem);
#if REPEAT_SEL == 2
    phase_prep(p, smem);
#endif
    GRID_BAR();
#if STOP_AFTER == 2
    { const size_t gt = (size_t)blockIdx.x * 512 + threadIdx.x, NGT = (size_t)gridDim.x * 512; const bf16* KPd = (const bf16*)(p.ws + WS_KP); const bf16* XBCd = (const bf16*)(p.ws + WS_XBC);
      for (size_t i = gt; i < 8454144; i += NGT) { p.out[i] = bf2f(KPd[i]); p.out[8454144 + i] = bf2f(XBCd[i]); } }
    return;
#endif
#if USE_CHUNKED
    phase_scan2(p, smem);
#else
    phase_scan(p, smem);
#endif
    phase_ssd(p, smem);
    phase_sample_step(p, smem);
#if REPEAT_SEL == 3
    phase_scan2(p, smem);
    phase_ssd(p, smem);
    phase_sample_step(p, smem);
#endif
#if REPEAT_SEL == 5
    phase_sample_step(p, smem);
    phase_sample_step(p, smem);
#endif
#if REPEAT_SEL == 6
    phase_ssd(p, smem);
#endif
#if REPEAT_SEL == 4
    phase_ssd(p, smem);
    phase_sample_step(p, smem);
#endif
    GRID_BAR();
#if STOP_AFTER == 4
    { const size_t gt = (size_t)blockIdx.x * 512 + threadIdx.x, NGT = (size_t)gridDim.x * 512; const bf16* Yd = (const bf16*)(p.ws + WS_XB);
      for (size_t i = gt; i < 8388608; i += NGT) { p.out[i] = (DUMP_SEL & 1) ? bf2f(Yd[i]) : 0.f; p.out[8388608 + i] = (DUMP_SEL & 2) ? bf2f(Yd[8388608 + i]) : 0.f; }
      for (size_t i = gt; i < 131072; i += NGT) p.out[16777216 + i] = (DUMP_SEL & 4) ? bf2f(((const bf16*)(p.ws + WS_YS))[i]) : 0.f; }
    return;
#endif
    phase_post(p);
    GRID_BAR();
#if STOP_AFTER == 5
    { const size_t gt = (size_t)blockIdx.x * 512 + threadIdx.x, NGT = (size_t)gridDim.x * 512; for (size_t i = gt; i < (size_t)MTOT * 1024; i += NGT) p.out[i] = bf2f(((const bf16*)(p.ws + WS_MIX))[i]); }
    return;
#endif
    {
        pg8::Gemm g{(const bf16*)(p.ws + WS_MIX), (const bf16*)(p.ws + WS_WOUT), MPR, 1024, 1024}; pg8::StaticOrder S; S.init(MPR, 1024, G, bid);
        pg8::EpiResF32 E{p.in[0], nullptr, (bf16*)p.out, 1024, ALPHA};
        pg8::gemm_phase<pg8::EpiResF32, pg8::StaticOrder, true, true>(lds, g, S, E);
        const float* xs = p.in[1]; float* out = p.out;
        small_gemm<2, 1024>((const bf16*)(p.ws + WS_MIX) + (size_t)MPR * 1024, (const bf16*)(p.ws + WS_WOUT), 1024, smem, [=](int rs, int c, float v) { ((bf16*)out)[(size_t)(MPR + rs) * 1024 + c] = f2bf(ALPHA * xs[(size_t)rs * 1024 + c] + v); });
    }
    GRID_BAR();
    phase_ln<true>(p, p.in[25], p.in[26], XB, 0, 1024);
    phase0_late(p, smem, 0, 1);
    GRID_BAR();
    {
        pg8::Gemm g{XB, (const bf16*)(p.ws + WS_WFF1), MPR, 4096, 1024}; pg8::StaticOrder S; S.init(MPR, 4096, G, bid);
        pg8::EpiRelu2 E{HID, 4096};
        pg8::gemm_phase<pg8::EpiRelu2, pg8::StaticOrder, true, true>(lds, g, S, E);
        small_gemm<4, 1024>(XB + (size_t)MPR * 1024, (const bf16*)(p.ws + WS_WFF1), 4096, smem, [=](int rs, int c, float v) { const float a = fmaxf(v, 0.f); HID[(size_t)(MPR + rs) * 4096 + c] = f2bf(a * a); });
    }
    GRID_BAR();
    {
        pg8::Gemm g{HID, (const bf16*)(p.ws + WS_WFF2), MPR, 1024, 4096}; pg8::StaticOrder S; S.init(MPR, 1024, G, bid);
        pg8::EpiResF32 E{nullptr, XB, (bf16*)p.out + 1024, 2048, ALPHA};
        pg8::gemm_phase<pg8::EpiResF32, pg8::StaticOrder, true, true>(lds, g, S, E);
        float* out = p.out;
        small_gemm<2, 4096>(HID + (size_t)MPR * 4096, (const bf16*)(p.ws + WS_WFF2), 1024, smem, [=](int rs, int c, float v) { ((bf16*)out)[(size_t)(MPR + rs) * 2048 + 1024 + c] = f2bf(ALPHA * bf2f(XB[(size_t)(MPR + rs) * 1024 + c]) + v); });
    }
    GRID_BAR();
    phase_ln<false>(p, p.in[29], p.in[30], nullptr, 1024, 2048);
}

extern "C" void kernel_launch(void* const* d_in, const int* in_sizes, int n_in, void* d_out, int out_size, void* d_ws, size_t ws_size, hipStream_t stream) {
    static int grid = 0;
    if (grid == 0) {
        int dev = 0, cus = 0, per_cu = 0;
        (void)hipGetDevice(&dev);
        (void)hipDeviceGetAttribute(&cus, hipDeviceAttributeMultiprocessorCount, dev);
        if (hipFuncSetAttribute((const void*)mega, hipFuncAttributeMaxDynamicSharedMemorySize, LDS_BYTES) != hipSuccess) fprintf(stderr, "kernel_launch: hipFuncSetAttribute failed\n");
        if (hipOccupancyMaxActiveBlocksPerMultiprocessor(&per_cu, (const void*)mega, 512, LDS_BYTES) != hipSuccess || per_cu < 1) { fprintf(stderr, "kernel_launch: occupancy query says %d\n", per_cu); per_cu = 1; }
        (void)hipGetLastError();
        grid = cus * 1;
        if (n_in != 31 || out_size != 30939136 || ws_size < WS_CTL + 16384) fprintf(stderr, "kernel_launch: unexpected sizes n_in %d out %d ws %zu\n", n_in, out_size, ws_size);
    }
    (void)hipMemsetAsync((char*)d_ws + WS_CTL, 0, 16384, stream);
    P a{};
    for (int i = 0; i < 31; ++i) a.in[i] = (const float*)d_in[i];
    a.out = (float*)d_out; a.ws = (unsigned char*)d_ws; a.never = 0; a.pad = 0;
    void* args[] = {&a};
    hipError_t e = hipLaunchCooperativeKernel((const void*)mega, dim3(grid), dim3(512), args, LDS_BYTES, stream);
    if (e != hipSuccess) fprintf(stderr, "kernel_launch: cooperative launch failed: %s (grid %d)\n", hipGetErrorString(e), grid);
}
```

```cpp
#include <hip/hip_runtime.h>
#include <hip/hip_cooperative_groups.h>
#include <cstdio>
#include <cstdint>
namespace cg = cooperative_groups;
#define LAS __attribute__((address_space(3)))

typedef unsigned short bf16;
typedef short bf16x8 __attribute__((ext_vector_type(8)));
typedef float f32x4 __attribute__((ext_vector_type(4)));
typedef unsigned u32x4 __attribute__((ext_vector_type(4)));

constexpr int DM = 1024, SEQ = 2048, MPR = 8 * SEQ, MSM = 128, MTOT = MPR + MSM;
constexpr int RPJ = 1792, PLD = 3328, PROJN = 3336, DFF = 4096;
constexpr float ALPHA = 1.189207115f;
constexpr size_t O_Y = 0, O_YS = 16777216, O_SHP = 16908288, O_WKVP = 16922624, O_CONVP = 17184768, O_SSMP = 17209344,
                 O_SHS = 17733632, O_WKVS = 17963008, O_CONVS = 22157312, O_SSMS = 22550528;
constexpr size_t OS_WD = 0, OS_GG = 8454144;
constexpr size_t WS_WIN = 0, WS_WOUT = 7340032, WS_WFF1 = 9437184, WS_WFF2 = 17825792, WS_LORA = 26214400, WS_XB = 26476544,
                 WS_PROJ = 60293120, WS_DT = 170196992, WS_KP = 170725376, WS_KK = 187633664, WS_KB = 204541952, WS_XBC = 221450240,
                 WS_CTL = 255004672, WS_YS = WS_CTL + 65536, WS_HID = WS_PROJ, WS_MIX = WS_KK;
constexpr int LDS_BYTES = 147456, MISC_OFF = LDS_BYTES - 64;

struct P { const float* in[31]; float* out; unsigned char* ws; int never; int pad; };

__device__ __forceinline__ float bf2f(unsigned short b) { return __uint_as_float(((unsigned)b) << 16); }
__device__ __forceinline__ float bflo(unsigned u) { return __uint_as_float(u << 16); }
__device__ __forceinline__ float bfhi(unsigned u) { return __uint_as_float(u & 0xffff0000u); }
typedef float f32x2_t __attribute__((ext_vector_type(2)));
typedef __bf16 bf16x2_t __attribute__((ext_vector_type(2)));
__device__ __forceinline__ unsigned pkbf(float lo, float hi) { const f32x2_t v = {lo, hi}; const bf16x2_t b = __builtin_convertvector(v, bf16x2_t); return __builtin_bit_cast(unsigned, b); }
__device__ __forceinline__ unsigned short f2bf(float f) { return (unsigned short)(pkbf(f, f) & 0xffffu); }
__device__ __forceinline__ void unpack8(u32x4 v, float* o) { o[0] = bflo(v.x); o[1] = bfhi(v.x); o[2] = bflo(v.y); o[3] = bfhi(v.y); o[4] = bflo(v.z); o[5] = bfhi(v.z); o[6] = bflo(v.w); o[7] = bfhi(v.w); }
__device__ __forceinline__ u32x4 pack8(const float* o) { u32x4 v; v.x = pkbf(o[0], o[1]); v.y = pkbf(o[2], o[3]); v.z = pkbf(o[4], o[5]); v.w = pkbf(o[6], o[7]); return v; }
__device__ __forceinline__ float sigm(float x) { return __builtin_amdgcn_rcpf(1.f + __expf(-x)); }
__device__ __forceinline__ float silu(float x) { return x * __builtin_amdgcn_rcpf(1.f + __expf(-x)); }
__device__ __forceinline__ float softplus(float x) { return fmaxf(x, 0.f) + __logf(1.f + __expf(-fabsf(x))); }
__device__ __forceinline__ float tanh_(float x) { const float e = __expf(2.f * x); return 1.f - 2.f * __builtin_amdgcn_rcpf(e + 1.f); }
template <int CTRL> __device__ __forceinline__ float dppf(float x) { return __int_as_float(__builtin_amdgcn_update_dpp(0, __float_as_int(x), CTRL, 0xf, 0xf, true)); }
template <int CTRL> __device__ __forceinline__ float dppo(float x) { return __int_as_float(__builtin_amdgcn_update_dpp(0x3f800000, __float_as_int(x), CTRL, 0xf, 0xf, false)); }
__device__ __forceinline__ float sum16(float x) { x += dppf<0xB1>(x); x += dppf<0x4E>(x); x += dppf<0x141>(x); x += dppf<0x140>(x); return x; }
__device__ __forceinline__ float sum8(float x) { x += dppf<0xB1>(x); x += dppf<0x4E>(x); x += dppf<0x141>(x); return x; }
__device__ __forceinline__ float rdl(float x, int l) { return __int_as_float(__builtin_amdgcn_readlane(__float_as_int(x), l)); }
__device__ __forceinline__ float sum64(float x) { x = sum16(x); return (rdl(x, 0) + rdl(x, 16)) + (rdl(x, 32) + rdl(x, 48)); }
__device__ __forceinline__ float sum32(float x, bool hi) { x = sum16(x); const float a = rdl(x, 0) + rdl(x, 16), b = rdl(x, 32) + rdl(x, 48); return hi ? b : a; }
__device__ __forceinline__ f32x4 mfma16(bf16x8 a, bf16x8 b, f32x4 c) { return __builtin_amdgcn_mfma_f32_16x16x32_bf16(a, b, c, 0, 0, 0); }
typedef short s16x4 __attribute__((ext_vector_type(4)));
__device__ __forceinline__ f32x4 mf16(s16x4 a, s16x4 b, f32x4 c) { return __builtin_amdgcn_mfma_f32_16x16x16bf16_1k(a, b, c, 0, 0, 0); }
__device__ __forceinline__ s16x4 cvt4(f32x4 v) { struct { unsigned a, b; } t = {pkbf(v[0], v[1]), pkbf(v[2], v[3])}; return __builtin_bit_cast(s16x4, t); }
#define LDS_FENCE() asm volatile("s_waitcnt lgkmcnt(0)" ::: "memory")

#define PHASE_PROLOGUE P p = p_in; { size_t z_ = 0; asm volatile("" : "+s"(z_)); p.ws += z_; p.out += z_; } int tid = threadIdx.x; asm volatile("" : "+v"(tid))
namespace pg8 {
#define PG8_LAS __attribute__((address_space(3)))
typedef unsigned short bf16_t;
typedef short bf16x8 __attribute__((ext_vector_type(8)));
typedef float f32x4 __attribute__((ext_vector_type(4)));
typedef unsigned u32x4 __attribute__((ext_vector_type(4)));
constexpr int BM = 256, BK = 64, HALF = 128, HTB = HALF * BK * 2  , STAGE_BYTES = 8 * HTB, NXCD = 8, WGM = 8;

__host__ __device__ __forceinline__ int lds_byte(int r, int c) { const int st = (r >> 4) * 2 + (c >> 5), rr = r & 15, cc = c & 31, ob = rr * 64 + cc * 2; return st * 1024 + (ob ^ (((ob >> 9) & 1) << 5)); }
__host__ __device__ __forceinline__ void stage_rc(int b, int& R, int& C) { const int st = b / 1024, sb = b % 1024, swz = sb ^ (((sb >> 9) & 1) << 5); R = (st >> 1) * 16 + swz / 64; C = (st & 1) * 32 + (swz % 64) / 2; }
__host__ __device__ __forceinline__ int perm32(int rho) { const int n = rho >> 4, i = rho & 15; return 8 * (i >> 2) + 4 * n + (i & 3); }

struct Unit { int pm, pn; };
struct Gemm { const bf16_t* A; const bf16_t* Bt; int M, N, K; };

struct StaticOrder {
    int nM, nN, nwg, G, c;
    __host__ __device__ void init(int M, int N, int G_, int c_) { nM = M / BM; nN = N / BM; nwg = nM * nN; G = G_; c = c_; }
    __host__ __device__ bool next(int i, Unit& u) const {
        const long L = (long)i * G + c; if (L >= nwg) return false;
        int wgid = (int)L; { const int q = nwg / NXCD, r = nwg % NXCD, xcd = wgid % NXCD, off = wgid / NXCD; wgid = (xcd < r ? xcd * (q + 1) : r * (q + 1) + (xcd - r) * q) + off; }
        const int nig = WGM * nN, gid = wgid / nig, fm = gid * WGM, gsz = (nM - fm) < WGM ? (nM - fm) : WGM;
        u.pm = fm + ((wgid % nig) % gsz); u.pn = (wgid % nig) / gsz; return true;
    }
    __device__ __forceinline__ void a_ready(const Unit&) const {}
    __device__ __forceinline__ void done(const Unit&) const {}
};

__device__ __forceinline__ unsigned cvt_pk_bf16(float lo, float hi) { return ::pkbf(lo, hi); }
typedef float f32x2 __attribute__((ext_vector_type(2)));
struct EpiProj {
    static constexpr bool PERM = true, AFTER_DRAIN = false;
    bf16_t* PROJ; float* DT; const float* dt_bias; float* out;
    __device__ __forceinline__ void operator()(const f32x4 (&acc)[2][2][4][2], const Unit& u, int wr, int wc, int fr, int fq) const {
        const int row0 = u.pm * BM + wr * 64 + fr;
#pragma unroll
        for (int bj = 0; bj < 2; ++bj) {
            const int c0 = u.pn * BM + bj * HALF + wc * 32 + 8 * fq;
            if (c0 >= 3336) continue;
#pragma unroll
            for (int ai = 0; ai < 2; ++ai)
#pragma unroll
                for (int m = 0; m < 4; ++m) {
                    const int row = row0 + ai * HALF + m * 16; const f32x4 v0 = acc[ai][bj][m][0], v1 = acc[ai][bj][m][1];
                    if (c0 < 3328) { u32x4 w; w.x = cvt_pk_bf16(v0[0], v0[1]); w.y = cvt_pk_bf16(v0[2], v0[3]); w.z = cvt_pk_bf16(v1[0], v1[1]); w.w = cvt_pk_bf16(v1[2], v1[3]);
                        *(u32x4*)(PROJ + (size_t)row * 3328 + c0) = w; }
                    else { f32x4 a, b;
#pragma unroll
                        for (int i = 0; i < 4; ++i) { float x = v0[i] + dt_bias[i]; a[i] = x > 20.f ? x : log1pf(__expf(x)); float y = v1[i] + dt_bias[4 + i]; b[i] = y > 20.f ? y : log1pf(__expf(y)); }
                        *(f32x4*)(DT + (size_t)row * 8) = a; *(f32x4*)(DT + (size_t)row * 8 + 4) = b; }
                    const int t = row & 2047, b_ = row >> 11;
                    if (t == 2047 && c0 < 1792) { float* o = out + 16908288 + (size_t)b_ * 1792 + c0; *(f32x4*)o = v0; *(f32x4*)(o + 4) = v1; }
                    if (t >= 2045 && c0 >= 2304 && c0 < 3328) { float* o = out + 17184768 + ((size_t)b_ * 3 + (t - 2045)) * 1024 + (c0 - 2304); *(f32x4*)o = v0; *(f32x4*)(o + 4) = v1; }
                }
        }
    }
};
struct EpiResF32 {
    static constexpr bool PERM = true, AFTER_DRAIN = false;
    const float* resf; const bf16_t* resb; bf16_t* ob; int ld; float alpha;
    __device__ __forceinline__ void operator()(const f32x4 (&acc)[2][2][4][2], const Unit& u, int wr, int wc, int fr, int fq) const {
        const int row0 = u.pm * BM + wr * 64 + fr;
#pragma unroll
        for (int ai = 0; ai < 2; ++ai)
#pragma unroll
            for (int m = 0; m < 4; ++m)
#pragma unroll
                for (int bj = 0; bj < 2; ++bj) {
                    const int row = row0 + ai * HALF + m * 16, c0 = u.pn * BM + bj * HALF + wc * 32 + 8 * fq; const size_t o = (size_t)row * 1024 + c0;
                    f32x4 r0, r1;
                    if (resf) { r0 = *(const f32x4*)(resf + o); r1 = *(const f32x4*)(resf + o + 4); }
                    else { const u32x4 w = *(const u32x4*)(resb + o); r0[0] = __uint_as_float(w.x << 16); r0[1] = __uint_as_float(w.x & 0xffff0000u); r0[2] = __uint_as_float(w.y << 16); r0[3] = __uint_as_float(w.y & 0xffff0000u);
                        r1[0] = __uint_as_float(w.z << 16); r1[1] = __uint_as_float(w.z & 0xffff0000u); r1[2] = __uint_as_float(w.w << 16); r1[3] = __uint_as_float(w.w & 0xffff0000u); }
                    const f32x4 v0 = r0 * alpha + acc[ai][bj][m][0], v1 = r1 * alpha + acc[ai][bj][m][1];
                    u32x4 w8; w8.x = cvt_pk_bf16(v0[0], v0[1]); w8.y = cvt_pk_bf16(v0[2], v0[3]); w8.z = cvt_pk_bf16(v1[0], v1[1]); w8.w = cvt_pk_bf16(v1[2], v1[3]);
                    *(u32x4*)(ob + (size_t)row * ld + c0) = w8;
                }
    }
};
struct EpiRelu2 {
    static constexpr bool PERM = true, AFTER_DRAIN = false;
    bf16_t* O; int ldc;
    __device__ __forceinline__ void operator()(const f32x4 (&acc)[2][2][4][2], const Unit& u, int wr, int wc, int fr, int fq) const {
        const int row0 = u.pm * BM + wr * 64 + fr;
#pragma unroll
        for (int ai = 0; ai < 2; ++ai)
#pragma unroll
            for (int m = 0; m < 4; ++m)
#pragma unroll
                for (int bj = 0; bj < 2; ++bj) {
                    const int row = row0 + ai * HALF + m * 16, c0 = u.pn * BM + bj * HALF + wc * 32 + 8 * fq;
                    f32x4 v0 = acc[ai][bj][m][0], v1 = acc[ai][bj][m][1];
#pragma unroll
                    for (int i = 0; i < 4; ++i) { float a = fmaxf(v0[i], 0.f); v0[i] = a * a; float b = fmaxf(v1[i], 0.f); v1[i] = b * b; }
                    u32x4 w; w.x = cvt_pk_bf16(v0[0], v0[1]); w.y = cvt_pk_bf16(v0[2], v0[3]); w.z = cvt_pk_bf16(v1[0], v1[1]); w.w = cvt_pk_bf16(v1[2], v1[3]);
                    *(u32x4*)(O + (size_t)row * ldc + c0) = w;
                }
    }
};
template <class Epi, class Sched, bool ALIGN_EPI = false, bool SP2 = false>
__device__ __forceinline__ void gemm_phase(PG8_LAS unsigned char* lds, const Gemm g, const Sched& S, const Epi& E) {
    int tid = threadIdx.x; asm volatile("" : "+v"(tid)); const int wid = __builtin_amdgcn_readfirstlane(tid >> 6), lane = tid & 63, wr = wid >> 2, wc = wid & 3, fr = lane & 15, fq = lane >> 4;
    const int K = g.K, nt = K / BK;
    unsigned voffA[2], voffB[2];
#pragma unroll
    for (int i = 0; i < 2; ++i) { int R, C; stage_rc(tid * 16 + i * 8192, R, C); const int Rb = Epi::PERM ? ((R & ~31) + perm32(R & 31)) : R;
        voffA[i] = (unsigned)(R * K + C) * 2u; voffB[i] = (unsigned)(Rb * K + C) * 2u; }
    const size_t kstep = (size_t)(BK * 2);
    const size_t hstep = (size_t)HALF * K * 2;
    const size_t tstep = 2 * hstep;
    const unsigned ldsw = (unsigned)wid * 1024u;
    const int aoff = lds_byte(wr * 64 + fr, fq * 8), boff = lds_byte(wc * 32 + fr, fq * 8);
#define PG8_SA(b, h) (((b) * 2 + (h)) * HTB)
#define PG8_SB(b, h) ((4 + (b) * 2 + (h)) * HTB)
#define PG8_STAGE(bufoff, gbase, voff) do { _Pragma("unroll") for (int _i = 0; _i < 2; ++_i) \
        __builtin_amdgcn_global_load_lds((const unsigned*)((const char*)(gbase) + (voff)[_i]), (PG8_LAS unsigned*)(lds + (bufoff) + ldsw + _i * 8192), 16, 0, 0); } while (0)
#define PG8_LDA(dst, b, h) do { _Pragma("unroll") for (int m = 0; m < 4; ++m) _Pragma("unroll") for (int k = 0; k < 2; ++k) dst[m][k] = *(const PG8_LAS bf16x8*)(lds + PG8_SA(b, h) + aoff + m * 2048 + k * 1024); } while (0)
#define PG8_LDB(dst, b, h) do { _Pragma("unroll") for (int n = 0; n < 2; ++n) _Pragma("unroll") for (int k = 0; k < 2; ++k) dst[n][k] = *(const PG8_LAS bf16x8*)(lds + PG8_SB(b, h) + boff + n * 2048 + k * 1024); } while (0)
#define PG8_MMA(ai, bj, At, Bt) do { __builtin_amdgcn_s_setprio(1); _Pragma("unroll") for (int m = 0; m < 4; ++m) _Pragma("unroll") for (int n = 0; n < 2; ++n) _Pragma("unroll") for (int k = 0; k < 2; ++k) \
        acc[ai][bj][m][n] = __builtin_amdgcn_mfma_f32_16x16x32_bf16(Bt[n][k], At[m][k], acc[ai][bj][m][n], 0, 0, 0); __builtin_amdgcn_s_setprio(0); } while (0)
#define PG8_WAIT_V(n) asm volatile("s_waitcnt vmcnt(" #n ")" ::: "memory")
#define PG8_WAIT_L(n) asm volatile("s_waitcnt lgkmcnt(" #n ")" ::: "memory")
#define PG8_BAR __builtin_amdgcn_s_barrier()
#define PG8_SCHED __builtin_amdgcn_sched_barrier(0)
    Unit cur, nxt; int ui = 0;
    if (!S.next(0, cur)) return;
    f32x4 acc[2][2][4][2];
#pragma unroll
    for (int a = 0; a < 2; ++a)
#pragma unroll
        for (int b = 0; b < 2; ++b)
#pragma unroll
            for (int m = 0; m < 4; ++m)
#pragma unroll
                for (int n = 0; n < 2; ++n) acc[a][b][m][n] = (f32x4){0.f, 0.f, 0.f, 0.f};
    bf16x8 At[4][2], B0[2][2], B1[2][2];
    const char* cA = (const char*)g.A + (size_t)cur.pm * tstep; const char* cB = (const char*)g.Bt + (size_t)cur.pn * tstep;
    S.a_ready(cur);
    if constexpr (SP2) {
        PG8_STAGE(PG8_SB(0, 0), cB, voffB); PG8_STAGE(PG8_SB(0, 1), cB + hstep, voffB); PG8_STAGE(PG8_SA(0, 0), cA, voffA); PG8_STAGE(PG8_SA(0, 1), cA + hstep, voffA);
        if (wr == 1) PG8_BAR;
        PG8_WAIT_V(2); PG8_BAR;
        PG8_STAGE(PG8_SB(1, 0), cB + kstep, voffB); PG8_STAGE(PG8_SA(1, 0), cA + kstep, voffA); PG8_STAGE(PG8_SB(1, 1), cB + hstep + kstep, voffB);
        PG8_WAIT_V(6); PG8_BAR;
    } else {
        PG8_STAGE(PG8_SB(0, 0), cB, voffB); PG8_STAGE(PG8_SA(0, 0), cA, voffA); PG8_STAGE(PG8_SB(0, 1), cB + hstep, voffB); PG8_STAGE(PG8_SA(0, 1), cA + hstep, voffA);
        if (wr == 1) PG8_BAR;
        PG8_WAIT_V(4); PG8_BAR;
        PG8_STAGE(PG8_SB(1, 0), cB + kstep, voffB); PG8_STAGE(PG8_SA(1, 0), cA + kstep, voffA); PG8_STAGE(PG8_SB(1, 1), cB + hstep + kstep, voffB);
        PG8_WAIT_V(6); PG8_BAR;
    }
    for (;;) {
        const bool has_next = S.next(ui + 1, nxt);
        const char* nA = has_next ? (const char*)g.A + (size_t)nxt.pm * tstep : cA; const char* nB = has_next ? (const char*)g.Bt + (size_t)nxt.pn * tstep : cB;
        for (int t = 0; t < nt; t += 2) {
            const bool last = (t == nt - 2);
            const char* a1 = cA + (size_t)(t + 1) * kstep;
            const char* a2 = last ? nA : cA + (size_t)(t + 2) * kstep; const char* b2 = last ? nB : cB + (size_t)(t + 2) * kstep;
            const char* a3 = a2 + kstep; const char* b3 = b2 + kstep;
            if (last && has_next) S.a_ready(nxt);
            if constexpr (SP2) {
            PG8_LDB(B0, 0, 0); PG8_LDB(B1, 0, 1); PG8_SCHED; PG8_LDA(At, 0, 0); PG8_STAGE(PG8_SA(1, 1), a1 + hstep, voffA);
            PG8_WAIT_V(8); PG8_WAIT_L(0); PG8_BAR; PG8_MMA(0, 0, At, B0); PG8_MMA(0, 1, At, B1); PG8_BAR; PG8_SCHED;
            PG8_LDA(At, 0, 1); PG8_STAGE(PG8_SB(0, 0), b2, voffB); PG8_STAGE(PG8_SB(0, 1), b2 + hstep, voffB); PG8_STAGE(PG8_SA(0, 0), a2, voffA);
            PG8_WAIT_V(8); PG8_WAIT_L(0); PG8_BAR; PG8_MMA(1, 0, At, B0); PG8_MMA(1, 1, At, B1); PG8_BAR; PG8_SCHED;
            PG8_LDB(B0, 1, 0); PG8_LDB(B1, 1, 1); PG8_SCHED; PG8_LDA(At, 1, 0); PG8_STAGE(PG8_SA(0, 1), a2 + hstep, voffA);
            PG8_WAIT_V(8); PG8_WAIT_L(0); PG8_BAR; PG8_MMA(0, 0, At, B0); PG8_MMA(0, 1, At, B1); PG8_BAR; PG8_SCHED;
            PG8_LDA(At, 1, 1); PG8_STAGE(PG8_SB(1, 0), b3, voffB); PG8_STAGE(PG8_SB(1, 1), b3 + hstep, voffB); PG8_STAGE(PG8_SA(1, 0), a3, voffA);
            PG8_WAIT_V(8); PG8_WAIT_L(0); PG8_BAR; PG8_MMA(1, 0, At, B0); PG8_MMA(1, 1, At, B1); PG8_BAR; PG8_SCHED;
            } else {
            PG8_LDB(B0, 0, 0); PG8_SCHED; PG8_LDA(At, 0, 0); PG8_STAGE(PG8_SA(1, 1), a1 + hstep, voffA);
            PG8_WAIT_L(8); PG8_BAR; PG8_WAIT_L(0); PG8_MMA(0, 0, At, B0); PG8_BAR; PG8_SCHED;
            PG8_LDB(B1, 0, 1); PG8_STAGE(PG8_SB(0, 0), b2, voffB);
            PG8_BAR; PG8_WAIT_L(0); PG8_MMA(0, 1, At, B1); PG8_BAR;
            PG8_LDA(At, 0, 1); PG8_STAGE(PG8_SA(0, 0), a2, voffA);
            PG8_BAR; PG8_WAIT_L(0); PG8_MMA(1, 0, At, B0); PG8_BAR; PG8_SCHED;
            PG8_STAGE(PG8_SB(0, 1), b2 + hstep, voffB);
            PG8_WAIT_V(6); PG8_BAR; PG8_MMA(1, 1, At, B1); PG8_BAR;
            PG8_LDB(B0, 1, 0); PG8_SCHED; PG8_LDA(At, 1, 0); PG8_STAGE(PG8_SA(0, 1), a2 + hstep, voffA);
            PG8_WAIT_L(8); PG8_BAR; PG8_WAIT_L(0); PG8_MMA(0, 0, At, B0); PG8_BAR; PG8_SCHED;
            PG8_LDB(B1, 1, 1); PG8_STAGE(PG8_SB(1, 0), b3, voffB);
            PG8_BAR; PG8_WAIT_L(0); PG8_MMA(0, 1, At, B1); PG8_BAR;
            PG8_LDA(At, 1, 1); PG8_STAGE(PG8_SA(1, 0), a3, voffA);
            PG8_BAR; PG8_WAIT_L(0); PG8_MMA(1, 0, At, B0); PG8_BAR; PG8_SCHED;
            PG8_STAGE(PG8_SB(1, 1), b3 + hstep, voffB);
            PG8_WAIT_V(6); PG8_BAR; PG8_MMA(1, 1, At, B1); PG8_BAR;
            }
        }
        if constexpr (ALIGN_EPI) { if (wr == 0) PG8_BAR; }
        if constexpr (!Epi::AFTER_DRAIN) { E(acc, cur, wr, wc, fr, fq); S.done(cur); }
        if (!has_next) break;
#pragma unroll
        for (int a = 0; a < 2; ++a)
#pragma unroll
            for (int b = 0; b < 2; ++b)
#pragma unroll
                for (int m = 0; m < 4; ++m)
#pragma unroll
                    for (int n = 0; n < 2; ++n) acc[a][b][m][n] = (f32x4){0.f, 0.f, 0.f, 0.f};
        cur = nxt; cA = nA; cB = nB; ++ui;
        if constexpr (ALIGN_EPI) { if (wr == 1) PG8_BAR; }
    }
    PG8_WAIT_V(0);
    if constexpr (!ALIGN_EPI) { if (wr == 0) PG8_BAR; }
    PG8_BAR;
    if constexpr (Epi::AFTER_DRAIN) { E.fused(acc, cur, wr, wc, fr, fq, lds, wid, lane); S.done(cur); }
#undef PG8_SA
#undef PG8_SB
#undef PG8_STAGE
#undef PG8_LDA
#undef PG8_LDB
#undef PG8_MMA
#undef PG8_WAIT_V
#undef PG8_WAIT_L
#undef PG8_BAR
#undef PG8_SCHED
}
}

#define XB_TMO      128
#define XB_XCNT(j)  (256  + 64 * (j))
#define XB_XSUB(j)  (1280 + 64 * (j))
#define XB_XGEN(j)  (2304 + 64 * (j))
#define XB_TOP      3328
#define XB_TOPGEN   3392
#define XCD_BAR_WORDS 3456
#define XB_SPIN_CAP (1u << 18)

__device__ __forceinline__ unsigned xb_ld(unsigned* p)              { return __hip_atomic_load(p, __ATOMIC_RELAXED, __HIP_MEMORY_SCOPE_AGENT); }
__device__ __forceinline__ unsigned xb_add(unsigned* p, unsigned v) { return __hip_atomic_fetch_add(p, v, __ATOMIC_RELAXED, __HIP_MEMORY_SCOPE_AGENT); }
__device__ __forceinline__ unsigned xb_xcc_id() { return (unsigned)__builtin_amdgcn_s_getreg((3 << 11) | 20) & 0xFu; }
#define XB_SPIN(cond, bar) do { unsigned _sp = 0; while (cond) { __builtin_amdgcn_s_sleep(1); \
    if ((++_sp & 255u) == 0u) { if (xb_ld(&(bar)[XB_TMO])) break; if (_sp > XB_SPIN_CAP) { atomicAdd(&(bar)[XB_TMO], 1u); break; } } } } while (0)

struct XcdBarrier {
    unsigned* bar; unsigned x;
    volatile LAS unsigned* st;
};

__device__ __forceinline__ XcdBarrier xcd_barrier_post(unsigned* bar, volatile LAS unsigned* st) {
    XcdBarrier b; b.bar = bar; b.x = xb_xcc_id(); b.st = st;
    if (threadIdx.x == 0) (void)xb_add(&bar[XB_XCNT(b.x)], 1u);
    return b;
}
__device__ __forceinline__ void xcd_barrier_complete(unsigned* bar, unsigned x, unsigned& nloc, unsigned& nx) {
    const unsigned G = gridDim.x * gridDim.y * gridDim.z;
    unsigned sum, cnt, mine, sp = 0u;
    for (;;) {
        sum = 0u; cnt = 0u; mine = 0u;
#pragma unroll
        for (unsigned j = 0; j < 16; ++j) { const unsigned c = xb_ld(&bar[XB_XCNT(j)]); sum += c; cnt += (c > 0u) ? 1u : 0u; mine = (j == x) ? c : mine; }
        if (sum == G) break;
        __builtin_amdgcn_s_sleep(1);
        if ((++sp & 255u) == 0u) { if (xb_ld(&bar[XB_TMO])) break; if (sp > XB_SPIN_CAP) { atomicAdd(&bar[XB_TMO], 1u); break; } }
    }
    nloc = mine > 0u ? mine : 1u; nx = cnt > 0u ? cnt : 1u;
}

__device__ __forceinline__ void xcd_barrier(const XcdBarrier& b) {
    asm volatile("s_waitcnt vmcnt(0)" ::: "memory");
    __syncthreads();
    if (threadIdx.x == 0) {
        unsigned* bar = b.bar;
        __builtin_amdgcn_s_waitcnt(0);
        unsigned nloc = b.st[0], nx = b.st[1];
        if (nloc == 0u) { xcd_barrier_complete(bar, b.x, nloc, nx); b.st[0] = nloc; b.st[1] = nx; }
        const unsigned old = xb_add(&bar[XB_XSUB(b.x)], 1u);
        const unsigned gen = old / nloc;
        if (old + 1u == (gen + 1u) * nloc) {
            __builtin_amdgcn_fence(__ATOMIC_RELEASE, "agent");
            asm volatile("s_waitcnt vmcnt(0)" ::: "memory");
            const unsigned og = xb_add(&bar[XB_TOP], 1u);
            const unsigned tg = og / nx;
            if (og + 1u == (tg + 1u) * nx) xb_add(&bar[XB_TOPGEN], 1u);
            else XB_SPIN(xb_ld(&bar[XB_TOPGEN]) == tg, bar);
            __builtin_amdgcn_fence(__ATOMIC_ACQUIRE, "agent");
            xb_add(&bar[XB_XGEN(b.x)], 1u);
            asm volatile("s_waitcnt vmcnt(0)" ::: "memory");
        } else {
            XB_SPIN(xb_ld(&bar[XB_XGEN(b.x)]) == gen, bar);
            __builtin_amdgcn_fence(__ATOMIC_ACQUIRE, "agent");
            asm volatile("s_waitcnt vmcnt(0)" ::: "memory");
        }
    }
    __syncthreads();
}

__device__ __forceinline__ void lerp8(const P& p, int row, int col, float* o) {
    const bf16* PROJ = (const bf16*)(p.ws + WS_PROJ);
    float cur[8], prv[8];
    unpack8(*(const u32x4*)(PROJ + (size_t)row * PLD + col), cur);
    if (row >= MPR) { const float* s = p.in[2] + (size_t)(row - MPR) * RPJ + col; const f32x4 a = *(const f32x4*)s, b = *(const f32x4*)(s + 4);
        prv[0] = a[0]; prv[1] = a[1]; prv[2] = a[2]; prv[3] = a[3]; prv[4] = b[0]; prv[5] = b[1]; prv[6] = b[2]; prv[7] = b[3]; }
    else if ((row & (SEQ - 1)) == 0) {
#pragma unroll
        for (int i = 0; i < 8; ++i) prv[i] = 0.f; }
    else unpack8(*(const u32x4*)(PROJ + (size_t)(row - 1) * PLD + col), prv);
    const float* mu = p.in[7] + col; const f32x4 m0 = *(const f32x4*)mu, m1 = *(const f32x4*)(mu + 4);
#pragma unroll
    for (int i = 0; i < 4; ++i) { o[i] = cur[i] + (prv[i] - cur[i]) * m0[i]; o[4 + i] = cur[4 + i] + (prv[4 + i] - cur[4 + i]) * m1[i]; }
}
__device__ __forceinline__ float lerp1(const P& p, int row, int col) {
    const bf16* PROJ = (const bf16*)(p.ws + WS_PROJ);
    const float cur = bf2f(PROJ[(size_t)row * PLD + col]); float prv;
    if (row >= MPR) prv = p.in[2][(size_t)(row - MPR) * RPJ + col];
    else if ((row & (SEQ - 1)) == 0) prv = 0.f;
    else prv = bf2f(PROJ[(size_t)(row - 1) * PLD + col]);
    return cur + (prv - cur) * p.in[7][col];
}

__device__ __forceinline__ void transpose_item(const float* W, int K, int N, bf16* WT, float* scr, int item, int lane) {
    const int nblk = (N + 31) / 32, kb = item / nblk, nb = item % nblk, k0 = 64 * kb, n0 = 32 * nb;
#pragma unroll 8
    for (int i = 0; i < 32; ++i) { const int kk = 2 * i + (lane >> 5), n = n0 + (lane & 31); scr[kk * 33 + (lane & 31)] = (n < N) ? W[(size_t)(k0 + kk) * N + n] : 0.f; }
    LDS_FENCE();
    const int c = lane & 7;
#pragma unroll
    for (int j = 0; j < 4; ++j) { const int n = (lane >> 3) + 8 * j; const float* s = scr + (8 * c) * 33 + n;
        u32x4 o; o.x = pkbf(s[0 * 33], s[1 * 33]); o.y = pkbf(s[2 * 33], s[3 * 33]); o.z = pkbf(s[4 * 33], s[5 * 33]); o.w = pkbf(s[6 * 33], s[7 * 33]);
        *(u32x4*)(WT + (size_t)(n0 + n) * K + k0 + 8 * c) = o; }
    LDS_FENCE();
}

__device__ __forceinline__ void phase0(const P& p_in, unsigned char* smem) {
    PHASE_PROLOGUE;
    const int lane = tid & 63, wave = tid >> 6, G = gridDim.x, bid = blockIdx.x;
    const int gw = bid * 8 + wave, NGW = G * 8; const size_t gt = (size_t)bid * 512 + tid, NGT = (size_t)G * 512;
    bf16* XB = (bf16*)(p.ws + WS_XB);
    for (size_t i = gt; i < (size_t)MTOT * DM / 8; i += NGT) { const size_t e = i * 8; const float* src = e < (size_t)MPR * DM ? p.in[0] + e : p.in[1] + (e - (size_t)MPR * DM);
        const f32x4 a = *(const f32x4*)src, b = *(const f32x4*)(src + 4); u32x4 o; o.x = pkbf(a[0], a[1]); o.y = pkbf(a[2], a[3]); o.z = pkbf(b[0], b[1]); o.w = pkbf(b[2], b[3]); *(u32x4*)(XB + e) = o; }
    float* scr = (float*)(smem + wave * 8448);
    constexpr int I_IN = 16 * 105, I_WU = 16, I_AU = 16, I_GU = 32;
    constexpr int NIT = I_IN + I_WU + I_AU + I_GU;
    for (int it = gw; it < NIT; it += NGW) {
        int r = it;
        if (r < I_IN) { transpose_item(p.in[6], 1024, PROJN, (bf16*)(p.ws + WS_WIN), scr, r, lane); continue; } r -= I_IN;
        if (r < I_WU) { transpose_item(p.in[9], 64, 512, (bf16*)(p.ws + WS_LORA), scr, r, lane); continue; } r -= I_WU;
        if (r < I_AU) { transpose_item(p.in[11], 64, 512, (bf16*)(p.ws + WS_LORA + 65536), scr, r, lane); continue; } r -= I_AU;
        transpose_item(p.in[12], 128, 512, (bf16*)(p.ws + WS_LORA + 131072), scr, r, lane);
    }
    for (size_t i = gt; i < (size_t)MSM * 2048 / 4; i += NGT) { const size_t idx = i * 4, b = idx >> 11, rem = idx & 2047;
        *(f32x4*)(p.out + O_CONVS + b * 3072 + rem) = *(const f32x4*)(p.in[4] + b * 3072 + 1024 + rem); }
}

__device__ __forceinline__ void phase0_late(const P& p_in, unsigned char* smem, int first, int which) {
    PHASE_PROLOGUE;
    const int lane = tid & 63, wave = tid >> 6, G = gridDim.x, bid = blockIdx.x;
    if (bid < first) return;
    const int gw = (bid - first) * 8 + wave, NGW = (G - first) * 8;
    float* scr = (float*)(smem + wave * 8448);
    constexpr int I_OUT = 16 * 32, I_F1 = 16 * 128, I_F2 = 64 * 32;
    const int lo = which ? I_OUT + I_F1 : 0, hi = which ? I_OUT + I_F1 + I_F2 : I_OUT + I_F1;
    for (int it = lo + gw; it < hi; it += NGW) {
        int r = it;
        if (r < I_OUT) { transpose_item(p.in[24], 1024, 1024, (bf16*)(p.ws + WS_WOUT), scr, r, lane); continue; } r -= I_OUT;
        if (r < I_F1) { transpose_item(p.in[27], 1024, 4096, (bf16*)(p.ws + WS_WFF1), scr, r, lane); continue; } r -= I_F1;
        transpose_item(p.in[28], 4096, 1024, (bf16*)(p.ws + WS_WFF2), scr, r, lane);
    }
}

template <int RG, int K, class F> __device__ __forceinline__ void small_gemm(const bf16* A, const bf16* Bt, int N, unsigned char* smem, const F& epi, int first = 0) {
    int tid = threadIdx.x; asm volatile("" : "+v"(tid));
    const int lane = tid & 63, wave = tid >> 6, r = lane & 15, q = lane >> 4;
    constexpr int KS = K / 8, NST = KS / 32, RGN = 8 / RG;
    const int nunits = ((N + 15) / 16) * RGN;
    float* part = (float*)smem;
    for (int u = (int)gridDim.x - 1 - (int)blockIdx.x; u < nunits && (int)blockIdx.x >= first; u += (int)gridDim.x - first) {
        const int ct = u / RGN, rg = u - ct * RGN, n0 = ct * 16;
        f32x4 acc[RG];
#pragma unroll
        for (int t = 0; t < RG; ++t) acc[t] = (f32x4){0.f, 0.f, 0.f, 0.f};
        const bf16* ap = A + (size_t)(rg * RG * 16 + r) * K + wave * KS + q * 8;
        const bf16* bp = Bt + (size_t)(n0 + r) * K + wave * KS + q * 8;
#pragma unroll 8
        for (int ks = 0; ks < NST; ++ks) {
            const bf16x8 b = *(const bf16x8*)(bp + ks * 32);
#pragma unroll
            for (int t = 0; t < RG; ++t) acc[t] = mfma16(*(const bf16x8*)(ap + (size_t)t * 16 * K + ks * 32), b, acc[t]);
        }
#pragma unroll
        for (int t = 0; t < RG; ++t)
#pragma unroll
            for (int j = 0; j < 4; ++j) part[(wave * RG + t) * 256 + (q * 4 + j) * 16 + r] = acc[t][j];
        __syncthreads();
        for (int e = tid; e < RG * 256; e += 512) { const int t = e >> 8, idx = e & 255; float v = 0.f;
#pragma unroll
            for (int w = 0; w < 8; ++w) v += part[(w * RG + t) * 256 + idx];
            const int col = n0 + (idx & 15);
            if (col < N) epi((rg * RG + t) * 16 + (idx >> 4), col, v); }
        __syncthreads();
    }
}

__device__ __forceinline__ void phase_prep(const P& p_in, unsigned char* smem) {
    PHASE_PROLOGUE;
    const int lane = tid & 63, wave = tid >> 6, G = gridDim.x, bid = blockIdx.x, r = lane & 15, q = lane >> 4;
    const bf16* WUPT = (const bf16*)(p.ws + WS_LORA); const bf16* AUPT = (const bf16*)(p.ws + WS_LORA + 65536); const bf16* GUPT = (const bf16*)(p.ws + WS_LORA + 131072);
    const bf16* PROJ = (const bf16*)(p.ws + WS_PROJ);
    float* WD = p.out + OS_WD; bf16* GG = (bf16*)(p.out + OS_GG);
    bf16* KP = (bf16*)(p.ws + WS_KP); bf16* KK = (bf16*)(p.ws + WS_KK); bf16* KB = (bf16*)(p.ws + WS_KB);
    bf16* WU = (bf16*)smem; bf16* AU = WU + 64 * 72; bf16* GU = AU + 64 * 72;
    bf16* kcur = (bf16*)(smem + 35840 + wave * 4608); bf16* kprv = kcur + 16 * 72;
#pragma unroll 1
    for (int tile = bid; tile < MTOT / 128; tile += G) {
        const int item = tile * 8 + wave, rowa = item * 16 + r;
        bf16x8 aw[2], aa[2], ag[4];
        float u[8];
#pragma unroll
        for (int ks = 0; ks < 2; ++ks) { lerp8(p, rowa, 1536 + ks * 32 + q * 8, u);
#pragma unroll
            for (int i = 0; i < 8; ++i) u[i] = tanh_(u[i]);
            aw[ks] = __builtin_bit_cast(bf16x8, pack8(u)); }
#pragma unroll
        for (int ks = 0; ks < 2; ++ks) { lerp8(p, rowa, 1600 + ks * 32 + q * 8, u); aa[ks] = __builtin_bit_cast(bf16x8, pack8(u)); }
#pragma unroll
        for (int ks = 0; ks < 4; ++ks) { lerp8(p, rowa, 1664 + ks * 32 + q * 8, u);
#pragma unroll
            for (int i = 0; i < 8; ++i) u[i] = sigm(u[i]);
            ag[ks] = __builtin_bit_cast(bf16x8, pack8(u)); }
        u32x4 pw, pa, pg[2];
#define PREP_LOAD(hh_) do { const int c_ = tid >> 3, k8_ = (tid & 7) * 8; \
            pw = *(const u32x4*)(WUPT + (size_t)((hh_) * 64 + c_) * 64 + k8_); pa = *(const u32x4*)(AUPT + (size_t)((hh_) * 64 + c_) * 64 + k8_); \
            _Pragma("unroll") for (int i = 0; i < 2; ++i) { const int pc_ = tid + i * 512, c2_ = pc_ >> 4, k82_ = (pc_ & 15) * 8; pg[i] = *(const u32x4*)(GUPT + (size_t)((hh_) * 64 + c2_) * 128 + k82_); } } while (0)
        PREP_LOAD(0);
#pragma unroll 1
        for (int h = 0; h < 8; ++h) {
            __syncthreads();
            { const int c = tid >> 3, k8 = (tid & 7) * 8;
              *(u32x4*)(WU + c * 72 + k8) = pw; *(u32x4*)(AU + c * 72 + k8) = pa;
#pragma unroll
              for (int i = 0; i < 2; ++i) { const int pc = tid + i * 512, c2 = pc >> 4, k82 = (pc & 15) * 8; *(u32x4*)(GU + c2 * 136 + k82) = pg[i]; } }
#pragma unroll
            for (int i = 0; i < 2; ++i) { const int pc = lane + i * 64, rr = pc >> 3, c8 = (pc & 7) * 8, row = item * 16 + rr, col = 512 + h * 64 + c8;
                *(u32x4*)(kcur + rr * 72 + c8) = *(const u32x4*)(PROJ + (size_t)row * PLD + col);
                u32x4 pv = {0u, 0u, 0u, 0u};
                if (row >= MPR) { const float* sp = p.in[2] + (size_t)(row - MPR) * RPJ + col; const f32x4 a = *(const f32x4*)sp, b = *(const f32x4*)(sp + 4); pv.x = pkbf(a[0], a[1]); pv.y = pkbf(a[2], a[3]); pv.z = pkbf(b[0], b[1]); pv.w = pkbf(b[2], b[3]); }
                else if ((row & (SEQ - 1)) != 0) pv = *(const u32x4*)(PROJ + (size_t)(row - 1) * PLD + col);
                *(u32x4*)(kprv + rr * 72 + c8) = pv; }
            if (h + 1 < 8) PREP_LOAD(h + 1);
            __syncthreads();
            float ss[4] = {0.f, 0.f, 0.f, 0.f};
#pragma unroll
            for (int ctl = 0; ctl < 4; ++ctl) { const int cl = ctl * 16 + r, col = h * 64 + cl; const float kkc = p.in[13][col], muc = p.in[7][512 + col];
#pragma unroll
                for (int j = 0; j < 4; ++j) { const float kc = bf2f(kcur[(q * 4 + j) * 72 + cl]), kv = bf2f(kprv[(q * 4 + j) * 72 + cl]); const float kr = (kc + (kv - kc) * muc) * kkc; ss[j] += kr * kr; } }
#pragma unroll
            for (int j = 0; j < 4; ++j) { ss[j] = sum16(ss[j]); ss[j] = rsqrtf(fmaxf(ss[j], 1e-24f)); }
#pragma unroll 1
            for (int ctl = 0; ctl < 4; ++ctl) {
                const int cl = ctl * 16 + r, col = h * 64 + cl;
                f32x4 cw = {0.f, 0.f, 0.f, 0.f}, ca = cw, cgt = cw;
#pragma unroll
                for (int ks = 0; ks < 2; ++ks) { cw = mfma16(aw[ks], *(const bf16x8*)(WU + cl * 72 + ks * 32 + q * 8), cw); ca = mfma16(aa[ks], *(const bf16x8*)(AU + cl * 72 + ks * 32 + q * 8), ca); }
#pragma unroll
                for (int ks = 0; ks < 4; ++ks) cgt = mfma16(ag[ks], *(const bf16x8*)(GU + cl * 136 + ks * 32 + q * 8), cgt);
                const float w0c = p.in[8][col], a0c = p.in[10][col], kkc = p.in[13][col], kac = p.in[14][col], muc = p.in[7][512 + col];
#pragma unroll
                for (int j = 0; j < 4; ++j) {
                    const int row = item * 16 + q * 4 + j; const size_t o = (size_t)row * 512 + col;
                    const float wl = -softplus(-(w0c + cw[j])) - 0.5f;
                    WD[o] = __expf(-__expf(wl));
                    const float a = sigm(a0c + ca[j]);
                    GG[o] = f2bf(cgt[j]);
                    const float kc = bf2f(kcur[(q * 4 + j) * 72 + cl]), kv = bf2f(kprv[(q * 4 + j) * 72 + cl]); const float k = kc + (kv - kc) * muc;
                    KP[o] = f2bf(k * (1.f + (a - 1.f) * kac));
                    const float kk = k * kkc * ss[j];
                    KK[o] = f2bf(kk); KB[o] = f2bf(kk * a);
                }
            }
        }
    }
    __syncthreads();
#undef PREP_LOAD
    bf16* XBC = (bf16*)(p.ws + WS_XBC);
    const int ntl = MTOT / 128, cb = (G > ntl + 32) ? ntl : 0;
    if (bid < cb) return;
    const size_t gt = (size_t)(bid - cb) * 512 + tid, NGT = (size_t)(G - cb) * 512;
    for (size_t idx = gt; idx < (size_t)MPR * 128; idx += NGT) {
        const int row = (int)(idx >> 7), c0 = (int)(idx & 127) * 8, t = row & (SEQ - 1);
        float acc[8], x[8];
        { const f32x4 b0 = *(const f32x4*)(p.in[19] + c0), b1 = *(const f32x4*)(p.in[19] + c0 + 4);
#pragma unroll
          for (int i = 0; i < 4; ++i) { acc[i] = b0[i]; acc[4 + i] = b1[i]; } }
#pragma unroll
        for (int d = 0; d < 4; ++d) { if (t - 3 + d < 0) continue;
            unpack8(*(const u32x4*)(PROJ + (size_t)(row - 3 + d) * PLD + 2304 + c0), x);
            const f32x4 w0 = *(const f32x4*)(p.in[18] + d * 1024 + c0), w1 = *(const f32x4*)(p.in[18] + d * 1024 + c0 + 4);
#pragma unroll
            for (int i = 0; i < 4; ++i) { acc[i] += w0[i] * x[i]; acc[4 + i] += w1[i] * x[4 + i]; } }
#pragma unroll
        for (int i = 0; i < 8; ++i) acc[i] = silu(acc[i]);
        *(u32x4*)(XBC + (size_t)row * 1024 + c0) = pack8(acc);
    }
}

constexpr int TC = 32, SBUF = 5 * TC * 64 + TC * 16 + TC * 2;
struct StageRegs { f32x4 w0, w1; u32x4 kp, kk, kb, rc, rp, vc, vp; };
__device__ __forceinline__ void scan_issue(const P& p, StageRegs& R, int row0, int h, int vq, int st) {
    const float* WD = p.out + OS_WD; const bf16* KP = (const bf16*)(p.ws + WS_KP); const bf16* KK = (const bf16*)(p.ws + WS_KK); const bf16* KB = (const bf16*)(p.ws + WS_KB); const bf16* PROJ = (const bf16*)(p.ws + WS_PROJ);
    const int tt = st >> 3, k8 = (st & 7) * 8, row = row0 + tt, prow = (row & (SEQ - 1)) ? row - 1 : row; const size_t o = (size_t)row * 512 + h * 64 + k8;
    R.w0 = *(const f32x4*)(WD + o); R.w1 = *(const f32x4*)(WD + o + 4); R.kp = *(const u32x4*)(KP + o); R.kk = *(const u32x4*)(KK + o); R.kb = *(const u32x4*)(KB + o);
    R.rc = *(const u32x4*)(PROJ + (size_t)row * PLD + h * 64 + k8); R.rp = *(const u32x4*)(PROJ + (size_t)prow * PLD + h * 64 + k8);
    if (st < 64) { const int t2 = st >> 1, v8 = (st & 1) * 8, row2 = row0 + t2, prow2 = (row2 & (SEQ - 1)) ? row2 - 1 : row2;
        R.vc = *(const u32x4*)(PROJ + (size_t)row2 * PLD + 1024 + h * 64 + vq * 16 + v8); R.vp = *(const u32x4*)(PROJ + (size_t)prow2 * PLD + 1024 + h * 64 + vq * 16 + v8); }
}
__device__ __forceinline__ void scan_commit(const StageRegs& R, float* B, int row0, int st, const float* mur, const float* muv) {
    const int tt = st >> 3, k8 = (st & 7) * 8; float kp[8], kb[8], v[8], rc[8], rp[8];
    *(f32x4*)(B + tt * 64 + k8) = R.w0; *(f32x4*)(B + tt * 64 + k8 + 4) = R.w1;
    unpack8(R.kp, kp); *(f32x4*)(B + TC * 64 + tt * 64 + k8) = (f32x4){kp[0], kp[1], kp[2], kp[3]}; *(f32x4*)(B + TC * 64 + tt * 64 + k8 + 4) = (f32x4){kp[4], kp[5], kp[6], kp[7]};
    unpack8(R.kk, v); *(f32x4*)(B + 2 * TC * 64 + tt * 64 + k8) = (f32x4){-v[0], -v[1], -v[2], -v[3]}; *(f32x4*)(B + 2 * TC * 64 + tt * 64 + k8 + 4) = (f32x4){-v[4], -v[5], -v[6], -v[7]};
    unpack8(R.kb, kb); *(f32x4*)(B + 3 * TC * 64 + tt * 64 + k8) = (f32x4){kb[0], kb[1], kb[2], kb[3]}; *(f32x4*)(B + 3 * TC * 64 + tt * 64 + k8 + 4) = (f32x4){kb[4], kb[5], kb[6], kb[7]};
    unpack8(R.rc, rc); unpack8(R.rp, rp); const float pz = ((row0 + tt) & (SEQ - 1)) ? 1.f : 0.f;
    float c1 = 0.f, c2 = 0.f;
#pragma unroll
    for (int j = 0; j < 8; ++j) { v[j] = rc[j] + (rp[j] * pz - rc[j]) * mur[j]; c1 += kb[j] * v[j]; c2 += kp[j] * v[j]; }
    *(f32x4*)(B + 4 * TC * 64 + tt * 64 + k8) = (f32x4){R.w0[0] * v[0], R.w0[1] * v[1], R.w0[2] * v[2], R.w0[3] * v[3]}; *(f32x4*)(B + 4 * TC * 64 + tt * 64 + k8 + 4) = (f32x4){R.w1[0] * v[4], R.w1[1] * v[5], R.w1[2] * v[6], R.w1[3] * v[7]};
    c1 += __shfl_xor(c1, 1); c2 += __shfl_xor(c2, 1); c1 += __shfl_xor(c1, 2); c2 += __shfl_xor(c2, 2); c1 += __shfl_xor(c1, 4); c2 += __shfl_xor(c2, 4);
    if ((st & 7) == 0) { B[5 * TC * 64 + TC * 16 + tt * 2] = c1; B[5 * TC * 64 + TC * 16 + tt * 2 + 1] = c2; }
    if (st < 64) { const int t2 = st >> 1, v8 = (st & 1) * 8; unpack8(R.vc, rc); unpack8(R.vp, rp); const float pz2 = ((row0 + t2) & (SEQ - 1)) ? 1.f : 0.f;
#pragma unroll
        for (int j = 0; j < 8; ++j) v[j] = rc[j] + (rp[j] * pz2 - rc[j]) * muv[j];
        *(f32x4*)(B + 5 * TC * 64 + t2 * 16 + v8) = (f32x4){v[0], v[1], v[2], v[3]}; *(f32x4*)(B + 5 * TC * 64 + t2 * 16 + v8 + 4) = (f32x4){v[4], v[5], v[6], v[7]}; }
}
struct ScanIn { f32x4 w, kp, ka, kb, wr; float vv, c1, c2; };
__device__ __forceinline__ ScanIn scan_load(const float* B, int tt, int kg, int rloc) {
    ScanIn s; s.w = *(const f32x4*)(B + tt * 64 + kg * 4); s.kp = *(const f32x4*)(B + TC * 64 + tt * 64 + kg * 4); s.ka = *(const f32x4*)(B + 2 * TC * 64 + tt * 64 + kg * 4);
    s.kb = *(const f32x4*)(B + 3 * TC * 64 + tt * 64 + kg * 4); s.wr = *(const f32x4*)(B + 4 * TC * 64 + tt * 64 + kg * 4);
    s.vv = B[5 * TC * 64 + tt * 16 + rloc]; s.c1 = B[5 * TC * 64 + TC * 16 + tt * 2]; s.c2 = B[5 * TC * 64 + TC * 16 + tt * 2 + 1]; return s;
}
__device__ __forceinline__ void phase_scan(const P& p_in, unsigned char* smem) {
    PHASE_PROLOGUE;
    const int lane = tid & 63, wave = tid >> 6;
    float* buf0 = (float*)smem; float* ybuf = buf0 + 2 * SBUF;
    bf16* YR = (bf16*)(p.ws + WS_XB);
    constexpr int NCH = SEQ / TC;
    for (int unit = blockIdx.x; unit < 256; unit += gridDim.x) {
        const int xcd = unit & 7, slot = unit >> 3, bh = xcd * 8 + (slot >> 2), vq = slot & 3, b = bh >> 3, h = bh & 7, rowbase = b * SEQ;
        bf16* yu = YR + (size_t)(bh * 4 + vq) * SEQ * 16;
        const int st = tid - 256;
        StageRegs R; float mur[8], muv[8];
        if (wave >= 4) {
#pragma unroll
            for (int j = 0; j < 8; ++j) { mur[j] = p.in[7][h * 64 + (st & 7) * 8 + j]; muv[j] = p.in[7][1024 + h * 64 + vq * 16 + (st & 1) * 8 + j]; }
            scan_issue(p, R, rowbase, h, vq, st); scan_commit(R, buf0, rowbase, st, mur, muv); scan_issue(p, R, rowbase + TC, h, vq, st);
        }
        __syncthreads();
        float S0 = 0.f, S1 = 0.f, S2 = 0.f, S3 = 0.f;
        const int rl = lane >> 4, kg = lane & 15, rloc = (wave & 3) * 4 + rl;
        for (int c = 0; c < NCH; ++c) {
            if (wave < 4) {
                const float* B = buf0 + (c & 1) * SBUF; float* yb = ybuf + (c & 1) * (TC * 16);
                ScanIn cur = scan_load(B, 0, kg, rloc);
#pragma unroll 4
                for (int tt = 0; tt < TC; ++tt) {
                    const ScanIn nxt = scan_load(B, (tt + 1) & (TC - 1), kg, rloc);
                    float sa = (S0 * cur.ka[0] + S1 * cur.ka[1]) + (S2 * cur.ka[2] + S3 * cur.ka[3]);
                    float y1 = (S0 * cur.wr[0] + S1 * cur.wr[1]) + (S2 * cur.wr[2] + S3 * cur.wr[3]);
                    sa += dppf<0xB1>(sa); y1 += dppf<0xB1>(y1); sa += dppf<0x4E>(sa); y1 += dppf<0x4E>(y1);
                    sa += dppf<0x141>(sa); y1 += dppf<0x141>(y1); sa += dppf<0x140>(sa); y1 += dppf<0x140>(y1);
                    S0 = S0 * cur.w[0] + (sa * cur.kb[0] + cur.vv * cur.kp[0]); S1 = S1 * cur.w[1] + (sa * cur.kb[1] + cur.vv * cur.kp[1]);
                    S2 = S2 * cur.w[2] + (sa * cur.kb[2] + cur.vv * cur.kp[2]); S3 = S3 * cur.w[3] + (sa * cur.kb[3] + cur.vv * cur.kp[3]);
                    if (kg == 0) yb[tt * 16 + rloc] = y1 + sa * cur.c1 + cur.vv * cur.c2;
                    cur = nxt;
                }
            } else {
                if (c + 1 < NCH) scan_commit(R, buf0 + ((c + 1) & 1) * SBUF, rowbase + (c + 1) * TC, st, mur, muv);
                if (c + 2 < NCH) scan_issue(p, R, rowbase + (c + 2) * TC, h, vq, st);
                if (c > 0) { const float* yp = ybuf + ((c - 1) & 1) * (TC * 16); const int i2 = st * 2;
                    *(unsigned*)(yu + (size_t)(c - 1) * TC * 16 + i2) = pkbf(yp[i2], yp[i2 + 1]); }
            }
            __syncthreads();
        }
        if (wave >= 4) { const float* yp = ybuf + ((NCH - 1) & 1) * (TC * 16); const int i2 = st * 2;
            *(unsigned*)(yu + (size_t)(NCH - 1) * TC * 16 + i2) = pkbf(yp[i2], yp[i2 + 1]); }
        else *(f32x4*)(p.out + O_WKVP + ((size_t)(bh * 64 + vq * 16 + rloc)) * 64 + kg * 4) = (f32x4){S0, S1, S2, S3};
        __syncthreads();
    }
}


constexpr int CK = 16, NCHAIN = 2, NHELP = 8 - NCHAIN, SLOTB = 22912, NCHK = SEQ / CK, SCAN_WGS = 256 / NCHAIN;
constexpr int SO_AT = 0, SO_RT = 2304, SO_BT = 4608, SO_KT = 6912, SO_BH = 9216, SO_KH = 12288, SO_NAK = 15360, SO_NBR = 16128, SO_NKR = 16896, SO_TT = 17664, SO_VT = 18432, SO_DC = 21504, SO_NAB = 21760;
constexpr int CR_SB = NHELP * SLOTB, FL_OFF = CR_SB + NCHAIN * 3072;
static_assert(FL_OFF + 256 <= MISC_OFF, "scan LDS map");
struct HelpRegs { f32x4 w0, w1; u32x4 kp, kk, kb, rc, rp, vc, vp; };
__device__ __forceinline__ void help_issue(const P& p, HelpRegs (&R)[2], int row0, int h, int lane) {
    const float* WD = p.out + OS_WD; const bf16* KP = (const bf16*)(p.ws + WS_KP); const bf16* KK = (const bf16*)(p.ws + WS_KK); const bf16* KB = (const bf16*)(p.ws + WS_KB); const bf16* PROJ = (const bf16*)(p.ws + WS_PROJ);
#pragma unroll
    for (int i = 0; i < 2; ++i) { const int pc = lane + i * 64, tt = pc & 15, k8 = (pc >> 4) * 8, row = row0 + tt, prow = (row & (SEQ - 1)) ? row - 1 : row; const size_t o = (size_t)row * 512 + h * 64 + k8;
        R[i].w0 = *(const f32x4*)(WD + o); R[i].w1 = *(const f32x4*)(WD + o + 4); R[i].kp = *(const u32x4*)(KP + o); R[i].kk = *(const u32x4*)(KK + o); R[i].kb = *(const u32x4*)(KB + o);
        R[i].rc = *(const u32x4*)(PROJ + (size_t)row * PLD + h * 64 + k8); R[i].rp = *(const u32x4*)(PROJ + (size_t)prow * PLD + h * 64 + k8);
        R[i].vc = *(const u32x4*)(PROJ + (size_t)row * PLD + 1024 + h * 64 + k8); R[i].vp = *(const u32x4*)(PROJ + (size_t)prow * PLD + 1024 + h * 64 + k8); }
}
__device__ __forceinline__ void phase_scan2(const P& p_in, unsigned char* smem) {
    PHASE_PROLOGUE;
    const int lane = tid & 63, wave = tid >> 6, r = lane & 15, q = lane >> 4;
    bf16* YR = (bf16*)(p.ws + WS_XB);
    volatile unsigned* flags = (volatile unsigned*)(smem + FL_OFF);
    const bf16x8 zero8 = {0, 0, 0, 0, 0, 0, 0, 0};
    for (int unit = blockIdx.x; unit < SCAN_WGS; unit += SCAN_WGS) {
        const int ub = unit / (4 / NCHAIN), part = unit % (4 / NCHAIN), bh = (ub & 7) * 8 + (ub >> 3), vq = part * NCHAIN + (wave % NCHAIN), b = bh >> 3, h = bh & 7, rowbase = b * SEQ;
        if (tid < 64) flags[tid] = 0u;
        __syncthreads();
        if (wave < NCHAIN) {
            __builtin_amdgcn_s_setprio(3);
            bf16* yu = YR + (size_t)(bh * 4 + vq) * SEQ * 16;
            f32x4 ST[4];
#pragma unroll
            for (int mt = 0; mt < 4; ++mt) ST[mt] = (f32x4){0.f, 0.f, 0.f, 0.f};
            for (int c = 0; c < NCHK; ++c) {
                const int slot = c % NHELP; unsigned char* sb = smem + slot * SLOTB;
                const bf16* AT = (const bf16*)(sb + SO_AT); const bf16* RT = (const bf16*)(sb + SO_RT); const bf16* BH = (const bf16*)(sb + SO_BH); const bf16* KH = (const bf16*)(sb + SO_KH);
                const bf16* NAK = (const bf16*)(sb + SO_NAK); const bf16* NBR = (const bf16*)(sb + SO_NBR); const bf16* NKR = (const bf16*)(sb + SO_NKR); const bf16* TT = (const bf16*)(sb + SO_TT);
                const bf16* VT = (const bf16*)(sb + SO_VT) + vq * 16 * 24; const float* DC = (const float*)(sb + SO_DC);
                s16x4 sb4[4];
#pragma unroll
                for (int mt = 0; mt < 4; ++mt) sb4[mt] = cvt4(ST[mt]);
                { unsigned sp = 0; while (flags[slot] != (unsigned)(c + 1)) { __builtin_amdgcn_s_sleep(1); if (++sp > (1u << 22)) break; } }
                asm volatile("" ::: "memory");
                s16x4 fa[4], fr[4], fbh[4], fkh[4]; f32x4 dcv[4];
#pragma unroll
                for (int mt = 0; mt < 4; ++mt) { fa[mt] = *(const s16x4*)(AT + r * 72 + mt * 16 + q * 4); fr[mt] = *(const s16x4*)(RT + r * 72 + mt * 16 + q * 4);
                    fbh[mt] = *(const s16x4*)(BH + (mt * 16 + r) * 24 + q * 4); fkh[mt] = *(const s16x4*)(KH + (mt * 16 + r) * 24 + q * 4); dcv[mt] = *(const f32x4*)(DC + mt * 16 + q * 4); }
                const s16x4 fnak = *(const s16x4*)(NAK + lane * 4), ftt = *(const s16x4*)(TT + lane * 4), fnbr = *(const s16x4*)(NBR + lane * 4), fnkr = *(const s16x4*)(NKR + lane * 4);
                const s16x4 fvt = *(const s16x4*)(VT + r * 24 + q * 4);
                LDS_FENCE();
                if (lane == 0) flags[8 + slot * NCHAIN + wave] = (unsigned)(c + 1);
                f32x4 Wt = {0.f, 0.f, 0.f, 0.f};
#pragma unroll
                for (int mt = 0; mt < 4; ++mt) Wt = mf16(fa[mt], sb4[mt], Wt);
                Wt = mf16(fnak, fvt, Wt);
                f32x4 Ut = {0.f, 0.f, 0.f, 0.f};
                Ut = mf16(ftt, cvt4(Wt), Ut);
                const s16x4 ub = cvt4(Ut);
#pragma unroll
                for (int mt = 0; mt < 4; ++mt) { ST[mt] = ST[mt] * dcv[mt]; ST[mt] = mf16(fbh[mt], ub, ST[mt]); ST[mt] = mf16(fkh[mt], fvt, ST[mt]); }
                f32x4 Yt = {0.f, 0.f, 0.f, 0.f};
#pragma unroll
                for (int mt = 0; mt < 4; ++mt) Yt = mf16(fr[mt], sb4[mt], Yt);
                Yt = mf16(fnbr, ub, Yt); Yt = mf16(fnkr, fvt, Yt);
#pragma unroll
                for (int j = 0; j < 4; ++j) yu[(size_t)(c * CK + q * 4 + j) * 16 + r] = f2bf(Yt[j]);
            }
#pragma unroll
            for (int mt = 0; mt < 4; ++mt) *(f32x4*)(p.out + O_WKVP + ((size_t)(bh * 64 + vq * 16 + r)) * 64 + mt * 16 + q * 4) = ST[mt];
            __builtin_amdgcn_s_setprio(0);
        } else {
            const int hw = wave - NCHAIN; unsigned char* sb = smem + hw * SLOTB;
            bf16* AT = (bf16*)(sb + SO_AT); bf16* RT = (bf16*)(sb + SO_RT); bf16* BT = (bf16*)(sb + SO_BT); bf16* KT = (bf16*)(sb + SO_KT); bf16* BH = (bf16*)(sb + SO_BH); bf16* KH = (bf16*)(sb + SO_KH);
            bf16* NAK = (bf16*)(sb + SO_NAK); bf16* NBR = (bf16*)(sb + SO_NBR); bf16* NKR = (bf16*)(sb + SO_NKR); bf16* TT = (bf16*)(sb + SO_TT); bf16* VT = (bf16*)(sb + SO_VT);
            float* DC = (float*)(sb + SO_DC); float* NAB = (float*)(sb + SO_NAB); float* WR = (float*)(sb + SO_BH);
            float mur[2][8], muv[2][8];
#pragma unroll
            for (int i = 0; i < 2; ++i)
#pragma unroll
                for (int j = 0; j < 8; ++j) { mur[i][j] = p.in[7][h * 64 + ((lane + i * 64) >> 4) * 8 + j]; muv[i][j] = p.in[7][1024 + h * 64 + ((lane + i * 64) >> 4) * 8 + j]; }
            HelpRegs R[2];
            help_issue(p, R, rowbase + hw * CK, h, lane);
            for (int c = hw; c < NCHK; c += NHELP) {
                if (c >= NHELP) { const unsigned want = (unsigned)(c - NHELP + 1); unsigned sp = 0;
                    for (;;) { bool ok = true;
#pragma unroll
                        for (int w = 0; w < NCHAIN; ++w) ok = ok && (flags[8 + hw * NCHAIN + w] == want);
                        if (ok) break; __builtin_amdgcn_s_sleep(2); if (++sp > (1u << 22)) break; } }
                asm volatile("" ::: "memory");
                const int row0 = rowbase + c * CK;
#pragma unroll
                for (int i = 0; i < 2; ++i) { const int k8 = ((lane >> 4) + 4 * i) * 8, tt = lane & 15; float w[8], pre[8], suf[8], x[8], y[8], rc[8], rp[8];
#pragma unroll
                    for (int j = 0; j < 4; ++j) { w[j] = R[i].w0[j]; w[4 + j] = R[i].w1[j]; }
#pragma unroll
                    for (int j = 0; j < 8; ++j) { float a = w[j], z = w[j];
                        a *= dppo<0x111>(a); a *= dppo<0x112>(a); a *= dppo<0x114>(a); a *= dppo<0x118>(a);
                        z *= dppo<0x101>(z); z *= dppo<0x102>(z); z *= dppo<0x104>(z); z *= dppo<0x108>(z);
                        pre[j] = a; suf[j] = z * __builtin_amdgcn_rcpf(w[j]); }
                    if (tt == 15) { *(f32x4*)(DC + k8) = (f32x4){pre[0], pre[1], pre[2], pre[3]}; *(f32x4*)(DC + k8 + 4) = (f32x4){pre[4], pre[5], pre[6], pre[7]}; }
                    unpack8(R[i].kk, x);
#pragma unroll
                    for (int j = 0; j < 8; ++j) y[j] = -x[j] * dppo<0x111>(pre[j]);
                    *(u32x4*)(AT + tt * 72 + k8) = pack8(y);
                    unpack8(R[i].kb, x);
#pragma unroll
                    for (int j = 0; j < 8; ++j) { const float inv = __builtin_amdgcn_rcpf(pre[j]); rp[j] = inv; y[j] = x[j] * inv; x[j] *= suf[j]; }
                    *(u32x4*)(BT + tt * 72 + k8) = pack8(y);
#pragma unroll
                    for (int j = 0; j < 8; ++j) BH[(k8 + j) * 24 + tt] = f2bf(x[j]);
                    unpack8(R[i].kp, x);
#pragma unroll
                    for (int j = 0; j < 8; ++j) { y[j] = x[j] * rp[j]; x[j] *= suf[j]; }
                    *(u32x4*)(KT + tt * 72 + k8) = pack8(y);
#pragma unroll
                    for (int j = 0; j < 8; ++j) KH[(k8 + j) * 24 + tt] = f2bf(x[j]);
                    unpack8(R[i].rc, rc); unpack8(R[i].rp, rp); const float pz = ((row0 + tt) & (SEQ - 1)) ? 1.f : 0.f;
#pragma unroll
                    for (int j = 0; j < 8; ++j) y[j] = (rc[j] + (rp[j] * pz - rc[j]) * mur[i][j]) * pre[j];
                    *(u32x4*)(RT + tt * 72 + k8) = pack8(y);
                    unpack8(R[i].vc, rc); unpack8(R[i].vp, rp);
#pragma unroll
                    for (int j = 0; j < 8; ++j) VT[(k8 + j) * 24 + tt] = f2bf(rc[j] + (rp[j] * pz - rc[j]) * muv[i][j]); }
                if (c + NHELP < NCHK) help_issue(p, R, rowbase + (c + NHELP) * CK, h, lane);
                LDS_FENCE();
                { f32x4 nab = {0.f, 0.f, 0.f, 0.f}, nabT = nab, nak = nab, nbr = nab, nkr = nab;
#pragma unroll
                  for (int ks = 0; ks < 2; ++ks) { const bf16x8 fb = *(const bf16x8*)(BT + r * 72 + ks * 32 + q * 8), fk = *(const bf16x8*)(KT + r * 72 + ks * 32 + q * 8), fa = *(const bf16x8*)(AT + r * 72 + ks * 32 + q * 8), fr = *(const bf16x8*)(RT + r * 72 + ks * 32 + q * 8);
                      nab = mfma16(fb, fa, nab); nabT = mfma16(fa, fb, nabT); nak = mfma16(fk, fa, nak); nbr = mfma16(fb, fr, nbr); nkr = mfma16(fk, fr, nkr); }
#pragma unroll
                  for (int j = 0; j < 4; ++j) { const int i = q * 4 + j, t = r;
                      nab[j] = (i < t) ? nab[j] : 0.f; nabT[j] = (r < i) ? nabT[j] : 0.f; nak[j] = (i < t) ? nak[j] : 0.f; nbr[j] = (i <= t) ? nbr[j] : 0.f; nkr[j] = (i <= t) ? nkr[j] : 0.f; }
                  *(s16x4*)(NAK + lane * 4) = cvt4(nak); *(s16x4*)(NBR + lane * 4) = cvt4(nbr); *(s16x4*)(NKR + lane * 4) = cvt4(nkr);
                  const f32x4 z4 = {0.f, 0.f, 0.f, 0.f};
                  const s16x4 bN = cvt4(nab), bNT = cvt4(nabT);
                  const f32x4 n2 = mf16(bNT, bN, z4), n2T = mf16(bN, bNT, z4);
                  const s16x4 b2 = cvt4(n2), b2T = cvt4(n2T);
                  const f32x4 n4 = mf16(b2T, b2, z4), n4T = mf16(b2, b2T, z4);
                  const s16x4 b4 = cvt4(n4), b4T = cvt4(n4T);
                  f32x4 X = mf16(b4T, b4, z4);
#pragma unroll
                  for (int j = 0; j < 4; ++j) X[j] += (q * 4 + j == r) ? 1.f : 0.f;
                  X = mf16(b4T, cvt4(X), X);
                  X = mf16(b2T, cvt4(X), X);
                  X = mf16(bNT, cvt4(X), X);
                  *(s16x4*)(TT + lane * 4) = cvt4(X); }
                LDS_FENCE();
                if (lane == 0) flags[hw] = (unsigned)(c + 1);
            }
        }
        __syncthreads();
    }
}

__device__ __forceinline__ bf16x8 ldfrag(const bf16* base, int ld, int row0, int k0, int r, int q) { return *(const bf16x8*)(base + (row0 + r) * ld + k0 + q * 8); }
__device__ __forceinline__ void phase_ssd(const P& p_in, unsigned char* smem) {
    PHASE_PROLOGUE;
    const int lane = tid & 63, wave = tid >> 6, r = lane & 15, q = lane >> 4;
    bf16* XT = (bf16*)(smem + 53248); bf16* XdT = (bf16*)(smem + 57856); bf16* Gs = (bf16*)(smem + 62464); bf16* Hb = (bf16*)(smem + 71680); float* xsn = (float*)(smem + 80384);
    const bf16* XBC = (const bf16*)(p.ws + WS_XBC); const float* DT = (const float*)(p.ws + WS_DT); bf16* YM = (bf16*)(p.ws + WS_XB) + (size_t)MPR * 512;
    for (int unit = (int)blockIdx.x - SCAN_WGS; unit >= 0 && unit < 128; unit += 128) {
        const int bg = unit >> 3, e = (unit >> 1) & 3, ph = unit & 1, b = bg >> 1, g = bg & 1, h = g * 4 + e;
        const float A = -__expf(p.in[21][h]), Dh = p.in[22][h];
        f32x4 hacc[2] = {{0.f, 0.f, 0.f, 0.f}, {0.f, 0.f, 0.f, 0.f}};
        for (int i = tid; i < 32 * 136; i += 512) Hb[i] = 0;
        u32x4 rc[2], rb[2]; unsigned rx0, rx1; float rdt = 0.f;
#define SSD_LOAD(c_) do { const int row0_ = b * SEQ + (c_) * 64; \
            _Pragma("unroll") for (int i = 0; i < 2; ++i) { const int pc = tid + i * 512, s_ = pc >> 4, n8 = (pc & 15) * 8; \
                rc[i] = *(const u32x4*)(XBC + (size_t)(row0_ + s_) * 1024 + 768 + g * 128 + n8); rb[i] = *(const u32x4*)(XBC + (size_t)(row0_ + s_) * 1024 + 512 + g * 128 + n8); } \
            { const unsigned* xp_ = (const unsigned*)(XBC + (size_t)(row0_ + (tid >> 3)) * 1024 + h * 64 + ph * 32 + (tid & 7) * 4); rx0 = xp_[0]; rx1 = xp_[1]; } \
            if (tid < 64) rdt = DT[(size_t)(row0_ + tid) * 8 + h]; } while (0)
        SSD_LOAD(0);
        for (int c = 0; c < SEQ / 64; ++c) {
            unsigned char* sb = smem + (c & 1) * 89088; bf16* Cs = (bf16*)sb; bf16* Bs = (bf16*)(sb + 17408); bf16* BT = (bf16*)(sb + 34816);
            float* cs = (float*)(smem + ((c & 1) ? 142336 : 88576)); float* dtv = cs + 64;
#pragma unroll
            for (int i = 0; i < 2; ++i) { const int pc = tid + i * 512, s_ = pc >> 4, n8 = (pc & 15) * 8;
                *(u32x4*)(Cs + s_ * 136 + n8) = rc[i]; *(u32x4*)(Bs + s_ * 136 + n8) = rb[i];
                const unsigned w[4] = {rb[i].x, rb[i].y, rb[i].z, rb[i].w};
                const int sp = ((((s_ >> 3) ^ (pc & 7)) << 3) | (s_ & 7));
#pragma unroll
                for (int j = 0; j < 4; ++j) { BT[(n8 + 2 * j) * 72 + sp] = (bf16)(w[j] & 0xffffu); BT[(n8 + 2 * j + 1) * 72 + sp] = (bf16)(w[j] >> 16); } }
            if (wave == 0) { float v = A * rdt;
                v += dppf<0x111>(v); v += dppf<0x112>(v); v += dppf<0x114>(v); v += dppf<0x118>(v);
                v += __int_as_float(__builtin_amdgcn_update_dpp(0, __float_as_int(v), 0x142, 0xa, 0xf, false));
                v += __int_as_float(__builtin_amdgcn_update_dpp(0, __float_as_int(v), 0x143, 0xc, 0xf, false));
                cs[lane] = v; dtv[lane] = rdt; }
            __syncthreads();
            { const int s_ = tid >> 3, p4 = (tid & 7) * 4; const float dts = dtv[s_], dec = __expf(cs[63] - cs[s_]);
              const float x[4] = {bflo(rx0), bfhi(rx0), bflo(rx1), bfhi(rx1)};
#pragma unroll
              for (int j = 0; j < 4; ++j) { const float X = x[j] * dts; XT[(p4 + j) * 72 + s_] = f2bf(X); XdT[(p4 + j) * 72 + s_] = f2bf(X * dec); }
              *(f32x4*)(xsn + s_ * 32 + p4) = (f32x4){x[0], x[1], x[2], x[3]}; }
            if (c + 1 < SEQ / 64) SSD_LOAD(c + 1);
#pragma unroll
            for (int i = 0; i < 2; ++i) { const int tile = wave * 2 + i, mt = tile >> 2, nt = tile & 3; f32x4 acc = {0.f, 0.f, 0.f, 0.f};
#pragma unroll
                for (int ks = 0; ks < 4; ++ks) acc = mfma16(ldfrag(Cs, 136, mt * 16, ks * 32, r, q), ldfrag(Bs, 136, nt * 16, ks * 32, r, q), acc);
                const int s_ = nt * 16 + r; const float css = cs[s_];
#pragma unroll
                for (int j = 0; j < 4; ++j) { const int l = mt * 16 + q * 4 + j; const float gv = (s_ <= l) ? acc[j] * __expf(cs[l] - css) : 0.f; Gs[l * 72 + s_] = f2bf(gv); } }
            const int mt = wave >> 1, pt = wave & 1;
            f32x4 yacc = {0.f, 0.f, 0.f, 0.f};
#pragma unroll
            for (int ks = 0; ks < 4; ++ks) yacc = mfma16(ldfrag(Cs, 136, mt * 16, ks * 32, r, q), ldfrag(Hb, 136, pt * 16, ks * 32, r, q), yacc);
#pragma unroll
            for (int j = 0; j < 4; ++j) yacc[j] *= __expf(cs[mt * 16 + q * 4 + j]);
            __syncthreads();
#pragma unroll
            for (int ks = 0; ks < 2; ++ks) yacc = mfma16(ldfrag(Gs, 72, mt * 16, ks * 32, r, q), ldfrag(XT, 72, pt * 16, ks * 32, r, q), yacc);
#pragma unroll
            for (int j = 0; j < 4; ++j) { const int l = mt * 16 + q * 4 + j; YM[((size_t)((b * 8 + h) * 4 + ph * 2 + pt) * SEQ + c * 64 + l) * 16 + r] = f2bf(yacc[j] + Dh * xsn[l * 32 + pt * 16 + r]); }
            { const float dl = __expf(cs[63]);
#pragma unroll
              for (int t2 = 0; t2 < 2; ++t2) { hacc[t2] = hacc[t2] * dl;
#pragma unroll
                  for (int ks = 0; ks < 2; ++ks) hacc[t2] = mfma16(ldfrag(XdT, 72, t2 * 16, ks * 32, r, q), *(const bf16x8*)(BT + (wave * 16 + r) * 72 + (((ks * 4 + q) ^ ((wave * 2 + (r >> 3)) & 7)) << 3)), hacc[t2]);
#pragma unroll
                  for (int j = 0; j < 4; ++j) Hb[(t2 * 16 + q * 4 + j) * 136 + wave * 16 + r] = f2bf(hacc[t2][j]); } }
        }
#undef SSD_LOAD
#pragma unroll
        for (int t2 = 0; t2 < 2; ++t2)
#pragma unroll
            for (int j = 0; j < 4; ++j) p.out[O_SSMP + ((size_t)((b * 8 + h) * 64 + ph * 32 + t2 * 16 + q * 4 + j)) * 128 + wave * 16 + r] = hacc[t2][j];
        __syncthreads();
    }
}

__device__ __forceinline__ float conv_act_s(const P& p, int bs, int c) {
    const bf16* PROJ = (const bf16*)(p.ws + WS_PROJ); const float* sc = p.in[4] + (size_t)bs * 3072 + c; const float* cw = p.in[18] + c;
    const float v = p.in[19][c] + cw[0] * sc[0] + cw[1024] * sc[1024] + cw[2048] * sc[2048] + cw[3072] * bf2f(PROJ[(size_t)(MPR + bs) * PLD + 2304 + c]);
    return silu(v);
}
__device__ __forceinline__ void phase_sample_step(const P& p_in, unsigned char* smem) {
    PHASE_PROLOGUE;
    const int lane = tid & 63, wave = tid >> 6, G = gridDim.x, bid = blockIdx.x;
    const int first = SCAN_WGS;
    const int gw = (bid - first) * 8 + wave, NGW = (G - first) * 8;
    if (bid < first) return;
    float* sv = (float*)(smem + wave * 2048);
    const float* WD = p.out + OS_WD; const bf16* KP = (const bf16*)(p.ws + WS_KP); const bf16* KK = (const bf16*)(p.ws + WS_KK); const bf16* KB = (const bf16*)(p.ws + WS_KB);
    bf16* YS = (bf16*)(p.ws + WS_YS); const float* DT = (const float*)(p.ws + WS_DT);
    const int kq = lane & 15, rr = lane >> 4;
    for (int unit = gw; unit < 2048; unit += NGW) {
        const int bs = (unit & 1023) >> 3, h = unit & 7, row = MPR + bs;
        if (unit < 1024) {
            const size_t o = (size_t)row * 512 + h * 64 + lane;
            sv[lane] = WD[o]; sv[64 + lane] = bf2f(KP[o]); sv[128 + lane] = -bf2f(KK[o]); sv[192 + lane] = bf2f(KB[o]); sv[256 + lane] = lerp1(p, row, h * 64 + lane); sv[320 + lane] = lerp1(p, row, 1024 + h * 64 + lane);
            LDS_FENCE();
            const f32x4 w4 = *(const f32x4*)(sv + kq * 4), kp4 = *(const f32x4*)(sv + 64 + kq * 4), ka4 = *(const f32x4*)(sv + 128 + kq * 4), kb4 = *(const f32x4*)(sv + 192 + kq * 4), r4 = *(const f32x4*)(sv + 256 + kq * 4);
            const size_t so = (size_t)(bs * 8 + h) * 4096 + rr * 64 + kq * 4;
            const float* Sb = p.in[3] + so; float* Ob = p.out + O_WKVS + so;
            f32x4 S[16]; float sa[16];
#pragma unroll
            for (int i = 0; i < 16; ++i) S[i] = *(const f32x4*)(Sb + i * 256);
#pragma unroll
            for (int i = 0; i < 16; ++i) sa[i] = sum16((S[i][0] * ka4[0] + S[i][1] * ka4[1]) + (S[i][2] * ka4[2] + S[i][3] * ka4[3]));
#pragma unroll
            for (int i = 0; i < 16; ++i) { const float vv = sv[320 + 4 * i + rr]; f32x4 n;
#pragma unroll
                for (int j = 0; j < 4; ++j) n[j] = S[i][j] * w4[j] + (sa[i] * kb4[j] + vv * kp4[j]);
                *(f32x4*)(Ob + i * 256) = n;
                const float y = sum16((n[0] * r4[0] + n[1] * r4[1]) + (n[2] * r4[2] + n[3] * r4[3]));
                if (kq == 0) YS[(size_t)bs * 1024 + h * 64 + 4 * i + rr] = f2bf(y); }
            LDS_FENCE();
        } else {
            const int g = h >> 2;
            sv[lane] = conv_act_s(p, bs, 512 + g * 128 + lane); sv[64 + lane] = conv_act_s(p, bs, 512 + g * 128 + 64 + lane);
            sv[128 + lane] = conv_act_s(p, bs, 768 + g * 128 + lane); sv[192 + lane] = conv_act_s(p, bs, 768 + g * 128 + 64 + lane);
            sv[256 + lane] = conv_act_s(p, bs, h * 64 + lane);
            LDS_FENCE();
            const float dt = DT[(size_t)row * 8 + h], A = -__expf(p.in[21][h]), dA = __expf(A * dt), Dh = p.in[22][h];
            const f32x4 Bl = *(const f32x4*)(sv + kq * 4), Bh = *(const f32x4*)(sv + 64 + kq * 4), Cl = *(const f32x4*)(sv + 128 + kq * 4), Ch = *(const f32x4*)(sv + 192 + kq * 4);
            const size_t so = (size_t)(bs * 8 + h) * 8192 + rr * 128 + kq * 4;
            const float* Hb_ = p.in[5] + so; float* Ob = p.out + O_SSMS + so;
#pragma unroll
            for (int half = 0; half < 2; ++half) { f32x4 hl[8], hh[8];
#pragma unroll
                for (int i = 0; i < 8; ++i) { hl[i] = *(const f32x4*)(Hb_ + (half * 8 + i) * 512); hh[i] = *(const f32x4*)(Hb_ + (half * 8 + i) * 512 + 64); }
#pragma unroll
                for (int i = 0; i < 8; ++i) { const int pp = 4 * (half * 8 + i) + rr; const float x = sv[256 + pp], dtx = dt * x; f32x4 nl, nh; float y = 0.f;
#pragma unroll
                    for (int j = 0; j < 4; ++j) { nl[j] = hl[i][j] * dA + dtx * Bl[j]; nh[j] = hh[i][j] * dA + dtx * Bh[j]; y += nl[j] * Cl[j] + nh[j] * Ch[j]; }
                    *(f32x4*)(Ob + (half * 8 + i) * 512) = nl; *(f32x4*)(Ob + (half * 8 + i) * 512 + 64) = nh;
                    y = sum16(y) + Dh * x;
                    if (kq == 0) YS[(size_t)bs * 1024 + 512 + h * 64 + pp] = f2bf(y); } }
            LDS_FENCE();
        }
    }
}

__device__ __forceinline__ void phase_post(const P& p_in) {
    PHASE_PROLOGUE;
    const int lane = tid & 63, wave = tid >> 6, G = gridDim.x, bid = blockIdx.x;
    const int gw = bid * 8 + wave, NGW = G * 8;
    bf16* MIX = (bf16*)(p.ws + WS_MIX); const bf16* YR = (const bf16*)(p.ws + WS_XB); const bf16* YM = YR + (size_t)MPR * 512; const bf16* YS = (const bf16*)(p.ws + WS_YS);
    const bf16* PROJ = (const bf16*)(p.ws + WS_PROJ); const bf16* KP = (const bf16*)(p.ws + WS_KP); const bf16* GG = (const bf16*)(p.out + OS_GG);
    const int c0 = lane * 8;
    float rk[8], lw[8], lb[8], gn[8], mur[8], muv[8];
#pragma unroll
    for (int i = 0; i < 8; ++i) { rk[i] = p.in[15][c0 + i]; lw[i] = p.in[16][c0 + i]; lb[i] = p.in[17][c0 + i]; gn[i] = p.in[23][c0 + i]; mur[i] = p.in[7][c0 + i]; muv[i] = p.in[7][1024 + c0 + i]; }
    struct PostRegs { u32x4 yr, ym, rc, rp, vc, vp, kp, gg, z; };
    PostRegs nx;
#define POST_LOAD(R_, row_) do { const int rw_ = (row_); \
        const size_t yo_ = ((size_t)(((rw_ >> 11) * 8 + (lane >> 3)) * 4 + ((lane & 7) >> 1)) * SEQ + (rw_ & (SEQ - 1))) * 16 + (lane & 1) * 8; \
        R_.yr = rw_ < MPR ? *(const u32x4*)(YR + yo_) : *(const u32x4*)(YS + (size_t)(rw_ - MPR) * 1024 + c0); \
        R_.ym = rw_ < MPR ? *(const u32x4*)(YM + yo_) : *(const u32x4*)(YS + (size_t)(rw_ - MPR) * 1024 + 512 + c0); \
        R_.rc = *(const u32x4*)(PROJ + (size_t)rw_ * PLD + c0); R_.vc = *(const u32x4*)(PROJ + (size_t)rw_ * PLD + 1024 + c0); R_.z = *(const u32x4*)(PROJ + (size_t)rw_ * PLD + 1792 + c0); \
        R_.kp = *(const u32x4*)(KP + (size_t)rw_ * 512 + c0); R_.gg = *(const u32x4*)(GG + (size_t)rw_ * 512 + c0); \
        u32x4 pr_ = {0u, 0u, 0u, 0u}, pv_ = pr_; \
        if (rw_ >= MPR) { const float* sp_ = p.in[2] + (size_t)(rw_ - MPR) * RPJ + c0; const f32x4 a_ = *(const f32x4*)sp_, b_ = *(const f32x4*)(sp_ + 4), c_ = *(const f32x4*)(sp_ + 1024), d_ = *(const f32x4*)(sp_ + 1028); \
            pr_.x = pkbf(a_[0], a_[1]); pr_.y = pkbf(a_[2], a_[3]); pr_.z = pkbf(b_[0], b_[1]); pr_.w = pkbf(b_[2], b_[3]); pv_.x = pkbf(c_[0], c_[1]); pv_.y = pkbf(c_[2], c_[3]); pv_.z = pkbf(d_[0], d_[1]); pv_.w = pkbf(d_[2], d_[3]); } \
        else if ((rw_ & (SEQ - 1)) != 0) { pr_ = *(const u32x4*)(PROJ + (size_t)(rw_ - 1) * PLD + c0); pv_ = *(const u32x4*)(PROJ + (size_t)(rw_ - 1) * PLD + 1024 + c0); } \
        R_.rp = pr_; R_.vp = pv_; } while (0)
    if (gw < MTOT) POST_LOAD(nx, gw);
    for (int row = gw; row < MTOT; row += NGW) {
        const PostRegs cu = nx;
        if (row + NGW < MTOT) POST_LOAD(nx, row + NGW);
        {
            float y[8], rr[8], kp[8], vv[8], gg[8], t0[8], t1[8];
            unpack8(cu.yr, y);
            float s = 0.f;
#pragma unroll
            for (int i = 0; i < 8; ++i) s += y[i];
            s = sum8(s);
            const float mean = s * (1.f / 64.f); float s2 = 0.f;
#pragma unroll
            for (int i = 0; i < 8; ++i) { y[i] -= mean; s2 += y[i] * y[i]; }
            s2 = sum8(s2);
            const float rstd = rsqrtf(s2 * (1.f / 64.f) + 64e-5f);
            unpack8(cu.rc, t0); unpack8(cu.rp, t1);
#pragma unroll
            for (int i = 0; i < 8; ++i) rr[i] = t0[i] + (t1[i] - t0[i]) * mur[i];
            unpack8(cu.vc, t0); unpack8(cu.vp, t1);
#pragma unroll
            for (int i = 0; i < 8; ++i) vv[i] = t0[i] + (t1[i] - t0[i]) * muv[i];
            unpack8(cu.kp, kp); unpack8(cu.gg, gg);
            float bo = 0.f;
#pragma unroll
            for (int i = 0; i < 8; ++i) bo += rr[i] * kp[i] * rk[i];
            bo = sum8(bo);
#pragma unroll
            for (int i = 0; i < 8; ++i) y[i] = (y[i] * rstd * lw[i] + lb[i] + bo * vv[i]) * gg[i];
            *(u32x4*)(MIX + (size_t)row * 1024 + c0) = pack8(y);
        }
        {
            float y[8], z[8];
            unpack8(cu.ym, y); unpack8(cu.z, z);
            float ss = 0.f;
#pragma unroll
            for (int i = 0; i < 8; ++i) { y[i] *= silu(z[i]); ss += y[i] * y[i]; }
            ss = sum32(ss, lane >= 32);
            const float sc = rsqrtf(ss * (1.f / 256.f) + 1e-5f);
#pragma unroll
            for (int i = 0; i < 8; ++i) y[i] = y[i] * sc * gn[i];
            *(u32x4*)(MIX + (size_t)row * 1024 + 512 + c0) = pack8(y);
        }
    }
#undef POST_LOAD
}

template <bool TO_BF16> __device__ __forceinline__ void phase_ln(const P& p_in, const float* gam, const float* bet, bf16* ob, size_t src_off, int sld) {
    PHASE_PROLOGUE;
    const int lane = tid & 63, wave = tid >> 6, G = gridDim.x, bid = blockIdx.x;
    const int gw = bid * 8 + wave, NGW = G * 8;
    const bf16* src = (const bf16*)p.out + src_off;
    f32x4 gv[4], bv[4];
#pragma unroll
    for (int j = 0; j < 4; ++j) { gv[j] = *(const f32x4*)(gam + lane * 4 + 256 * j); bv[j] = *(const f32x4*)(bet + lane * 4 + 256 * j); }
    unsigned long long nx[4] = {0ull, 0ull, 0ull, 0ull};
    if (gw < MTOT) {
#pragma unroll
        for (int j = 0; j < 4; ++j) nx[j] = *(const unsigned long long*)(src + (size_t)gw * sld + lane * 4 + 256 * j); }
    for (int row = gw; row < MTOT; row += NGW) {
        float* xr = p.out + (size_t)row * 1024 + lane * 4;
        f32x4 v[4]; float s = 0.f;
#pragma unroll
        for (int j = 0; j < 4; ++j) { const unsigned lo = (unsigned)nx[j], hi = (unsigned)(nx[j] >> 32);
            v[j] = (f32x4){bflo(lo), bfhi(lo), bflo(hi), bfhi(hi)}; s += (v[j][0] + v[j][1]) + (v[j][2] + v[j][3]); }
        if (row + NGW < MTOT) {
#pragma unroll
            for (int j = 0; j < 4; ++j) nx[j] = *(const unsigned long long*)(src + (size_t)(row + NGW) * sld + lane * 4 + 256 * j); }
        s = sum64(s);
        const float mean = s * (1.f / 1024.f); float s2 = 0.f;
#pragma unroll
        for (int j = 0; j < 4; ++j) { v[j] = v[j] - mean; s2 += (v[j][0] * v[j][0] + v[j][1] * v[j][1]) + (v[j][2] * v[j][2] + v[j][3] * v[j][3]); }
        s2 = sum64(s2);
        const float rstd = rsqrtf(s2 * (1.f / 1024.f) + 1e-5f);
#pragma unroll
        for (int j = 0; j < 4; ++j) { const f32x4 o = v[j] * rstd * gv[j] + bv[j];
            if (TO_BF16) { unsigned long long w = (unsigned long long)pkbf(o[0], o[1]) | ((unsigned long long)pkbf(o[2], o[3]) << 32); *(unsigned long long*)(ob + (size_t)row * 1024 + lane * 4 + 256 * j) = w; }
            else *(f32x4*)(xr + 256 * j) = o; }
    }
}

#ifndef USE_CHUNKED
#define USE_CHUNKED 1
#endif
#ifndef REPEAT_SEL
#define REPEAT_SEL 0
#endif
#ifndef DUMP_SEL
#define DUMP_SEL 0
#endif
#ifndef STOP_AFTER
#define STOP_AFTER 99
#endif
__global__ void __launch_bounds__(512, 2) mega(P p) {
    extern __shared__ __attribute__((aligned(16))) unsigned char smem[];
    LAS unsigned char* lds = (LAS unsigned char*)smem;
    volatile LAS unsigned* MISC = (volatile LAS unsigned*)(lds + MISC_OFF);
    if (threadIdx.x < 16) MISC[threadIdx.x] = 0u;
    __syncthreads();
    XcdBarrier bar = xcd_barrier_post((unsigned*)(p.ws + WS_CTL), MISC);
    if (p.never) cg::this_grid().sync();
#define GRID_BAR() xcd_barrier(bar)
    const int G = gridDim.x, bid = blockIdx.x;
    bf16* XB = (bf16*)(p.ws + WS_XB); bf16* PROJ = (bf16*)(p.ws + WS_PROJ); float* DT = (float*)(p.ws + WS_DT); bf16* HID = (bf16*)(p.ws + WS_HID);

#if STOP_AFTER != 99
    { const size_t gt = (size_t)blockIdx.x * 512 + threadIdx.x, NGT = (size_t)gridDim.x * 512; for (size_t i = O_SHP + gt; i < 30939136; i += NGT) p.out[i] = 0.f; }
    GRID_BAR();
#endif
    phase0(p, smem);
    GRID_BAR();
    {
        pg8::Gemm g{XB, (const bf16*)(p.ws + WS_WIN), MPR, 3584, 1024}; pg8::StaticOrder S; S.init(MPR, 3584, G, bid);
        pg8::EpiProj E{PROJ, DT, p.in[20], p.out};
        pg8::gemm_phase<pg8::EpiProj, pg8::StaticOrder, true, true>(lds, g, S, E);
        const float* dtb = p.in[20]; float* out = p.out;
        small_gemm<4, 1024>(XB + (size_t)MPR * 1024, (const bf16*)(p.ws + WS_WIN), PROJN, smem, [=](int rs, int c, float v) {
            if (c < 3328) PROJ[(size_t)(MPR + rs) * PLD + c] = f2bf(v); else DT[(size_t)(MPR + rs) * 8 + (c - 3328)] = softplus(v + dtb[c - 3328]);
            if (c < 1792) out[O_SHS + (size_t)rs * 1792 + c] = v;
            if (c >= 2304 && c < 3328) out[O_CONVS + ((size_t)rs * 3 + 2) * 1024 + (c - 2304)] = v; }, (G == 256) ? 128 : 0);
        phase0_late(p, smem, (G == 256) ? 128 : 0, 0);
    }
    GRID_BAR();
    phase_prep(p, smem);
#if REPEAT_SEL == 2
    phase_prep(p, smem);
#endif
    GRID_BAR();
#if STOP_AFTER == 2
    { const size_t gt = (size_t)blockIdx.x * 512 + threadIdx.x, NGT = (size_t)gridDim.x * 512; const bf16* KPd = (const bf16*)(p.ws + WS_KP); const bf16* XBCd = (const bf16*)(p.ws + WS_XBC);
      for (size_t i = gt; i < 8454144; i += NGT) { p.out[i] = bf2f(KPd[i]); p.out[8454144 + i] = bf2f(XBCd[i]); } }
    return;
#endif
#if USE_CHUNKED
    phase_scan2(p, smem);
#else
    phase_scan(p, smem);
#endif
    phase_ssd(p, smem);
    phase_sample_step(p, smem);
#if REPEAT_SEL == 3
    phase_scan2(p, smem);
    phase_ssd(p, smem);
    phase_sample_step(p, smem);
#endif
#if REPEAT_SEL == 5
    phase_sample_step(p, smem);
    phase_sample_step(p, smem);
#endif
#if REPEAT_SEL == 6
    phase_ssd(p, smem);
#endif
#if REPEAT_SEL == 4
    phase_ssd(p, smem);
    phase_sample_step(p, smem);
#endif
    GRID_BAR();
#if STOP_AFTER == 4
    { const size_t gt = (size_t)blockIdx.x * 512 + threadIdx.x, NGT = (size_t)gridDim.x * 512; const bf16* Yd = (const bf16*)(p.ws + WS_XB);
      for (size_t i = gt; i < 8388608; i += NGT) { p.out[i] = (DUMP_SEL & 1) ? bf2f(Yd[i]) : 0.f; p.out[8388608 + i] = (DUMP_SEL & 2) ? bf2f(Yd[8388608 + i]) : 0.f; }
      for (size_t i = gt; i < 131072; i += NGT) p.out[16777216 + i] = (DUMP_SEL & 4) ? bf2f(((const bf16*)(p.ws + WS_YS))[i]) : 0.f; }
    return;
#endif
    phase_post(p);
    GRID_BAR();
#if STOP_AFTER == 5
    { const size_t gt = (size_t)blockIdx.x * 512 + threadIdx.x, NGT = (size_t)gridDim.x * 512; for (size_t i = gt; i < (size_t)MTOT * 1024; i += NGT) p.out[i] = bf2f(((const bf16*)(p.ws + WS_MIX))[i]); }
    return;
#endif
    {
        pg8::Gemm g{(const bf16*)(p.ws + WS_MIX), (const bf16*)(p.ws + WS_WOUT), MPR, 1024, 1024}; pg8::StaticOrder S; S.init(MPR, 1024, G, bid);
        pg8::EpiResF32 E{p.in[0], nullptr, (bf16*)p.out, 1024, ALPHA};
        pg8::gemm_phase<pg8::EpiResF32, pg8::StaticOrder, true, true>(lds, g, S, E);
        const float* xs = p.in[1]; float* out = p.out;
        small_gemm<2, 1024>((const bf16*)(p.ws + WS_MIX) + (size_t)MPR * 1024, (const bf16*)(p.ws + WS_WOUT), 1024, smem, [=](int rs, int c, float v) { ((bf16*)out)[(size_t)(MPR + rs) * 1024 + c] = f2bf(ALPHA * xs[(size_t)rs * 1024 + c] + v); });
    }
    GRID_BAR();
    phase_ln<true>(p, p.in[25], p.in[26], XB, 0, 1024);
    phase0_late(p, smem, 0, 1);
    GRID_BAR();
    {
        pg8::Gemm g{XB, (const bf16*)(p.ws + WS_WFF1), MPR, 4096, 1024}; pg8::StaticOrder S; S.init(MPR, 4096, G, bid);
        pg8::EpiRelu2 E{HID, 4096};
        pg8::gemm_phase<pg8::EpiRelu2, pg8::StaticOrder, true, true>(lds, g, S, E);
        small_gemm<4, 1024>(XB + (size_t)MPR * 1024, (const bf16*)(p.ws + WS_WFF1), 4096, smem, [=](int rs, int c, float v) { const float a = fmaxf(v, 0.f); HID[(size_t)(MPR + rs) * 4096 + c] = f2bf(a * a); });
    }
    GRID_BAR();
    {
        pg8::Gemm g{HID, (const bf16*)(p.ws + WS_WFF2), MPR, 1024, 4096}; pg8::StaticOrder S; S.init(MPR, 1024, G, bid);
        pg8::EpiResF32 E{nullptr, XB, (bf16*)p.out + 1024, 2048, ALPHA};
        pg8::gemm_phase<pg8::EpiResF32, pg8::StaticOrder, true, true>(lds, g, S, E);
        float* out = p.out;
        small_gemm<2, 4096>(HID + (size_t)MPR * 4096, (const bf16*)(p.ws + WS_WFF2), 1024, smem, [=](int rs, int c, float v) { ((bf16*)out)[(size_t)(MPR + rs) * 2048 + 1024 + c] = f2bf(ALPHA * bf2f(XB[(size_t)(MPR + rs) * 1024 + c]) + v); });
    }
    GRID_BAR();
    phase_ln<false>(p, p.in[29], p.in[30], nullptr, 1024, 2048);
}

extern "C" void kernel_launch(void* const* d_in, const int* in_sizes, int n_in, void* d_out, int out_size, void* d_ws, size_t ws_size, hipStream_t stream) {
    static int grid = 0;
    if (grid == 0) {
        int dev = 0, cus = 0, per_cu = 0;
        (void)hipGetDevice(&dev);
        (void)hipDeviceGetAttribute(&cus, hipDeviceAttributeMultiprocessorCount, dev);
        if (hipFuncSetAttribute((const void*)mega, hipFuncAttributeMaxDynamicSharedMemorySize, LDS_BYTES) != hipSuccess) fprintf(stderr, "kernel_launch: hipFuncSetAttribute failed\n");
        if (hipOccupancyMaxActiveBlocksPerMultiprocessor(&per_cu, (const void*)mega, 512, LDS_BYTES) != hipSuccess || per_cu < 1) { fprintf(stderr, "kernel_launch: occupancy query says %d\n", per_cu); per_cu = 1; }
        (void)hipGetLastError();
        grid = cus * 1;
        if (n_in != 31 || out_size != 30939136 || ws_size < WS_CTL + 16384) fprintf(stderr, "kernel_launch: unexpected sizes n_in %d out %d ws %zu\n", n_in, out_size, ws_size);
    }
    (void)hipMemsetAsync((char*)d_ws + WS_CTL, 0, 16384, stream);
    P a{};
    for (int i = 0; i < 31; ++i) a.in[i] = (const float*)d_in[i];
    a.out = (float*)d_out; a.ws = (unsigned char*)d_ws; a.never = 0; a.pad = 0;
    void* args[] = {&a};
    hipError_t e = hipLaunchCooperativeKernel((const void*)mega, dim3(grid), dim3(512), args, LDS_BYTES, stream);
    if (e != hipSuccess) fprintf(stderr, "kernel_launch: cooperative launch failed: %s (grid %d)\n", hipGetErrorString(e), grid);
}
```

```cpp
#include <hip/hip_runtime.h>
#include <hip/hip_cooperative_groups.h>
#include <cstdio>
#include <cstdint>
namespace cg = cooperative_groups;
#define LAS __attribute__((address_space(3)))

typedef unsigned short bf16;
typedef short bf16x8 __attribute__((ext_vector_type(8)));
typedef float f32x4 __attribute__((ext_vector_type(4)));
typedef unsigned u32x4 __attribute__((ext_vector_type(4)));

constexpr int DM = 1024, SEQ = 2048, MPR = 8 * SEQ, MSM = 128, MTOT = MPR + MSM;
constexpr int RPJ = 1792, PLD = 3328, PROJN = 3336, DFF = 4096;
constexpr float ALPHA = 1.189207115f;
constexpr size_t O_Y = 0, O_YS = 16777216, O_SHP = 16908288, O_WKVP = 16922624, O_CONVP = 17184768, O_SSMP = 17209344,
                 O_SHS = 17733632, O_WKVS = 17963008, O_CONVS = 22157312, O_SSMS = 22550528;
constexpr size_t OS_WD = 0, OS_GG = 8454144;
constexpr size_t WS_WIN = 0, WS_WOUT = 7340032, WS_WFF1 = 9437184, WS_WFF2 = 17825792, WS_LORA = 26214400, WS_XB = 26476544,
                 WS_PROJ = 60293120, WS_DT = 170196992, WS_KP = 170725376, WS_KK = 187633664, WS_KB = 204541952, WS_XBC = 221450240,
                 WS_CTL = 255004672, WS_YS = WS_CTL + 65536, WS_HID = WS_PROJ, WS_MIX = WS_KK;
constexpr int LDS_BYTES = 147456, MISC_OFF = LDS_BYTES - 64;

struct P { const float* in[31]; float* out; unsigned char* ws; int never; int pad; };

__device__ __forceinline__ float bf2f(unsigned short b) { return __uint_as_float(((unsigned)b) << 16); }
__device__ __forceinline__ float bflo(unsigned u) { return __uint_as_float(u << 16); }
__device__ __forceinline__ float bfhi(unsigned u) { return __uint_as_float(u & 0xffff0000u); }
typedef float f32x2_t __attribute__((ext_vector_type(2)));
typedef __bf16 bf16x2_t __attribute__((ext_vector_type(2)));
__device__ __forceinline__ unsigned pkbf(float lo, float hi) { const f32x2_t v = {lo, hi}; const bf16x2_t b = __builtin_convertvector(v, bf16x2_t); return __builtin_bit_cast(unsigned, b); }
__device__ __forceinline__ unsigned short f2bf(float f) { return (unsigned short)(pkbf(f, f) & 0xffffu); }
__device__ __forceinline__ void unpack8(u32x4 v, float* o) { o[0] = bflo(v.x); o[1] = bfhi(v.x); o[2] = bflo(v.y); o[3] = bfhi(v.y); o[4] = bflo(v.z); o[5] = bfhi(v.z); o[6] = bflo(v.w); o[7] = bfhi(v.w); }
__device__ __forceinline__ u32x4 pack8(const float* o) { u32x4 v; v.x = pkbf(o[0], o[1]); v.y = pkbf(o[2], o[3]); v.z = pkbf(o[4], o[5]); v.w = pkbf(o[6], o[7]); return v; }
__device__ __forceinline__ float sigm(float x) { return __builtin_amdgcn_rcpf(1.f + __expf(-x)); }
__device__ __forceinline__ float silu(float x) { return x * __builtin_amdgcn_rcpf(1.f + __expf(-x)); }
__device__ __forceinline__ float softplus(float x) { return fmaxf(x, 0.f) + __logf(1.f + __expf(-fabsf(x))); }
__device__ __forceinline__ float tanh_(float x) { const float e = __expf(2.f * x); return 1.f - 2.f * __builtin_amdgcn_rcpf(e + 1.f); }
template <int CTRL> __device__ __forceinline__ float dppf(float x) { return __int_as_float(__builtin_amdgcn_update_dpp(0, __float_as_int(x), CTRL, 0xf, 0xf, true)); }
template <int CTRL> __device__ __forceinline__ float dppo(float x) { return __int_as_float(__builtin_amdgcn_update_dpp(0x3f800000, __float_as_int(x), CTRL, 0xf, 0xf, false)); }
__device__ __forceinline__ float sum16(float x) { x += dppf<0xB1>(x); x += dppf<0x4E>(x); x += dppf<0x141>(x); x += dppf<0x140>(x); return x; }
__device__ __forceinline__ float sum8(float x) { x += dppf<0xB1>(x); x += dppf<0x4E>(x); x += dppf<0x141>(x); return x; }
__device__ __forceinline__ float rdl(float x, int l) { return __int_as_float(__builtin_amdgcn_readlane(__float_as_int(x), l)); }
__device__ __forceinline__ float sum64(float x) { x = sum16(x); return (rdl(x, 0) + rdl(x, 16)) + (rdl(x, 32) + rdl(x, 48)); }
__device__ __forceinline__ float sum32(float x, bool hi) { x = sum16(x); const float a = rdl(x, 0) + rdl(x, 16), b = rdl(x, 32) + rdl(x, 48); return hi ? b : a; }
__device__ __forceinline__ f32x4 mfma16(bf16x8 a, bf16x8 b, f32x4 c) { return __builtin_amdgcn_mfma_f32_16x16x32_bf16(a, b, c, 0, 0, 0); }
typedef short s16x4 __attribute__((ext_vector_type(4)));
__device__ __forceinline__ f32x4 mf16(s16x4 a, s16x4 b, f32x4 c) { return __builtin_amdgcn_mfma_f32_16x16x16bf16_1k(a, b, c, 0, 0, 0); }
__device__ __forceinline__ s16x4 cvt4(f32x4 v) { struct { unsigned a, b; } t = {pkbf(v[0], v[1]), pkbf(v[2], v[3])}; return __builtin_bit_cast(s16x4, t); }
#define LDS_FENCE() asm volatile("s_waitcnt lgkmcnt(0)" ::: "memory")

#define PHASE_PROLOGUE P p = p_in; { size_t z_ = 0; asm volatile("" : "+s"(z_)); p.ws += z_; p.out += z_; } int tid = threadIdx.x; asm volatile("" : "+v"(tid))
namespace pg8 {
#define PG8_LAS __attribute__((address_space(3)))
typedef unsigned short bf16_t;
typedef short bf16x8 __attribute__((ext_vector_type(8)));
typedef float f32x4 __attribute__((ext_vector_type(4)));
typedef unsigned u32x4 __attribute__((ext_vector_type(4)));
constexpr int BM = 256, BK = 64, HALF = 128, HTB = HALF * BK * 2  , STAGE_BYTES = 8 * HTB, NXCD = 8, WGM = 8;

__host__ __device__ __forceinline__ int lds_byte(int r, int c) { const int st = (r >> 4) * 2 + (c >> 5), rr = r & 15, cc = c & 31, ob = rr * 64 + cc * 2; return st * 1024 + (ob ^ (((ob >> 9) & 1) << 5)); }
__host__ __device__ __forceinline__ void stage_rc(int b, int& R, int& C) { const int st = b / 1024, sb = b % 1024, swz = sb ^ (((sb >> 9) & 1) << 5); R = (st >> 1) * 16 + swz / 64; C = (st & 1) * 32 + (swz % 64) / 2; }
__host__ __device__ __forceinline__ int perm32(int rho) { const int n = rho >> 4, i = rho & 15; return 8 * (i >> 2) + 4 * n + (i & 3); }

struct Unit { int pm, pn; };
struct Gemm { const bf16_t* A; const bf16_t* Bt; int M, N, K; };

struct StaticOrder {
    int nM, nN, nwg, G, c;
    __host__ __device__ void init(int M, int N, int G_, int c_) { nM = M / BM; nN = N / BM; nwg = nM * nN; G = G_; c = c_; }
    __host__ __device__ bool next(int i, Unit& u) const {
        const long L = (long)i * G + c; if (L >= nwg) return false;
        int wgid = (int)L; { const int q = nwg / NXCD, r = nwg % NXCD, xcd = wgid % NXCD, off = wgid / NXCD; wgid = (xcd < r ? xcd * (q + 1) : r * (q + 1) + (xcd - r) * q) + off; }
        const int nig = WGM * nN, gid = wgid / nig, fm = gid * WGM, gsz = (nM - fm) < WGM ? (nM - fm) : WGM;
        u.pm = fm + ((wgid % nig) % gsz); u.pn = (wgid % nig) / gsz; return true;
    }
    __device__ __forceinline__ void a_ready(const Unit&) const {}
    __device__ __forceinline__ void done(const Unit&) const {}
};

__device__ __forceinline__ unsigned cvt_pk_bf16(float lo, float hi) { return ::pkbf(lo, hi); }
typedef float f32x2 __attribute__((ext_vector_type(2)));
struct EpiProj {
    static constexpr bool PERM = true, AFTER_DRAIN = false;
    bf16_t* PROJ; float* DT; const float* dt_bias; float* out;
    __device__ __forceinline__ void operator()(const f32x4 (&acc)[2][2][4][2], const Unit& u, int wr, int wc, int fr, int fq) const {
        const int row0 = u.pm * BM + wr * 64 + fr;
#pragma unroll
        for (int bj = 0; bj < 2; ++bj) {
            const int c0 = u.pn * BM + bj * HALF + wc * 32 + 8 * fq;
            if (c0 >= 3336) continue;
#pragma unroll
            for (int ai = 0; ai < 2; ++ai)
#pragma unroll
                for (int m = 0; m < 4; ++m) {
                    const int row = row0 + ai * HALF + m * 16; const f32x4 v0 = acc[ai][bj][m][0], v1 = acc[ai][bj][m][1];
                    if (c0 < 3328) { u32x4 w; w.x = cvt_pk_bf16(v0[0], v0[1]); w.y = cvt_pk_bf16(v0[2], v0[3]); w.z = cvt_pk_bf16(v1[0], v1[1]); w.w = cvt_pk_bf16(v1[2], v1[3]);
                        *(u32x4*)(PROJ + (size_t)row * 3328 + c0) = w; }
                    else { f32x4 a, b;
#pragma unroll
                        for (int i = 0; i < 4; ++i) { float x = v0[i] + dt_bias[i]; a[i] = x > 20.f ? x : log1pf(__expf(x)); float y = v1[i] + dt_bias[4 + i]; b[i] = y > 20.f ? y : log1pf(__expf(y)); }
                        *(f32x4*)(DT + (size_t)row * 8) = a; *(f32x4*)(DT + (size_t)row * 8 + 4) = b; }
                    const int t = row & 2047, b_ = row >> 11;
                    if (t == 2047 && c0 < 1792) { float* o = out + 16908288 + (size_t)b_ * 1792 + c0; *(f32x4*)o = v0; *(f32x4*)(o + 4) = v1; }
                    if (t >= 2045 && c0 >= 2304 && c0 < 3328) { float* o = out + 17184768 + ((size_t)b_ * 3 + (t - 2045)) * 1024 + (c0 - 2304); *(f32x4*)o = v0; *(f32x4*)(o + 4) = v1; }
                }
        }
    }
};
struct EpiResF32 {
    static constexpr bool PERM = true, AFTER_DRAIN = false;
    const float* resf; const bf16_t* resb; bf16_t* ob; int ld; float alpha;
    __device__ __forceinline__ void operator()(const f32x4 (&acc)[2][2][4][2], const Unit& u, int wr, int wc, int fr, int fq) const {
        const int row0 = u.pm * BM + wr * 64 + fr;
#pragma unroll
        for (int ai = 0; ai < 2; ++ai)
#pragma unroll
            for (int m = 0; m < 4; ++m)
#pragma unroll
                for (int bj = 0; bj < 2; ++bj) {
                    const int row = row0 + ai * HALF + m * 16, c0 = u.pn * BM + bj * HALF + wc * 32 + 8 * fq; const size_t o = (size_t)row * 1024 + c0;
                    f32x4 r0, r1;
                    if (resf) { r0 = *(const f32x4*)(resf + o); r1 = *(const f32x4*)(resf + o + 4); }
                    else { const u32x4 w = *(const u32x4*)(resb + o); r0[0] = __uint_as_float(w.x << 16); r0[1] = __uint_as_float(w.x & 0xffff0000u); r0[2] = __uint_as_float(w.y << 16); r0[3] = __uint_as_float(w.y & 0xffff0000u);
                        r1[0] = __uint_as_float(w.z << 16); r1[1] = __uint_as_float(w.z & 0xffff0000u); r1[2] = __uint_as_float(w.w << 16); r1[3] = __uint_as_float(w.w & 0xffff0000u); }
                    const f32x4 v0 = r0 * alpha + acc[ai][bj][m][0], v1 = r1 * alpha + acc[ai][bj][m][1];
                    u32x4 w8; w8.x = cvt_pk_bf16(v0[0], v0[1]); w8.y = cvt_pk_bf16(v0[2], v0[3]); w8.z = cvt_pk_bf16(v1[0], v1[1]); w8.w = cvt_pk_bf16(v1[2], v1[3]);
                    *(u32x4*)(ob + (size_t)row * ld + c0) = w8;
                }
    }
};
struct EpiRelu2 {
    static constexpr bool PERM = true, AFTER_DRAIN = false;
    bf16_t* O; int ldc;
    __device__ __forceinline__ void operator()(const f32x4 (&acc)[2][2][4][2], const Unit& u, int wr, int wc, int fr, int fq) const {
        const int row0 = u.pm * BM + wr * 64 + fr;
#pragma unroll
        for (int ai = 0; ai < 2; ++ai)
#pragma unroll
            for (int m = 0; m < 4; ++m)
#pragma unroll
                for (int bj = 0; bj < 2; ++bj) {
                    const int row = row0 + ai * HALF + m * 16, c0 = u.pn * BM + bj * HALF + wc * 32 + 8 * fq;
                    f32x4 v0 = acc[ai][bj][m][0], v1 = acc[ai][bj][m][1];
#pragma unroll
                    for (int i = 0; i < 4; ++i) { float a = fmaxf(v0[i], 0.f); v0[i] = a * a; float b = fmaxf(v1[i], 0.f); v1[i] = b * b; }
                    u32x4 w; w.x = cvt_pk_bf16(v0[0], v0[1]); w.y = cvt_pk_bf16(v0[2], v0[3]); w.z = cvt_pk_bf16(v1[0], v1[1]); w.w = cvt_pk_bf16(v1[2], v1[3]);
                    *(u32x4*)(O + (size_t)row * ldc + c0) = w;
                }
    }
};
template <class Epi, class Sched, bool ALIGN_EPI = false, bool SP2 = false>
__device__ __forceinline__ void gemm_phase(PG8_LAS unsigned char* lds, const Gemm g, const Sched& S, const Epi& E) {
    int tid = threadIdx.x; asm volatile("" : "+v"(tid)); const int wid = __builtin_amdgcn_readfirstlane(tid >> 6), lane = tid & 63, wr = wid >> 2, wc = wid & 3, fr = lane & 15, fq = lane >> 4;
    const int K = g.K, nt = K / BK;
    unsigned voffA[2], voffB[2];
#pragma unroll
    for (int i = 0; i < 2; ++i) { int R, C; stage_rc(tid * 16 + i * 8192, R, C); const int Rb = Epi::PERM ? ((R & ~31) + perm32(R & 31)) : R;
        voffA[i] = (unsigned)(R * K + C) * 2u; voffB[i] = (unsigned)(Rb * K + C) * 2u; }
    const size_t kstep = (size_t)(BK * 2);
    const size_t hstep = (size_t)HALF * K * 2;
    const size_t tstep = 2 * hstep;
    const unsigned ldsw = (unsigned)wid * 1024u;
    const int aoff = lds_byte(wr * 64 + fr, fq * 8), boff = lds_byte(wc * 32 + fr, fq * 8);
#define PG8_SA(b, h) (((b) * 2 + (h)) * HTB)
#define PG8_SB(b, h) ((4 + (b) * 2 + (h)) * HTB)
#define PG8_STAGE(bufoff, gbase, voff) do { _Pragma("unroll") for (int _i = 0; _i < 2; ++_i) \
        __builtin_amdgcn_global_load_lds((const unsigned*)((const char*)(gbase) + (voff)[_i]), (PG8_LAS unsigned*)(lds + (bufoff) + ldsw + _i * 8192), 16, 0, 0); } while (0)
#define PG8_LDA(dst, b, h) do { _Pragma("unroll") for (int m = 0; m < 4; ++m) _Pragma("unroll") for (int k = 0; k < 2; ++k) dst[m][k] = *(const PG8_LAS bf16x8*)(lds + PG8_SA(b, h) + aoff + m * 2048 + k * 1024); } while (0)
#define PG8_LDB(dst, b, h) do { _Pragma("unroll") for (int n = 0; n < 2; ++n) _Pragma("unroll") for (int k = 0; k < 2; ++k) dst[n][k] = *(const PG8_LAS bf16x8*)(lds + PG8_SB(b, h) + boff + n * 2048 + k * 1024); } while (0)
#define PG8_MMA(ai, bj, At, Bt) do { __builtin_amdgcn_s_setprio(1); _Pragma("unroll") for (int m = 0; m < 4; ++m) _Pragma("unroll") for (int n = 0; n < 2; ++n) _Pragma("unroll") for (int k = 0; k < 2; ++k) \
        acc[ai][bj][m][n] = __builtin_amdgcn_mfma_f32_16x16x32_bf16(Bt[n][k], At[m][k], acc[ai][bj][m][n], 0, 0, 0); __builtin_amdgcn_s_setprio(0); } while (0)
#define PG8_WAIT_V(n) asm volatile("s_waitcnt vmcnt(" #n ")" ::: "memory")
#define PG8_WAIT_L(n) asm volatile("s_waitcnt lgkmcnt(" #n ")" ::: "memory")
#define PG8_BAR __builtin_amdgcn_s_barrier()
#define PG8_SCHED __builtin_amdgcn_sched_barrier(0)
    Unit cur, nxt; int ui = 0;
    if (!S.next(0, cur)) return;
    f32x4 acc[2][2][4][2];
#pragma unroll
    for (int a = 0; a < 2; ++a)
#pragma unroll
        for (int b = 0; b < 2; ++b)
#pragma unroll
            for (int m = 0; m < 4; ++m)
#pragma unroll
                for (int n = 0; n < 2; ++n) acc[a][b][m][n] = (f32x4){0.f, 0.f, 0.f, 0.f};
    bf16x8 At[4][2], B0[2][2], B1[2][2];
    const char* cA = (const char*)g.A + (size_t)cur.pm * tstep; const char* cB = (const char*)g.Bt + (size_t)cur.pn * tstep;
    S.a_ready(cur);
    if constexpr (SP2) {
        PG8_STAGE(PG8_SB(0, 0), cB, voffB); PG8_STAGE(PG8_SB(0, 1), cB + hstep, voffB); PG8_STAGE(PG8_SA(0, 0), cA, voffA); PG8_STAGE(PG8_SA(0, 1), cA + hstep, voffA);
        if (wr == 1) PG8_BAR;
        PG8_WAIT_V(2); PG8_BAR;
        PG8_STAGE(PG8_SB(1, 0), cB + kstep, voffB); PG8_STAGE(PG8_SA(1, 0), cA + kstep, voffA); PG8_STAGE(PG8_SB(1, 1), cB + hstep + kstep, voffB);
        PG8_WAIT_V(6); PG8_BAR;
    } else {
        PG8_STAGE(PG8_SB(0, 0), cB, voffB); PG8_STAGE(PG8_SA(0, 0), cA, voffA); PG8_STAGE(PG8_SB(0, 1), cB + hstep, voffB); PG8_STAGE(PG8_SA(0, 1), cA + hstep, voffA);
        if (wr == 1) PG8_BAR;
        PG8_WAIT_V(4); PG8_BAR;
        PG8_STAGE(PG8_SB(1, 0), cB + kstep, voffB); PG8_STAGE(PG8_SA(1, 0), cA + kstep, voffA); PG8_STAGE(PG8_SB(1, 1), cB + hstep + kstep, voffB);
        PG8_WAIT_V(6); PG8_BAR;
    }
    for (;;) {
        const bool has_next = S.next(ui + 1, nxt);
        const char* nA = has_next ? (const char*)g.A + (size_t)nxt.pm * tstep : cA; const char* nB = has_next ? (const char*)g.Bt + (size_t)nxt.pn * tstep : cB;
        for (int t = 0; t < nt; t += 2) {
            const bool last = (t == nt - 2);
            const char* a1 = cA + (size_t)(t + 1) * kstep;
            const char* a2 = last ? nA : cA + (size_t)(t + 2) * kstep; const char* b2 = last ? nB : cB + (size_t)(t + 2) * kstep;
            const char* a3 = a2 + kstep; const char* b3 = b2 + kstep;
            if (last && has_next) S.a_ready(nxt);
            if constexpr (SP2) {
            PG8_LDB(B0, 0, 0); PG8_LDB(B1, 0, 1); PG8_SCHED; PG8_LDA(At, 0, 0); PG8_STAGE(PG8_SA(1, 1), a1 + hstep, voffA);
            PG8_WAIT_V(8); PG8_WAIT_L(0); PG8_BAR; PG8_MMA(0, 0, At, B0); PG8_MMA(0, 1, At, B1); PG8_BAR; PG8_SCHED;
            PG8_LDA(At, 0, 1); PG8_STAGE(PG8_SB(0, 0), b2, voffB); PG8_STAGE(PG8_SB(0, 1), b2 + hstep, voffB); PG8_STAGE(PG8_SA(0, 0), a2, voffA);
            PG8_WAIT_V(8); PG8_WAIT_L(0); PG8_BAR; PG8_MMA(1, 0, At, B0); PG8_MMA(1, 1, At, B1); PG8_BAR; PG8_SCHED;
            PG8_LDB(B0, 1, 0); PG8_LDB(B1, 1, 1); PG8_SCHED; PG8_LDA(At, 1, 0); PG8_STAGE(PG8_SA(0, 1), a2 + hstep, voffA);
            PG8_WAIT_V(8); PG8_WAIT_L(0); PG8_BAR; PG8_MMA(0, 0, At, B0); PG8_MMA(0, 1, At, B1); PG8_BAR; PG8_SCHED;
            PG8_LDA(At, 1, 1); PG8_STAGE(PG8_SB(1, 0), b3, voffB); PG8_STAGE(PG8_SB(1, 1), b3 + hstep, voffB); PG8_STAGE(PG8_SA(1, 0), a3, voffA);
            PG8_WAIT_V(8); PG8_WAIT_L(0); PG8_BAR; PG8_MMA(1, 0, At, B0); PG8_MMA(1, 1, At, B1); PG8_BAR; PG8_SCHED;
            } else {
            PG8_LDB(B0, 0, 0); PG8_SCHED; PG8_LDA(At, 0, 0); PG8_STAGE(PG8_SA(1, 1), a1 + hstep, voffA);
            PG8_WAIT_L(8); PG8_BAR; PG8_WAIT_L(0); PG8_MMA(0, 0, At, B0); PG8_BAR; PG8_SCHED;
            PG8_LDB(B1, 0, 1); PG8_STAGE(PG8_SB(0, 0), b2, voffB);
            PG8_BAR; PG8_WAIT_L(0); PG8_MMA(0, 1, At, B1); PG8_BAR;
            PG8_LDA(At, 0, 1); PG8_STAGE(PG8_SA(0, 0), a2, voffA);
            PG8_BAR; PG8_WAIT_L(0); PG8_MMA(1, 0, At, B0); PG8_BAR; PG8_SCHED;
            PG8_STAGE(PG8_SB(0, 1), b2 + hstep, voffB);
            PG8_WAIT_V(6); PG8_BAR; PG8_MMA(1, 1, At, B1); PG8_BAR;
            PG8_LDB(B0, 1, 0); PG8_SCHED; PG8_LDA(At, 1, 0); PG8_STAGE(PG8_SA(0, 1), a2 + hstep, voffA);
            PG8_WAIT_L(8); PG8_BAR; PG8_WAIT_L(0); PG8_MMA(0, 0, At, B0); PG8_BAR; PG8_SCHED;
            PG8_LDB(B1, 1, 1); PG8_STAGE(PG8_SB(1, 0), b3, voffB);
            PG8_BAR; PG8_WAIT_L(0); PG8_MMA(0, 1, At, B1); PG8_BAR;
            PG8_LDA(At, 1, 1); PG8_STAGE(PG8_SA(1, 0), a3, voffA);
            PG8_BAR; PG8_WAIT_L(0); PG8_MMA(1, 0, At, B0); PG8_BAR; PG8_SCHED;
            PG8_STAGE(PG8_SB(1, 1), b3 + hstep, voffB);
            PG8_WAIT_V(6); PG8_BAR; PG8_MMA(1, 1, At, B1); PG8_BAR;
            }
        }
        if constexpr (ALIGN_EPI) { if (wr == 0) PG8_BAR; }
        if constexpr (!Epi::AFTER_DRAIN) { E(acc, cur, wr, wc, fr, fq); S.done(cur); }
        if (!has_next) break;
#pragma unroll
        for (int a = 0; a < 2; ++a)
#pragma unroll
            for (int b = 0; b < 2; ++b)
#pragma unroll
                for (int m = 0; m < 4; ++m)
#pragma unroll
                    for (int n = 0; n < 2; ++n) acc[a][b][m][n] = (f32x4){0.f, 0.f, 0.f, 0.f};
        cur = nxt; cA = nA; cB = nB; ++ui;
        if constexpr (ALIGN_EPI) { if (wr == 1) PG8_BAR; }
    }
    PG8_WAIT_V(0);
    if constexpr (!ALIGN_EPI) { if (wr == 0) PG8_BAR; }
    PG8_BAR;
    if constexpr (Epi::AFTER_DRAIN) { E.fused(acc, cur, wr, wc, fr, fq, lds, wid, lane); S.done(cur); }
#undef PG8_SA
#undef PG8_SB
#undef PG8_STAGE
#undef PG8_LDA
#undef PG8_LDB
#undef PG8_MMA
#undef PG8_WAIT_V
#undef PG8_WAIT_L
#undef PG8_BAR
#undef PG8_SCHED
}
}

#define XB_TMO      128
#define XB_XCNT(j)  (256  + 64 * (j))
#define XB_XSUB(j)  (1280 + 64 * (j))
#define XB_XGEN(j)  (2304 + 64 * (j))
#define XB_TOP      3328
#define XB_TOPGEN   3392
#define XCD_BAR_WORDS 3456
#define XB_SPIN_CAP (1u << 18)

__device__ __forceinline__ unsigned xb_ld(unsigned* p)              { return __hip_atomic_load(p, __ATOMIC_RELAXED, __HIP_MEMORY_SCOPE_AGENT); }
__device__ __forceinline__ unsigned xb_add(unsigned* p, unsigned v) { return __hip_atomic_fetch_add(p, v, __ATOMIC_RELAXED, __HIP_MEMORY_SCOPE_AGENT); }
__device__ __forceinline__ unsigned xb_xcc_id() { return (unsigned)__builtin_amdgcn_s_getreg((3 << 11) | 20) & 0xFu; }
#define XB_SPIN(cond, bar) do { unsigned _sp = 0; while (cond) { __builtin_amdgcn_s_sleep(1); \
    if ((++_sp & 255u) == 0u) { if (xb_ld(&(bar)[XB_TMO])) break; if (_sp > XB_SPIN_CAP) { atomicAdd(&(bar)[XB_TMO], 1u); break; } } } } while (0)

struct XcdBarrier {
    unsigned* bar; unsigned x;
    volatile LAS unsigned* st;
};

__device__ __forceinline__ XcdBarrier xcd_barrier_post(unsigned* bar, volatile LAS unsigned* st) {
    XcdBarrier b; b.bar = bar; b.x = xb_xcc_id(); b.st = st;
    if (threadIdx.x == 0) (void)xb_add(&bar[XB_XCNT(b.x)], 1u);
    return b;
}
__device__ __forceinline__ void xcd_barrier_complete(unsigned* bar, unsigned x, unsigned& nloc, unsigned& nx) {
    const unsigned G = gridDim.x * gridDim.y * gridDim.z;
    unsigned sum, cnt, mine, sp = 0u;
    for (;;) {
        sum = 0u; cnt = 0u; mine = 0u;
#pragma unroll
        for (unsigned j = 0; j < 16; ++j) { const unsigned c = xb_ld(&bar[XB_XCNT(j)]); sum += c; cnt += (c > 0u) ? 1u : 0u; mine = (j == x) ? c : mine; }
        if (sum == G) break;
        __builtin_amdgcn_s_sleep(1);
        if ((++sp & 255u) == 0u) { if (xb_ld(&bar[XB_TMO])) break; if (sp > XB_SPIN_CAP) { atomicAdd(&bar[XB_TMO], 1u); break; } }
    }
    nloc = mine > 0u ? mine : 1u; nx = cnt > 0u ? cnt : 1u;
}

__device__ __forceinline__ void xcd_barrier(const XcdBarrier& b) {
    asm volatile("s_waitcnt vmcnt(0)" ::: "memory");
    __syncthreads();
    if (threadIdx.x == 0) {
        unsigned* bar = b.bar;
        __builtin_amdgcn_s_waitcnt(0);
        unsigned nloc = b.st[0], nx = b.st[1];
        if (nloc == 0u) { xcd_barrier_complete(bar, b.x, nloc, nx); b.st[0] = nloc; b.st[1] = nx; }
        const unsigned old = xb_add(&bar[XB_XSUB(b.x)], 1u);
        const unsigned gen = old / nloc;
        if (old + 1u == (gen + 1u) * nloc) {
            __builtin_amdgcn_fence(__ATOMIC_RELEASE, "agent");
            asm volatile("s_waitcnt vmcnt(0)" ::: "memory");
            const unsigned og = xb_add(&bar[XB_TOP], 1u);
            const unsigned tg = og / nx;
            if (og + 1u == (tg + 1u) * nx) xb_add(&bar[XB_TOPGEN], 1u);
            else XB_SPIN(xb_ld(&bar[XB_TOPGEN]) == tg, bar);
            __builtin_amdgcn_fence(__ATOMIC_ACQUIRE, "agent");
            xb_add(&bar[XB_XGEN(b.x)], 1u);
            asm volatile("s_waitcnt vmcnt(0)" ::: "memory");
        } else {
            XB_SPIN(xb_ld(&bar[XB_XGEN(b.x)]) == gen, bar);
            __builtin_amdgcn_fence(__ATOMIC_ACQUIRE, "agent");
            asm volatile("s_waitcnt vmcnt(0)" ::: "memory");
        }
    }
    __syncthreads();
}

__device__ __forceinline__ void lerp8(const P& p, int row, int col, float* o) {
    const bf16* PROJ = (const bf16*)(p.ws + WS_PROJ);
    float cur[8], prv[8];
    unpack8(*(const u32x4*)(PROJ + (size_t)row * PLD + col), cur);
    if (row >= MPR) { const float* s = p.in[2] + (size_t)(row - MPR) * RPJ + col; const f32x4 a = *(const f32x4*)s, b = *(const f32x4*)(s + 4);
        prv[0] = a[0]; prv[1] = a[1]; prv[2] = a[2]; prv[3] = a[3]; prv[4] = b[0]; prv[5] = b[1]; prv[6] = b[2]; prv[7] = b[3]; }
    else if ((row & (SEQ - 1)) == 0) {
#pragma unroll
        for (int i = 0; i < 8; ++i) prv[i] = 0.f; }
    else unpack8(*(const u32x4*)(PROJ + (size_t)(row - 1) * PLD + col), prv);
    const float* mu = p.in[7] + col; const f32x4 m0 = *(const f32x4*)mu, m1 = *(const f32x4*)(mu + 4);
#pragma unroll
    for (int i = 0; i < 4; ++i) { o[i] = cur[i] + (prv[i] - cur[i]) * m0[i]; o[4 + i] = cur[4 + i] + (prv[4 + i] - cur[4 + i]) * m1[i]; }
}
__device__ __forceinline__ float lerp1(const P& p, int row, int col) {
    const bf16* PROJ = (const bf16*)(p.ws + WS_PROJ);
    const float cur = bf2f(PROJ[(size_t)row * PLD + col]); float prv;
    if (row >= MPR) prv = p.in[2][(size_t)(row - MPR) * RPJ + col];
    else if ((row & (SEQ - 1)) == 0) prv = 0.f;
    else prv = bf2f(PROJ[(size_t)(row - 1) * PLD + col]);
    return cur + (prv - cur) * p.in[7][col];
}

__device__ __forceinline__ void transpose_item(const float* W, int K, int N, bf16* WT, float* scr, int item, int lane) {
    const int nblk = (N + 31) / 32, kb = item / nblk, nb = item % nblk, k0 = 64 * kb, n0 = 32 * nb;
#pragma unroll 8
    for (int i = 0; i < 32; ++i) { const int kk = 2 * i + (lane >> 5), n = n0 + (lane & 31); scr[kk * 33 + (lane & 31)] = (n < N) ? W[(size_t)(k0 + kk) * N + n] : 0.f; }
    LDS_FENCE();
    const int c = lane & 7;
#pragma unroll
    for (int j = 0; j < 4; ++j) { const int n = (lane >> 3) + 8 * j; const float* s = scr + (8 * c) * 33 + n;
        u32x4 o; o.x = pkbf(s[0 * 33], s[1 * 33]); o.y = pkbf(s[2 * 33], s[3 * 33]); o.z = pkbf(s[4 * 33], s[5 * 33]); o.w = pkbf(s[6 * 33], s[7 * 33]);
        *(u32x4*)(WT + (size_t)(n0 + n) * K + k0 + 8 * c) = o; }
    LDS_FENCE();
}

__device__ __forceinline__ void phase0(const P& p_in, unsigned char* smem) {
    PHASE_PROLOGUE;
    const int lane = tid & 63, wave = tid >> 6, G = gridDim.x, bid = blockIdx.x;
    const int gw = bid * 8 + wave, NGW = G * 8; const size_t gt = (size_t)bid * 512 + tid, NGT = (size_t)G * 512;
    bf16* XB = (bf16*)(p.ws + WS_XB);
#pragma unroll 4
    for (size_t i = gt; i < (size_t)MTOT * DM / 8; i += NGT) { const size_t e = i * 8; const float* src = e < (size_t)MPR * DM ? p.in[0] + e : p.in[1] + (e - (size_t)MPR * DM);
        const f32x4 a = *(const f32x4*)src, b = *(const f32x4*)(src + 4); u32x4 o; o.x = pkbf(a[0], a[1]); o.y = pkbf(a[2], a[3]); o.z = pkbf(b[0], b[1]); o.w = pkbf(b[2], b[3]); *(u32x4*)(XB + e) = o; }
    float* scr = (float*)(smem + wave * 8448);
    constexpr int I_IN = 16 * 105, I_WU = 16, I_AU = 16, I_GU = 32;
    constexpr int NIT = I_IN + I_WU + I_AU + I_GU;
    for (int it = gw; it < NIT; it += NGW) {
        int r = it;
        if (r < I_IN) { transpose_item(p.in[6], 1024, PROJN, (bf16*)(p.ws + WS_WIN), scr, r, lane); continue; } r -= I_IN;
        if (r < I_WU) { transpose_item(p.in[9], 64, 512, (bf16*)(p.ws + WS_LORA), scr, r, lane); continue; } r -= I_WU;
        if (r < I_AU) { transpose_item(p.in[11], 64, 512, (bf16*)(p.ws + WS_LORA + 65536), scr, r, lane); continue; } r -= I_AU;
        transpose_item(p.in[12], 128, 512, (bf16*)(p.ws + WS_LORA + 131072), scr, r, lane);
    }
    for (size_t i = gt; i < (size_t)MSM * 2048 / 4; i += NGT) { const size_t idx = i * 4, b = idx >> 11, rem = idx & 2047;
        *(f32x4*)(p.out + O_CONVS + b * 3072 + rem) = *(const f32x4*)(p.in[4] + b * 3072 + 1024 + rem); }
}

__device__ __forceinline__ void phase0_late(const P& p_in, unsigned char* smem, int first, int which) {
    PHASE_PROLOGUE;
    const int lane = tid & 63, wave = tid >> 6, G = gridDim.x, bid = blockIdx.x;
    if (bid < first) return;
    const int gw = (bid - first) * 8 + wave, NGW = (G - first) * 8;
    float* scr = (float*)(smem + wave * 8448);
    constexpr int I_OUT = 16 * 32, I_F1 = 16 * 128, I_F2 = 64 * 32;
    const int lo = which ? I_OUT + I_F1 : 0, hi = which ? I_OUT + I_F1 + I_F2 : I_OUT + I_F1;
    for (int it = lo + gw; it < hi; it += NGW) {
        int r = it;
        if (r < I_OUT) { transpose_item(p.in[24], 1024, 1024, (bf16*)(p.ws + WS_WOUT), scr, r, lane); continue; } r -= I_OUT;
        if (r < I_F1) { transpose_item(p.in[27], 1024, 4096, (bf16*)(p.ws + WS_WFF1), scr, r, lane); continue; } r -= I_F1;
        transpose_item(p.in[28], 4096, 1024, (bf16*)(p.ws + WS_WFF2), scr, r, lane);
    }
}

template <int RG, int K, class F> __device__ __forceinline__ void small_gemm(const bf16* A, const bf16* Bt, int N, unsigned char* smem, const F& epi, int first = 0) {
    int tid = threadIdx.x; asm volatile("" : "+v"(tid));
    const int lane = tid & 63, wave = tid >> 6, r = lane & 15, q = lane >> 4;
    constexpr int KS = K / 8, NST = KS / 32, RGN = 8 / RG;
    const int nunits = ((N + 15) / 16) * RGN;
    float* part = (float*)smem;
    for (int u = (int)gridDim.x - 1 - (int)blockIdx.x; u < nunits && (int)blockIdx.x >= first; u += (int)gridDim.x - first) {
        const int ct = u / RGN, rg = u - ct * RGN, n0 = ct * 16;
        f32x4 acc[RG];
#pragma unroll
        for (int t = 0; t < RG; ++t) acc[t] = (f32x4){0.f, 0.f, 0.f, 0.f};
        const bf16* ap = A + (size_t)(rg * RG * 16 + r) * K + wave * KS + q * 8;
        const bf16* bp = Bt + (size_t)(n0 + r) * K + wave * KS + q * 8;
#pragma unroll 8
        for (int ks = 0; ks < NST; ++ks) {
            const bf16x8 b = *(const bf16x8*)(bp + ks * 32);
#pragma unroll
            for (int t = 0; t < RG; ++t) acc[t] = mfma16(*(const bf16x8*)(ap + (size_t)t * 16 * K + ks * 32), b, acc[t]);
        }
#pragma unroll
        for (int t = 0; t < RG; ++t)
#pragma unroll
            for (int j = 0; j < 4; ++j) part[(wave * RG + t) * 256 + (q * 4 + j) * 16 + r] = acc[t][j];
        __syncthreads();
        for (int e = tid; e < RG * 256; e += 512) { const int t = e >> 8, idx = e & 255; float v = 0.f;
#pragma unroll
            for (int w = 0; w < 8; ++w) v += part[(w * RG + t) * 256 + idx];
            const int col = n0 + (idx & 15);
            if (col < N) epi((rg * RG + t) * 16 + (idx >> 4), col, v); }
        __syncthreads();
    }
}

__device__ __forceinline__ void phase_prep(const P& p_in, unsigned char* smem) {
    PHASE_PROLOGUE;
    const int lane = tid & 63, wave = tid >> 6, G = gridDim.x, bid = blockIdx.x, r = lane & 15, q = lane >> 4;
    const bf16* WUPT = (const bf16*)(p.ws + WS_LORA); const bf16* AUPT = (const bf16*)(p.ws + WS_LORA + 65536); const bf16* GUPT = (const bf16*)(p.ws + WS_LORA + 131072);
    const bf16* PROJ = (const bf16*)(p.ws + WS_PROJ);
    float* WD = p.out + OS_WD; bf16* GG = (bf16*)(p.out + OS_GG);
    bf16* KP = (bf16*)(p.ws + WS_KP); bf16* KK = (bf16*)(p.ws + WS_KK); bf16* KB = (bf16*)(p.ws + WS_KB);
    bf16* WU = (bf16*)smem; bf16* AU = WU + 64 * 72; bf16* GU = AU + 64 * 72;
    bf16* kcur = (bf16*)(smem + 35840 + wave * 4608); bf16* kprv = kcur + 16 * 72;
#pragma unroll 1
    for (int tile = bid; tile < MTOT / 128; tile += G) {
        const int item = tile * 8 + wave, rowa = item * 16 + r;
        bf16x8 aw[2], aa[2], ag[4];
        float u[8];
#pragma unroll
        for (int ks = 0; ks < 2; ++ks) { lerp8(p, rowa, 1536 + ks * 32 + q * 8, u);
#pragma unroll
            for (int i = 0; i < 8; ++i) u[i] = tanh_(u[i]);
            aw[ks] = __builtin_bit_cast(bf16x8, pack8(u)); }
#pragma unroll
        for (int ks = 0; ks < 2; ++ks) { lerp8(p, rowa, 1600 + ks * 32 + q * 8, u); aa[ks] = __builtin_bit_cast(bf16x8, pack8(u)); }
#pragma unroll
        for (int ks = 0; ks < 4; ++ks) { lerp8(p, rowa, 1664 + ks * 32 + q * 8, u);
#pragma unroll
            for (int i = 0; i < 8; ++i) u[i] = sigm(u[i]);
            ag[ks] = __builtin_bit_cast(bf16x8, pack8(u)); }
        u32x4 pw, pa, pg[2];
#define PREP_LOAD(hh_) do { const int c_ = tid >> 3, k8_ = (tid & 7) * 8; \
            pw = *(const u32x4*)(WUPT + (size_t)((hh_) * 64 + c_) * 64 + k8_); pa = *(const u32x4*)(AUPT + (size_t)((hh_) * 64 + c_) * 64 + k8_); \
            _Pragma("unroll") for (int i = 0; i < 2; ++i) { const int pc_ = tid + i * 512, c2_ = pc_ >> 4, k82_ = (pc_ & 15) * 8; pg[i] = *(const u32x4*)(GUPT + (size_t)((hh_) * 64 + c2_) * 128 + k82_); } } while (0)
        PREP_LOAD(0);
#pragma unroll 1
        for (int h = 0; h < 8; ++h) {
            __syncthreads();
            { const int c = tid >> 3, k8 = (tid & 7) * 8;
              *(u32x4*)(WU + c * 72 + k8) = pw; *(u32x4*)(AU + c * 72 + k8) = pa;
#pragma unroll
              for (int i = 0; i < 2; ++i) { const int pc = tid + i * 512, c2 = pc >> 4, k82 = (pc & 15) * 8; *(u32x4*)(GU + c2 * 136 + k82) = pg[i]; } }
#pragma unroll
            for (int i = 0; i < 2; ++i) { const int pc = lane + i * 64, rr = pc >> 3, c8 = (pc & 7) * 8, row = item * 16 + rr, col = 512 + h * 64 + c8;
                *(u32x4*)(kcur + rr * 72 + c8) = *(const u32x4*)(PROJ + (size_t)row * PLD + col);
                u32x4 pv = {0u, 0u, 0u, 0u};
                if (row >= MPR) { const float* sp = p.in[2] + (size_t)(row - MPR) * RPJ + col; const f32x4 a = *(const f32x4*)sp, b = *(const f32x4*)(sp + 4); pv.x = pkbf(a[0], a[1]); pv.y = pkbf(a[2], a[3]); pv.z = pkbf(b[0], b[1]); pv.w = pkbf(b[2], b[3]); }
                else if ((row & (SEQ - 1)) != 0) pv = *(const u32x4*)(PROJ + (size_t)(row - 1) * PLD + col);
                *(u32x4*)(kprv + rr * 72 + c8) = pv; }
            if (h + 1 < 8) PREP_LOAD(h + 1);
            __syncthreads();
            float ss[4] = {0.f, 0.f, 0.f, 0.f};
#pragma unroll
            for (int ctl = 0; ctl < 4; ++ctl) { const int cl = ctl * 16 + r, col = h * 64 + cl; const float kkc = p.in[13][col], muc = p.in[7][512 + col];
#pragma unroll
                for (int j = 0; j < 4; ++j) { const float kc = bf2f(kcur[(q * 4 + j) * 72 + cl]), kv = bf2f(kprv[(q * 4 + j) * 72 + cl]); const float kr = (kc + (kv - kc) * muc) * kkc; ss[j] += kr * kr; } }
#pragma unroll
            for (int j = 0; j < 4; ++j) { ss[j] = sum16(ss[j]); ss[j] = rsqrtf(fmaxf(ss[j], 1e-24f)); }
#pragma unroll 1
            for (int ctl = 0; ctl < 4; ++ctl) {
                const int cl = ctl * 16 + r, col = h * 64 + cl;
                f32x4 cw = {0.f, 0.f, 0.f, 0.f}, ca = cw, cgt = cw;
#pragma unroll
                for (int ks = 0; ks < 2; ++ks) { cw = mfma16(aw[ks], *(const bf16x8*)(WU + cl * 72 + ks * 32 + q * 8), cw); ca = mfma16(aa[ks], *(const bf16x8*)(AU + cl * 72 + ks * 32 + q * 8), ca); }
#pragma unroll
                for (int ks = 0; ks < 4; ++ks) cgt = mfma16(ag[ks], *(const bf16x8*)(GU + cl * 136 + ks * 32 + q * 8), cgt);
                const float w0c = p.in[8][col], a0c = p.in[10][col], kkc = p.in[13][col], kac = p.in[14][col], muc = p.in[7][512 + col];
#pragma unroll
                for (int j = 0; j < 4; ++j) {
                    const int row = item * 16 + q * 4 + j; const size_t o = (size_t)row * 512 + col;
                    const float wl = -softplus(-(w0c + cw[j])) - 0.5f;
                    WD[o] = __expf(-__expf(wl));
                    const float a = sigm(a0c + ca[j]);
                    GG[o] = f2bf(cgt[j]);
                    const float kc = bf2f(kcur[(q * 4 + j) * 72 + cl]), kv = bf2f(kprv[(q * 4 + j) * 72 + cl]); const float k = kc + (kv - kc) * muc;
                    KP[o] = f2bf(k * (1.f + (a - 1.f) * kac));
                    const float kk = k * kkc * ss[j];
                    KK[o] = f2bf(kk); KB[o] = f2bf(kk * a);
                }
            }
        }
    }
    __syncthreads();
#undef PREP_LOAD
    bf16* XBC = (bf16*)(p.ws + WS_XBC);
    const int ntl = MTOT / 128, cb = (G > ntl + 32) ? ntl : 0;
    if (bid < cb) return;
    const size_t gt = (size_t)(bid - cb) * 512 + tid, NGT = (size_t)(G - cb) * 512;
    for (size_t idx = gt; idx < (size_t)MPR * 128; idx += NGT) {
        const int row = (int)(idx >> 7), c0 = (int)(idx & 127) * 8, t = row & (SEQ - 1);
        float acc[8], x[8];
        { const f32x4 b0 = *(const f32x4*)(p.in[19] + c0), b1 = *(const f32x4*)(p.in[19] + c0 + 4);
#pragma unroll
          for (int i = 0; i < 4; ++i) { acc[i] = b0[i]; acc[4 + i] = b1[i]; } }
#pragma unroll
        for (int d = 0; d < 4; ++d) { if (t - 3 + d < 0) continue;
            unpack8(*(const u32x4*)(PROJ + (size_t)(row - 3 + d) * PLD + 2304 + c0), x);
            const f32x4 w0 = *(const f32x4*)(p.in[18] + d * 1024 + c0), w1 = *(const f32x4*)(p.in[18] + d * 1024 + c0 + 4);
#pragma unroll
            for (int i = 0; i < 4; ++i) { acc[i] += w0[i] * x[i]; acc[4 + i] += w1[i] * x[4 + i]; } }
#pragma unroll
        for (int i = 0; i < 8; ++i) acc[i] = silu(acc[i]);
        *(u32x4*)(XBC + (size_t)row * 1024 + c0) = pack8(acc);
    }
}

constexpr int TC = 32, SBUF = 5 * TC * 64 + TC * 16 + TC * 2;
struct StageRegs { f32x4 w0, w1; u32x4 kp, kk, kb, rc, rp, vc, vp; };
__device__ __forceinline__ void scan_issue(const P& p, StageRegs& R, int row0, int h, int vq, int st) {
    const float* WD = p.out + OS_WD; const bf16* KP = (const bf16*)(p.ws + WS_KP); const bf16* KK = (const bf16*)(p.ws + WS_KK); const bf16* KB = (const bf16*)(p.ws + WS_KB); const bf16* PROJ = (const bf16*)(p.ws + WS_PROJ);
    const int tt = st >> 3, k8 = (st & 7) * 8, row = row0 + tt, prow = (row & (SEQ - 1)) ? row - 1 : row; const size_t o = (size_t)row * 512 + h * 64 + k8;
    R.w0 = *(const f32x4*)(WD + o); R.w1 = *(const f32x4*)(WD + o + 4); R.kp = *(const u32x4*)(KP + o); R.kk = *(const u32x4*)(KK + o); R.kb = *(const u32x4*)(KB + o);
    R.rc = *(const u32x4*)(PROJ + (size_t)row * PLD + h * 64 + k8); R.rp = *(const u32x4*)(PROJ + (size_t)prow * PLD + h * 64 + k8);
    if (st < 64) { const int t2 = st >> 1, v8 = (st & 1) * 8, row2 = row0 + t2, prow2 = (row2 & (SEQ - 1)) ? row2 - 1 : row2;
        R.vc = *(const u32x4*)(PROJ + (size_t)row2 * PLD + 1024 + h * 64 + vq * 16 + v8); R.vp = *(const u32x4*)(PROJ + (size_t)prow2 * PLD + 1024 + h * 64 + vq * 16 + v8); }
}
__device__ __forceinline__ void scan_commit(const StageRegs& R, float* B, int row0, int st, const float* mur, const float* muv) {
    const int tt = st >> 3, k8 = (st & 7) * 8; float kp[8], kb[8], v[8], rc[8], rp[8];
    *(f32x4*)(B + tt * 64 + k8) = R.w0; *(f32x4*)(B + tt * 64 + k8 + 4) = R.w1;
    unpack8(R.kp, kp); *(f32x4*)(B + TC * 64 + tt * 64 + k8) = (f32x4){kp[0], kp[1], kp[2], kp[3]}; *(f32x4*)(B + TC * 64 + tt * 64 + k8 + 4) = (f32x4){kp[4], kp[5], kp[6], kp[7]};
    unpack8(R.kk, v); *(f32x4*)(B + 2 * TC * 64 + tt * 64 + k8) = (f32x4){-v[0], -v[1], -v[2], -v[3]}; *(f32x4*)(B + 2 * TC * 64 + tt * 64 + k8 + 4) = (f32x4){-v[4], -v[5], -v[6], -v[7]};
    unpack8(R.kb, kb); *(f32x4*)(B + 3 * TC * 64 + tt * 64 + k8) = (f32x4){kb[0], kb[1], kb[2], kb[3]}; *(f32x4*)(B + 3 * TC * 64 + tt * 64 + k8 + 4) = (f32x4){kb[4], kb[5], kb[6], kb[7]};
    unpack8(R.rc, rc); unpack8(R.rp, rp); const float pz = ((row0 + tt) & (SEQ - 1)) ? 1.f : 0.f;
    float c1 = 0.f, c2 = 0.f;
#pragma unroll
    for (int j = 0; j < 8; ++j) { v[j] = rc[j] + (rp[j] * pz - rc[j]) * mur[j]; c1 += kb[j] * v[j]; c2 += kp[j] * v[j]; }
    *(f32x4*)(B + 4 * TC * 64 + tt * 64 + k8) = (f32x4){R.w0[0] * v[0], R.w0[1] * v[1], R.w0[2] * v[2], R.w0[3] * v[3]}; *(f32x4*)(B + 4 * TC * 64 + tt * 64 + k8 + 4) = (f32x4){R.w1[0] * v[4], R.w1[1] * v[5], R.w1[2] * v[6], R.w1[3] * v[7]};
    c1 += __shfl_xor(c1, 1); c2 += __shfl_xor(c2, 1); c1 += __shfl_xor(c1, 2); c2 += __shfl_xor(c2, 2); c1 += __shfl_xor(c1, 4); c2 += __shfl_xor(c2, 4);
    if ((st & 7) == 0) { B[5 * TC * 64 + TC * 16 + tt * 2] = c1; B[5 * TC * 64 + TC * 16 + tt * 2 + 1] = c2; }
    if (st < 64) { const int t2 = st >> 1, v8 = (st & 1) * 8; unpack8(R.vc, rc); unpack8(R.vp, rp); const float pz2 = ((row0 + t2) & (SEQ - 1)) ? 1.f : 0.f;
#pragma unroll
        for (int j = 0; j < 8; ++j) v[j] = rc[j] + (rp[j] * pz2 - rc[j]) * muv[j];
        *(f32x4*)(B + 5 * TC * 64 + t2 * 16 + v8) = (f32x4){v[0], v[1], v[2], v[3]}; *(f32x4*)(B + 5 * TC * 64 + t2 * 16 + v8 + 4) = (f32x4){v[4], v[5], v[6], v[7]}; }
}
struct ScanIn { f32x4 w, kp, ka, kb, wr; float vv, c1, c2; };
__device__ __forceinline__ ScanIn scan_load(const float* B, int tt, int kg, int rloc) {
    ScanIn s; s.w = *(const f32x4*)(B + tt * 64 + kg * 4); s.kp = *(const f32x4*)(B + TC * 64 + tt * 64 + kg * 4); s.ka = *(const f32x4*)(B + 2 * TC * 64 + tt * 64 + kg * 4);
    s.kb = *(const f32x4*)(B + 3 * TC * 64 + tt * 64 + kg * 4); s.wr = *(const f32x4*)(B + 4 * TC * 64 + tt * 64 + kg * 4);
    s.vv = B[5 * TC * 64 + tt * 16 + rloc]; s.c1 = B[5 * TC * 64 + TC * 16 + tt * 2]; s.c2 = B[5 * TC * 64 + TC * 16 + tt * 2 + 1]; return s;
}
__device__ __forceinline__ void phase_scan(const P& p_in, unsigned char* smem) {
    PHASE_PROLOGUE;
    const int lane = tid & 63, wave = tid >> 6;
    float* buf0 = (float*)smem; float* ybuf = buf0 + 2 * SBUF;
    bf16* YR = (bf16*)(p.ws + WS_XB);
    constexpr int NCH = SEQ / TC;
    for (int unit = blockIdx.x; unit < 256; unit += gridDim.x) {
        const int xcd = unit & 7, slot = unit >> 3, bh = xcd * 8 + (slot >> 2), vq = slot & 3, b = bh >> 3, h = bh & 7, rowbase = b * SEQ;
        bf16* yu = YR + (size_t)(bh * 4 + vq) * SEQ * 16;
        const int st = tid - 256;
        StageRegs R; float mur[8], muv[8];
        if (wave >= 4) {
#pragma unroll
            for (int j = 0; j < 8; ++j) { mur[j] = p.in[7][h * 64 + (st & 7) * 8 + j]; muv[j] = p.in[7][1024 + h * 64 + vq * 16 + (st & 1) * 8 + j]; }
            scan_issue(p, R, rowbase, h, vq, st); scan_commit(R, buf0, rowbase, st, mur, muv); scan_issue(p, R, rowbase + TC, h, vq, st);
        }
        __syncthreads();
        float S0 = 0.f, S1 = 0.f, S2 = 0.f, S3 = 0.f;
        const int rl = lane >> 4, kg = lane & 15, rloc = (wave & 3) * 4 + rl;
        for (int c = 0; c < NCH; ++c) {
            if (wave < 4) {
                const float* B = buf0 + (c & 1) * SBUF; float* yb = ybuf + (c & 1) * (TC * 16);
                ScanIn cur = scan_load(B, 0, kg, rloc);
#pragma unroll 4
                for (int tt = 0; tt < TC; ++tt) {
                    const ScanIn nxt = scan_load(B, (tt + 1) & (TC - 1), kg, rloc);
                    float sa = (S0 * cur.ka[0] + S1 * cur.ka[1]) + (S2 * cur.ka[2] + S3 * cur.ka[3]);
                    float y1 = (S0 * cur.wr[0] + S1 * cur.wr[1]) + (S2 * cur.wr[2] + S3 * cur.wr[3]);
                    sa += dppf<0xB1>(sa); y1 += dppf<0xB1>(y1); sa += dppf<0x4E>(sa); y1 += dppf<0x4E>(y1);
                    sa += dppf<0x141>(sa); y1 += dppf<0x141>(y1); sa += dppf<0x140>(sa); y1 += dppf<0x140>(y1);
                    S0 = S0 * cur.w[0] + (sa * cur.kb[0] + cur.vv * cur.kp[0]); S1 = S1 * cur.w[1] + (sa * cur.kb[1] + cur.vv * cur.kp[1]);
                    S2 = S2 * cur.w[2] + (sa * cur.kb[2] + cur.vv * cur.kp[2]); S3 = S3 * cur.w[3] + (sa * cur.kb[3] + cur.vv * cur.kp[3]);
                    if (kg == 0) yb[tt * 16 + rloc] = y1 + sa * cur.c1 + cur.vv * cur.c2;
                    cur = nxt;
                }
            } else {
                if (c + 1 < NCH) scan_commit(R, buf0 + ((c + 1) & 1) * SBUF, rowbase + (c + 1) * TC, st, mur, muv);
                if (c + 2 < NCH) scan_issue(p, R, rowbase + (c + 2) * TC, h, vq, st);
                if (c > 0) { const float* yp = ybuf + ((c - 1) & 1) * (TC * 16); const int i2 = st * 2;
                    *(unsigned*)(yu + (size_t)(c - 1) * TC * 16 + i2) = pkbf(yp[i2], yp[i2 + 1]); }
            }
            __syncthreads();
        }
        if (wave >= 4) { const float* yp = ybuf + ((NCH - 1) & 1) * (TC * 16); const int i2 = st * 2;
            *(unsigned*)(yu + (size_t)(NCH - 1) * TC * 16 + i2) = pkbf(yp[i2], yp[i2 + 1]); }
        else *(f32x4*)(p.out + O_WKVP + ((size_t)(bh * 64 + vq * 16 + rloc)) * 64 + kg * 4) = (f32x4){S0, S1, S2, S3};
        __syncthreads();
    }
}


constexpr int CK = 16, NCHAIN = 2, NHELP = 8 - NCHAIN, SLOTB = 22912, NCHK = SEQ / CK, SCAN_WGS = 256 / NCHAIN;
constexpr int SO_AT = 0, SO_RT = 2304, SO_BT = 4608, SO_KT = 6912, SO_BH = 9216, SO_KH = 12288, SO_NAK = 15360, SO_NBR = 16128, SO_NKR = 16896, SO_TT = 17664, SO_VT = 18432, SO_DC = 21504, SO_NAB = 21760;
constexpr int CR_SB = NHELP * SLOTB, FL_OFF = CR_SB + NCHAIN * 3072;
static_assert(FL_OFF + 256 <= MISC_OFF, "scan LDS map");
struct HelpRegs { f32x4 w0, w1; u32x4 kp, kk, kb, rc, rp, vc, vp; };
__device__ __forceinline__ void help_issue(const P& p, HelpRegs (&R)[2], int row0, int h, int lane) {
    const float* WD = p.out + OS_WD; const bf16* KP = (const bf16*)(p.ws + WS_KP); const bf16* KK = (const bf16*)(p.ws + WS_KK); const bf16* KB = (const bf16*)(p.ws + WS_KB); const bf16* PROJ = (const bf16*)(p.ws + WS_PROJ);
#pragma unroll
    for (int i = 0; i < 2; ++i) { const int pc = lane + i * 64, tt = pc & 15, k8 = (pc >> 4) * 8, row = row0 + tt, prow = (row & (SEQ - 1)) ? row - 1 : row; const size_t o = (size_t)row * 512 + h * 64 + k8;
        R[i].w0 = *(const f32x4*)(WD + o); R[i].w1 = *(const f32x4*)(WD + o + 4); R[i].kp = *(const u32x4*)(KP + o); R[i].kk = *(const u32x4*)(KK + o); R[i].kb = *(const u32x4*)(KB + o);
        R[i].rc = *(const u32x4*)(PROJ + (size_t)row * PLD + h * 64 + k8); R[i].rp = *(const u32x4*)(PROJ + (size_t)prow * PLD + h * 64 + k8);
        R[i].vc = *(const u32x4*)(PROJ + (size_t)row * PLD + 1024 + h * 64 + k8); R[i].vp = *(const u32x4*)(PROJ + (size_t)prow * PLD + 1024 + h * 64 + k8); }
}
__device__ __forceinline__ void phase_scan2(const P& p_in, unsigned char* smem) {
    PHASE_PROLOGUE;
    const int lane = tid & 63, wave = tid >> 6, r = lane & 15, q = lane >> 4;
    bf16* YR = (bf16*)(p.ws + WS_XB);
    volatile unsigned* flags = (volatile unsigned*)(smem + FL_OFF);
    const bf16x8 zero8 = {0, 0, 0, 0, 0, 0, 0, 0};
    for (int unit = blockIdx.x; unit < SCAN_WGS; unit += SCAN_WGS) {
        const int ub = unit / (4 / NCHAIN), part = unit % (4 / NCHAIN), bh = (ub & 7) * 8 + (ub >> 3), vq = part * NCHAIN + (wave % NCHAIN), b = bh >> 3, h = bh & 7, rowbase = b * SEQ;
        if (tid < 64) flags[tid] = 0u;
        __syncthreads();
        if (wave < NCHAIN) {
            __builtin_amdgcn_s_setprio(3);
            bf16* yu = YR + (size_t)(bh * 4 + vq) * SEQ * 16;
            f32x4 ST[4];
#pragma unroll
            for (int mt = 0; mt < 4; ++mt) ST[mt] = (f32x4){0.f, 0.f, 0.f, 0.f};
            for (int c = 0; c < NCHK; ++c) {
                const int slot = c % NHELP; unsigned char* sb = smem + slot * SLOTB;
                const bf16* AT = (const bf16*)(sb + SO_AT); const bf16* RT = (const bf16*)(sb + SO_RT); const bf16* BH = (const bf16*)(sb + SO_BH); const bf16* KH = (const bf16*)(sb + SO_KH);
                const bf16* NAK = (const bf16*)(sb + SO_NAK); const bf16* NBR = (const bf16*)(sb + SO_NBR); const bf16* NKR = (const bf16*)(sb + SO_NKR); const bf16* TT = (const bf16*)(sb + SO_TT);
                const bf16* VT = (const bf16*)(sb + SO_VT) + vq * 16 * 24; const float* DC = (const float*)(sb + SO_DC);
                s16x4 sb4[4];
#pragma unroll
                for (int mt = 0; mt < 4; ++mt) sb4[mt] = cvt4(ST[mt]);
                { unsigned sp = 0; while (flags[slot] != (unsigned)(c + 1)) { __builtin_amdgcn_s_sleep(1); if (++sp > (1u << 22)) break; } }
                asm volatile("" ::: "memory");
                s16x4 fa[4], fr[4], fbh[4], fkh[4]; f32x4 dcv[4];
#pragma unroll
                for (int mt = 0; mt < 4; ++mt) { fa[mt] = *(const s16x4*)(AT + r * 72 + mt * 16 + q * 4); fr[mt] = *(const s16x4*)(RT + r * 72 + mt * 16 + q * 4);
                    fbh[mt] = *(const s16x4*)(BH + (mt * 16 + r) * 24 + q * 4); fkh[mt] = *(const s16x4*)(KH + (mt * 16 + r) * 24 + q * 4); dcv[mt] = *(const f32x4*)(DC + mt * 16 + q * 4); }
                const s16x4 fnak = *(const s16x4*)(NAK + lane * 4), ftt = *(const s16x4*)(TT + lane * 4), fnbr = *(const s16x4*)(NBR + lane * 4), fnkr = *(const s16x4*)(NKR + lane * 4);
                const s16x4 fvt = *(const s16x4*)(VT + r * 24 + q * 4);
                LDS_FENCE();
                if (lane == 0) flags[8 + slot * NCHAIN + wave] = (unsigned)(c + 1);
                f32x4 Wt = {0.f, 0.f, 0.f, 0.f};
#pragma unroll
                for (int mt = 0; mt < 4; ++mt) Wt = mf16(fa[mt], sb4[mt], Wt);
                Wt = mf16(fnak, fvt, Wt);
                f32x4 Ut = {0.f, 0.f, 0.f, 0.f};
                Ut = mf16(ftt, cvt4(Wt), Ut);
                const s16x4 ub = cvt4(Ut);
#pragma unroll
                for (int mt = 0; mt < 4; ++mt) { ST[mt] = ST[mt] * dcv[mt]; ST[mt] = mf16(fbh[mt], ub, ST[mt]); ST[mt] = mf16(fkh[mt], fvt, ST[mt]); }
                f32x4 Yt = {0.f, 0.f, 0.f, 0.f};
#pragma unroll
                for (int mt = 0; mt < 4; ++mt) Yt = mf16(fr[mt], sb4[mt], Yt);
                Yt = mf16(fnbr, ub, Yt); Yt = mf16(fnkr, fvt, Yt);
#pragma unroll
                for (int j = 0; j < 4; ++j) yu[(size_t)(c * CK + q * 4 + j) * 16 + r] = f2bf(Yt[j]);
            }
#pragma unroll
            for (int mt = 0; mt < 4; ++mt) *(f32x4*)(p.out + O_WKVP + ((size_t)(bh * 64 + vq * 16 + r)) * 64 + mt * 16 + q * 4) = ST[mt];
            __builtin_amdgcn_s_setprio(0);
        } else {
            const int hw = wave - NCHAIN; unsigned char* sb = smem + hw * SLOTB;
            bf16* AT = (bf16*)(sb + SO_AT); bf16* RT = (bf16*)(sb + SO_RT); bf16* BT = (bf16*)(sb + SO_BT); bf16* KT = (bf16*)(sb + SO_KT); bf16* BH = (bf16*)(sb + SO_BH); bf16* KH = (bf16*)(sb + SO_KH);
            bf16* NAK = (bf16*)(sb + SO_NAK); bf16* NBR = (bf16*)(sb + SO_NBR); bf16* NKR = (bf16*)(sb + SO_NKR); bf16* TT = (bf16*)(sb + SO_TT); bf16* VT = (bf16*)(sb + SO_VT);
            float* DC = (float*)(sb + SO_DC); float* NAB = (float*)(sb + SO_NAB); float* WR = (float*)(sb + SO_BH);
            float mur[2][8], muv[2][8];
#pragma unroll
            for (int i = 0; i < 2; ++i)
#pragma unroll
                for (int j = 0; j < 8; ++j) { mur[i][j] = p.in[7][h * 64 + ((lane + i * 64) >> 4) * 8 + j]; muv[i][j] = p.in[7][1024 + h * 64 + ((lane + i * 64) >> 4) * 8 + j]; }
            HelpRegs R[2];
            help_issue(p, R, rowbase + hw * CK, h, lane);
            for (int c = hw; c < NCHK; c += NHELP) {
                if (c >= NHELP) { const unsigned want = (unsigned)(c - NHELP + 1); unsigned sp = 0;
                    for (;;) { bool ok = true;
#pragma unroll
                        for (int w = 0; w < NCHAIN; ++w) ok = ok && (flags[8 + hw * NCHAIN + w] == want);
                        if (ok) break; __builtin_amdgcn_s_sleep(2); if (++sp > (1u << 22)) break; } }
                asm volatile("" ::: "memory");
                const int row0 = rowbase + c * CK;
#pragma unroll
                for (int i = 0; i < 2; ++i) { const int k8 = ((lane >> 4) + 4 * i) * 8, tt = lane & 15; float w[8], pre[8], suf[8], x[8], y[8], rc[8], rp[8];
#pragma unroll
                    for (int j = 0; j < 4; ++j) { w[j] = R[i].w0[j]; w[4 + j] = R[i].w1[j]; }
#pragma unroll
                    for (int j = 0; j < 8; ++j) { float a = w[j], z = w[j];
                        a *= dppo<0x111>(a); a *= dppo<0x112>(a); a *= dppo<0x114>(a); a *= dppo<0x118>(a);
                        z *= dppo<0x101>(z); z *= dppo<0x102>(z); z *= dppo<0x104>(z); z *= dppo<0x108>(z);
                        pre[j] = a; suf[j] = z * __builtin_amdgcn_rcpf(w[j]); }
                    if (tt == 15) { *(f32x4*)(DC + k8) = (f32x4){pre[0], pre[1], pre[2], pre[3]}; *(f32x4*)(DC + k8 + 4) = (f32x4){pre[4], pre[5], pre[6], pre[7]}; }
                    unpack8(R[i].kk, x);
#pragma unroll
                    for (int j = 0; j < 8; ++j) y[j] = -x[j] * dppo<0x111>(pre[j]);
                    *(u32x4*)(AT + tt * 72 + k8) = pack8(y);
                    unpack8(R[i].kb, x);
#pragma unroll
                    for (int j = 0; j < 8; ++j) { const float inv = __builtin_amdgcn_rcpf(pre[j]); rp[j] = inv; y[j] = x[j] * inv; x[j] *= suf[j]; }
                    *(u32x4*)(BT + tt * 72 + k8) = pack8(y);
#pragma unroll
                    for (int j = 0; j < 8; ++j) BH[(k8 + j) * 24 + tt] = f2bf(x[j]);
                    unpack8(R[i].kp, x);
#pragma unroll
                    for (int j = 0; j < 8; ++j) { y[j] = x[j] * rp[j]; x[j] *= suf[j]; }
                    *(u32x4*)(KT + tt * 72 + k8) = pack8(y);
#pragma unroll
                    for (int j = 0; j < 8; ++j) KH[(k8 + j) * 24 + tt] = f2bf(x[j]);
                    unpack8(R[i].rc, rc); unpack8(R[i].rp, rp); const float pz = ((row0 + tt) & (SEQ - 1)) ? 1.f : 0.f;
#pragma unroll
                    for (int j = 0; j < 8; ++j) y[j] = (rc[j] + (rp[j] * pz - rc[j]) * mur[i][j]) * pre[j];
                    *(u32x4*)(RT + tt * 72 + k8) = pack8(y);
                    unpack8(R[i].vc, rc); unpack8(R[i].vp, rp);
#pragma unroll
                    for (int j = 0; j < 8; ++j) VT[(k8 + j) * 24 + tt] = f2bf(rc[j] + (rp[j] * pz - rc[j]) * muv[i][j]); }
                if (c + NHELP < NCHK) help_issue(p, R, rowbase + (c + NHELP) * CK, h, lane);
                LDS_FENCE();
                { f32x4 nab = {0.f, 0.f, 0.f, 0.f}, nabT = nab, nak = nab, nbr = nab, nkr = nab;
#pragma unroll
                  for (int ks = 0; ks < 2; ++ks) { const bf16x8 fb = *(const bf16x8*)(BT + r * 72 + ks * 32 + q * 8), fk = *(const bf16x8*)(KT + r * 72 + ks * 32 + q * 8), fa = *(const bf16x8*)(AT + r * 72 + ks * 32 + q * 8), fr = *(const bf16x8*)(RT + r * 72 + ks * 32 + q * 8);
                      nab = mfma16(fb, fa, nab); nabT = mfma16(fa, fb, nabT); nak = mfma16(fk, fa, nak); nbr = mfma16(fb, fr, nbr); nkr = mfma16(fk, fr, nkr); }
#pragma unroll
                  for (int j = 0; j < 4; ++j) { const int i = q * 4 + j, t = r;
                      nab[j] = (i < t) ? nab[j] : 0.f; nabT[j] = (r < i) ? nabT[j] : 0.f; nak[j] = (i < t) ? nak[j] : 0.f; nbr[j] = (i <= t) ? nbr[j] : 0.f; nkr[j] = (i <= t) ? nkr[j] : 0.f; }
                  *(s16x4*)(NAK + lane * 4) = cvt4(nak); *(s16x4*)(NBR + lane * 4) = cvt4(nbr); *(s16x4*)(NKR + lane * 4) = cvt4(nkr);
                  const f32x4 z4 = {0.f, 0.f, 0.f, 0.f};
                  const s16x4 bN = cvt4(nab), bNT = cvt4(nabT);
                  const f32x4 n2 = mf16(bNT, bN, z4), n2T = mf16(bN, bNT, z4);
                  const s16x4 b2 = cvt4(n2), b2T = cvt4(n2T);
                  const f32x4 n4 = mf16(b2T, b2, z4), n4T = mf16(b2, b2T, z4);
                  const s16x4 b4 = cvt4(n4), b4T = cvt4(n4T);
                  f32x4 X = mf16(b4T, b4, z4);
#pragma unroll
                  for (int j = 0; j < 4; ++j) X[j] += (q * 4 + j == r) ? 1.f : 0.f;
                  X = mf16(b4T, cvt4(X), X);
                  X = mf16(b2T, cvt4(X), X);
                  X = mf16(bNT, cvt4(X), X);
                  *(s16x4*)(TT + lane * 4) = cvt4(X); }
                LDS_FENCE();
                if (lane == 0) flags[hw] = (unsigned)(c + 1);
            }
        }
        __syncthreads();
    }
}

__device__ __forceinline__ bf16x8 ldfrag(const bf16* base, int ld, int row0, int k0, int r, int q) { return *(const bf16x8*)(base + (row0 + r) * ld + k0 + q * 8); }
__device__ __forceinline__ void phase_ssd(const P& p_in, unsigned char* smem) {
    PHASE_PROLOGUE;
    const int lane = tid & 63, wave = tid >> 6, r = lane & 15, q = lane >> 4;
    bf16* XT = (bf16*)(smem + 53248); bf16* XdT = (bf16*)(smem + 57856); bf16* Gs = (bf16*)(smem + 62464); bf16* Hb = (bf16*)(smem + 71680); float* xsn = (float*)(smem + 80384);
    const bf16* XBC = (const bf16*)(p.ws + WS_XBC); const float* DT = (const float*)(p.ws + WS_DT); bf16* YM = (bf16*)(p.ws + WS_XB) + (size_t)MPR * 512;
    for (int unit = (int)blockIdx.x - SCAN_WGS; unit >= 0 && unit < 128; unit += 128) {
        const int bg = unit >> 3, e = (unit >> 1) & 3, ph = unit & 1, b = bg >> 1, g = bg & 1, h = g * 4 + e;
        const float A = -__expf(p.in[21][h]), Dh = p.in[22][h];
        f32x4 hacc[2] = {{0.f, 0.f, 0.f, 0.f}, {0.f, 0.f, 0.f, 0.f}};
        for (int i = tid; i < 32 * 136; i += 512) Hb[i] = 0;
        u32x4 rc[2], rb[2]; unsigned rx0, rx1; float rdt = 0.f;
#define SSD_LOAD(c_) do { const int row0_ = b * SEQ + (c_) * 64; \
            _Pragma("unroll") for (int i = 0; i < 2; ++i) { const int pc = tid + i * 512, s_ = pc >> 4, n8 = (pc & 15) * 8; \
                rc[i] = *(const u32x4*)(XBC + (size_t)(row0_ + s_) * 1024 + 768 + g * 128 + n8); rb[i] = *(const u32x4*)(XBC + (size_t)(row0_ + s_) * 1024 + 512 + g * 128 + n8); } \
            { const unsigned* xp_ = (const unsigned*)(XBC + (size_t)(row0_ + (tid >> 3)) * 1024 + h * 64 + ph * 32 + (tid & 7) * 4); rx0 = xp_[0]; rx1 = xp_[1]; } \
            if (tid < 64) rdt = DT[(size_t)(row0_ + tid) * 8 + h]; } while (0)
        SSD_LOAD(0);
        for (int c = 0; c < SEQ / 64; ++c) {
            unsigned char* sb = smem + (c & 1) * 89088; bf16* Cs = (bf16*)sb; bf16* Bs = (bf16*)(sb + 17408); bf16* BT = (bf16*)(sb + 34816);
            float* cs = (float*)(smem + ((c & 1) ? 142336 : 88576)); float* dtv = cs + 64;
#pragma unroll
            for (int i = 0; i < 2; ++i) { const int pc = tid + i * 512, s_ = pc >> 4, n8 = (pc & 15) * 8;
                *(u32x4*)(Cs + s_ * 136 + n8) = rc[i]; *(u32x4*)(Bs + s_ * 136 + n8) = rb[i];
                const unsigned w[4] = {rb[i].x, rb[i].y, rb[i].z, rb[i].w};
                const int sp = ((((s_ >> 3) ^ (pc & 7)) << 3) | (s_ & 7));
#pragma unroll
                for (int j = 0; j < 4; ++j) { BT[(n8 + 2 * j) * 72 + sp] = (bf16)(w[j] & 0xffffu); BT[(n8 + 2 * j + 1) * 72 + sp] = (bf16)(w[j] >> 16); } }
            if (wave == 0) { float v = A * rdt;
                v += dppf<0x111>(v); v += dppf<0x112>(v); v += dppf<0x114>(v); v += dppf<0x118>(v);
                v += __int_as_float(__builtin_amdgcn_update_dpp(0, __float_as_int(v), 0x142, 0xa, 0xf, false));
                v += __int_as_float(__builtin_amdgcn_update_dpp(0, __float_as_int(v), 0x143, 0xc, 0xf, false));
                cs[lane] = v; dtv[lane] = rdt; }
            __syncthreads();
            { const int s_ = tid >> 3, p4 = (tid & 7) * 4; const float dts = dtv[s_], dec = __expf(cs[63] - cs[s_]);
              const float x[4] = {bflo(rx0), bfhi(rx0), bflo(rx1), bfhi(rx1)};
#pragma unroll
              for (int j = 0; j < 4; ++j) { const float X = x[j] * dts; XT[(p4 + j) * 72 + s_] = f2bf(X); XdT[(p4 + j) * 72 + s_] = f2bf(X * dec); }
              *(f32x4*)(xsn + s_ * 32 + p4) = (f32x4){x[0], x[1], x[2], x[3]}; }
            if (c + 1 < SEQ / 64) SSD_LOAD(c + 1);
#pragma unroll
            for (int i = 0; i < 2; ++i) { const int tile = wave * 2 + i, mt = tile >> 2, nt = tile & 3; f32x4 acc = {0.f, 0.f, 0.f, 0.f};
#pragma unroll
                for (int ks = 0; ks < 4; ++ks) acc = mfma16(ldfrag(Cs, 136, mt * 16, ks * 32, r, q), ldfrag(Bs, 136, nt * 16, ks * 32, r, q), acc);
                const int s_ = nt * 16 + r; const float css = cs[s_];
#pragma unroll
                for (int j = 0; j < 4; ++j) { const int l = mt * 16 + q * 4 + j; const float gv = (s_ <= l) ? acc[j] * __expf(cs[l] - css) : 0.f; Gs[l * 72 + s_] = f2bf(gv); } }
            const int mt = wave >> 1, pt = wave & 1;
            f32x4 yacc = {0.f, 0.f, 0.f, 0.f};
#pragma unroll
            for (int ks = 0; ks < 4; ++ks) yacc = mfma16(ldfrag(Cs, 136, mt * 16, ks * 32, r, q), ldfrag(Hb, 136, pt * 16, ks * 32, r, q), yacc);
#pragma unroll
            for (int j = 0; j < 4; ++j) yacc[j] *= __expf(cs[mt * 16 + q * 4 + j]);
            __syncthreads();
#pragma unroll
            for (int ks = 0; ks < 2; ++ks) yacc = mfma16(ldfrag(Gs, 72, mt * 16, ks * 32, r, q), ldfrag(XT, 72, pt * 16, ks * 32, r, q), yacc);
#pragma unroll
            for (int j = 0; j < 4; ++j) { const int l = mt * 16 + q * 4 + j; YM[((size_t)((b * 8 + h) * 4 + ph * 2 + pt) * SEQ + c * 64 + l) * 16 + r] = f2bf(yacc[j] + Dh * xsn[l * 32 + pt * 16 + r]); }
            { const float dl = __expf(cs[63]);
#pragma unroll
              for (int t2 = 0; t2 < 2; ++t2) { hacc[t2] = hacc[t2] * dl;
#pragma unroll
                  for (int ks = 0; ks < 2; ++ks) hacc[t2] = mfma16(ldfrag(XdT, 72, t2 * 16, ks * 32, r, q), *(const bf16x8*)(BT + (wave * 16 + r) * 72 + (((ks * 4 + q) ^ ((wave * 2 + (r >> 3)) & 7)) << 3)), hacc[t2]);
#pragma unroll
                  for (int j = 0; j < 4; ++j) Hb[(t2 * 16 + q * 4 + j) * 136 + wave * 16 + r] = f2bf(hacc[t2][j]); } }
        }
#undef SSD_LOAD
#pragma unroll
        for (int t2 = 0; t2 < 2; ++t2)
#pragma unroll
            for (int j = 0; j < 4; ++j) p.out[O_SSMP + ((size_t)((b * 8 + h) * 64 + ph * 32 + t2 * 16 + q * 4 + j)) * 128 + wave * 16 + r] = hacc[t2][j];
        __syncthreads();
    }
}

__device__ __forceinline__ float conv_act_s(const P& p, int bs, int c) {
    const bf16* PROJ = (const bf16*)(p.ws + WS_PROJ); const float* sc = p.in[4] + (size_t)bs * 3072 + c; const float* cw = p.in[18] + c;
    const float v = p.in[19][c] + cw[0] * sc[0] + cw[1024] * sc[1024] + cw[2048] * sc[2048] + cw[3072] * bf2f(PROJ[(size_t)(MPR + bs) * PLD + 2304 + c]);
    return silu(v);
}
__device__ __forceinline__ void phase_sample_step(const P& p_in, unsigned char* smem) {
    PHASE_PROLOGUE;
    const int lane = tid & 63, wave = tid >> 6, G = gridDim.x, bid = blockIdx.x;
    const int first = SCAN_WGS;
    const int gw = (bid - first) * 8 + wave, NGW = (G - first) * 8;
    if (bid < first) return;
    float* sv = (float*)(smem + wave * 2048);
    const float* WD = p.out + OS_WD; const bf16* KP = (const bf16*)(p.ws + WS_KP); const bf16* KK = (const bf16*)(p.ws + WS_KK); const bf16* KB = (const bf16*)(p.ws + WS_KB);
    bf16* YS = (bf16*)(p.ws + WS_YS); const float* DT = (const float*)(p.ws + WS_DT);
    const int kq = lane & 15, rr = lane >> 4;
    for (int unit = gw; unit < 2048; unit += NGW) {
        const int bs = (unit & 1023) >> 3, h = unit & 7, row = MPR + bs;
        if (unit < 1024) {
            const size_t o = (size_t)row * 512 + h * 64 + lane;
            sv[lane] = WD[o]; sv[64 + lane] = bf2f(KP[o]); sv[128 + lane] = -bf2f(KK[o]); sv[192 + lane] = bf2f(KB[o]); sv[256 + lane] = lerp1(p, row, h * 64 + lane); sv[320 + lane] = lerp1(p, row, 1024 + h * 64 + lane);
            LDS_FENCE();
            const f32x4 w4 = *(const f32x4*)(sv + kq * 4), kp4 = *(const f32x4*)(sv + 64 + kq * 4), ka4 = *(const f32x4*)(sv + 128 + kq * 4), kb4 = *(const f32x4*)(sv + 192 + kq * 4), r4 = *(const f32x4*)(sv + 256 + kq * 4);
            const size_t so = (size_t)(bs * 8 + h) * 4096 + rr * 64 + kq * 4;
            const float* Sb = p.in[3] + so; float* Ob = p.out + O_WKVS + so;
            f32x4 S[16]; float sa[16];
#pragma unroll
            for (int i = 0; i < 16; ++i) S[i] = *(const f32x4*)(Sb + i * 256);
#pragma unroll
            for (int i = 0; i < 16; ++i) sa[i] = sum16((S[i][0] * ka4[0] + S[i][1] * ka4[1]) + (S[i][2] * ka4[2] + S[i][3] * ka4[3]));
#pragma unroll
            for (int i = 0; i < 16; ++i) { const float vv = sv[320 + 4 * i + rr]; f32x4 n;
#pragma unroll
                for (int j = 0; j < 4; ++j) n[j] = S[i][j] * w4[j] + (sa[i] * kb4[j] + vv * kp4[j]);
                *(f32x4*)(Ob + i * 256) = n;
                const float y = sum16((n[0] * r4[0] + n[1] * r4[1]) + (n[2] * r4[2] + n[3] * r4[3]));
                if (kq == 0) YS[(size_t)bs * 1024 + h * 64 + 4 * i + rr] = f2bf(y); }
            LDS_FENCE();
        } else {
            const int g = h >> 2;
            sv[lane] = conv_act_s(p, bs, 512 + g * 128 + lane); sv[64 + lane] = conv_act_s(p, bs, 512 + g * 128 + 64 + lane);
            sv[128 + lane] = conv_act_s(p, bs, 768 + g * 128 + lane); sv[192 + lane] = conv_act_s(p, bs, 768 + g * 128 + 64 + lane);
            sv[256 + lane] = conv_act_s(p, bs, h * 64 + lane);
            LDS_FENCE();
            const float dt = DT[(size_t)row * 8 + h], A = -__expf(p.in[21][h]), dA = __expf(A * dt), Dh = p.in[22][h];
            const f32x4 Bl = *(const f32x4*)(sv + kq * 4), Bh = *(const f32x4*)(sv + 64 + kq * 4), Cl = *(const f32x4*)(sv + 128 + kq * 4), Ch = *(const f32x4*)(sv + 192 + kq * 4);
            const size_t so = (size_t)(bs * 8 + h) * 8192 + rr * 128 + kq * 4;
            const float* Hb_ = p.in[5] + so; float* Ob = p.out + O_SSMS + so;
#pragma unroll
            for (int half = 0; half < 2; ++half) { f32x4 hl[8], hh[8];
#pragma unroll
                for (int i = 0; i < 8; ++i) { hl[i] = *(const f32x4*)(Hb_ + (half * 8 + i) * 512); hh[i] = *(const f32x4*)(Hb_ + (half * 8 + i) * 512 + 64); }
#pragma unroll
                for (int i = 0; i < 8; ++i) { const int pp = 4 * (half * 8 + i) + rr; const float x = sv[256 + pp], dtx = dt * x; f32x4 nl, nh; float y = 0.f;
#pragma unroll
                    for (int j = 0; j < 4; ++j) { nl[j] = hl[i][j] * dA + dtx * Bl[j]; nh[j] = hh[i][j] * dA + dtx * Bh[j]; y += nl[j] * Cl[j] + nh[j] * Ch[j]; }
                    *(f32x4*)(Ob + (half * 8 + i) * 512) = nl; *(f32x4*)(Ob + (half * 8 + i) * 512 + 64) = nh;
                    y = sum16(y) + Dh * x;
                    if (kq == 0) YS[(size_t)bs * 1024 + 512 + h * 64 + pp] = f2bf(y); } }
            LDS_FENCE();
        }
    }
}

__device__ __forceinline__ void phase_post(const P& p_in) {
    PHASE_PROLOGUE;
    const int lane = tid & 63, wave = tid >> 6, G = gridDim.x, bid = blockIdx.x;
    const int gw = bid * 8 + wave, NGW = G * 8;
    bf16* MIX = (bf16*)(p.ws + WS_MIX); const bf16* YR = (const bf16*)(p.ws + WS_XB); const bf16* YM = YR + (size_t)MPR * 512; const bf16* YS = (const bf16*)(p.ws + WS_YS);
    const bf16* PROJ = (const bf16*)(p.ws + WS_PROJ); const bf16* KP = (const bf16*)(p.ws + WS_KP); const bf16* GG = (const bf16*)(p.out + OS_GG);
    const int c0 = lane * 8;
    float rk[8], lw[8], lb[8], gn[8], mur[8], muv[8];
#pragma unroll
    for (int i = 0; i < 8; ++i) { rk[i] = p.in[15][c0 + i]; lw[i] = p.in[16][c0 + i]; lb[i] = p.in[17][c0 + i]; gn[i] = p.in[23][c0 + i]; mur[i] = p.in[7][c0 + i]; muv[i] = p.in[7][1024 + c0 + i]; }
    struct PostRegs { u32x4 yr, ym, rc, rp, vc, vp, kp, gg, z; };
    PostRegs nx;
#define POST_LOAD(R_, row_) do { const int rw_ = (row_); \
        const size_t yo_ = ((size_t)(((rw_ >> 11) * 8 + (lane >> 3)) * 4 + ((lane & 7) >> 1)) * SEQ + (rw_ & (SEQ - 1))) * 16 + (lane & 1) * 8; \
        R_.yr = rw_ < MPR ? *(const u32x4*)(YR + yo_) : *(const u32x4*)(YS + (size_t)(rw_ - MPR) * 1024 + c0); \
        R_.ym = rw_ < MPR ? *(const u32x4*)(YM + yo_) : *(const u32x4*)(YS + (size_t)(rw_ - MPR) * 1024 + 512 + c0); \
        R_.rc = *(const u32x4*)(PROJ + (size_t)rw_ * PLD + c0); R_.vc = *(const u32x4*)(PROJ + (size_t)rw_ * PLD + 1024 + c0); R_.z = *(const u32x4*)(PROJ + (size_t)rw_ * PLD + 1792 + c0); \
        R_.kp = *(const u32x4*)(KP + (size_t)rw_ * 512 + c0); R_.gg = *(const u32x4*)(GG + (size_t)rw_ * 512 + c0); \
        u32x4 pr_ = {0u, 0u, 0u, 0u}, pv_ = pr_; \
        if (rw_ >= MPR) { const float* sp_ = p.in[2] + (size_t)(rw_ - MPR) * RPJ + c0; const f32x4 a_ = *(const f32x4*)sp_, b_ = *(const f32x4*)(sp_ + 4), c_ = *(const f32x4*)(sp_ + 1024), d_ = *(const f32x4*)(sp_ + 1028); \
            pr_.x = pkbf(a_[0], a_[1]); pr_.y = pkbf(a_[2], a_[3]); pr_.z = pkbf(b_[0], b_[1]); pr_.w = pkbf(b_[2], b_[3]); pv_.x = pkbf(c_[0], c_[1]); pv_.y = pkbf(c_[2], c_[3]); pv_.z = pkbf(d_[0], d_[1]); pv_.w = pkbf(d_[2], d_[3]); } \
        else if ((rw_ & (SEQ - 1)) != 0) { pr_ = *(const u32x4*)(PROJ + (size_t)(rw_ - 1) * PLD + c0); pv_ = *(const u32x4*)(PROJ + (size_t)(rw_ - 1) * PLD + 1024 + c0); } \
        R_.rp = pr_; R_.vp = pv_; } while (0)
    if (gw < MTOT) POST_LOAD(nx, gw);
    for (int row = gw; row < MTOT; row += NGW) {
        const PostRegs cu = nx;
        if (row + NGW < MTOT) POST_LOAD(nx, row + NGW);
        {
            float y[8], rr[8], kp[8], vv[8], gg[8], t0[8], t1[8];
            unpack8(cu.yr, y);
            float s = 0.f;
#pragma unroll
            for (int i = 0; i < 8; ++i) s += y[i];
            s = sum8(s);
            const float mean = s * (1.f / 64.f); float s2 = 0.f;
#pragma unroll
            for (int i = 0; i < 8; ++i) { y[i] -= mean; s2 += y[i] * y[i]; }
            s2 = sum8(s2);
            const float rstd = rsqrtf(s2 * (1.f / 64.f) + 64e-5f);
            unpack8(cu.rc, t0); unpack8(cu.rp, t1);
#pragma unroll
            for (int i = 0; i < 8; ++i) rr[i] = t0[i] + (t1[i] - t0[i]) * mur[i];
            unpack8(cu.vc, t0); unpack8(cu.vp, t1);
#pragma unroll
            for (int i = 0; i < 8; ++i) vv[i] = t0[i] + (t1[i] - t0[i]) * muv[i];
            unpack8(cu.kp, kp); unpack8(cu.gg, gg);
            float bo = 0.f;
#pragma unroll
            for (int i = 0; i < 8; ++i) bo += rr[i] * kp[i] * rk[i];
            bo = sum8(bo);
#pragma unroll
            for (int i = 0; i < 8; ++i) y[i] = (y[i] * rstd * lw[i] + lb[i] + bo * vv[i]) * gg[i];
            *(u32x4*)(MIX + (size_t)row * 1024 + c0) = pack8(y);
        }
        {
            float y[8], z[8];
            unpack8(cu.ym, y); unpack8(cu.z, z);
            float ss = 0.f;
#pragma unroll
            for (int i = 0; i < 8; ++i) { y[i] *= silu(z[i]); ss += y[i] * y[i]; }
            ss = sum32(ss, lane >= 32);
            const float sc = rsqrtf(ss * (1.f / 256.f) + 1e-5f);
#pragma unroll
            for (int i = 0; i < 8; ++i) y[i] = y[i] * sc * gn[i];
            *(u32x4*)(MIX + (size_t)row * 1024 + 512 + c0) = pack8(y);
        }
    }
#undef POST_LOAD
}

template <bool TO_BF16> __device__ __forceinline__ void phase_ln(const P& p_in, const float* gam, const float* bet, bf16* ob, size_t src_off, int sld) {
    PHASE_PROLOGUE;
    const int lane = tid & 63, wave = tid >> 6, G = gridDim.x, bid = blockIdx.x;
    const int gw = bid * 8 + wave, NGW = G * 8;
    const bf16* src = (const bf16*)p.out + src_off;
    f32x4 gv[4], bv[4];
#pragma unroll
    for (int j = 0; j < 4; ++j) { gv[j] = *(const f32x4*)(gam + lane * 4 + 256 * j); bv[j] = *(const f32x4*)(bet + lane * 4 + 256 * j); }
    unsigned long long nx[4] = {0ull, 0ull, 0ull, 0ull};
    if (gw < MTOT) {
#pragma unroll
        for (int j = 0; j < 4; ++j) nx[j] = *(const unsigned long long*)(src + (size_t)gw * sld + lane * 4 + 256 * j); }
    for (int row = gw; row < MTOT; row += NGW) {
        float* xr = p.out + (size_t)row * 1024 + lane * 4;
        f32x4 v[4]; float s = 0.f;
#pragma unroll
        for (int j = 0; j < 4; ++j) { const unsigned lo = (unsigned)nx[j], hi = (unsigned)(nx[j] >> 32);
            v[j] = (f32x4){bflo(lo), bfhi(lo), bflo(hi), bfhi(hi)}; s += (v[j][0] + v[j][1]) + (v[j][2] + v[j][3]); }
        if (row + NGW < MTOT) {
#pragma unroll
            for (int j = 0; j < 4; ++j) nx[j] = *(const unsigned long long*)(src + (size_t)(row + NGW) * sld + lane * 4 + 256 * j); }
        s = sum64(s);
        const float mean = s * (1.f / 1024.f); float s2 = 0.f;
#pragma unroll
        for (int j = 0; j < 4; ++j) { v[j] = v[j] - mean; s2 += (v[j][0] * v[j][0] + v[j][1] * v[j][1]) + (v[j][2] * v[j][2] + v[j][3] * v[j][3]); }
        s2 = sum64(s2);
        const float rstd = rsqrtf(s2 * (1.f / 1024.f) + 1e-5f);
#pragma unroll
        for (int j = 0; j < 4; ++j) { const f32x4 o = v[j] * rstd * gv[j] + bv[j];
            if (TO_BF16) { unsigned long long w = (unsigned long long)pkbf(o[0], o[1]) | ((unsigned long long)pkbf(o[2], o[3]) << 32); *(unsigned long long*)(ob + (size_t)row * 1024 + lane * 4 + 256 * j) = w; }
            else *(f32x4*)(xr + 256 * j) = o; }
    }
}

#ifndef USE_CHUNKED
#define USE_CHUNKED 1
#endif
#ifndef REPEAT_SEL
#define REPEAT_SEL 0
#endif
#ifndef DUMP_SEL
#define DUMP_SEL 0
#endif
#ifndef STOP_AFTER
#define STOP_AFTER 99
#endif
__global__ void __launch_bounds__(512, 2) mega(P p) {
    extern __shared__ __attribute__((aligned(16))) unsigned char smem[];
    LAS unsigned char* lds = (LAS unsigned char*)smem;
    volatile LAS unsigned* MISC = (volatile LAS unsigned*)(lds + MISC_OFF);
    if (threadIdx.x < 16) MISC[threadIdx.x] = 0u;
    __syncthreads();
    XcdBarrier bar = xcd_barrier_post((unsigned*)(p.ws + WS_CTL), MISC);
    if (p.never) cg::this_grid().sync();
#define GRID_BAR() xcd_barrier(bar)
    const int G = gridDim.x, bid = blockIdx.x;
    bf16* XB = (bf16*)(p.ws + WS_XB); bf16* PROJ = (bf16*)(p.ws + WS_PROJ); float* DT = (float*)(p.ws + WS_DT); bf16* HID = (bf16*)(p.ws + WS_HID);

#if STOP_AFTER != 99
    { const size_t gt = (size_t)blockIdx.x * 512 + threadIdx.x, NGT = (size_t)gridDim.x * 512; for (size_t i = O_SHP + gt; i < 30939136; i += NGT) p.out[i] = 0.f; }
    GRID_BAR();
#endif
    phase0(p, smem);
    GRID_BAR();
    {
        pg8::Gemm g{XB, (const bf16*)(p.ws + WS_WIN), MPR, 3584, 1024}; pg8::StaticOrder S; S.init(MPR, 3584, G, bid);
        pg8::EpiProj E{PROJ, DT, p.in[20], p.out};
        pg8::gemm_phase<pg8::EpiProj, pg8::StaticOrder, true, true>(lds, g, S, E);
        const float* dtb = p.in[20]; float* out = p.out;
        small_gemm<4, 1024>(XB + (size_t)MPR * 1024, (const bf16*)(p.ws + WS_WIN), PROJN, smem, [=](int rs, int c, float v) {
            if (c < 3328) PROJ[(size_t)(MPR + rs) * PLD + c] = f2bf(v); else DT[(size_t)(MPR + rs) * 8 + (c - 3328)] = softplus(v + dtb[c - 3328]);
            if (c < 1792) out[O_SHS + (size_t)rs * 1792 + c] = v;
            if (c >= 2304 && c < 3328) out[O_CONVS + ((size_t)rs * 3 + 2) * 1024 + (c - 2304)] = v; }, (G == 256) ? 128 : 0);
        phase0_late(p, smem, (G == 256) ? 128 : 0, 0);
    }
    GRID_BAR();
    phase_prep(p, smem);
#if REPEAT_SEL == 2
    phase_prep(p, smem);
#endif
    GRID_BAR();
#if STOP_AFTER == 2
    { const size_t gt = (size_t)blockIdx.x * 512 + threadIdx.x, NGT = (size_t)gridDim.x * 512; const bf16* KPd = (const bf16*)(p.ws + WS_KP); const bf16* XBCd = (const bf16*)(p.ws + WS_XBC);
      for (size_t i = gt; i < 8454144; i += NGT) { p.out[i] = bf2f(KPd[i]); p.out[8454144 + i] = bf2f(XBCd[i]); } }
    return;
#endif
#if USE_CHUNKED
    phase_scan2(p, smem);
#else
    phase_scan(p, smem);
#endif
    phase_ssd(p, smem);
    phase_sample_step(p, smem);
#if REPEAT_SEL == 3
    phase_scan2(p, smem);
    phase_ssd(p, smem);
    phase_sample_step(p, smem);
#endif
#if REPEAT_SEL == 5
    phase_sample_step(p, smem);
    phase_sample_step(p, smem);
#endif
#if REPEAT_SEL == 6
    phase_ssd(p, smem);
#endif
#if REPEAT_SEL == 4
    phase_ssd(p, smem);
    phase_sample_step(p, smem);
#endif
    GRID_BAR();
#if STOP_AFTER == 4
    { const size_t gt = (size_t)blockIdx.x * 512 + threadIdx.x, NGT = (size_t)gridDim.x * 512; const bf16* Yd = (const bf16*)(p.ws + WS_XB);
      for (size_t i = gt; i < 8388608; i += NGT) { p.out[i] = (DUMP_SEL & 1) ? bf2f(Yd[i]) : 0.f; p.out[8388608 + i] = (DUMP_SEL & 2) ? bf2f(Yd[8388608 + i]) : 0.f; }
      for (size_t i = gt; i < 131072; i += NGT) p.out[16777216 + i] = (DUMP_SEL & 4) ? bf2f(((const bf16*)(p.ws + WS_YS))[i]) : 0.f; }
    return;
#endif
    phase_post(p);
    GRID_BAR();
#if STOP_AFTER == 5
    { const size_t gt = (size_t)blockIdx.x * 512 + threadIdx.x, NGT = (size_t)gridDim.x * 512; for (size_t i = gt; i < (size_t)MTOT * 1024; i += NGT) p.out[i] = bf2f(((const bf16*)(p.ws + WS_MIX))[i]); }
    return;
#endif
    {
        pg8::Gemm g{(const bf16*)(p.ws + WS_MIX), (const bf16*)(p.ws + WS_WOUT), MPR, 1024, 1024}; pg8::StaticOrder S; S.init(MPR, 1024, G, bid);
        pg8::EpiResF32 E{p.in[0], nullptr, (bf16*)p.out, 1024, ALPHA};
        pg8::gemm_phase<pg8::EpiResF32, pg8::StaticOrder, true, true>(lds, g, S, E);
        const float* xs = p.in[1]; float* out = p.out;
        small_gemm<2, 1024>((const bf16*)(p.ws + WS_MIX) + (size_t)MPR * 1024, (const bf16*)(p.ws + WS_WOUT), 1024, smem, [=](int rs, int c, float v) { ((bf16*)out)[(size_t)(MPR + rs) * 1024 + c] = f2bf(ALPHA * xs[(size_t)rs * 1024 + c] + v); });
    }
    GRID_BAR();
    phase_ln<true>(p, p.in[25], p.in[26], XB, 0, 1024);
    phase0_late(p, smem, 0, 1);
    GRID_BAR();
    {
        pg8::Gemm g{XB, (const bf16*)(p.ws + WS_WFF1), MPR, 4096, 1024}; pg8::StaticOrder S; S.init(MPR, 4096, G, bid);
        pg8::EpiRelu2 E{HID, 4096};
        pg8::gemm_phase<pg8::EpiRelu2, pg8::StaticOrder, true, true>(lds, g, S, E);
        small_gemm<4, 1024>(XB + (size_t)MPR * 1024, (const bf16*)(p.ws + WS_WFF1), 4096, smem, [=](int rs, int c, float v) { const float a = fmaxf(v, 0.f); HID[(size_t)(MPR + rs) * 4096 + c] = f2bf(a * a); });
    }
    GRID_BAR();
    {
        pg8::Gemm g{HID, (const bf16*)(p.ws + WS_WFF2), MPR, 1024, 4096}; pg8::StaticOrder S; S.init(MPR, 1024, G, bid);
        pg8::EpiResF32 E{nullptr, XB, (bf16*)p.out + 1024, 2048, ALPHA};
        pg8::gemm_phase<pg8::EpiResF32, pg8::StaticOrder, true, true>(lds, g, S, E);
        float* out = p.out;
        small_gemm<2, 4096>(HID + (size_t)MPR * 4096, (const bf16*)(p.ws + WS_WFF2), 1024, smem, [=](int rs, int c, float v) { ((bf16*)out)[(size_t)(MPR + rs) * 2048 + 1024 + c] = f2bf(ALPHA * bf2f(XB[(size_t)(MPR + rs) * 1024 + c]) + v); });
    }
    GRID_BAR();
    phase_ln<false>(p, p.in[29], p.in[30], nullptr, 1024, 2048);
}

extern "C" void kernel_launch(void* const* d_in, const int* in_sizes, int n_in, void* d_out, int out_size, void* d_ws, size_t ws_size, hipStream_t stream) {
    static int grid = 0;
    if (grid == 0) {
        int dev = 0, cus = 0, per_cu = 0;
        (void)hipGetDevice(&dev);
        (void)hipDeviceGetAttribute(&cus, hipDeviceAttributeMultiprocessorCount, dev);
        if (hipFuncSetAttribute((const void*)mega, hipFuncAttributeMaxDynamicSharedMemorySize, LDS_BYTES) != hipSuccess) fprintf(stderr, "kernel_launch: hipFuncSetAttribute failed\n");
        if (hipOccupancyMaxActiveBlocksPerMultiprocessor(&per_cu, (const void*)mega, 512, LDS_BYTES) != hipSuccess || per_cu < 1) { fprintf(stderr, "kernel_launch: occupancy query says %d\n", per_cu); per_cu = 1; }
        (void)hipGetLastError();
        grid = cus * 1;
        if (n_in != 31 || out_size != 30939136 || ws_size < WS_CTL + 16384) fprintf(stderr, "kernel_launch: unexpected sizes n_in %d out %d ws %zu\n", n_in, out_size, ws_size);
    }
    (void)hipMemsetAsync((char*)d_ws + WS_CTL, 0, 16384, stream);
    P a{};
    for (int i = 0; i < 31; ++i) a.in[i] = (const float*)d_in[i];
    a.out = (float*)d_out; a.ws = (unsigned char*)d_ws; a.never = 0; a.pad = 0;
    void* args[] = {&a};
    hipError_t e = hipLaunchCooperativeKernel((const void*)mega, dim3(grid), dim3(512), args, LDS_BYTES, stream);
    if (e != hipSuccess) fprintf(stderr, "kernel_launch: cooperative launch failed: %s (grid %d)\n", hipGetErrorString(e), grid);
}
```

```cpp
#include <hip/hip_runtime.h>
#include <hip/hip_cooperative_groups.h>
#include <cstdio>
#include <cstdint>
namespace cg = cooperative_groups;
#define LAS __attribute__((address_space(3)))

typedef unsigned short bf16;
typedef short bf16x8 __attribute__((ext_vector_type(8)));
typedef float f32x4 __attribute__((ext_vector_type(4)));
typedef unsigned u32x4 __attribute__((ext_vector_type(4)));

constexpr int DM = 1024, SEQ = 2048, MPR = 8 * SEQ, MSM = 128, MTOT = MPR + MSM;
constexpr int RPJ = 1792, PLD = 3328, PROJN = 3336, DFF = 4096;
constexpr float ALPHA = 1.189207115f;
constexpr size_t O_Y = 0, O_YS = 16777216, O_SHP = 16908288, O_WKVP = 16922624, O_CONVP = 17184768, O_SSMP = 17209344,
                 O_SHS = 17733632, O_WKVS = 17963008, O_CONVS = 22157312, O_SSMS = 22550528;
constexpr size_t OS_WD = 0, OS_GG = 8454144;
constexpr size_t WS_WIN = 0, WS_WOUT = 7340032, WS_WFF1 = 9437184, WS_WFF2 = 17825792, WS_LORA = 26214400, WS_XB = 26476544,
                 WS_PROJ = 60293120, WS_DT = 170196992, WS_KP = 170725376, WS_KK = 187633664, WS_KB = 204541952, WS_XBC = 221450240,
                 WS_CTL = 255004672, WS_YS = WS_CTL + 65536, WS_HID = WS_PROJ, WS_MIX = WS_KK;
constexpr int LDS_BYTES = 147456, MISC_OFF = LDS_BYTES - 64;

struct P { const float* in[31]; float* out; unsigned char* ws; int never; int pad; };

__device__ __forceinline__ float bf2f(unsigned short b) { return __uint_as_float(((unsigned)b) << 16); }
__device__ __forceinline__ float bflo(unsigned u) { return __uint_as_float(u << 16); }
__device__ __forceinline__ float bfhi(unsigned u) { return __uint_as_float(u & 0xffff0000u); }
typedef float f32x2_t __attribute__((ext_vector_type(2)));
typedef __bf16 bf16x2_t __attribute__((ext_vector_type(2)));
__device__ __forceinline__ unsigned pkbf(float lo, float hi) { const f32x2_t v = {lo, hi}; const bf16x2_t b = __builtin_convertvector(v, bf16x2_t); return __builtin_bit_cast(unsigned, b); }
__device__ __forceinline__ unsigned short f2bf(float f) { return (unsigned short)(pkbf(f, f) & 0xffffu); }
__device__ __forceinline__ void unpack8(u32x4 v, float* o) { o[0] = bflo(v.x); o[1] = bfhi(v.x); o[2] = bflo(v.y); o[3] = bfhi(v.y); o[4] = bflo(v.z); o[5] = bfhi(v.z); o[6] = bflo(v.w); o[7] = bfhi(v.w); }
__device__ __forceinline__ u32x4 pack8(const float* o) { u32x4 v; v.x = pkbf(o[0], o[1]); v.y = pkbf(o[2], o[3]); v.z = pkbf(o[4], o[5]); v.w = pkbf(o[6], o[7]); return v; }
__device__ __forceinline__ float sigm(float x) { return __builtin_amdgcn_rcpf(1.f + __expf(-x)); }
__device__ __forceinline__ float silu(float x) { return x * __builtin_amdgcn_rcpf(1.f + __expf(-x)); }
__device__ __forceinline__ float softplus(float x) { return fmaxf(x, 0.f) + __logf(1.f + __expf(-fabsf(x))); }
__device__ __forceinline__ float tanh_(float x) { const float e = __expf(2.f * x); return 1.f - 2.f * __builtin_amdgcn_rcpf(e + 1.f); }
template <int CTRL> __device__ __forceinline__ float dppf(float x) { return __int_as_float(__builtin_amdgcn_update_dpp(0, __float_as_int(x), CTRL, 0xf, 0xf, true)); }
template <int CTRL> __device__ __forceinline__ float dppo(float x) { return __int_as_float(__builtin_amdgcn_update_dpp(0x3f800000, __float_as_int(x), CTRL, 0xf, 0xf, false)); }
__device__ __forceinline__ float sum16(float x) { x += dppf<0xB1>(x); x += dppf<0x4E>(x); x += dppf<0x141>(x); x += dppf<0x140>(x); return x; }
__device__ __forceinline__ float sum8(float x) { x += dppf<0xB1>(x); x += dppf<0x4E>(x); x += dppf<0x141>(x); return x; }
__device__ __forceinline__ float rdl(float x, int l) { return __int_as_float(__builtin_amdgcn_readlane(__float_as_int(x), l)); }
__device__ __forceinline__ float sum64(float x) { x = sum16(x); return (rdl(x, 0) + rdl(x, 16)) + (rdl(x, 32) + rdl(x, 48)); }
__device__ __forceinline__ float sum32(float x, bool hi) { x = sum16(x); const float a = rdl(x, 0) + rdl(x, 16), b = rdl(x, 32) + rdl(x, 48); return hi ? b : a; }
__device__ __forceinline__ f32x4 mfma16(bf16x8 a, bf16x8 b, f32x4 c) { return __builtin_amdgcn_mfma_f32_16x16x32_bf16(a, b, c, 0, 0, 0); }
typedef short s16x4 __attribute__((ext_vector_type(4)));
__device__ __forceinline__ f32x4 mf16(s16x4 a, s16x4 b, f32x4 c) { return __builtin_amdgcn_mfma_f32_16x16x16bf16_1k(a, b, c, 0, 0, 0); }
__device__ __forceinline__ s16x4 cvt4(f32x4 v) { struct { unsigned a, b; } t = {pkbf(v[0], v[1]), pkbf(v[2], v[3])}; return __builtin_bit_cast(s16x4, t); }
#define LDS_FENCE() asm volatile("s_waitcnt lgkmcnt(0)" ::: "memory")

#define PHASE_PROLOGUE P p = p_in; { size_t z_ = 0; asm volatile("" : "+s"(z_)); p.ws += z_; p.out += z_; } int tid = threadIdx.x; asm volatile("" : "+v"(tid))
namespace pg8 {
#define PG8_LAS __attribute__((address_space(3)))
typedef unsigned short bf16_t;
typedef short bf16x8 __attribute__((ext_vector_type(8)));
typedef float f32x4 __attribute__((ext_vector_type(4)));
typedef unsigned u32x4 __attribute__((ext_vector_type(4)));
constexpr int BM = 256, BK = 64, HALF = 128, HTB = HALF * BK * 2  , STAGE_BYTES = 8 * HTB, NXCD = 8, WGM = 8;

__host__ __device__ __forceinline__ int lds_byte(int r, int c) { const int st = (r >> 4) * 2 + (c >> 5), rr = r & 15, cc = c & 31, ob = rr * 64 + cc * 2; return st * 1024 + (ob ^ (((ob >> 9) & 1) << 5)); }
__host__ __device__ __forceinline__ void stage_rc(int b, int& R, int& C) { const int st = b / 1024, sb = b % 1024, swz = sb ^ (((sb >> 9) & 1) << 5); R = (st >> 1) * 16 + swz / 64; C = (st & 1) * 32 + (swz % 64) / 2; }
__host__ __device__ __forceinline__ int perm32(int rho) { const int n = rho >> 4, i = rho & 15; return 8 * (i >> 2) + 4 * n + (i & 3); }

struct Unit { int pm, pn; };
struct Gemm { const bf16_t* A; const bf16_t* Bt; int M, N, K; };

struct StaticOrder {
    int nM, nN, nwg, G, c;
    __host__ __device__ void init(int M, int N, int G_, int c_) { nM = M / BM; nN = N / BM; nwg = nM * nN; G = G_; c = c_; }
    __host__ __device__ bool next(int i, Unit& u) const {
        const long L = (long)i * G + c; if (L >= nwg) return false;
        int wgid = (int)L; { const int q = nwg / NXCD, r = nwg % NXCD, xcd = wgid % NXCD, off = wgid / NXCD; wgid = (xcd < r ? xcd * (q + 1) : r * (q + 1) + (xcd - r) * q) + off; }
        const int nig = WGM * nN, gid = wgid / nig, fm = gid * WGM, gsz = (nM - fm) < WGM ? (nM - fm) : WGM;
        u.pm = fm + ((wgid % nig) % gsz); u.pn = (wgid % nig) / gsz; return true;
    }
    __device__ __forceinline__ void a_ready(const Unit&) const {}
    __device__ __forceinline__ void done(const Unit&) const {}
};

__device__ __forceinline__ unsigned cvt_pk_bf16(float lo, float hi) { return ::pkbf(lo, hi); }
typedef float f32x2 __attribute__((ext_vector_type(2)));
struct EpiProj {
    static constexpr bool PERM = true, AFTER_DRAIN = false;
    bf16_t* PROJ; float* DT; const float* dt_bias; float* out;
    __device__ __forceinline__ void operator()(const f32x4 (&acc)[2][2][4][2], const Unit& u, int wr, int wc, int fr, int fq) const {
        const int row0 = u.pm * BM + wr * 64 + fr;
#pragma unroll
        for (int bj = 0; bj < 2; ++bj) {
            const int c0 = u.pn * BM + bj * HALF + wc * 32 + 8 * fq;
            if (c0 >= 3336) continue;
#pragma unroll
            for (int ai = 0; ai < 2; ++ai)
#pragma unroll
                for (int m = 0; m < 4; ++m) {
                    const int row = row0 + ai * HALF + m * 16; const f32x4 v0 = acc[ai][bj][m][0], v1 = acc[ai][bj][m][1];
                    if (c0 < 3328) { u32x4 w; w.x = cvt_pk_bf16(v0[0], v0[1]); w.y = cvt_pk_bf16(v0[2], v0[3]); w.z = cvt_pk_bf16(v1[0], v1[1]); w.w = cvt_pk_bf16(v1[2], v1[3]);
                        *(u32x4*)(PROJ + (size_t)row * 3328 + c0) = w; }
                    else { f32x4 a, b;
#pragma unroll
                        for (int i = 0; i < 4; ++i) { float x = v0[i] + dt_bias[i]; a[i] = x > 20.f ? x : log1pf(__expf(x)); float y = v1[i] + dt_bias[4 + i]; b[i] = y > 20.f ? y : log1pf(__expf(y)); }
                        *(f32x4*)(DT + (size_t)row * 8) = a; *(f32x4*)(DT + (size_t)row * 8 + 4) = b; }
                    const int t = row & 2047, b_ = row >> 11;
                    if (t == 2047 && c0 < 1792) { float* o = out + 16908288 + (size_t)b_ * 1792 + c0; *(f32x4*)o = v0; *(f32x4*)(o + 4) = v1; }
                    if (t >= 2045 && c0 >= 2304 && c0 < 3328) { float* o = out + 17184768 + ((size_t)b_ * 3 + (t - 2045)) * 1024 + (c0 - 2304); *(f32x4*)o = v0; *(f32x4*)(o + 4) = v1; }
                }
        }
    }
};
struct EpiResF32 {
    static constexpr bool PERM = true, AFTER_DRAIN = false;
    const float* resf; const bf16_t* resb; bf16_t* ob; int ld; float alpha;
    __device__ __forceinline__ void operator()(const f32x4 (&acc)[2][2][4][2], const Unit& u, int wr, int wc, int fr, int fq) const {
        const int row0 = u.pm * BM + wr * 64 + fr;
#pragma unroll
        for (int ai = 0; ai < 2; ++ai)
#pragma unroll
            for (int m = 0; m < 4; ++m)
#pragma unroll
                for (int bj = 0; bj < 2; ++bj) {
                    const int row = row0 + ai * HALF + m * 16, c0 = u.pn * BM + bj * HALF + wc * 32 + 8 * fq; const size_t o = (size_t)row * 1024 + c0;
                    f32x4 r0, r1;
                    if (resf) { r0 = *(const f32x4*)(resf + o); r1 = *(const f32x4*)(resf + o + 4); }
                    else { const u32x4 w = *(const u32x4*)(resb + o); r0[0] = __uint_as_float(w.x << 16); r0[1] = __uint_as_float(w.x & 0xffff0000u); r0[2] = __uint_as_float(w.y << 16); r0[3] = __uint_as_float(w.y & 0xffff0000u);
                        r1[0] = __uint_as_float(w.z << 16); r1[1] = __uint_as_float(w.z & 0xffff0000u); r1[2] = __uint_as_float(w.w << 16); r1[3] = __uint_as_float(w.w & 0xffff0000u); }
                    const f32x4 v0 = r0 * alpha + acc[ai][bj][m][0], v1 = r1 * alpha + acc[ai][bj][m][1];
                    u32x4 w8; w8.x = cvt_pk_bf16(v0[0], v0[1]); w8.y = cvt_pk_bf16(v0[2], v0[3]); w8.z = cvt_pk_bf16(v1[0], v1[1]); w8.w = cvt_pk_bf16(v1[2], v1[3]);
                    *(u32x4*)(ob + (size_t)row * ld + c0) = w8;
                }
    }
};
struct EpiRelu2 {
    static constexpr bool PERM = true, AFTER_DRAIN = false;
    bf16_t* O; int ldc;
    __device__ __forceinline__ void operator()(const f32x4 (&acc)[2][2][4][2], const Unit& u, int wr, int wc, int fr, int fq) const {
        const int row0 = u.pm * BM + wr * 64 + fr;
#pragma unroll
        for (int ai = 0; ai < 2; ++ai)
#pragma unroll
            for (int m = 0; m < 4; ++m)
#pragma unroll
                for (int bj = 0; bj < 2; ++bj) {
                    const int row = row0 + ai * HALF + m * 16, c0 = u.pn * BM + bj * HALF + wc * 32 + 8 * fq;
                    f32x4 v0 = acc[ai][bj][m][0], v1 = acc[ai][bj][m][1];
#pragma unroll
                    for (int i = 0; i < 4; ++i) { float a = fmaxf(v0[i], 0.f); v0[i] = a * a; float b = fmaxf(v1[i], 0.f); v1[i] = b * b; }
                    u32x4 w; w.x = cvt_pk_bf16(v0[0], v0[1]); w.y = cvt_pk_bf16(v0[2], v0[3]); w.z = cvt_pk_bf16(v1[0], v1[1]); w.w = cvt_pk_bf16(v1[2], v1[3]);
                    *(u32x4*)(O + (size_t)row * ldc + c0) = w;
                }
    }
};
template <class Epi, class Sched, bool ALIGN_EPI = false, bool SP2 = false>
__device__ __forceinline__ void gemm_phase(PG8_LAS unsigned char* lds, const Gemm g, const Sched& S, const Epi& E) {
    int tid = threadIdx.x; asm volatile("" : "+v"(tid)); const int wid = __builtin_amdgcn_readfirstlane(tid >> 6), lane = tid & 63, wr = wid >> 2, wc = wid & 3, fr = lane & 15, fq = lane >> 4;
    const int K = g.K, nt = K / BK;
    unsigned voffA[2], voffB[2];
#pragma unroll
    for (int i = 0; i < 2; ++i) { int R, C; stage_rc(tid * 16 + i * 8192, R, C); const int Rb = Epi::PERM ? ((R & ~31) + perm32(R & 31)) : R;
        voffA[i] = (unsigned)(R * K + C) * 2u; voffB[i] = (unsigned)(Rb * K + C) * 2u; }
    const size_t kstep = (size_t)(BK * 2);
    const size_t hstep = (size_t)HALF * K * 2;
    const size_t tstep = 2 * hstep;
    const unsigned ldsw = (unsigned)wid * 1024u;
    const int aoff = lds_byte(wr * 64 + fr, fq * 8), boff = lds_byte(wc * 32 + fr, fq * 8);
#define PG8_SA(b, h) (((b) * 2 + (h)) * HTB)
#define PG8_SB(b, h) ((4 + (b) * 2 + (h)) * HTB)
#define PG8_STAGE(bufoff, gbase, voff) do { _Pragma("unroll") for (int _i = 0; _i < 2; ++_i) \
        __builtin_amdgcn_global_load_lds((const unsigned*)((const char*)(gbase) + (voff)[_i]), (PG8_LAS unsigned*)(lds + (bufoff) + ldsw + _i * 8192), 16, 0, 0); } while (0)
#define PG8_LDA(dst, b, h) do { _Pragma("unroll") for (int m = 0; m < 4; ++m) _Pragma("unroll") for (int k = 0; k < 2; ++k) dst[m][k] = *(const PG8_LAS bf16x8*)(lds + PG8_SA(b, h) + aoff + m * 2048 + k * 1024); } while (0)
#define PG8_LDB(dst, b, h) do { _Pragma("unroll") for (int n = 0; n < 2; ++n) _Pragma("unroll") for (int k = 0; k < 2; ++k) dst[n][k] = *(const PG8_LAS bf16x8*)(lds + PG8_SB(b, h) + boff + n * 2048 + k * 1024); } while (0)
#define PG8_MMA(ai, bj, At, Bt) do { __builtin_amdgcn_s_setprio(1); _Pragma("unroll") for (int m = 0; m < 4; ++m) _Pragma("unroll") for (int n = 0; n < 2; ++n) _Pragma("unroll") for (int k = 0; k < 2; ++k) \
        acc[ai][bj][m][n] = __builtin_amdgcn_mfma_f32_16x16x32_bf16(Bt[n][k], At[m][k], acc[ai][bj][m][n], 0, 0, 0); __builtin_amdgcn_s_setprio(0); } while (0)
#define PG8_WAIT_V(n) asm volatile("s_waitcnt vmcnt(" #n ")" ::: "memory")
#define PG8_WAIT_L(n) asm volatile("s_waitcnt lgkmcnt(" #n ")" ::: "memory")
#define PG8_BAR __builtin_amdgcn_s_barrier()
#define PG8_SCHED __builtin_amdgcn_sched_barrier(0)
    Unit cur, nxt; int ui = 0;
    if (!S.next(0, cur)) return;
    f32x4 acc[2][2][4][2];
#pragma unroll
    for (int a = 0; a < 2; ++a)
#pragma unroll
        for (int b = 0; b < 2; ++b)
#pragma unroll
            for (int m = 0; m < 4; ++m)
#pragma unroll
                for (int n = 0; n < 2; ++n) acc[a][b][m][n] = (f32x4){0.f, 0.f, 0.f, 0.f};
    bf16x8 At[4][2], B0[2][2], B1[2][2];
    const char* cA = (const char*)g.A + (size_t)cur.pm * tstep; const char* cB = (const char*)g.Bt + (size_t)cur.pn * tstep;
    S.a_ready(cur);
    if constexpr (SP2) {
        PG8_STAGE(PG8_SB(0, 0), cB, voffB); PG8_STAGE(PG8_SB(0, 1), cB + hstep, voffB); PG8_STAGE(PG8_SA(0, 0), cA, voffA); PG8_STAGE(PG8_SA(0, 1), cA + hstep, voffA);
        if (wr == 1) PG8_BAR;
        PG8_WAIT_V(2); PG8_BAR;
        PG8_STAGE(PG8_SB(1, 0), cB + kstep, voffB); PG8_STAGE(PG8_SA(1, 0), cA + kstep, voffA); PG8_STAGE(PG8_SB(1, 1), cB + hstep + kstep, voffB);
        PG8_WAIT_V(6); PG8_BAR;
    } else {
        PG8_STAGE(PG8_SB(0, 0), cB, voffB); PG8_STAGE(PG8_SA(0, 0), cA, voffA); PG8_STAGE(PG8_SB(0, 1), cB + hstep, voffB); PG8_STAGE(PG8_SA(0, 1), cA + hstep, voffA);
        if (wr == 1) PG8_BAR;
        PG8_WAIT_V(4); PG8_BAR;
        PG8_STAGE(PG8_SB(1, 0), cB + kstep, voffB); PG8_STAGE(PG8_SA(1, 0), cA + kstep, voffA); PG8_STAGE(PG8_SB(1, 1), cB + hstep + kstep, voffB);
        PG8_WAIT_V(6); PG8_BAR;
    }
    for (;;) {
        const bool has_next = S.next(ui + 1, nxt);
        const char* nA = has_next ? (const char*)g.A + (size_t)nxt.pm * tstep : cA; const char* nB = has_next ? (const char*)g.Bt + (size_t)nxt.pn * tstep : cB;
        for (int t = 0; t < nt; t += 2) {
            const bool last = (t == nt - 2);
            const char* a1 = cA + (size_t)(t + 1) * kstep;
            const char* a2 = last ? nA : cA + (size_t)(t + 2) * kstep; const char* b2 = last ? nB : cB + (size_t)(t + 2) * kstep;
            const char* a3 = a2 + kstep; const char* b3 = b2 + kstep;
            if (last && has_next) S.a_ready(nxt);
            if constexpr (SP2) {
            PG8_LDB(B0, 0, 0); PG8_LDB(B1, 0, 1); PG8_SCHED; PG8_LDA(At, 0, 0); PG8_STAGE(PG8_SA(1, 1), a1 + hstep, voffA);
            PG8_WAIT_V(8); PG8_WAIT_L(0); PG8_BAR; PG8_MMA(0, 0, At, B0); PG8_MMA(0, 1, At, B1); PG8_BAR; PG8_SCHED;
            PG8_LDA(At, 0, 1); PG8_STAGE(PG8_SB(0, 0), b2, voffB); PG8_STAGE(PG8_SB(0, 1), b2 + hstep, voffB); PG8_STAGE(PG8_SA(0, 0), a2, voffA);
            PG8_WAIT_V(8); PG8_WAIT_L(0); PG8_BAR; PG8_MMA(1, 0, At, B0); PG8_MMA(1, 1, At, B1); PG8_BAR; PG8_SCHED;
            PG8_LDB(B0, 1, 0); PG8_LDB(B1, 1, 1); PG8_SCHED; PG8_LDA(At, 1, 0); PG8_STAGE(PG8_SA(0, 1), a2 + hstep, voffA);
            PG8_WAIT_V(8); PG8_WAIT_L(0); PG8_BAR; PG8_MMA(0, 0, At, B0); PG8_MMA(0, 1, At, B1); PG8_BAR; PG8_SCHED;
            PG8_LDA(At, 1, 1); PG8_STAGE(PG8_SB(1, 0), b3, voffB); PG8_STAGE(PG8_SB(1, 1), b3 + hstep, voffB); PG8_STAGE(PG8_SA(1, 0), a3, voffA);
            PG8_WAIT_V(8); PG8_WAIT_L(0); PG8_BAR; PG8_MMA(1, 0, At, B0); PG8_MMA(1, 1, At, B1); PG8_BAR; PG8_SCHED;
            } else {
            PG8_LDB(B0, 0, 0); PG8_SCHED; PG8_LDA(At, 0, 0); PG8_STAGE(PG8_SA(1, 1), a1 + hstep, voffA);
            PG8_WAIT_L(8); PG8_BAR; PG8_WAIT_L(0); PG8_MMA(0, 0, At, B0); PG8_BAR; PG8_SCHED;
            PG8_LDB(B1, 0, 1); PG8_STAGE(PG8_SB(0, 0), b2, voffB);
            PG8_BAR; PG8_WAIT_L(0); PG8_MMA(0, 1, At, B1); PG8_BAR;
            PG8_LDA(At, 0, 1); PG8_STAGE(PG8_SA(0, 0), a2, voffA);
            PG8_BAR; PG8_WAIT_L(0); PG8_MMA(1, 0, At, B0); PG8_BAR; PG8_SCHED;
            PG8_STAGE(PG8_SB(0, 1), b2 + hstep, voffB);
            PG8_WAIT_V(6); PG8_BAR; PG8_MMA(1, 1, At, B1); PG8_BAR;
            PG8_LDB(B0, 1, 0); PG8_SCHED; PG8_LDA(At, 1, 0); PG8_STAGE(PG8_SA(0, 1), a2 + hstep, voffA);
            PG8_WAIT_L(8); PG8_BAR; PG8_WAIT_L(0); PG8_MMA(0, 0, At, B0); PG8_BAR; PG8_SCHED;
            PG8_LDB(B1, 1, 1); PG8_STAGE(PG8_SB(1, 0), b3, voffB);
            PG8_BAR; PG8_WAIT_L(0); PG8_MMA(0, 1, At, B1); PG8_BAR;
            PG8_LDA(At, 1, 1); PG8_STAGE(PG8_SA(1, 0), a3, voffA);
            PG8_BAR; PG8_WAIT_L(0); PG8_MMA(1, 0, At, B0); PG8_BAR; PG8_SCHED;
            PG8_STAGE(PG8_SB(1, 1), b3 + hstep, voffB);
            PG8_WAIT_V(6); PG8_BAR; PG8_MMA(1, 1, At, B1); PG8_BAR;
            }
        }
        if constexpr (ALIGN_EPI) { if (wr == 0) PG8_BAR; }
        if constexpr (!Epi::AFTER_DRAIN) { E(acc, cur, wr, wc, fr, fq); S.done(cur); }
        if (!has_next) break;
#pragma unroll
        for (int a = 0; a < 2; ++a)
#pragma unroll
            for (int b = 0; b < 2; ++b)
#pragma unroll
                for (int m = 0; m < 4; ++m)
#pragma unroll
                    for (int n = 0; n < 2; ++n) acc[a][b][m][n] = (f32x4){0.f, 0.f, 0.f, 0.f};
        cur = nxt; cA = nA; cB = nB; ++ui;
        if constexpr (ALIGN_EPI) { if (wr == 1) PG8_BAR; }
    }
    PG8_WAIT_V(0);
    if constexpr (!ALIGN_EPI) { if (wr == 0) PG8_BAR; }
    PG8_BAR;
    if constexpr (Epi::AFTER_DRAIN) { E.fused(acc, cur, wr, wc, fr, fq, lds, wid, lane); S.done(cur); }
#undef PG8_SA
#undef PG8_SB
#undef PG8_STAGE
#undef PG8_LDA
#undef PG8_LDB
#undef PG8_MMA
#undef PG8_WAIT_V
#undef PG8_WAIT_L
#undef PG8_BAR
#undef PG8_SCHED
}
}

#define XB_TMO      128
#define XB_XCNT(j)  (256  + 64 * (j))
#define XB_XSUB(j)  (1280 + 64 * (j))
#define XB_XGEN(j)  (2304 + 64 * (j))
#define XB_TOP      3328
#define XB_TOPGEN   3392
#define XCD_BAR_WORDS 3456
#define XB_SPIN_CAP (1u << 18)

__device__ __forceinline__ unsigned xb_ld(unsigned* p)              { return __hip_atomic_load(p, __ATOMIC_RELAXED, __HIP_MEMORY_SCOPE_AGENT); }
__device__ __forceinline__ unsigned xb_add(unsigned* p, unsigned v) { return __hip_atomic_fetch_add(p, v, __ATOMIC_RELAXED, __HIP_MEMORY_SCOPE_AGENT); }
__device__ __forceinline__ unsigned xb_xcc_id() { return (unsigned)__builtin_amdgcn_s_getreg((3 << 11) | 20) & 0xFu; }
#define XB_SPIN(cond, bar) do { unsigned _sp = 0; while (cond) { __builtin_amdgcn_s_sleep(1); \
    if ((++_sp & 255u) == 0u) { if (xb_ld(&(bar)[XB_TMO])) break; if (_sp > XB_SPIN_CAP) { atomicAdd(&(bar)[XB_TMO], 1u); break; } } } } while (0)

struct XcdBarrier {
    unsigned* bar; unsigned x;
    volatile LAS unsigned* st;
};

__device__ __forceinline__ XcdBarrier xcd_barrier_post(unsigned* bar, volatile LAS unsigned* st) {
    XcdBarrier b; b.bar = bar; b.x = xb_xcc_id(); b.st = st;
    if (threadIdx.x == 0) (void)xb_add(&bar[XB_XCNT(b.x)], 1u);
    return b;
}
__device__ __forceinline__ void xcd_barrier_complete(unsigned* bar, unsigned x, unsigned& nloc, unsigned& nx) {
    const unsigned G = gridDim.x * gridDim.y * gridDim.z;
    unsigned sum, cnt, mine, sp = 0u;
    for (;;) {
        sum = 0u; cnt = 0u; mine = 0u;
#pragma unroll
        for (unsigned j = 0; j < 16; ++j) { const unsigned c = xb_ld(&bar[XB_XCNT(j)]); sum += c; cnt += (c > 0u) ? 1u : 0u; mine = (j == x) ? c : mine; }
        if (sum == G) break;
        __builtin_amdgcn_s_sleep(1);
        if ((++sp & 255u) == 0u) { if (xb_ld(&bar[XB_TMO])) break; if (sp > XB_SPIN_CAP) { atomicAdd(&bar[XB_TMO], 1u); break; } }
    }
    nloc = mine > 0u ? mine : 1u; nx = cnt > 0u ? cnt : 1u;
}

__device__ __forceinline__ void xcd_barrier(const XcdBarrier& b) {
    asm volatile("s_waitcnt vmcnt(0)" ::: "memory");
    __syncthreads();
    if (threadIdx.x == 0) {
        unsigned* bar = b.bar;
        __builtin_amdgcn_s_waitcnt(0);
        unsigned nloc = b.st[0], nx = b.st[1];
        if (nloc == 0u) { xcd_barrier_complete(bar, b.x, nloc, nx); b.st[0] = nloc; b.st[1] = nx; }
        const unsigned old = xb_add(&bar[XB_XSUB(b.x)], 1u);
        const unsigned gen = old / nloc;
        if (old + 1u == (gen + 1u) * nloc) {
            __builtin_amdgcn_fence(__ATOMIC_RELEASE, "agent");
            asm volatile("s_waitcnt vmcnt(0)" ::: "memory");
            const unsigned og = xb_add(&bar[XB_TOP], 1u);
            const unsigned tg = og / nx;
            if (og + 1u == (tg + 1u) * nx) xb_add(&bar[XB_TOPGEN], 1u);
            else XB_SPIN(xb_ld(&bar[XB_TOPGEN]) == tg, bar);
            __builtin_amdgcn_fence(__ATOMIC_ACQUIRE, "agent");
            xb_add(&bar[XB_XGEN(b.x)], 1u);
            asm volatile("s_waitcnt vmcnt(0)" ::: "memory");
        } else {
            XB_SPIN(xb_ld(&bar[XB_XGEN(b.x)]) == gen, bar);
            __builtin_amdgcn_fence(__ATOMIC_ACQUIRE, "agent");
            asm volatile("s_waitcnt vmcnt(0)" ::: "memory");
        }
    }
    __syncthreads();
}

__device__ __forceinline__ void lerp8(const P& p, int row, int col, float* o) {
    const bf16* PROJ = (const bf16*)(p.ws + WS_PROJ);
    float cur[8], prv[8];
    unpack8(*(const u32x4*)(PROJ + (size_t)row * PLD + col), cur);
    if (row >= MPR) { const float* s = p.in[2] + (size_t)(row - MPR) * RPJ + col; const f32x4 a = *(const f32x4*)s, b = *(const f32x4*)(s + 4);
        prv[0] = a[0]; prv[1] = a[1]; prv[2] = a[2]; prv[3] = a[3]; prv[4] = b[0]; prv[5] = b[1]; prv[6] = b[2]; prv[7] = b[3]; }
    else if ((row & (SEQ - 1)) == 0) {
#pragma unroll
        for (int i = 0; i < 8; ++i) prv[i] = 0.f; }
    else unpack8(*(const u32x4*)(PROJ + (size_t)(row - 1) * PLD + col), prv);
    const float* mu = p.in[7] + col; const f32x4 m0 = *(const f32x4*)mu, m1 = *(const f32x4*)(mu + 4);
#pragma unroll
    for (int i = 0; i < 4; ++i) { o[i] = cur[i] + (prv[i] - cur[i]) * m0[i]; o[4 + i] = cur[4 + i] + (prv[4 + i] - cur[4 + i]) * m1[i]; }
}
__device__ __forceinline__ float lerp1(const P& p, int row, int col) {
    const bf16* PROJ = (const bf16*)(p.ws + WS_PROJ);
    const float cur = bf2f(PROJ[(size_t)row * PLD + col]); float prv;
    if (row >= MPR) prv = p.in[2][(size_t)(row - MPR) * RPJ + col];
    else if ((row & (SEQ - 1)) == 0) prv = 0.f;
    else prv = bf2f(PROJ[(size_t)(row - 1) * PLD + col]);
    return cur + (prv - cur) * p.in[7][col];
}

__device__ __forceinline__ void transpose_item(const float* W, int K, int N, bf16* WT, float* scr, int item, int lane) {
    const int nblk = (N + 31) / 32, kb = item / nblk, nb = item % nblk, k0 = 64 * kb, n0 = 32 * nb;
    float tv[32];
#pragma unroll
    for (int i = 0; i < 32; ++i) { const int kk = 2 * i + (lane >> 5), n = n0 + (lane & 31); tv[i] = (n < N) ? W[(size_t)(k0 + kk) * N + n] : 0.f; }
#pragma unroll
    for (int i = 0; i < 32; ++i) { const int kk = 2 * i + (lane >> 5); scr[kk * 33 + (lane & 31)] = tv[i]; }
    LDS_FENCE();
    const int c = lane & 7;
#pragma unroll
    for (int j = 0; j < 4; ++j) { const int n = (lane >> 3) + 8 * j; const float* s = scr + (8 * c) * 33 + n;
        u32x4 o; o.x = pkbf(s[0 * 33], s[1 * 33]); o.y = pkbf(s[2 * 33], s[3 * 33]); o.z = pkbf(s[4 * 33], s[5 * 33]); o.w = pkbf(s[6 * 33], s[7 * 33]);
        *(u32x4*)(WT + (size_t)(n0 + n) * K + k0 + 8 * c) = o; }
    LDS_FENCE();
}

__device__ __forceinline__ void phase0(const P& p_in, unsigned char* smem) {
    PHASE_PROLOGUE;
    const int lane = tid & 63, wave = tid >> 6, G = gridDim.x, bid = blockIdx.x;
    const int gw = bid * 8 + wave, NGW = G * 8; const size_t gt = (size_t)bid * 512 + tid, NGT = (size_t)G * 512;
    bf16* XB = (bf16*)(p.ws + WS_XB);
#pragma unroll 4
    for (size_t i = gt; i < (size_t)MTOT * DM / 8; i += NGT) { const size_t e = i * 8; const float* src = e < (size_t)MPR * DM ? p.in[0] + e : p.in[1] + (e - (size_t)MPR * DM);
        const f32x4 a = *(const f32x4*)src, b = *(const f32x4*)(src + 4); u32x4 o; o.x = pkbf(a[0], a[1]); o.y = pkbf(a[2], a[3]); o.z = pkbf(b[0], b[1]); o.w = pkbf(b[2], b[3]); *(u32x4*)(XB + e) = o; }
    float* scr = (float*)(smem + wave * 8448);
    constexpr int I_IN = 16 * 105, I_WU = 16, I_AU = 16, I_GU = 32;
    constexpr int NIT = I_IN + I_WU + I_AU + I_GU;
    for (int it = gw; it < NIT; it += NGW) {
        int r = it;
        if (r < I_IN) { transpose_item(p.in[6], 1024, PROJN, (bf16*)(p.ws + WS_WIN), scr, r, lane); continue; } r -= I_IN;
        if (r < I_WU) { transpose_item(p.in[9], 64, 512, (bf16*)(p.ws + WS_LORA), scr, r, lane); continue; } r -= I_WU;
        if (r < I_AU) { transpose_item(p.in[11], 64, 512, (bf16*)(p.ws + WS_LORA + 65536), scr, r, lane); continue; } r -= I_AU;
        transpose_item(p.in[12], 128, 512, (bf16*)(p.ws + WS_LORA + 131072), scr, r, lane);
    }
    for (size_t i = gt; i < (size_t)MSM * 2048 / 4; i += NGT) { const size_t idx = i * 4, b = idx >> 11, rem = idx & 2047;
        *(f32x4*)(p.out + O_CONVS + b * 3072 + rem) = *(const f32x4*)(p.in[4] + b * 3072 + 1024 + rem); }
}

__device__ __forceinline__ void phase0_late(const P& p_in, unsigned char* smem, int first, int which) {
    PHASE_PROLOGUE;
    const int lane = tid & 63, wave = tid >> 6, G = gridDim.x, bid = blockIdx.x;
    if (bid < first) return;
    const int gw = (bid - first) * 8 + wave, NGW = (G - first) * 8;
    float* scr = (float*)(smem + wave * 8448);
    constexpr int I_OUT = 16 * 32, I_F1 = 16 * 128, I_F2 = 64 * 32;
    const int lo = which ? I_OUT + I_F1 : 0, hi = which ? I_OUT + I_F1 + I_F2 : I_OUT + I_F1;
    for (int it = lo + gw; it < hi; it += NGW) {
        int r = it;
        if (r < I_OUT) { transpose_item(p.in[24], 1024, 1024, (bf16*)(p.ws + WS_WOUT), scr, r, lane); continue; } r -= I_OUT;
        if (r < I_F1) { transpose_item(p.in[27], 1024, 4096, (bf16*)(p.ws + WS_WFF1), scr, r, lane); continue; } r -= I_F1;
        transpose_item(p.in[28], 4096, 1024, (bf16*)(p.ws + WS_WFF2), scr, r, lane);
    }
}

template <int RG, int K, class F> __device__ __forceinline__ void small_gemm(const bf16* A, const bf16* Bt, int N, unsigned char* smem, const F& epi, int first = 0) {
    int tid = threadIdx.x; asm volatile("" : "+v"(tid));
    const int lane = tid & 63, wave = tid >> 6, r = lane & 15, q = lane >> 4;
    constexpr int KS = K / 8, NST = KS / 32, RGN = 8 / RG;
    const int nunits = ((N + 15) / 16) * RGN;
    float* part = (float*)smem;
    for (int u = (int)gridDim.x - 1 - (int)blockIdx.x; u < nunits && (int)blockIdx.x >= first; u += (int)gridDim.x - first) {
        const int ct = u / RGN, rg = u - ct * RGN, n0 = ct * 16;
        f32x4 acc[RG];
#pragma unroll
        for (int t = 0; t < RG; ++t) acc[t] = (f32x4){0.f, 0.f, 0.f, 0.f};
        const bf16* ap = A + (size_t)(rg * RG * 16 + r) * K + wave * KS + q * 8;
        const bf16* bp = Bt + (size_t)(n0 + r) * K + wave * KS + q * 8;
#pragma unroll 8
        for (int ks = 0; ks < NST; ++ks) {
            const bf16x8 b = *(const bf16x8*)(bp + ks * 32);
#pragma unroll
            for (int t = 0; t < RG; ++t) acc[t] = mfma16(*(const bf16x8*)(ap + (size_t)t * 16 * K + ks * 32), b, acc[t]);
        }
#pragma unroll
        for (int t = 0; t < RG; ++t)
#pragma unroll
            for (int j = 0; j < 4; ++j) part[(wave * RG + t) * 256 + (q * 4 + j) * 16 + r] = acc[t][j];
        __syncthreads();
        for (int e = tid; e < RG * 256; e += 512) { const int t = e >> 8, idx = e & 255; float v = 0.f;
#pragma unroll
            for (int w = 0; w < 8; ++w) v += part[(w * RG + t) * 256 + idx];
            const int col = n0 + (idx & 15);
            if (col < N) epi((rg * RG + t) * 16 + (idx >> 4), col, v); }
        __syncthreads();
    }
}

__device__ __forceinline__ void phase_prep(const P& p_in, unsigned char* smem) {
    PHASE_PROLOGUE;
    const int lane = tid & 63, wave = tid >> 6, G = gridDim.x, bid = blockIdx.x, r = lane & 15, q = lane >> 4;
    const bf16* WUPT = (const bf16*)(p.ws + WS_LORA); const bf16* AUPT = (const bf16*)(p.ws + WS_LORA + 65536); const bf16* GUPT = (const bf16*)(p.ws + WS_LORA + 131072);
    const bf16* PROJ = (const bf16*)(p.ws + WS_PROJ);
    float* WD = p.out + OS_WD; bf16* GG = (bf16*)(p.out + OS_GG);
    bf16* KP = (bf16*)(p.ws + WS_KP); bf16* KK = (bf16*)(p.ws + WS_KK); bf16* KB = (bf16*)(p.ws + WS_KB);
    bf16* WU = (bf16*)smem; bf16* AU = WU + 64 * 72; bf16* GU = AU + 64 * 72;
    bf16* kcur = (bf16*)(smem + 35840 + wave * 4608); bf16* kprv = kcur + 16 * 72;
#pragma unroll 1
    for (int tile = bid; tile < MTOT / 128; tile += G) {
        const int item = tile * 8 + wave, rowa = item * 16 + r;
        bf16x8 aw[2], aa[2], ag[4];
        float u[8];
#pragma unroll
        for (int ks = 0; ks < 2; ++ks) { lerp8(p, rowa, 1536 + ks * 32 + q * 8, u);
#pragma unroll
            for (int i = 0; i < 8; ++i) u[i] = tanh_(u[i]);
            aw[ks] = __builtin_bit_cast(bf16x8, pack8(u)); }
#pragma unroll
        for (int ks = 0; ks < 2; ++ks) { lerp8(p, rowa, 1600 + ks * 32 + q * 8, u); aa[ks] = __builtin_bit_cast(bf16x8, pack8(u)); }
#pragma unroll
        for (int ks = 0; ks < 4; ++ks) { lerp8(p, rowa, 1664 + ks * 32 + q * 8, u);
#pragma unroll
            for (int i = 0; i < 8; ++i) u[i] = sigm(u[i]);
            ag[ks] = __builtin_bit_cast(bf16x8, pack8(u)); }
        u32x4 pw, pa, pg[2];
#define PREP_LOAD(hh_) do { const int c_ = tid >> 3, k8_ = (tid & 7) * 8; \
            pw = *(const u32x4*)(WUPT + (size_t)((hh_) * 64 + c_) * 64 + k8_); pa = *(const u32x4*)(AUPT + (size_t)((hh_) * 64 + c_) * 64 + k8_); \
            _Pragma("unroll") for (int i = 0; i < 2; ++i) { const int pc_ = tid + i * 512, c2_ = pc_ >> 4, k82_ = (pc_ & 15) * 8; pg[i] = *(const u32x4*)(GUPT + (size_t)((hh_) * 64 + c2_) * 128 + k82_); } } while (0)
        PREP_LOAD(0);
#pragma unroll 1
        for (int h = 0; h < 8; ++h) {
            __syncthreads();
            { const int c = tid >> 3, k8 = (tid & 7) * 8;
              *(u32x4*)(WU + c * 72 + k8) = pw; *(u32x4*)(AU + c * 72 + k8) = pa;
#pragma unroll
              for (int i = 0; i < 2; ++i) { const int pc = tid + i * 512, c2 = pc >> 4, k82 = (pc & 15) * 8; *(u32x4*)(GU + c2 * 136 + k82) = pg[i]; } }
#pragma unroll
            for (int i = 0; i < 2; ++i) { const int pc = lane + i * 64, rr = pc >> 3, c8 = (pc & 7) * 8, row = item * 16 + rr, col = 512 + h * 64 + c8;
                *(u32x4*)(kcur + rr * 72 + c8) = *(const u32x4*)(PROJ + (size_t)row * PLD + col);
                u32x4 pv = {0u, 0u, 0u, 0u};
                if (row >= MPR) { const float* sp = p.in[2] + (size_t)(row - MPR) * RPJ + col; const f32x4 a = *(const f32x4*)sp, b = *(const f32x4*)(sp + 4); pv.x = pkbf(a[0], a[1]); pv.y = pkbf(a[2], a[3]); pv.z = pkbf(b[0], b[1]); pv.w = pkbf(b[2], b[3]); }
                else if ((row & (SEQ - 1)) != 0) pv = *(const u32x4*)(PROJ + (size_t)(row - 1) * PLD + col);
                *(u32x4*)(kprv + rr * 72 + c8) = pv; }
            if (h + 1 < 8) PREP_LOAD(h + 1);
            __syncthreads();
            float ss[4] = {0.f, 0.f, 0.f, 0.f};
#pragma unroll
            for (int ctl = 0; ctl < 4; ++ctl) { const int cl = ctl * 16 + r, col = h * 64 + cl; const float kkc = p.in[13][col], muc = p.in[7][512 + col];
#pragma unroll
                for (int j = 0; j < 4; ++j) { const float kc = bf2f(kcur[(q * 4 + j) * 72 + cl]), kv = bf2f(kprv[(q * 4 + j) * 72 + cl]); const float kr = (kc + (kv - kc) * muc) * kkc; ss[j] += kr * kr; } }
#pragma unroll
            for (int j = 0; j < 4; ++j) { ss[j] = sum16(ss[j]); ss[j] = rsqrtf(fmaxf(ss[j], 1e-24f)); }
#pragma unroll 1
            for (int ctl = 0; ctl < 4; ++ctl) {
                const int cl = ctl * 16 + r, col = h * 64 + cl;
                f32x4 cw = {0.f, 0.f, 0.f, 0.f}, ca = cw, cgt = cw;
#pragma unroll
                for (int ks = 0; ks < 2; ++ks) { cw = mfma16(aw[ks], *(const bf16x8*)(WU + cl * 72 + ks * 32 + q * 8), cw); ca = mfma16(aa[ks], *(const bf16x8*)(AU + cl * 72 + ks * 32 + q * 8), ca); }
#pragma unroll
                for (int ks = 0; ks < 4; ++ks) cgt = mfma16(ag[ks], *(const bf16x8*)(GU + cl * 136 + ks * 32 + q * 8), cgt);
                const float w0c = p.in[8][col], a0c = p.in[10][col], kkc = p.in[13][col], kac = p.in[14][col], muc = p.in[7][512 + col];
#pragma unroll
                for (int j = 0; j < 4; ++j) {
                    const int row = item * 16 + q * 4 + j; const size_t o = (size_t)row * 512 + col;
                    const float wl = -softplus(-(w0c + cw[j])) - 0.5f;
                    WD[o] = __expf(-__expf(wl));
                    const float a = sigm(a0c + ca[j]);
                    GG[o] = f2bf(cgt[j]);
                    const float kc = bf2f(kcur[(q * 4 + j) * 72 + cl]), kv = bf2f(kprv[(q * 4 + j) * 72 + cl]); const float k = kc + (kv - kc) * muc;
                    KP[o] = f2bf(k * (1.f + (a - 1.f) * kac));
                    const float kk = k * kkc * ss[j];
                    KK[o] = f2bf(kk); KB[o] = f2bf(kk * a);
                }
            }
        }
    }
    __syncthreads();
#undef PREP_LOAD
    bf16* XBC = (bf16*)(p.ws + WS_XBC);
    const int ntl = MTOT / 128, cb = (G > ntl + 32) ? ntl : 0;
    if (bid < cb) return;
    const size_t gt = (size_t)(bid - cb) * 512 + tid, NGT = (size_t)(G - cb) * 512;
    for (size_t idx = gt; idx < (size_t)MPR * 128; idx += NGT) {
        const int row = (int)(idx >> 7), c0 = (int)(idx & 127) * 8, t = row & (SEQ - 1);
        float acc[8], x[8];
        { const f32x4 b0 = *(const f32x4*)(p.in[19] + c0), b1 = *(const f32x4*)(p.in[19] + c0 + 4);
#pragma unroll
          for (int i = 0; i < 4; ++i) { acc[i] = b0[i]; acc[4 + i] = b1[i]; } }
#pragma unroll
        for (int d = 0; d < 4; ++d) { if (t - 3 + d < 0) continue;
            unpack8(*(const u32x4*)(PROJ + (size_t)(row - 3 + d) * PLD + 2304 + c0), x);
            const f32x4 w0 = *(const f32x4*)(p.in[18] + d * 1024 + c0), w1 = *(const f32x4*)(p.in[18] + d * 1024 + c0 + 4);
#pragma unroll
            for (int i = 0; i < 4; ++i) { acc[i] += w0[i] * x[i]; acc[4 + i] += w1[i] * x[4 + i]; } }
#pragma unroll
        for (int i = 0; i < 8; ++i) acc[i] = silu(acc[i]);
        *(u32x4*)(XBC + (size_t)row * 1024 + c0) = pack8(acc);
    }
}

constexpr int TC = 32, SBUF = 5 * TC * 64 + TC * 16 + TC * 2;
struct StageRegs { f32x4 w0, w1; u32x4 kp, kk, kb, rc, rp, vc, vp; };
__device__ __forceinline__ void scan_issue(const P& p, StageRegs& R, int row0, int h, int vq, int st) {
    const float* WD = p.out + OS_WD; const bf16* KP = (const bf16*)(p.ws + WS_KP); const bf16* KK = (const bf16*)(p.ws + WS_KK); const bf16* KB = (const bf16*)(p.ws + WS_KB); const bf16* PROJ = (const bf16*)(p.ws + WS_PROJ);
    const int tt = st >> 3, k8 = (st & 7) * 8, row = row0 + tt, prow = (row & (SEQ - 1)) ? row - 1 : row; const size_t o = (size_t)row * 512 + h * 64 + k8;
    R.w0 = *(const f32x4*)(WD + o); R.w1 = *(const f32x4*)(WD + o + 4); R.kp = *(const u32x4*)(KP + o); R.kk = *(const u32x4*)(KK + o); R.kb = *(const u32x4*)(KB + o);
    R.rc = *(const u32x4*)(PROJ + (size_t)row * PLD + h * 64 + k8); R.rp = *(const u32x4*)(PROJ + (size_t)prow * PLD + h * 64 + k8);
    if (st < 64) { const int t2 = st >> 1, v8 = (st & 1) * 8, row2 = row0 + t2, prow2 = (row2 & (SEQ - 1)) ? row2 - 1 : row2;
        R.vc = *(const u32x4*)(PROJ + (size_t)row2 * PLD + 1024 + h * 64 + vq * 16 + v8); R.vp = *(const u32x4*)(PROJ + (size_t)prow2 * PLD + 1024 + h * 64 + vq * 16 + v8); }
}
__device__ __forceinline__ void scan_commit(const StageRegs& R, float* B, int row0, int st, const float* mur, const float* muv) {
    const int tt = st >> 3, k8 = (st & 7) * 8; float kp[8], kb[8], v[8], rc[8], rp[8];
    *(f32x4*)(B + tt * 64 + k8) = R.w0; *(f32x4*)(B + tt * 64 + k8 + 4) = R.w1;
    unpack8(R.kp, kp); *(f32x4*)(B + TC * 64 + tt * 64 + k8) = (f32x4){kp[0], kp[1], kp[2], kp[3]}; *(f32x4*)(B + TC * 64 + tt * 64 + k8 + 4) = (f32x4){kp[4], kp[5], kp[6], kp[7]};
    unpack8(R.kk, v); *(f32x4*)(B + 2 * TC * 64 + tt * 64 + k8) = (f32x4){-v[0], -v[1], -v[2], -v[3]}; *(f32x4*)(B + 2 * TC * 64 + tt * 64 + k8 + 4) = (f32x4){-v[4], -v[5], -v[6], -v[7]};
    unpack8(R.kb, kb); *(f32x4*)(B + 3 * TC * 64 + tt * 64 + k8) = (f32x4){kb[0], kb[1], kb[2], kb[3]}; *(f32x4*)(B + 3 * TC * 64 + tt * 64 + k8 + 4) = (f32x4){kb[4], kb[5], kb[6], kb[7]};
    unpack8(R.rc, rc); unpack8(R.rp, rp); const float pz = ((row0 + tt) & (SEQ - 1)) ? 1.f : 0.f;
    float c1 = 0.f, c2 = 0.f;
#pragma unroll
    for (int j = 0; j < 8; ++j) { v[j] = rc[j] + (rp[j] * pz - rc[j]) * mur[j]; c1 += kb[j] * v[j]; c2 += kp[j] * v[j]; }
    *(f32x4*)(B + 4 * TC * 64 + tt * 64 + k8) = (f32x4){R.w0[0] * v[0], R.w0[1] * v[1], R.w0[2] * v[2], R.w0[3] * v[3]}; *(f32x4*)(B + 4 * TC * 64 + tt * 64 + k8 + 4) = (f32x4){R.w1[0] * v[4], R.w1[1] * v[5], R.w1[2] * v[6], R.w1[3] * v[7]};
    c1 += __shfl_xor(c1, 1); c2 += __shfl_xor(c2, 1); c1 += __shfl_xor(c1, 2); c2 += __shfl_xor(c2, 2); c1 += __shfl_xor(c1, 4); c2 += __shfl_xor(c2, 4);
    if ((st & 7) == 0) { B[5 * TC * 64 + TC * 16 + tt * 2] = c1; B[5 * TC * 64 + TC * 16 + tt * 2 + 1] = c2; }
    if (st < 64) { const int t2 = st >> 1, v8 = (st & 1) * 8; unpack8(R.vc, rc); unpack8(R.vp, rp); const float pz2 = ((row0 + t2) & (SEQ - 1)) ? 1.f : 0.f;
#pragma unroll
        for (int j = 0; j < 8; ++j) v[j] = rc[j] + (rp[j] * pz2 - rc[j]) * muv[j];
        *(f32x4*)(B + 5 * TC * 64 + t2 * 16 + v8) = (f32x4){v[0], v[1], v[2], v[3]}; *(f32x4*)(B + 5 * TC * 64 + t2 * 16 + v8 + 4) = (f32x4){v[4], v[5], v[6], v[7]}; }
}
struct ScanIn { f32x4 w, kp, ka, kb, wr; float vv, c1, c2; };
__device__ __forceinline__ ScanIn scan_load(const float* B, int tt, int kg, int rloc) {
    ScanIn s; s.w = *(const f32x4*)(B + tt * 64 + kg * 4); s.kp = *(const f32x4*)(B + TC * 64 + tt * 64 + kg * 4); s.ka = *(const f32x4*)(B + 2 * TC * 64 + tt * 64 + kg * 4);
    s.kb = *(const f32x4*)(B + 3 * TC * 64 + tt * 64 + kg * 4); s.wr = *(const f32x4*)(B + 4 * TC * 64 + tt * 64 + kg * 4);
    s.vv = B[5 * TC * 64 + tt * 16 + rloc]; s.c1 = B[5 * TC * 64 + TC * 16 + tt * 2]; s.c2 = B[5 * TC * 64 + TC * 16 + tt * 2 + 1]; return s;
}
__device__ __forceinline__ void phase_scan(const P& p_in, unsigned char* smem) {
    PHASE_PROLOGUE;
    const int lane = tid & 63, wave = tid >> 6;
    float* buf0 = (float*)smem; float* ybuf = buf0 + 2 * SBUF;
    bf16* YR = (bf16*)(p.ws + WS_XB);
    constexpr int NCH = SEQ / TC;
    for (int unit = blockIdx.x; unit < 256; unit += gridDim.x) {
        const int xcd = unit & 7, slot = unit >> 3, bh = xcd * 8 + (slot >> 2), vq = slot & 3, b = bh >> 3, h = bh & 7, rowbase = b * SEQ;
        bf16* yu = YR + (size_t)(bh * 4 + vq) * SEQ * 16;
        const int st = tid - 256;
        StageRegs R; float mur[8], muv[8];
        if (wave >= 4) {
#pragma unroll
            for (int j = 0; j < 8; ++j) { mur[j] = p.in[7][h * 64 + (st & 7) * 8 + j]; muv[j] = p.in[7][1024 + h * 64 + vq * 16 + (st & 1) * 8 + j]; }
            scan_issue(p, R, rowbase, h, vq, st); scan_commit(R, buf0, rowbase, st, mur, muv); scan_issue(p, R, rowbase + TC, h, vq, st);
        }
        __syncthreads();
        float S0 = 0.f, S1 = 0.f, S2 = 0.f, S3 = 0.f;
        const int rl = lane >> 4, kg = lane & 15, rloc = (wave & 3) * 4 + rl;
        for (int c = 0; c < NCH; ++c) {
            if (wave < 4) {
                const float* B = buf0 + (c & 1) * SBUF; float* yb = ybuf + (c & 1) * (TC * 16);
                ScanIn cur = scan_load(B, 0, kg, rloc);
#pragma unroll 4
                for (int tt = 0; tt < TC; ++tt) {
                    const ScanIn nxt = scan_load(B, (tt + 1) & (TC - 1), kg, rloc);
                    float sa = (S0 * cur.ka[0] + S1 * cur.ka[1]) + (S2 * cur.ka[2] + S3 * cur.ka[3]);
                    float y1 = (S0 * cur.wr[0] + S1 * cur.wr[1]) + (S2 * cur.wr[2] + S3 * cur.wr[3]);
                    sa += dppf<0xB1>(sa); y1 += dppf<0xB1>(y1); sa += dppf<0x4E>(sa); y1 += dppf<0x4E>(y1);
                    sa += dppf<0x141>(sa); y1 += dppf<0x141>(y1); sa += dppf<0x140>(sa); y1 += dppf<0x140>(y1);
                    S0 = S0 * cur.w[0] + (sa * cur.kb[0] + cur.vv * cur.kp[0]); S1 = S1 * cur.w[1] + (sa * cur.kb[1] + cur.vv * cur.kp[1]);
                    S2 = S2 * cur.w[2] + (sa * cur.kb[2] + cur.vv * cur.kp[2]); S3 = S3 * cur.w[3] + (sa * cur.kb[3] + cur.vv * cur.kp[3]);
                    if (kg == 0) yb[tt * 16 + rloc] = y1 + sa * cur.c1 + cur.vv * cur.c2;
                    cur = nxt;
                }
            } else {
                if (c + 1 < NCH) scan_commit(R, buf0 + ((c + 1) & 1) * SBUF, rowbase + (c + 1) * TC, st, mur, muv);
                if (c + 2 < NCH) scan_issue(p, R, rowbase + (c + 2) * TC, h, vq, st);
                if (c > 0) { const float* yp = ybuf + ((c - 1) & 1) * (TC * 16); const int i2 = st * 2;
                    *(unsigned*)(yu + (size_t)(c - 1) * TC * 16 + i2) = pkbf(yp[i2], yp[i2 + 1]); }
            }
            __syncthreads();
        }
        if (wave >= 4) { const float* yp = ybuf + ((NCH - 1) & 1) * (TC * 16); const int i2 = st * 2;
            *(unsigned*)(yu + (size_t)(NCH - 1) * TC * 16 + i2) = pkbf(yp[i2], yp[i2 + 1]); }
        else *(f32x4*)(p.out + O_WKVP + ((size_t)(bh * 64 + vq * 16 + rloc)) * 64 + kg * 4) = (f32x4){S0, S1, S2, S3};
        __syncthreads();
    }
}


constexpr int CK = 16, NCHAIN = 2, NHELP = 8 - NCHAIN, SLOTB = 22912, NCHK = SEQ / CK, SCAN_WGS = 256 / NCHAIN;
constexpr int SO_AT = 0, SO_RT = 2304, SO_BT = 4608, SO_KT = 6912, SO_BH = 9216, SO_KH = 12288, SO_NAK = 15360, SO_NBR = 16128, SO_NKR = 16896, SO_TT = 17664, SO_VT = 18432, SO_DC = 21504, SO_NAB = 21760;
constexpr int CR_SB = NHELP * SLOTB, FL_OFF = CR_SB + NCHAIN * 3072;
static_assert(FL_OFF + 256 <= MISC_OFF, "scan LDS map");
struct HelpRegs { f32x4 w0, w1; u32x4 kp, kk, kb, rc, rp, vc, vp; };
__device__ __forceinline__ void help_issue(const P& p, HelpRegs (&R)[2], int row0, int h, int lane) {
    const float* WD = p.out + OS_WD; const bf16* KP = (const bf16*)(p.ws + WS_KP); const bf16* KK = (const bf16*)(p.ws + WS_KK); const bf16* KB = (const bf16*)(p.ws + WS_KB); const bf16* PROJ = (const bf16*)(p.ws + WS_PROJ);
#pragma unroll
    for (int i = 0; i < 2; ++i) { const int pc = lane + i * 64, tt = pc & 15, k8 = (pc >> 4) * 8, row = row0 + tt, prow = (row & (SEQ - 1)) ? row - 1 : row; const size_t o = (size_t)row * 512 + h * 64 + k8;
        R[i].w0 = *(const f32x4*)(WD + o); R[i].w1 = *(const f32x4*)(WD + o + 4); R[i].kp = *(const u32x4*)(KP + o); R[i].kk = *(const u32x4*)(KK + o); R[i].kb = *(const u32x4*)(KB + o);
        R[i].rc = *(const u32x4*)(PROJ + (size_t)row * PLD + h * 64 + k8); R[i].rp = *(const u32x4*)(PROJ + (size_t)prow * PLD + h * 64 + k8);
        R[i].vc = *(const u32x4*)(PROJ + (size_t)row * PLD + 1024 + h * 64 + k8); R[i].vp = *(const u32x4*)(PROJ + (size_t)prow * PLD + 1024 + h * 64 + k8); }
}
__device__ __forceinline__ void phase_scan2(const P& p_in, unsigned char* smem) {
    PHASE_PROLOGUE;
    const int lane = tid & 63, wave = tid >> 6, r = lane & 15, q = lane >> 4;
    bf16* YR = (bf16*)(p.ws + WS_XB);
    volatile unsigned* flags = (volatile unsigned*)(smem + FL_OFF);
    const bf16x8 zero8 = {0, 0, 0, 0, 0, 0, 0, 0};
    for (int unit = blockIdx.x; unit < SCAN_WGS; unit += SCAN_WGS) {
        const int ub = unit / (4 / NCHAIN), part = unit % (4 / NCHAIN), bh = (ub & 7) * 8 + (ub >> 3), vq = part * NCHAIN + (wave % NCHAIN), b = bh >> 3, h = bh & 7, rowbase = b * SEQ;
        if (tid < 64) flags[tid] = 0u;
        __syncthreads();
        if (wave < NCHAIN) {
            __builtin_amdgcn_s_setprio(3);
            bf16* yu = YR + (size_t)(bh * 4 + vq) * SEQ * 16;
            f32x4 ST[4];
#pragma unroll
            for (int mt = 0; mt < 4; ++mt) ST[mt] = (f32x4){0.f, 0.f, 0.f, 0.f};
            for (int c = 0; c < NCHK; ++c) {
                const int slot = c % NHELP; unsigned char* sb = smem + slot * SLOTB;
                const bf16* AT = (const bf16*)(sb + SO_AT); const bf16* RT = (const bf16*)(sb + SO_RT); const bf16* BH = (const bf16*)(sb + SO_BH); const bf16* KH = (const bf16*)(sb + SO_KH);
                const bf16* NAK = (const bf16*)(sb + SO_NAK); const bf16* NBR = (const bf16*)(sb + SO_NBR); const bf16* NKR = (const bf16*)(sb + SO_NKR); const bf16* TT = (const bf16*)(sb + SO_TT);
                const bf16* VT = (const bf16*)(sb + SO_VT) + vq * 16 * 24; const float* DC = (const float*)(sb + SO_DC);
                s16x4 sb4[4];
#pragma unroll
                for (int mt = 0; mt < 4; ++mt) sb4[mt] = cvt4(ST[mt]);
                { unsigned sp = 0; while (flags[slot] != (unsigned)(c + 1)) { __builtin_amdgcn_s_sleep(1); if (++sp > (1u << 22)) break; } }
                asm volatile("" ::: "memory");
                s16x4 fa[4], fr[4], fbh[4], fkh[4]; f32x4 dcv[4];
#pragma unroll
                for (int mt = 0; mt < 4; ++mt) { fa[mt] = *(const s16x4*)(AT + r * 72 + mt * 16 + q * 4); fr[mt] = *(const s16x4*)(RT + r * 72 + mt * 16 + q * 4);
                    fbh[mt] = *(const s16x4*)(BH + (mt * 16 + r) * 24 + q * 4); fkh[mt] = *(const s16x4*)(KH + (mt * 16 + r) * 24 + q * 4); dcv[mt] = *(const f32x4*)(DC + mt * 16 + q * 4); }
                const s16x4 fnak = *(const s16x4*)(NAK + lane * 4), ftt = *(const s16x4*)(TT + lane * 4), fnbr = *(const s16x4*)(NBR + lane * 4), fnkr = *(const s16x4*)(NKR + lane * 4);
                const s16x4 fvt = *(const s16x4*)(VT + r * 24 + q * 4);
                LDS_FENCE();
                if (lane == 0) flags[8 + slot * NCHAIN + wave] = (unsigned)(c + 1);
                f32x4 Wt = {0.f, 0.f, 0.f, 0.f};
#pragma unroll
                for (int mt = 0; mt < 4; ++mt) Wt = mf16(fa[mt], sb4[mt], Wt);
                Wt = mf16(fnak, fvt, Wt);
                f32x4 Ut = {0.f, 0.f, 0.f, 0.f};
                Ut = mf16(ftt, cvt4(Wt), Ut);
                const s16x4 ub = cvt4(Ut);
#pragma unroll
                for (int mt = 0; mt < 4; ++mt) { ST[mt] = ST[mt] * dcv[mt]; ST[mt] = mf16(fbh[mt], ub, ST[mt]); ST[mt] = mf16(fkh[mt], fvt, ST[mt]); }
                f32x4 Yt = {0.f, 0.f, 0.f, 0.f};
#pragma unroll
                for (int mt = 0; mt < 4; ++mt) Yt = mf16(fr[mt], sb4[mt], Yt);
                Yt = mf16(fnbr, ub, Yt); Yt = mf16(fnkr, fvt, Yt);
#pragma unroll
                for (int j = 0; j < 4; ++j) yu[(size_t)(c * CK + q * 4 + j) * 16 + r] = f2bf(Yt[j]);
            }
#pragma unroll
            for (int mt = 0; mt < 4; ++mt) *(f32x4*)(p.out + O_WKVP + ((size_t)(bh * 64 + vq * 16 + r)) * 64 + mt * 16 + q * 4) = ST[mt];
            __builtin_amdgcn_s_setprio(0);
        } else {
            const int hw = wave - NCHAIN; unsigned char* sb = smem + hw * SLOTB;
            bf16* AT = (bf16*)(sb + SO_AT); bf16* RT = (bf16*)(sb + SO_RT); bf16* BT = (bf16*)(sb + SO_BT); bf16* KT = (bf16*)(sb + SO_KT); bf16* BH = (bf16*)(sb + SO_BH); bf16* KH = (bf16*)(sb + SO_KH);
            bf16* NAK = (bf16*)(sb + SO_NAK); bf16* NBR = (bf16*)(sb + SO_NBR); bf16* NKR = (bf16*)(sb + SO_NKR); bf16* TT = (bf16*)(sb + SO_TT); bf16* VT = (bf16*)(sb + SO_VT);
            float* DC = (float*)(sb + SO_DC); float* NAB = (float*)(sb + SO_NAB); float* WR = (float*)(sb + SO_BH);
            float mur[2][8], muv[2][8];
#pragma unroll
            for (int i = 0; i < 2; ++i)
#pragma unroll
                for (int j = 0; j < 8; ++j) { mur[i][j] = p.in[7][h * 64 + ((lane + i * 64) >> 4) * 8 + j]; muv[i][j] = p.in[7][1024 + h * 64 + ((lane + i * 64) >> 4) * 8 + j]; }
            HelpRegs R[2];
            help_issue(p, R, rowbase + hw * CK, h, lane);
            for (int c = hw; c < NCHK; c += NHELP) {
                if (c >= NHELP) { const unsigned want = (unsigned)(c - NHELP + 1); unsigned sp = 0;
                    for (;;) { bool ok = true;
#pragma unroll
                        for (int w = 0; w < NCHAIN; ++w) ok = ok && (flags[8 + hw * NCHAIN + w] == want);
                        if (ok) break; __builtin_amdgcn_s_sleep(2); if (++sp > (1u << 22)) break; } }
                asm volatile("" ::: "memory");
                const int row0 = rowbase + c * CK;
#pragma unroll
                for (int i = 0; i < 2; ++i) { const int k8 = ((lane >> 4) + 4 * i) * 8, tt = lane & 15; float w[8], pre[8], suf[8], x[8], y[8], rc[8], rp[8];
#pragma unroll
                    for (int j = 0; j < 4; ++j) { w[j] = R[i].w0[j]; w[4 + j] = R[i].w1[j]; }
#pragma unroll
                    for (int j = 0; j < 8; ++j) { float a = w[j], z = w[j];
                        a *= dppo<0x111>(a); a *= dppo<0x112>(a); a *= dppo<0x114>(a); a *= dppo<0x118>(a);
                        z *= dppo<0x101>(z); z *= dppo<0x102>(z); z *= dppo<0x104>(z); z *= dppo<0x108>(z);
                        pre[j] = a; suf[j] = z * __builtin_amdgcn_rcpf(w[j]); }
                    if (tt == 15) { *(f32x4*)(DC + k8) = (f32x4){pre[0], pre[1], pre[2], pre[3]}; *(f32x4*)(DC + k8 + 4) = (f32x4){pre[4], pre[5], pre[6], pre[7]}; }
                    unpack8(R[i].kk, x);
#pragma unroll
                    for (int j = 0; j < 8; ++j) y[j] = -x[j] * dppo<0x111>(pre[j]);
                    *(u32x4*)(AT + tt * 72 + k8) = pack8(y);
                    unpack8(R[i].kb, x);
#pragma unroll
                    for (int j = 0; j < 8; ++j) { const float inv = __builtin_amdgcn_rcpf(pre[j]); rp[j] = inv; y[j] = x[j] * inv; x[j] *= suf[j]; }
                    *(u32x4*)(BT + tt * 72 + k8) = pack8(y);
#pragma unroll
                    for (int j = 0; j < 8; ++j) BH[(k8 + j) * 24 + tt] = f2bf(x[j]);
                    unpack8(R[i].kp, x);
#pragma unroll
                    for (int j = 0; j < 8; ++j) { y[j] = x[j] * rp[j]; x[j] *= suf[j]; }
                    *(u32x4*)(KT + tt * 72 + k8) = pack8(y);
#pragma unroll
                    for (int j = 0; j < 8; ++j) KH[(k8 + j) * 24 + tt] = f2bf(x[j]);
                    unpack8(R[i].rc, rc); unpack8(R[i].rp, rp); const float pz = ((row0 + tt) & (SEQ - 1)) ? 1.f : 0.f;
#pragma unroll
                    for (int j = 0; j < 8; ++j) y[j] = (rc[j] + (rp[j] * pz - rc[j]) * mur[i][j]) * pre[j];
                    *(u32x4*)(RT + tt * 72 + k8) = pack8(y);
                    unpack8(R[i].vc, rc); unpack8(R[i].vp, rp);
#pragma unroll
                    for (int j = 0; j < 8; ++j) VT[(k8 + j) * 24 + tt] = f2bf(rc[j] + (rp[j] * pz - rc[j]) * muv[i][j]); }
                if (c + NHELP < NCHK) help_issue(p, R, rowbase + (c + NHELP) * CK, h, lane);
                LDS_FENCE();
                { f32x4 nab = {0.f, 0.f, 0.f, 0.f}, nabT = nab, nak = nab, nbr = nab, nkr = nab;
#pragma unroll
                  for (int ks = 0; ks < 2; ++ks) { const bf16x8 fb = *(const bf16x8*)(BT + r * 72 + ks * 32 + q * 8), fk = *(const bf16x8*)(KT + r * 72 + ks * 32 + q * 8), fa = *(const bf16x8*)(AT + r * 72 + ks * 32 + q * 8), fr = *(const bf16x8*)(RT + r * 72 + ks * 32 + q * 8);
                      nab = mfma16(fb, fa, nab); nabT = mfma16(fa, fb, nabT); nak = mfma16(fk, fa, nak); nbr = mfma16(fb, fr, nbr); nkr = mfma16(fk, fr, nkr); }
#pragma unroll
                  for (int j = 0; j < 4; ++j) { const int i = q * 4 + j, t = r;
                      nab[j] = (i < t) ? nab[j] : 0.f; nabT[j] = (r < i) ? nabT[j] : 0.f; nak[j] = (i < t) ? nak[j] : 0.f; nbr[j] = (i <= t) ? nbr[j] : 0.f; nkr[j] = (i <= t) ? nkr[j] : 0.f; }
                  *(s16x4*)(NAK + lane * 4) = cvt4(nak); *(s16x4*)(NBR + lane * 4) = cvt4(nbr); *(s16x4*)(NKR + lane * 4) = cvt4(nkr);
                  const f32x4 z4 = {0.f, 0.f, 0.f, 0.f};
                  const s16x4 bN = cvt4(nab), bNT = cvt4(nabT);
                  const f32x4 n2 = mf16(bNT, bN, z4), n2T = mf16(bN, bNT, z4);
                  const s16x4 b2 = cvt4(n2), b2T = cvt4(n2T);
                  const f32x4 n4 = mf16(b2T, b2, z4), n4T = mf16(b2, b2T, z4);
                  const s16x4 b4 = cvt4(n4), b4T = cvt4(n4T);
                  f32x4 X = mf16(b4T, b4, z4);
#pragma unroll
                  for (int j = 0; j < 4; ++j) X[j] += (q * 4 + j == r) ? 1.f : 0.f;
                  X = mf16(b4T, cvt4(X), X);
                  X = mf16(b2T, cvt4(X), X);
                  X = mf16(bNT, cvt4(X), X);
                  *(s16x4*)(TT + lane * 4) = cvt4(X); }
                LDS_FENCE();
                if (lane == 0) flags[hw] = (unsigned)(c + 1);
            }
        }
        __syncthreads();
    }
}

__device__ __forceinline__ bf16x8 ldfrag(const bf16* base, int ld, int row0, int k0, int r, int q) { return *(const bf16x8*)(base + (row0 + r) * ld + k0 + q * 8); }
__device__ __forceinline__ void phase_ssd(const P& p_in, unsigned char* smem) {
    PHASE_PROLOGUE;
    const int lane = tid & 63, wave = tid >> 6, r = lane & 15, q = lane >> 4;
    bf16* XT = (bf16*)(smem + 53248); bf16* XdT = (bf16*)(smem + 57856); bf16* Gs = (bf16*)(smem + 62464); bf16* Hb = (bf16*)(smem + 71680); float* xsn = (float*)(smem + 80384);
    const bf16* XBC = (const bf16*)(p.ws + WS_XBC); const float* DT = (const float*)(p.ws + WS_DT); bf16* YM = (bf16*)(p.ws + WS_XB) + (size_t)MPR * 512;
    for (int unit = (int)blockIdx.x - SCAN_WGS; unit >= 0 && unit < 128; unit += 128) {
        const int bg = unit >> 3, e = (unit >> 1) & 3, ph = unit & 1, b = bg >> 1, g = bg & 1, h = g * 4 + e;
        const float A = -__expf(p.in[21][h]), Dh = p.in[22][h];
        f32x4 hacc[2] = {{0.f, 0.f, 0.f, 0.f}, {0.f, 0.f, 0.f, 0.f}};
        for (int i = tid; i < 32 * 136; i += 512) Hb[i] = 0;
        u32x4 rc[2], rb[2]; unsigned rx0, rx1; float rdt = 0.f;
#define SSD_LOAD(c_) do { const int row0_ = b * SEQ + (c_) * 64; \
            _Pragma("unroll") for (int i = 0; i < 2; ++i) { const int pc = tid + i * 512, s_ = pc >> 4, n8 = (pc & 15) * 8; \
                rc[i] = *(const u32x4*)(XBC + (size_t)(row0_ + s_) * 1024 + 768 + g * 128 + n8); rb[i] = *(const u32x4*)(XBC + (size_t)(row0_ + s_) * 1024 + 512 + g * 128 + n8); } \
            { const unsigned* xp_ = (const unsigned*)(XBC + (size_t)(row0_ + (tid >> 3)) * 1024 + h * 64 + ph * 32 + (tid & 7) * 4); rx0 = xp_[0]; rx1 = xp_[1]; } \
            if (tid < 64) rdt = DT[(size_t)(row0_ + tid) * 8 + h]; } while (0)
        SSD_LOAD(0);
        for (int c = 0; c < SEQ / 64; ++c) {
            unsigned char* sb = smem + (c & 1) * 89088; bf16* Cs = (bf16*)sb; bf16* Bs = (bf16*)(sb + 17408); bf16* BT = (bf16*)(sb + 34816);
            float* cs = (float*)(smem + ((c & 1) ? 142336 : 88576)); float* dtv = cs + 64;
#pragma unroll
            for (int i = 0; i < 2; ++i) { const int pc = tid + i * 512, s_ = pc >> 4, n8 = (pc & 15) * 8;
                *(u32x4*)(Cs + s_ * 136 + n8) = rc[i]; *(u32x4*)(Bs + s_ * 136 + n8) = rb[i];
                const unsigned w[4] = {rb[i].x, rb[i].y, rb[i].z, rb[i].w};
                const int sp = ((((s_ >> 3) ^ (pc & 7)) << 3) | (s_ & 7));
#pragma unroll
                for (int j = 0; j < 4; ++j) { BT[(n8 + 2 * j) * 72 + sp] = (bf16)(w[j] & 0xffffu); BT[(n8 + 2 * j + 1) * 72 + sp] = (bf16)(w[j] >> 16); } }
            if (wave == 0) { float v = A * rdt;
                v += dppf<0x111>(v); v += dppf<0x112>(v); v += dppf<0x114>(v); v += dppf<0x118>(v);
                v += __int_as_float(__builtin_amdgcn_update_dpp(0, __float_as_int(v), 0x142, 0xa, 0xf, false));
                v += __int_as_float(__builtin_amdgcn_update_dpp(0, __float_as_int(v), 0x143, 0xc, 0xf, false));
                cs[lane] = v; dtv[lane] = rdt; }
            __syncthreads();
            { const int s_ = tid >> 3, p4 = (tid & 7) * 4; const float dts = dtv[s_], dec = __expf(cs[63] - cs[s_]);
              const float x[4] = {bflo(rx0), bfhi(rx0), bflo(rx1), bfhi(rx1)};
#pragma unroll
              for (int j = 0; j < 4; ++j) { const float X = x[j] * dts; XT[(p4 + j) * 72 + s_] = f2bf(X); XdT[(p4 + j) * 72 + s_] = f2bf(X * dec); }
              *(f32x4*)(xsn + s_ * 32 + p4) = (f32x4){x[0], x[1], x[2], x[3]}; }
            if (c + 1 < SEQ / 64) SSD_LOAD(c + 1);
#pragma unroll
            for (int i = 0; i < 2; ++i) { const int tile = wave * 2 + i, mt = tile >> 2, nt = tile & 3; f32x4 acc = {0.f, 0.f, 0.f, 0.f};
#pragma unroll
                for (int ks = 0; ks < 4; ++ks) acc = mfma16(ldfrag(Cs, 136, mt * 16, ks * 32, r, q), ldfrag(Bs, 136, nt * 16, ks * 32, r, q), acc);
                const int s_ = nt * 16 + r; const float css = cs[s_];
#pragma unroll
                for (int j = 0; j < 4; ++j) { const int l = mt * 16 + q * 4 + j; const float gv = (s_ <= l) ? acc[j] * __expf(cs[l] - css) : 0.f; Gs[l * 72 + s_] = f2bf(gv); } }
            const int mt = wave >> 1, pt = wave & 1;
            f32x4 yacc = {0.f, 0.f, 0.f, 0.f};
#pragma unroll
            for (int ks = 0; ks < 4; ++ks) yacc = mfma16(ldfrag(Cs, 136, mt * 16, ks * 32, r, q), ldfrag(Hb, 136, pt * 16, ks * 32, r, q), yacc);
#pragma unroll
            for (int j = 0; j < 4; ++j) yacc[j] *= __expf(cs[mt * 16 + q * 4 + j]);
            __syncthreads();
#pragma unroll
            for (int ks = 0; ks < 2; ++ks) yacc = mfma16(ldfrag(Gs, 72, mt * 16, ks * 32, r, q), ldfrag(XT, 72, pt * 16, ks * 32, r, q), yacc);
#pragma unroll
            for (int j = 0; j < 4; ++j) { const int l = mt * 16 + q * 4 + j; YM[((size_t)((b * 8 + h) * 4 + ph * 2 + pt) * SEQ + c * 64 + l) * 16 + r] = f2bf(yacc[j] + Dh * xsn[l * 32 + pt * 16 + r]); }
            { const float dl = __expf(cs[63]);
#pragma unroll
              for (int t2 = 0; t2 < 2; ++t2) { hacc[t2] = hacc[t2] * dl;
#pragma unroll
                  for (int ks = 0; ks < 2; ++ks) hacc[t2] = mfma16(ldfrag(XdT, 72, t2 * 16, ks * 32, r, q), *(const bf16x8*)(BT + (wave * 16 + r) * 72 + (((ks * 4 + q) ^ ((wave * 2 + (r >> 3)) & 7)) << 3)), hacc[t2]);
#pragma unroll
                  for (int j = 0; j < 4; ++j) Hb[(t2 * 16 + q * 4 + j) * 136 + wave * 16 + r] = f2bf(hacc[t2][j]); } }
        }
#undef SSD_LOAD
#pragma unroll
        for (int t2 = 0; t2 < 2; ++t2)
#pragma unroll
            for (int j = 0; j < 4; ++j) p.out[O_SSMP + ((size_t)((b * 8 + h) * 64 + ph * 32 + t2 * 16 + q * 4 + j)) * 128 + wave * 16 + r] = hacc[t2][j];
        __syncthreads();
    }
}

__device__ __forceinline__ float conv_act_s(const P& p, int bs, int c) {
    const bf16* PROJ = (const bf16*)(p.ws + WS_PROJ); const float* sc = p.in[4] + (size_t)bs * 3072 + c; const float* cw = p.in[18] + c;
    const float v = p.in[19][c] + cw[0] * sc[0] + cw[1024] * sc[1024] + cw[2048] * sc[2048] + cw[3072] * bf2f(PROJ[(size_t)(MPR + bs) * PLD + 2304 + c]);
    return silu(v);
}
__device__ __forceinline__ void phase_sample_step(const P& p_in, unsigned char* smem) {
    PHASE_PROLOGUE;
    const int lane = tid & 63, wave = tid >> 6, G = gridDim.x, bid = blockIdx.x;
    const int first = SCAN_WGS;
    const int gw = (bid - first) * 8 + wave, NGW = (G - first) * 8;
    if (bid < first) return;
    float* sv = (float*)(smem + wave * 2048);
    const float* WD = p.out + OS_WD; const bf16* KP = (const bf16*)(p.ws + WS_KP); const bf16* KK = (const bf16*)(p.ws + WS_KK); const bf16* KB = (const bf16*)(p.ws + WS_KB);
    bf16* YS = (bf16*)(p.ws + WS_YS); const float* DT = (const float*)(p.ws + WS_DT);
    const int kq = lane & 15, rr = lane >> 4;
    for (int unit = gw; unit < 2048; unit += NGW) {
        const int bs = (unit & 1023) >> 3, h = unit & 7, row = MPR + bs;
        if (unit < 1024) {
            const size_t o = (size_t)row * 512 + h * 64 + lane;
            sv[lane] = WD[o]; sv[64 + lane] = bf2f(KP[o]); sv[128 + lane] = -bf2f(KK[o]); sv[192 + lane] = bf2f(KB[o]); sv[256 + lane] = lerp1(p, row, h * 64 + lane); sv[320 + lane] = lerp1(p, row, 1024 + h * 64 + lane);
            LDS_FENCE();
            const f32x4 w4 = *(const f32x4*)(sv + kq * 4), kp4 = *(const f32x4*)(sv + 64 + kq * 4), ka4 = *(const f32x4*)(sv + 128 + kq * 4), kb4 = *(const f32x4*)(sv + 192 + kq * 4), r4 = *(const f32x4*)(sv + 256 + kq * 4);
            const size_t so = (size_t)(bs * 8 + h) * 4096 + rr * 64 + kq * 4;
            const float* Sb = p.in[3] + so; float* Ob = p.out + O_WKVS + so;
            f32x4 S[16]; float sa[16];
#pragma unroll
            for (int i = 0; i < 16; ++i) S[i] = *(const f32x4*)(Sb + i * 256);
#pragma unroll
            for (int i = 0; i < 16; ++i) sa[i] = sum16((S[i][0] * ka4[0] + S[i][1] * ka4[1]) + (S[i][2] * ka4[2] + S[i][3] * ka4[3]));
#pragma unroll
            for (int i = 0; i < 16; ++i) { const float vv = sv[320 + 4 * i + rr]; f32x4 n;
#pragma unroll
                for (int j = 0; j < 4; ++j) n[j] = S[i][j] * w4[j] + (sa[i] * kb4[j] + vv * kp4[j]);
                *(f32x4*)(Ob + i * 256) = n;
                const float y = sum16((n[0] * r4[0] + n[1] * r4[1]) + (n[2] * r4[2] + n[3] * r4[3]));
                if (kq == 0) YS[(size_t)bs * 1024 + h * 64 + 4 * i + rr] = f2bf(y); }
            LDS_FENCE();
        } else {
            const int g = h >> 2;
            sv[lane] = conv_act_s(p, bs, 512 + g * 128 + lane); sv[64 + lane] = conv_act_s(p, bs, 512 + g * 128 + 64 + lane);
            sv[128 + lane] = conv_act_s(p, bs, 768 + g * 128 + lane); sv[192 + lane] = conv_act_s(p, bs, 768 + g * 128 + 64 + lane);
            sv[256 + lane] = conv_act_s(p, bs, h * 64 + lane);
            LDS_FENCE();
            const float dt = DT[(size_t)row * 8 + h], A = -__expf(p.in[21][h]), dA = __expf(A * dt), Dh = p.in[22][h];
            const f32x4 Bl = *(const f32x4*)(sv + kq * 4), Bh = *(const f32x4*)(sv + 64 + kq * 4), Cl = *(const f32x4*)(sv + 128 + kq * 4), Ch = *(const f32x4*)(sv + 192 + kq * 4);
            const size_t so = (size_t)(bs * 8 + h) * 8192 + rr * 128 + kq * 4;
            const float* Hb_ = p.in[5] + so; float* Ob = p.out + O_SSMS + so;
#pragma unroll
            for (int half = 0; half < 2; ++half) { f32x4 hl[8], hh[8];
#pragma unroll
                for (int i = 0; i < 8; ++i) { hl[i] = *(const f32x4*)(Hb_ + (half * 8 + i) * 512); hh[i] = *(const f32x4*)(Hb_ + (half * 8 + i) * 512 + 64); }
#pragma unroll
                for (int i = 0; i < 8; ++i) { const int pp = 4 * (half * 8 + i) + rr; const float x = sv[256 + pp], dtx = dt * x; f32x4 nl, nh; float y = 0.f;
#pragma unroll
                    for (int j = 0; j < 4; ++j) { nl[j] = hl[i][j] * dA + dtx * Bl[j]; nh[j] = hh[i][j] * dA + dtx * Bh[j]; y += nl[j] * Cl[j] + nh[j] * Ch[j]; }
                    *(f32x4*)(Ob + (half * 8 + i) * 512) = nl; *(f32x4*)(Ob + (half * 8 + i) * 512 + 64) = nh;
                    y = sum16(y) + Dh * x;
                    if (kq == 0) YS[(size_t)bs * 1024 + 512 + h * 64 + pp] = f2bf(y); } }
            LDS_FENCE();
        }
    }
}

__device__ __forceinline__ void phase_post(const P& p_in) {
    PHASE_PROLOGUE;
    const int lane = tid & 63, wave = tid >> 6, G = gridDim.x, bid = blockIdx.x;
    const int gw = bid * 8 + wave, NGW = G * 8;
    bf16* MIX = (bf16*)(p.ws + WS_MIX); const bf16* YR = (const bf16*)(p.ws + WS_XB); const bf16* YM = YR + (size_t)MPR * 512; const bf16* YS = (const bf16*)(p.ws + WS_YS);
    const bf16* PROJ = (const bf16*)(p.ws + WS_PROJ); const bf16* KP = (const bf16*)(p.ws + WS_KP); const bf16* GG = (const bf16*)(p.out + OS_GG);
    const int c0 = lane * 8;
    float rk[8], lw[8], lb[8], gn[8], mur[8], muv[8];
#pragma unroll
    for (int i = 0; i < 8; ++i) { rk[i] = p.in[15][c0 + i]; lw[i] = p.in[16][c0 + i]; lb[i] = p.in[17][c0 + i]; gn[i] = p.in[23][c0 + i]; mur[i] = p.in[7][c0 + i]; muv[i] = p.in[7][1024 + c0 + i]; }
    struct PostRegs { u32x4 yr, ym, rc, rp, vc, vp, kp, gg, z; };
    PostRegs nx;
#define POST_LOAD(R_, row_) do { const int rw_ = (row_); \
        const size_t yo_ = ((size_t)(((rw_ >> 11) * 8 + (lane >> 3)) * 4 + ((lane & 7) >> 1)) * SEQ + (rw_ & (SEQ - 1))) * 16 + (lane & 1) * 8; \
        R_.yr = rw_ < MPR ? *(const u32x4*)(YR + yo_) : *(const u32x4*)(YS + (size_t)(rw_ - MPR) * 1024 + c0); \
        R_.ym = rw_ < MPR ? *(const u32x4*)(YM + yo_) : *(const u32x4*)(YS + (size_t)(rw_ - MPR) * 1024 + 512 + c0); \
        R_.rc = *(const u32x4*)(PROJ + (size_t)rw_ * PLD + c0); R_.vc = *(const u32x4*)(PROJ + (size_t)rw_ * PLD + 1024 + c0); R_.z = *(const u32x4*)(PROJ + (size_t)rw_ * PLD + 1792 + c0); \
        R_.kp = *(const u32x4*)(KP + (size_t)rw_ * 512 + c0); R_.gg = *(const u32x4*)(GG + (size_t)rw_ * 512 + c0); \
        u32x4 pr_ = {0u, 0u, 0u, 0u}, pv_ = pr_; \
        if (rw_ >= MPR) { const float* sp_ = p.in[2] + (size_t)(rw_ - MPR) * RPJ + c0; const f32x4 a_ = *(const f32x4*)sp_, b_ = *(const f32x4*)(sp_ + 4), c_ = *(const f32x4*)(sp_ + 1024), d_ = *(const f32x4*)(sp_ + 1028); \
            pr_.x = pkbf(a_[0], a_[1]); pr_.y = pkbf(a_[2], a_[3]); pr_.z = pkbf(b_[0], b_[1]); pr_.w = pkbf(b_[2], b_[3]); pv_.x = pkbf(c_[0], c_[1]); pv_.y = pkbf(c_[2], c_[3]); pv_.z = pkbf(d_[0], d_[1]); pv_.w = pkbf(d_[2], d_[3]); } \
        else if ((rw_ & (SEQ - 1)) != 0) { pr_ = *(const u32x4*)(PROJ + (size_t)(rw_ - 1) * PLD + c0); pv_ = *(const u32x4*)(PROJ + (size_t)(rw_ - 1) * PLD + 1024 + c0); } \
        R_.rp = pr_; R_.vp = pv_; } while (0)
    if (gw < MTOT) POST_LOAD(nx, gw);
    for (int row = gw; row < MTOT; row += NGW) {
        const PostRegs cu = nx;
        if (row + NGW < MTOT) POST_LOAD(nx, row + NGW);
        {
            float y[8], rr[8], kp[8], vv[8], gg[8], t0[8], t1[8];
            unpack8(cu.yr, y);
            float s = 0.f;
#pragma unroll
            for (int i = 0; i < 8; ++i) s += y[i];
            s = sum8(s);
            const float mean = s * (1.f / 64.f); float s2 = 0.f;
#pragma unroll
            for (int i = 0; i < 8; ++i) { y[i] -= mean; s2 += y[i] * y[i]; }
            s2 = sum8(s2);
            const float rstd = rsqrtf(s2 * (1.f / 64.f) + 64e-5f);
            unpack8(cu.rc, t0); unpack8(cu.rp, t1);
#pragma unroll
            for (int i = 0; i < 8; ++i) rr[i] = t0[i] + (t1[i] - t0[i]) * mur[i];
            unpack8(cu.vc, t0); unpack8(cu.vp, t1);
#pragma unroll
            for (int i = 0; i < 8; ++i) vv[i] = t0[i] + (t1[i] - t0[i]) * muv[i];
            unpack8(cu.kp, kp); unpack8(cu.gg, gg);
            float bo = 0.f;
#pragma unroll
            for (int i = 0; i < 8; ++i) bo += rr[i] * kp[i] * rk[i];
            bo = sum8(bo);
#pragma unroll
            for (int i = 0; i < 8; ++i) y[i] = (y[i] * rstd * lw[i] + lb[i] + bo * vv[i]) * gg[i];
            *(u32x4*)(MIX + (size_t)row * 1024 + c0) = pack8(y);
        }
        {
            float y[8], z[8];
            unpack8(cu.ym, y); unpack8(cu.z, z);
            float ss = 0.f;
#pragma unroll
            for (int i = 0; i < 8; ++i) { y[i] *= silu(z[i]); ss += y[i] * y[i]; }
            ss = sum32(ss, lane >= 32);
            const float sc = rsqrtf(ss * (1.f / 256.f) + 1e-5f);
#pragma unroll
            for (int i = 0; i < 8; ++i) y[i] = y[i] * sc * gn[i];
            *(u32x4*)(MIX + (size_t)row * 1024 + 512 + c0) = pack8(y);
        }
    }
#undef POST_LOAD
}

template <bool TO_BF16> __device__ __forceinline__ void phase_ln(const P& p_in, const float* gam, const float* bet, bf16* ob, size_t src_off, int sld) {
    PHASE_PROLOGUE;
    const int lane = tid & 63, wave = tid >> 6, G = gridDim.x, bid = blockIdx.x;
    const int gw = bid * 8 + wave, NGW = G * 8;
    const bf16* src = (const bf16*)p.out + src_off;
    f32x4 gv[4], bv[4];
#pragma unroll
    for (int j = 0; j < 4; ++j) { gv[j] = *(const f32x4*)(gam + lane * 4 + 256 * j); bv[j] = *(const f32x4*)(bet + lane * 4 + 256 * j); }
    unsigned long long nx[4] = {0ull, 0ull, 0ull, 0ull};
    if (gw < MTOT) {
#pragma unroll
        for (int j = 0; j < 4; ++j) nx[j] = *(const unsigned long long*)(src + (size_t)gw * sld + lane * 4 + 256 * j); }
    for (int row = gw; row < MTOT; row += NGW) {
        float* xr = p.out + (size_t)row * 1024 + lane * 4;
        f32x4 v[4]; float s = 0.f;
#pragma unroll
        for (int j = 0; j < 4; ++j) { const unsigned lo = (unsigned)nx[j], hi = (unsigned)(nx[j] >> 32);
            v[j] = (f32x4){bflo(lo), bfhi(lo), bflo(hi), bfhi(hi)}; s += (v[j][0] + v[j][1]) + (v[j][2] + v[j][3]); }
        if (row + NGW < MTOT) {
#pragma unroll
            for (int j = 0; j < 4; ++j) nx[j] = *(const unsigned long long*)(src + (size_t)(row + NGW) * sld + lane * 4 + 256 * j); }
        s = sum64(s);
        const float mean = s * (1.f / 1024.f); float s2 = 0.f;
#pragma unroll
        for (int j = 0; j < 4; ++j) { v[j] = v[j] - mean; s2 += (v[j][0] * v[j][0] + v[j][1] * v[j][1]) + (v[j][2] * v[j][2] + v[j][3] * v[j][3]); }
        s2 = sum64(s2);
        const float rstd = rsqrtf(s2 * (1.f / 1024.f) + 1e-5f);
#pragma unroll
        for (int j = 0; j < 4; ++j) { const f32x4 o = v[j] * rstd * gv[j] + bv[j];
            if (TO_BF16) { unsigned long long w = (unsigned long long)pkbf(o[0], o[1]) | ((unsigned long long)pkbf(o[2], o[3]) << 32); *(unsigned long long*)(ob + (size_t)row * 1024 + lane * 4 + 256 * j) = w; }
            else *(f32x4*)(xr + 256 * j) = o; }
    }
}

#ifndef USE_CHUNKED
#define USE_CHUNKED 1
#endif
#ifndef REPEAT_SEL
#define REPEAT_SEL 0
#endif
#ifndef DUMP_SEL
#define DUMP_SEL 0
#endif
#ifndef STOP_AFTER
#define STOP_AFTER 99
#endif
__global__ void __launch_bounds__(512, 2) mega(P p) {
    extern __shared__ __attribute__((aligned(16))) unsigned char smem[];
    LAS unsigned char* lds = (LAS unsigned char*)smem;
    volatile LAS unsigned* MISC = (volatile LAS unsigned*)(lds + MISC_OFF);
    if (threadIdx.x < 16) MISC[threadIdx.x] = 0u;
    __syncthreads();
    XcdBarrier bar = xcd_barrier_post((unsigned*)(p.ws + WS_CTL), MISC);
    if (p.never) cg::this_grid().sync();
#define GRID_BAR() xcd_barrier(bar)
    const int G = gridDim.x, bid = blockIdx.x;
    bf16* XB = (bf16*)(p.ws + WS_XB); bf16* PROJ = (bf16*)(p.ws + WS_PROJ); float* DT = (float*)(p.ws + WS_DT); bf16* HID = (bf16*)(p.ws + WS_HID);

#if STOP_AFTER != 99
    { const size_t gt = (size_t)blockIdx.x * 512 + threadIdx.x, NGT = (size_t)gridDim.x * 512; for (size_t i = O_SHP + gt; i < 30939136; i += NGT) p.out[i] = 0.f; }
    GRID_BAR();
#endif
    phase0(p, smem);
    GRID_BAR();
    {
        pg8::Gemm g{XB, (const bf16*)(p.ws + WS_WIN), MPR, 3584, 1024}; pg8::StaticOrder S; S.init(MPR, 3584, G, bid);
        pg8::EpiProj E{PROJ, DT, p.in[20], p.out};
        pg8::gemm_phase<pg8::EpiProj, pg8::StaticOrder, true, true>(lds, g, S, E);
        const float* dtb = p.in[20]; float* out = p.out;
        small_gemm<4, 1024>(XB + (size_t)MPR * 1024, (const bf16*)(p.ws + WS_WIN), PROJN, smem, [=](int rs, int c, float v) {
            if (c < 3328) PROJ[(size_t)(MPR + rs) * PLD + c] = f2bf(v); else DT[(size_t)(MPR + rs) * 8 + (c - 3328)] = softplus(v + dtb[c - 3328]);
            if (c < 1792) out[O_SHS + (size_t)rs * 1792 + c] = v;
            if (c >= 2304 && c < 3328) out[O_CONVS + ((size_t)rs * 3 + 2) * 1024 + (c - 2304)] = v; }, (G == 256) ? 128 : 0);
        phase0_late(p, smem, (G == 256) ? 128 : 0, 0);
    }
    GRID_BAR();
    phase_prep(p, smem);
#if REPEAT_SEL == 2
    phase_prep(p, smem);
#endif
    GRID_BAR();
#if STOP_AFTER == 2
    { const size_t gt = (size_t)blockIdx.x * 512 + threadIdx.x, NGT = (size_t)gridDim.x * 512; const bf16* KPd = (const bf16*)(p.ws + WS_KP); const bf16* XBCd = (const bf16*)(p.ws + WS_XBC);
      for (size_t i = gt; i < 8454144; i += NGT) { p.out[i] = bf2f(KPd[i]); p.out[8454144 + i] = bf2f(XBCd[i]); } }
    return;
#endif
#if USE_CHUNKED
    phase_scan2(p, smem);
#else
    phase_scan(p, smem);
#endif
    phase_ssd(p, smem);
    phase_sample_step(p, smem);
#if REPEAT_SEL == 3
    phase_scan2(p, smem);
    phase_ssd(p, smem);
    phase_sample_step(p, smem);
#endif
#if REPEAT_SEL == 5
    phase_sample_step(p, smem);
    phase_sample_step(p, smem);
#endif
#if REPEAT_SEL == 6
    phase_ssd(p, smem);
#endif
#if REPEAT_SEL == 4
    phase_ssd(p, smem);
    phase_sample_step(p, smem);
#endif
    GRID_BAR();
#if STOP_AFTER == 4
    { const size_t gt = (size_t)blockIdx.x * 512 + threadIdx.x, NGT = (size_t)gridDim.x * 512; const bf16* Yd = (const bf16*)(p.ws + WS_XB);
      for (size_t i = gt; i < 8388608; i += NGT) { p.out[i] = (DUMP_SEL & 1) ? bf2f(Yd[i]) : 0.f; p.out[8388608 + i] = (DUMP_SEL & 2) ? bf2f(Yd[8388608 + i]) : 0.f; }
      for (size_t i = gt; i < 131072; i += NGT) p.out[16777216 + i] = (DUMP_SEL & 4) ? bf2f(((const bf16*)(p.ws + WS_YS))[i]) : 0.f; }
    return;
#endif
    phase_post(p);
    GRID_BAR();
#if STOP_AFTER == 5
    { const size_t gt = (size_t)blockIdx.x * 512 + threadIdx.x, NGT = (size_t)gridDim.x * 512; for (size_t i = gt; i < (size_t)MTOT * 1024; i += NGT) p.out[i] = bf2f(((const bf16*)(p.ws + WS_MIX))[i]); }
    return;
#endif
    {
        pg8::Gemm g{(const bf16*)(p.ws + WS_MIX), (const bf16*)(p.ws + WS_WOUT), MPR, 1024, 1024}; pg8::StaticOrder S; S.init(MPR, 1024, G, bid);
        pg8::EpiResF32 E{p.in[0], nullptr, (bf16*)p.out, 1024, ALPHA};
        pg8::gemm_phase<pg8::EpiResF32, pg8::StaticOrder, true, true>(lds, g, S, E);
        const float* xs = p.in[1]; float* out = p.out;
        small_gemm<2, 1024>((const bf16*)(p.ws + WS_MIX) + (size_t)MPR * 1024, (const bf16*)(p.ws + WS_WOUT), 1024, smem, [=](int rs, int c, float v) { ((bf16*)out)[(size_t)(MPR + rs) * 1024 + c] = f2bf(ALPHA * xs[(size_t)rs * 1024 + c] + v); });
    }
    GRID_BAR();
    phase_ln<true>(p, p.in[25], p.in[26], XB, 0, 1024);
    phase0_late(p, smem, 0, 1);
    GRID_BAR();
    {
        pg8::Gemm g{XB, (const bf16*)(p.ws + WS_WFF1), MPR, 4096, 1024}; pg8::StaticOrder S; S.init(MPR, 4096, G, bid);
        pg8::EpiRelu2 E{HID, 4096};
        pg8::gemm_phase<pg8::EpiRelu2, pg8::StaticOrder, true, true>(lds, g, S, E);
        small_gemm<4, 1024>(XB + (size_t)MPR * 1024, (const bf16*)(p.ws + WS_WFF1), 4096, smem, [=](int rs, int c, float v) { const float a = fmaxf(v, 0.f); HID[(size_t)(MPR + rs) * 4096 + c] = f2bf(a * a); });
    }
    GRID_BAR();
    {
        pg8::Gemm g{HID, (const bf16*)(p.ws + WS_WFF2), MPR, 1024, 4096}; pg8::StaticOrder S; S.init(MPR, 1024, G, bid);
        pg8::EpiResF32 E{nullptr, XB, (bf16*)p.out + 1024, 2048, ALPHA};
        pg8::gemm_phase<pg8::EpiResF32, pg8::StaticOrder, true, true>(lds, g, S, E);
        float* out = p.out;
        small_gemm<2, 4096>(HID + (size_t)MPR * 4096, (const bf16*)(p.ws + WS_WFF2), 1024, smem, [=](int rs, int c, float v) { ((bf16*)out)[(size_t)(MPR + rs) * 2048 + 1024 + c] = f2bf(ALPHA * bf2f(XB[(size_t)(MPR + rs) * 1024 + c]) + v); });
    }
    GRID_BAR();
    phase_ln<false>(p, p.in[29], p.in[30], nullptr, 1024, 2048);
}

extern "C" void kernel_launch(void* const* d_in, const int* in_sizes, int n_in, void* d_out, int out_size, void* d_ws, size_t ws_size, hipStream_t stream) {
    static int grid = 0;
    if (grid == 0) {
        int dev = 0, cus = 0, per_cu = 0;
        (void)hipGetDevice(&dev);
        (void)hipDeviceGetAttribute(&cus, hipDeviceAttributeMultiprocessorCount, dev);
        if (hipFuncSetAttribute((const void*)mega, hipFuncAttributeMaxDynamicSharedMemorySize, LDS_BYTES) != hipSuccess) fprintf(stderr, "kernel_launch: hipFuncSetAttribute failed\n");
        if (hipOccupancyMaxActiveBlocksPerMultiprocessor(&per_cu, (const void*)mega, 512, LDS_BYTES) != hipSuccess || per_cu < 1) { fprintf(stderr, "kernel_launch: occupancy query says %d\n", per_cu); per_cu = 1; }
        (void)hipGetLastError();
        grid = cus * 1;
        if (n_in != 31 || out_size != 30939136 || ws_size < WS_CTL + 16384) fprintf(stderr, "kernel_launch: unexpected sizes n_in %d out %d ws %zu\n", n_in, out_size, ws_size);
    }
    (void)hipMemsetAsync((char*)d_ws + WS_CTL, 0, 16384, stream);
    P a{};
    for (int i = 0; i < 31; ++i) a.in[i] = (const float*)d_in[i];
    a.out = (float*)d_out; a.ws = (unsigned char*)d_ws; a.never = 0; a.pad = 0;
    void* args[] = {&a};
    hipError_t e = hipLaunchCooperativeKernel((const void*)mega, dim3(grid), dim3(512), args, LDS_BYTES, stream);
    if (e != hipSuccess) fprintf(stderr, "kernel_launch: cooperative launch failed: %s (grid %d)\n", hipGetErrorString(e), grid);
}
```

```cpp
#include <hip/hip_runtime.h>
#include <hip/hip_cooperative_groups.h>
#include <cstdio>
#include <cstdint>
namespace cg = cooperative_groups;
#define LAS __attribute__((address_space(3)))

typedef unsigned short bf16;
typedef short bf16x8 __attribute__((ext_vector_type(8)));
typedef float f32x4 __attribute__((ext_vector_type(4)));
typedef unsigned u32x4 __attribute__((ext_vector_type(4)));

constexpr int DM = 1024, SEQ = 2048, MPR = 8 * SEQ, MSM = 128, MTOT = MPR + MSM;
constexpr int RPJ = 1792, PLD = 3328, PROJN = 3336, DFF = 4096;
constexpr float ALPHA = 1.189207115f;
constexpr size_t O_Y = 0, O_YS = 16777216, O_SHP = 16908288, O_WKVP = 16922624, O_CONVP = 17184768, O_SSMP = 17209344,
                 O_SHS = 17733632, O_WKVS = 17963008, O_CONVS = 22157312, O_SSMS = 22550528;
constexpr size_t OS_WD = 0, OS_GG = 8454144;
constexpr size_t WS_WIN = 0, WS_WOUT = 7340032, WS_WFF1 = 9437184, WS_WFF2 = 17825792, WS_LORA = 26214400, WS_XB = 26476544,
                 WS_PROJ = 60293120, WS_DT = 170196992, WS_KP = 170725376, WS_KK = 187633664, WS_KB = 204541952, WS_XBC = 221450240,
                 WS_CTL = 255004672, WS_YS = WS_CTL + 65536, WS_HID = WS_PROJ, WS_MIX = WS_KK;
constexpr int LDS_BYTES = 147456, MISC_OFF = LDS_BYTES - 64;

struct P { const float* in[31]; float* out; unsigned char* ws; int never; int pad; };

__device__ __forceinline__ float bf2f(unsigned short b) { return __uint_as_float(((unsigned)b) << 16); }
__device__ __forceinline__ float bflo(unsigned u) { return __uint_as_float(u << 16); }
__device__ __forceinline__ float bfhi(unsigned u) { return __uint_as_float(u & 0xffff0000u); }
typedef float f32x2_t __attribute__((ext_vector_type(2)));
typedef __bf16 bf16x2_t __attribute__((ext_vector_type(2)));
__device__ __forceinline__ unsigned pkbf(float lo, float hi) { const f32x2_t v = {lo, hi}; const bf16x2_t b = __builtin_convertvector(v, bf16x2_t); return __builtin_bit_cast(unsigned, b); }
__device__ __forceinline__ unsigned short f2bf(float f) { return (unsigned short)(pkbf(f, f) & 0xffffu); }
__device__ __forceinline__ void unpack8(u32x4 v, float* o) { o[0] = bflo(v.x); o[1] = bfhi(v.x); o[2] = bflo(v.y); o[3] = bfhi(v.y); o[4] = bflo(v.z); o[5] = bfhi(v.z); o[6] = bflo(v.w); o[7] = bfhi(v.w); }
__device__ __forceinline__ u32x4 pack8(const float* o) { u32x4 v; v.x = pkbf(o[0], o[1]); v.y = pkbf(o[2], o[3]); v.z = pkbf(o[4], o[5]); v.w = pkbf(o[6], o[7]); return v; }
__device__ __forceinline__ float sigm(float x) { return __builtin_amdgcn_rcpf(1.f + __expf(-x)); }
__device__ __forceinline__ float silu(float x) { return x * __builtin_amdgcn_rcpf(1.f + __expf(-x)); }
__device__ __forceinline__ float softplus(float x) { return fmaxf(x, 0.f) + __logf(1.f + __expf(-fabsf(x))); }
__device__ __forceinline__ float tanh_(float x) { const float e = __expf(2.f * x); return 1.f - 2.f * __builtin_amdgcn_rcpf(e + 1.f); }
template <int CTRL> __device__ __forceinline__ float dppf(float x) { return __int_as_float(__builtin_amdgcn_update_dpp(0, __float_as_int(x), CTRL, 0xf, 0xf, true)); }
template <int CTRL> __device__ __forceinline__ float dppo(float x) { return __int_as_float(__builtin_amdgcn_update_dpp(0x3f800000, __float_as_int(x), CTRL, 0xf, 0xf, false)); }
__device__ __forceinline__ float sum16(float x) { x += dppf<0xB1>(x); x += dppf<0x4E>(x); x += dppf<0x141>(x); x += dppf<0x140>(x); return x; }
__device__ __forceinline__ float sum8(float x) { x += dppf<0xB1>(x); x += dppf<0x4E>(x); x += dppf<0x141>(x); return x; }
__device__ __forceinline__ float rdl(float x, int l) { return __int_as_float(__builtin_amdgcn_readlane(__float_as_int(x), l)); }
__device__ __forceinline__ float sum64(float x) { x = sum16(x); return (rdl(x, 0) + rdl(x, 16)) + (rdl(x, 32) + rdl(x, 48)); }
__device__ __forceinline__ float sum32(float x, bool hi) { x = sum16(x); const float a = rdl(x, 0) + rdl(x, 16), b = rdl(x, 32) + rdl(x, 48); return hi ? b : a; }
__device__ __forceinline__ f32x4 mfma16(bf16x8 a, bf16x8 b, f32x4 c) { return __builtin_amdgcn_mfma_f32_16x16x32_bf16(a, b, c, 0, 0, 0); }
typedef short s16x4 __attribute__((ext_vector_type(4)));
__device__ __forceinline__ f32x4 mf16(s16x4 a, s16x4 b, f32x4 c) { return __builtin_amdgcn_mfma_f32_16x16x16bf16_1k(a, b, c, 0, 0, 0); }
__device__ __forceinline__ s16x4 cvt4(f32x4 v) { struct { unsigned a, b; } t = {pkbf(v[0], v[1]), pkbf(v[2], v[3])}; return __builtin_bit_cast(s16x4, t); }
#define LDS_FENCE() asm volatile("s_waitcnt lgkmcnt(0)" ::: "memory")

#define PHASE_PROLOGUE P p = p_in; { size_t z_ = 0; asm volatile("" : "+s"(z_)); p.ws += z_; p.out += z_; } int tid = threadIdx.x; asm volatile("" : "+v"(tid))
namespace pg8 {
#define PG8_LAS __attribute__((address_space(3)))
typedef unsigned short bf16_t;
typedef short bf16x8 __attribute__((ext_vector_type(8)));
typedef float f32x4 __attribute__((ext_vector_type(4)));
typedef unsigned u32x4 __attribute__((ext_vector_type(4)));
constexpr int BM = 256, BK = 64, HALF = 128, HTB = HALF * BK * 2  , STAGE_BYTES = 8 * HTB, NXCD = 8, WGM = 8;

__host__ __device__ __forceinline__ int lds_byte(int r, int c) { const int st = (r >> 4) * 2 + (c >> 5), rr = r & 15, cc = c & 31, ob = rr * 64 + cc * 2; return st * 1024 + (ob ^ (((ob >> 9) & 1) << 5)); }
__host__ __device__ __forceinline__ void stage_rc(int b, int& R, int& C) { const int st = b / 1024, sb = b % 1024, swz = sb ^ (((sb >> 9) & 1) << 5); R = (st >> 1) * 16 + swz / 64; C = (st & 1) * 32 + (swz % 64) / 2; }
__host__ __device__ __forceinline__ int perm32(int rho) { const int n = rho >> 4, i = rho & 15; return 8 * (i >> 2) + 4 * n + (i & 3); }

struct Unit { int pm, pn; };
struct Gemm { const bf16_t* A; const bf16_t* Bt; int M, N, K; };

struct StaticOrder {
    int nM, nN, nwg, G, c;
    __host__ __device__ void init(int M, int N, int G_, int c_) { nM = M / BM; nN = N / BM; nwg = nM * nN; G = G_; c = c_; }
    __host__ __device__ bool next(int i, Unit& u) const {
        const long L = (long)i * G + c; if (L >= nwg) return false;
        int wgid = (int)L; { const int q = nwg / NXCD, r = nwg % NXCD, xcd = wgid % NXCD, off = wgid / NXCD; wgid = (xcd < r ? xcd * (q + 1) : r * (q + 1) + (xcd - r) * q) + off; }
        const int nig = WGM * nN, gid = wgid / nig, fm = gid * WGM, gsz = (nM - fm) < WGM ? (nM - fm) : WGM;
        u.pm = fm + ((wgid % nig) % gsz); u.pn = (wgid % nig) / gsz; return true;
    }
    __device__ __forceinline__ void a_ready(const Unit&) const {}
    __device__ __forceinline__ void done(const Unit&) const {}
};

__device__ __forceinline__ unsigned cvt_pk_bf16(float lo, float hi) { return ::pkbf(lo, hi); }
typedef float f32x2 __attribute__((ext_vector_type(2)));
struct EpiProj {
    static constexpr bool PERM = true, AFTER_DRAIN = false;
    bf16_t* PROJ; float* DT; const float* dt_bias; float* out;
    __device__ __forceinline__ void operator()(const f32x4 (&acc)[2][2][4][2], const Unit& u, int wr, int wc, int fr, int fq) const {
        const int row0 = u.pm * BM + wr * 64 + fr;
#pragma unroll
        for (int bj = 0; bj < 2; ++bj) {
            const int c0 = u.pn * BM + bj * HALF + wc * 32 + 8 * fq;
            if (c0 >= 3336) continue;
#pragma unroll
            for (int ai = 0; ai < 2; ++ai)
#pragma unroll
                for (int m = 0; m < 4; ++m) {
                    const int row = row0 + ai * HALF + m * 16; const f32x4 v0 = acc[ai][bj][m][0], v1 = acc[ai][bj][m][1];
                    if (c0 < 3328) { u32x4 w; w.x = cvt_pk_bf16(v0[0], v0[1]); w.y = cvt_pk_bf16(v0[2], v0[3]); w.z = cvt_pk_bf16(v1[0], v1[1]); w.w = cvt_pk_bf16(v1[2], v1[3]);
                        *(u32x4*)(PROJ + (size_t)row * 3328 + c0) = w; }
                    else { f32x4 a, b;
#pragma unroll
                        for (int i = 0; i < 4; ++i) { float x = v0[i] + dt_bias[i]; a[i] = x > 20.f ? x : log1pf(__expf(x)); float y = v1[i] + dt_bias[4 + i]; b[i] = y > 20.f ? y : log1pf(__expf(y)); }
                        *(f32x4*)(DT + (size_t)row * 8) = a; *(f32x4*)(DT + (size_t)row * 8 + 4) = b; }
                    const int t = row & 2047, b_ = row >> 11;
                    if (t == 2047 && c0 < 1792) { float* o = out + 16908288 + (size_t)b_ * 1792 + c0; *(f32x4*)o = v0; *(f32x4*)(o + 4) = v1; }
                    if (t >= 2045 && c0 >= 2304 && c0 < 3328) { float* o = out + 17184768 + ((size_t)b_ * 3 + (t - 2045)) * 1024 + (c0 - 2304); *(f32x4*)o = v0; *(f32x4*)(o + 4) = v1; }
                }
        }
    }
};
struct EpiResF32 {
    static constexpr bool PERM = true, AFTER_DRAIN = false;
    const float* resf; const bf16_t* resb; bf16_t* ob; int ld; float alpha;
    __device__ __forceinline__ void operator()(const f32x4 (&acc)[2][2][4][2], const Unit& u, int wr, int wc, int fr, int fq) const {
        const int row0 = u.pm * BM + wr * 64 + fr;
#pragma unroll
        for (int ai = 0; ai < 2; ++ai)
#pragma unroll
            for (int m = 0; m < 4; ++m)
#pragma unroll
                for (int bj = 0; bj < 2; ++bj) {
                    const int row = row0 + ai * HALF + m * 16, c0 = u.pn * BM + bj * HALF + wc * 32 + 8 * fq; const size_t o = (size_t)row * 1024 + c0;
                    f32x4 r0, r1;
                    if (resf) { r0 = *(const f32x4*)(resf + o); r1 = *(const f32x4*)(resf + o + 4); }
                    else { const u32x4 w = *(const u32x4*)(resb + o); r0[0] = __uint_as_float(w.x << 16); r0[1] = __uint_as_float(w.x & 0xffff0000u); r0[2] = __uint_as_float(w.y << 16); r0[3] = __uint_as_float(w.y & 0xffff0000u);
                        r1[0] = __uint_as_float(w.z << 16); r1[1] = __uint_as_float(w.z & 0xffff0000u); r1[2] = __uint_as_float(w.w << 16); r1[3] = __uint_as_float(w.w & 0xffff0000u); }
                    const f32x4 v0 = r0 * alpha + acc[ai][bj][m][0], v1 = r1 * alpha + acc[ai][bj][m][1];
                    u32x4 w8; w8.x = cvt_pk_bf16(v0[0], v0[1]); w8.y = cvt_pk_bf16(v0[2], v0[3]); w8.z = cvt_pk_bf16(v1[0], v1[1]); w8.w = cvt_pk_bf16(v1[2], v1[3]);
                    *(u32x4*)(ob + (size_t)row * ld + c0) = w8;
                }
    }
};
struct EpiRelu2 {
    static constexpr bool PERM = true, AFTER_DRAIN = false;
    bf16_t* O; int ldc;
    __device__ __forceinline__ void operator()(const f32x4 (&acc)[2][2][4][2], const Unit& u, int wr, int wc, int fr, int fq) const {
        const int row0 = u.pm * BM + wr * 64 + fr;
#pragma unroll
        for (int ai = 0; ai < 2; ++ai)
#pragma unroll
            for (int m = 0; m < 4; ++m)
#pragma unroll
                for (int bj = 0; bj < 2; ++bj) {
                    const int row = row0 + ai * HALF + m * 16, c0 = u.pn * BM + bj * HALF + wc * 32 + 8 * fq;
                    f32x4 v0 = acc[ai][bj][m][0], v1 = acc[ai][bj][m][1];
#pragma unroll
                    for (int i = 0; i < 4; ++i) { float a = fmaxf(v0[i], 0.f); v0[i] = a * a; float b = fmaxf(v1[i], 0.f); v1[i] = b * b; }
                    u32x4 w; w.x = cvt_pk_bf16(v0[0], v0[1]); w.y = cvt_pk_bf16(v0[2], v0[3]); w.z = cvt_pk_bf16(v1[0], v1[1]); w.w = cvt_pk_bf16(v1[2], v1[3]);
                    *(u32x4*)(O + (size_t)row * ldc + c0) = w;
                }
    }
};
template <class Epi, class Sched, bool ALIGN_EPI = false, bool SP2 = false>
__device__ __forceinline__ void gemm_phase(PG8_LAS unsigned char* lds, const Gemm g, const Sched& S, const Epi& E) {
    int tid = threadIdx.x; asm volatile("" : "+v"(tid)); const int wid = __builtin_amdgcn_readfirstlane(tid >> 6), lane = tid & 63, wr = wid >> 2, wc = wid & 3, fr = lane & 15, fq = lane >> 4;
    const int K = g.K, nt = K / BK;
    unsigned voffA[2], voffB[2];
#pragma unroll
    for (int i = 0; i < 2; ++i) { int R, C; stage_rc(tid * 16 + i * 8192, R, C); const int Rb = Epi::PERM ? ((R & ~31) + perm32(R & 31)) : R;
        voffA[i] = (unsigned)(R * K + C) * 2u; voffB[i] = (unsigned)(Rb * K + C) * 2u; }
    const size_t kstep = (size_t)(BK * 2);
    const size_t hstep = (size_t)HALF * K * 2;
    const size_t tstep = 2 * hstep;
    const unsigned ldsw = (unsigned)wid * 1024u;
    const int aoff = lds_byte(wr * 64 + fr, fq * 8), boff = lds_byte(wc * 32 + fr, fq * 8);
#define PG8_SA(b, h) (((b) * 2 + (h)) * HTB)
#define PG8_SB(b, h) ((4 + (b) * 2 + (h)) * HTB)
#define PG8_STAGE(bufoff, gbase, voff) do { _Pragma("unroll") for (int _i = 0; _i < 2; ++_i) \
        __builtin_amdgcn_global_load_lds((const unsigned*)((const char*)(gbase) + (voff)[_i]), (PG8_LAS unsigned*)(lds + (bufoff) + ldsw + _i * 8192), 16, 0, 0); } while (0)
#define PG8_LDA(dst, b, h) do { _Pragma("unroll") for (int m = 0; m < 4; ++m) _Pragma("unroll") for (int k = 0; k < 2; ++k) dst[m][k] = *(const PG8_LAS bf16x8*)(lds + PG8_SA(b, h) + aoff + m * 2048 + k * 1024); } while (0)
#define PG8_LDB(dst, b, h) do { _Pragma("unroll") for (int n = 0; n < 2; ++n) _Pragma("unroll") for (int k = 0; k < 2; ++k) dst[n][k] = *(const PG8_LAS bf16x8*)(lds + PG8_SB(b, h) + boff + n * 2048 + k * 1024); } while (0)
#define PG8_MMA(ai, bj, At, Bt) do { __builtin_amdgcn_s_setprio(1); _Pragma("unroll") for (int m = 0; m < 4; ++m) _Pragma("unroll") for (int n = 0; n < 2; ++n) _Pragma("unroll") for (int k = 0; k < 2; ++k) \
        acc[ai][bj][m][n] = __builtin_amdgcn_mfma_f32_16x16x32_bf16(Bt[n][k], At[m][k], acc[ai][bj][m][n], 0, 0, 0); __builtin_amdgcn_s_setprio(0); } while (0)
#define PG8_WAIT_V(n) asm volatile("s_waitcnt vmcnt(" #n ")" ::: "memory")
#define PG8_WAIT_L(n) asm volatile("s_waitcnt lgkmcnt(" #n ")" ::: "memory")
#define PG8_BAR __builtin_amdgcn_s_barrier()
#define PG8_SCHED __builtin_amdgcn_sched_barrier(0)
    Unit cur, nxt; int ui = 0;
    if (!S.next(0, cur)) return;
    f32x4 acc[2][2][4][2];
#pragma unroll
    for (int a = 0; a < 2; ++a)
#pragma unroll
        for (int b = 0; b < 2; ++b)
#pragma unroll
            for (int m = 0; m < 4; ++m)
#pragma unroll
                for (int n = 0; n < 2; ++n) acc[a][b][m][n] = (f32x4){0.f, 0.f, 0.f, 0.f};
    bf16x8 At[4][2], B0[2][2], B1[2][2];
    const char* cA = (const char*)g.A + (size_t)cur.pm * tstep; const char* cB = (const char*)g.Bt + (size_t)cur.pn * tstep;
    S.a_ready(cur);
    if constexpr (SP2) {
        PG8_STAGE(PG8_SB(0, 0), cB, voffB); PG8_STAGE(PG8_SB(0, 1), cB + hstep, voffB); PG8_STAGE(PG8_SA(0, 0), cA, voffA); PG8_STAGE(PG8_SA(0, 1), cA + hstep, voffA);
        if (wr == 1) PG8_BAR;
        PG8_WAIT_V(2); PG8_BAR;
        PG8_STAGE(PG8_SB(1, 0), cB + kstep, voffB); PG8_STAGE(PG8_SA(1, 0), cA + kstep, voffA); PG8_STAGE(PG8_SB(1, 1), cB + hstep + kstep, voffB);
        PG8_WAIT_V(6); PG8_BAR;
    } else {
        PG8_STAGE(PG8_SB(0, 0), cB, voffB); PG8_STAGE(PG8_SA(0, 0), cA, voffA); PG8_STAGE(PG8_SB(0, 1), cB + hstep, voffB); PG8_STAGE(PG8_SA(0, 1), cA + hstep, voffA);
        if (wr == 1) PG8_BAR;
        PG8_WAIT_V(4); PG8_BAR;
        PG8_STAGE(PG8_SB(1, 0), cB + kstep, voffB); PG8_STAGE(PG8_SA(1, 0), cA + kstep, voffA); PG8_STAGE(PG8_SB(1, 1), cB + hstep + kstep, voffB);
        PG8_WAIT_V(6); PG8_BAR;
    }
    for (;;) {
        const bool has_next = S.next(ui + 1, nxt);
        const char* nA = has_next ? (const char*)g.A + (size_t)nxt.pm * tstep : cA; const char* nB = has_next ? (const char*)g.Bt + (size_t)nxt.pn * tstep : cB;
        for (int t = 0; t < nt; t += 2) {
            const bool last = (t == nt - 2);
            const char* a1 = cA + (size_t)(t + 1) * kstep;
            const char* a2 = last ? nA : cA + (size_t)(t + 2) * kstep; const char* b2 = last ? nB : cB + (size_t)(t + 2) * kstep;
            const char* a3 = a2 + kstep; const char* b3 = b2 + kstep;
            if (last && has_next) S.a_ready(nxt);
            if constexpr (SP2) {
            PG8_LDB(B0, 0, 0); PG8_LDB(B1, 0, 1); PG8_SCHED; PG8_LDA(At, 0, 0); PG8_STAGE(PG8_SA(1, 1), a1 + hstep, voffA);
            PG8_WAIT_V(8); PG8_WAIT_L(0); PG8_BAR; PG8_MMA(0, 0, At, B0); PG8_MMA(0, 1, At, B1); PG8_BAR; PG8_SCHED;
            PG8_LDA(At, 0, 1); PG8_STAGE(PG8_SB(0, 0), b2, voffB); PG8_STAGE(PG8_SB(0, 1), b2 + hstep, voffB); PG8_STAGE(PG8_SA(0, 0), a2, voffA);
            PG8_WAIT_V(8); PG8_WAIT_L(0); PG8_BAR; PG8_MMA(1, 0, At, B0); PG8_MMA(1, 1, At, B1); PG8_BAR; PG8_SCHED;
            PG8_LDB(B0, 1, 0); PG8_LDB(B1, 1, 1); PG8_SCHED; PG8_LDA(At, 1, 0); PG8_STAGE(PG8_SA(0, 1), a2 + hstep, voffA);
            PG8_WAIT_V(8); PG8_WAIT_L(0); PG8_BAR; PG8_MMA(0, 0, At, B0); PG8_MMA(0, 1, At, B1); PG8_BAR; PG8_SCHED;
            PG8_LDA(At, 1, 1); PG8_STAGE(PG8_SB(1, 0), b3, voffB); PG8_STAGE(PG8_SB(1, 1), b3 + hstep, voffB); PG8_STAGE(PG8_SA(1, 0), a3, voffA);
            PG8_WAIT_V(8); PG8_WAIT_L(0); PG8_BAR; PG8_MMA(1, 0, At, B0); PG8_MMA(1, 1, At, B1); PG8_BAR; PG8_SCHED;
            } else {
            PG8_LDB(B0, 0, 0); PG8_SCHED; PG8_LDA(At, 0, 0); PG8_STAGE(PG8_SA(1, 1), a1 + hstep, voffA);
            PG8_WAIT_L(8); PG8_BAR; PG8_WAIT_L(0); PG8_MMA(0, 0, At, B0); PG8_BAR; PG8_SCHED;
            PG8_LDB(B1, 0, 1); PG8_STAGE(PG8_SB(0, 0), b2, voffB);
            PG8_BAR; PG8_WAIT_L(0); PG8_MMA(0, 1, At, B1); PG8_BAR;
            PG8_LDA(At, 0, 1); PG8_STAGE(PG8_SA(0, 0), a2, voffA);
            PG8_BAR; PG8_WAIT_L(0); PG8_MMA(1, 0, At, B0); PG8_BAR; PG8_SCHED;
            PG8_STAGE(PG8_SB(0, 1), b2 + hstep, voffB);
            PG8_WAIT_V(6); PG8_BAR; PG8_MMA(1, 1, At, B1); PG8_BAR;
            PG8_LDB(B0, 1, 0); PG8_SCHED; PG8_LDA(At, 1, 0); PG8_STAGE(PG8_SA(0, 1), a2 + hstep, voffA);
            PG8_WAIT_L(8); PG8_BAR; PG8_WAIT_L(0); PG8_MMA(0, 0, At, B0); PG8_BAR; PG8_SCHED;
            PG8_LDB(B1, 1, 1); PG8_STAGE(PG8_SB(1, 0), b3, voffB);
            PG8_BAR; PG8_WAIT_L(0); PG8_MMA(0, 1, At, B1); PG8_BAR;
            PG8_LDA(At, 1, 1); PG8_STAGE(PG8_SA(1, 0), a3, voffA);
            PG8_BAR; PG8_WAIT_L(0); PG8_MMA(1, 0, At, B0); PG8_BAR; PG8_SCHED;
            PG8_STAGE(PG8_SB(1, 1), b3 + hstep, voffB);
            PG8_WAIT_V(6); PG8_BAR; PG8_MMA(1, 1, At, B1); PG8_BAR;
            }
        }
        if constexpr (ALIGN_EPI) { if (wr == 0) PG8_BAR; }
        if constexpr (!Epi::AFTER_DRAIN) { E(acc, cur, wr, wc, fr, fq); S.done(cur); }
        if (!has_next) break;
#pragma unroll
        for (int a = 0; a < 2; ++a)
#pragma unroll
            for (int b = 0; b < 2; ++b)
#pragma unroll
                for (int m = 0; m < 4; ++m)
#pragma unroll
                    for (int n = 0; n < 2; ++n) acc[a][b][m][n] = (f32x4){0.f, 0.f, 0.f, 0.f};
        cur = nxt; cA = nA; cB = nB; ++ui;
        if constexpr (ALIGN_EPI) { if (wr == 1) PG8_BAR; }
    }
    PG8_WAIT_V(0);
    if constexpr (!ALIGN_EPI) { if (wr == 0) PG8_BAR; }
    PG8_BAR;
    if constexpr (Epi::AFTER_DRAIN) { E.fused(acc, cur, wr, wc, fr, fq, lds, wid, lane); S.done(cur); }
#undef PG8_SA
#undef PG8_SB
#undef PG8_STAGE
#undef PG8_LDA
#undef PG8_LDB
#undef PG8_MMA
#undef PG8_WAIT_V
#undef PG8_WAIT_L
#undef PG8_BAR
#undef PG8_SCHED
}
}

#define XB_TMO      128
#define XB_XCNT(j)  (256  + 64 * (j))
#define XB_XSUB(j)  (1280 + 64 * (j))
#define XB_XGEN(j)  (2304 + 64 * (j))
#define XB_TOP      3328
#define XB_TOPGEN   3392
#define XCD_BAR_WORDS 3456
#define XB_SPIN_CAP (1u << 18)

__device__ __forceinline__ unsigned xb_ld(unsigned* p)              { return __hip_atomic_load(p, __ATOMIC_RELAXED, __HIP_MEMORY_SCOPE_AGENT); }
__device__ __forceinline__ unsigned xb_add(unsigned* p, unsigned v) { return __hip_atomic_fetch_add(p, v, __ATOMIC_RELAXED, __HIP_MEMORY_SCOPE_AGENT); }
__device__ __forceinline__ unsigned xb_xcc_id() { return (unsigned)__builtin_amdgcn_s_getreg((3 << 11) | 20) & 0xFu; }
#define XB_SPIN(cond, bar) do { unsigned _sp = 0; while (cond) { __builtin_amdgcn_s_sleep(1); \
    if ((++_sp & 255u) == 0u) { if (xb_ld(&(bar)[XB_TMO])) break; if (_sp > XB_SPIN_CAP) { atomicAdd(&(bar)[XB_TMO], 1u); break; } } } } while (0)

struct XcdBarrier {
    unsigned* bar; unsigned x;
    volatile LAS unsigned* st;
};

__device__ __forceinline__ XcdBarrier xcd_barrier_post(unsigned* bar, volatile LAS unsigned* st) {
    XcdBarrier b; b.bar = bar; b.x = xb_xcc_id(); b.st = st;
    if (threadIdx.x == 0) (void)xb_add(&bar[XB_XCNT(b.x)], 1u);
    return b;
}
__device__ __forceinline__ void xcd_barrier_complete(unsigned* bar, unsigned x, unsigned& nloc, unsigned& nx) {
    const unsigned G = gridDim.x * gridDim.y * gridDim.z;
    unsigned sum, cnt, mine, sp = 0u;
    for (;;) {
        sum = 0u; cnt = 0u; mine = 0u;
#pragma unroll
        for (unsigned j = 0; j < 16; ++j) { const unsigned c = xb_ld(&bar[XB_XCNT(j)]); sum += c; cnt += (c > 0u) ? 1u : 0u; mine = (j == x) ? c : mine; }
        if (sum == G) break;
        __builtin_amdgcn_s_sleep(1);
        if ((++sp & 255u) == 0u) { if (xb_ld(&bar[XB_TMO])) break; if (sp > XB_SPIN_CAP) { atomicAdd(&bar[XB_TMO], 1u); break; } }
    }
    nloc = mine > 0u ? mine : 1u; nx = cnt > 0u ? cnt : 1u;
}

__device__ __forceinline__ void xcd_barrier(const XcdBarrier& b) {
    asm volatile("s_waitcnt vmcnt(0)" ::: "memory");
    __syncthreads();
    if (threadIdx.x == 0) {
        unsigned* bar = b.bar;
        __builtin_amdgcn_s_waitcnt(0);
        unsigned nloc = b.st[0], nx = b.st[1];
        if (nloc == 0u) { xcd_barrier_complete(bar, b.x, nloc, nx); b.st[0] = nloc; b.st[1] = nx; }
        const unsigned old = xb_add(&bar[XB_XSUB(b.x)], 1u);
        const unsigned gen = old / nloc;
        if (old + 1u == (gen + 1u) * nloc) {
            __builtin_amdgcn_fence(__ATOMIC_RELEASE, "agent");
            asm volatile("s_waitcnt vmcnt(0)" ::: "memory");
            const unsigned og = xb_add(&bar[XB_TOP], 1u);
            const unsigned tg = og / nx;
            if (og + 1u == (tg + 1u) * nx) xb_add(&bar[XB_TOPGEN], 1u);
            else XB_SPIN(xb_ld(&bar[XB_TOPGEN]) == tg, bar);
            __builtin_amdgcn_fence(__ATOMIC_ACQUIRE, "agent");
            xb_add(&bar[XB_XGEN(b.x)], 1u);
            asm volatile("s_waitcnt vmcnt(0)" ::: "memory");
        } else {
            XB_SPIN(xb_ld(&bar[XB_XGEN(b.x)]) == gen, bar);
            __builtin_amdgcn_fence(__ATOMIC_ACQUIRE, "agent");
            asm volatile("s_waitcnt vmcnt(0)" ::: "memory");
        }
    }
    __syncthreads();
}

__device__ __forceinline__ void lerp8(const P& p, int row, int col, float* o) {
    const bf16* PROJ = (const bf16*)(p.ws + WS_PROJ);
    float cur[8], prv[8];
    unpack8(*(const u32x4*)(PROJ + (size_t)row * PLD + col), cur);
    if (row >= MPR) { const float* s = p.in[2] + (size_t)(row - MPR) * RPJ + col; const f32x4 a = *(const f32x4*)s, b = *(const f32x4*)(s + 4);
        prv[0] = a[0]; prv[1] = a[1]; prv[2] = a[2]; prv[3] = a[3]; prv[4] = b[0]; prv[5] = b[1]; prv[6] = b[2]; prv[7] = b[3]; }
    else if ((row & (SEQ - 1)) == 0) {
#pragma unroll
        for (int i = 0; i < 8; ++i) prv[i] = 0.f; }
    else unpack8(*(const u32x4*)(PROJ + (size_t)(row - 1) * PLD + col), prv);
    const float* mu = p.in[7] + col; const f32x4 m0 = *(const f32x4*)mu, m1 = *(const f32x4*)(mu + 4);
#pragma unroll
    for (int i = 0; i < 4; ++i) { o[i] = cur[i] + (prv[i] - cur[i]) * m0[i]; o[4 + i] = cur[4 + i] + (prv[4 + i] - cur[4 + i]) * m1[i]; }
}
__device__ __forceinline__ float lerp1(const P& p, int row, int col) {
    const bf16* PROJ = (const bf16*)(p.ws + WS_PROJ);
    const float cur = bf2f(PROJ[(size_t)row * PLD + col]); float prv;
    if (row >= MPR) prv = p.in[2][(size_t)(row - MPR) * RPJ + col];
    else if ((row & (SEQ - 1)) == 0) prv = 0.f;
    else prv = bf2f(PROJ[(size_t)(row - 1) * PLD + col]);
    return cur + (prv - cur) * p.in[7][col];
}

__device__ __forceinline__ void transpose_item(const float* W, int K, int N, bf16* WT, float* scr, int item, int lane) {
    const int nblk = (N + 31) / 32, kb = item / nblk, nb = item % nblk, k0 = 64 * kb, n0 = 32 * nb;
    float tv[32];
#pragma unroll
    for (int i = 0; i < 32; ++i) { const int kk = 2 * i + (lane >> 5), n = n0 + (lane & 31); tv[i] = (n < N) ? W[(size_t)(k0 + kk) * N + n] : 0.f; }
#pragma unroll
    for (int i = 0; i < 32; ++i) { const int kk = 2 * i + (lane >> 5); scr[kk * 33 + (lane & 31)] = tv[i]; }
    LDS_FENCE();
    const int c = lane & 7;
#pragma unroll
    for (int j = 0; j < 4; ++j) { const int n = (lane >> 3) + 8 * j; const float* s = scr + (8 * c) * 33 + n;
        u32x4 o; o.x = pkbf(s[0 * 33], s[1 * 33]); o.y = pkbf(s[2 * 33], s[3 * 33]); o.z = pkbf(s[4 * 33], s[5 * 33]); o.w = pkbf(s[6 * 33], s[7 * 33]);
        *(u32x4*)(WT + (size_t)(n0 + n) * K + k0 + 8 * c) = o; }
    LDS_FENCE();
}

__device__ __forceinline__ void phase0(const P& p_in, unsigned char* smem) {
    PHASE_PROLOGUE;
    const int lane = tid & 63, wave = tid >> 6, G = gridDim.x, bid = blockIdx.x;
    const int gw = bid * 8 + wave, NGW = G * 8; const size_t gt = (size_t)bid * 512 + tid, NGT = (size_t)G * 512;
    bf16* XB = (bf16*)(p.ws + WS_XB);
#pragma unroll 4
    for (size_t i = gt; i < (size_t)MTOT * DM / 8; i += NGT) { const size_t e = i * 8; const float* src = e < (size_t)MPR * DM ? p.in[0] + e : p.in[1] + (e - (size_t)MPR * DM);
        const f32x4 a = *(const f32x4*)src, b = *(const f32x4*)(src + 4); u32x4 o; o.x = pkbf(a[0], a[1]); o.y = pkbf(a[2], a[3]); o.z = pkbf(b[0], b[1]); o.w = pkbf(b[2], b[3]); *(u32x4*)(XB + e) = o; }
    float* scr = (float*)(smem + wave * 8448);
    constexpr int I_IN = 16 * 105, I_WU = 16, I_AU = 16, I_GU = 32;
    constexpr int NIT = I_IN + I_WU + I_AU + I_GU;
    for (int it = gw; it < NIT; it += NGW) {
        int r = it;
        if (r < I_IN) { transpose_item(p.in[6], 1024, PROJN, (bf16*)(p.ws + WS_WIN), scr, r, lane); continue; } r -= I_IN;
        if (r < I_WU) { transpose_item(p.in[9], 64, 512, (bf16*)(p.ws + WS_LORA), scr, r, lane); continue; } r -= I_WU;
        if (r < I_AU) { transpose_item(p.in[11], 64, 512, (bf16*)(p.ws + WS_LORA + 65536), scr, r, lane); continue; } r -= I_AU;
        transpose_item(p.in[12], 128, 512, (bf16*)(p.ws + WS_LORA + 131072), scr, r, lane);
    }
    for (size_t i = gt; i < (size_t)MSM * 2048 / 4; i += NGT) { const size_t idx = i * 4, b = idx >> 11, rem = idx & 2047;
        *(f32x4*)(p.out + O_CONVS + b * 3072 + rem) = *(const f32x4*)(p.in[4] + b * 3072 + 1024 + rem); }
}

__device__ __forceinline__ void phase0_late(const P& p_in, unsigned char* smem, int first, int which) {
    PHASE_PROLOGUE;
    const int lane = tid & 63, wave = tid >> 6, G = gridDim.x, bid = blockIdx.x;
    if (bid < first) return;
    const int gw = (bid - first) * 8 + wave, NGW = (G - first) * 8;
    float* scr = (float*)(smem + wave * 8448);
    constexpr int I_OUT = 16 * 32, I_F1 = 16 * 128, I_F2 = 64 * 32;
    const int lo = which ? I_OUT + I_F1 : 0, hi = which ? I_OUT + I_F1 + I_F2 : I_OUT + I_F1;
    for (int it = lo + gw; it < hi; it += NGW) {
        int r = it;
        if (r < I_OUT) { transpose_item(p.in[24], 1024, 1024, (bf16*)(p.ws + WS_WOUT), scr, r, lane); continue; } r -= I_OUT;
        if (r < I_F1) { transpose_item(p.in[27], 1024, 4096, (bf16*)(p.ws + WS_WFF1), scr, r, lane); continue; } r -= I_F1;
        transpose_item(p.in[28], 4096, 1024, (bf16*)(p.ws + WS_WFF2), scr, r, lane);
    }
}

template <int RG, int K, class F> __device__ __forceinline__ void small_gemm(const bf16* A, const bf16* Bt, int N, unsigned char* smem, const F& epi, int first = 0) {
    int tid = threadIdx.x; asm volatile("" : "+v"(tid));
    const int lane = tid & 63, wave = tid >> 6, r = lane & 15, q = lane >> 4;
    constexpr int KS = K / 8, NST = KS / 32, RGN = 8 / RG;
    const int nunits = ((N + 15) / 16) * RGN;
    float* part = (float*)smem;
    for (int u = (int)gridDim.x - 1 - (int)blockIdx.x; u < nunits && (int)blockIdx.x >= first; u += (int)gridDim.x - first) {
        const int ct = u / RGN, rg = u - ct * RGN, n0 = ct * 16;
        f32x4 acc[RG];
#pragma unroll
        for (int t = 0; t < RG; ++t) acc[t] = (f32x4){0.f, 0.f, 0.f, 0.f};
        const bf16* ap = A + (size_t)(rg * RG * 16 + r) * K + wave * KS + q * 8;
        const bf16* bp = Bt + (size_t)(n0 + r) * K + wave * KS + q * 8;
#pragma unroll 8
        for (int ks = 0; ks < NST; ++ks) {
            const bf16x8 b = *(const bf16x8*)(bp + ks * 32);
#pragma unroll
            for (int t = 0; t < RG; ++t) acc[t] = mfma16(*(const bf16x8*)(ap + (size_t)t * 16 * K + ks * 32), b, acc[t]);
        }
#pragma unroll
        for (int t = 0; t < RG; ++t)
#pragma unroll
            for (int j = 0; j < 4; ++j) part[(wave * RG + t) * 256 + (q * 4 + j) * 16 + r] = acc[t][j];
        __syncthreads();
        for (int e = tid; e < RG * 256; e += 512) { const int t = e >> 8, idx = e & 255; float v = 0.f;
#pragma unroll
            for (int w = 0; w < 8; ++w) v += part[(w * RG + t) * 256 + idx];
            const int col = n0 + (idx & 15);
            if (col < N) epi((rg * RG + t) * 16 + (idx >> 4), col, v); }
        __syncthreads();
    }
}

__device__ __forceinline__ void phase_prep(const P& p_in, unsigned char* smem) {
    PHASE_PROLOGUE;
    const int lane = tid & 63, wave = tid >> 6, G = gridDim.x, bid = blockIdx.x, r = lane & 15, q = lane >> 4;
    const bf16* WUPT = (const bf16*)(p.ws + WS_LORA); const bf16* AUPT = (const bf16*)(p.ws + WS_LORA + 65536); const bf16* GUPT = (const bf16*)(p.ws + WS_LORA + 131072);
    const bf16* PROJ = (const bf16*)(p.ws + WS_PROJ);
    float* WD = p.out + OS_WD; bf16* GG = (bf16*)(p.out + OS_GG);
    bf16* KP = (bf16*)(p.ws + WS_KP); bf16* KK = (bf16*)(p.ws + WS_KK); bf16* KB = (bf16*)(p.ws + WS_KB);
    bf16* WU = (bf16*)smem; bf16* AU = WU + 64 * 72; bf16* GU = AU + 64 * 72;
    bf16* kcur = (bf16*)(smem + 35840 + wave * 4608); bf16* kprv = kcur + 16 * 72;
#pragma unroll 1
    for (int tile = bid; tile < MTOT / 128; tile += G) {
        const int item = tile * 8 + wave, rowa = item * 16 + r;
        bf16x8 aw[2], aa[2], ag[4];
        float u[8];
        if (rowa < MPR) {
            const int prow = (rowa & (SEQ - 1)) ? rowa - 1 : rowa; const float pz = (rowa & (SEQ - 1)) ? 1.f : 0.f;
            u32x4 cu[8], pv[8];
#pragma unroll
            for (int i = 0; i < 8; ++i) { const int col = 1536 + i * 32 + q * 8; cu[i] = *(const u32x4*)(PROJ + (size_t)rowa * PLD + col); pv[i] = *(const u32x4*)(PROJ + (size_t)prow * PLD + col); }
#pragma unroll
            for (int i = 0; i < 8; ++i) { const int col = 1536 + i * 32 + q * 8; float c8[8], p8[8]; unpack8(cu[i], c8); unpack8(pv[i], p8);
                const f32x4 m0 = *(const f32x4*)(p.in[7] + col), m1 = *(const f32x4*)(p.in[7] + col + 4);
#pragma unroll
                for (int j = 0; j < 4; ++j) { u[j] = c8[j] + (p8[j] * pz - c8[j]) * m0[j]; u[4 + j] = c8[4 + j] + (p8[4 + j] * pz - c8[4 + j]) * m1[j]; }
                if (i < 2) {
#pragma unroll
                    for (int j = 0; j < 8; ++j) u[j] = tanh_(u[j]);
                    aw[i] = __builtin_bit_cast(bf16x8, pack8(u)); }
                else if (i < 4) aa[i - 2] = __builtin_bit_cast(bf16x8, pack8(u));
                else {
#pragma unroll
                    for (int j = 0; j < 8; ++j) u[j] = sigm(u[j]);
                    ag[i - 4] = __builtin_bit_cast(bf16x8, pack8(u)); } }
        } else {
#pragma unroll
        for (int ks = 0; ks < 2; ++ks) { lerp8(p, rowa, 1536 + ks * 32 + q * 8, u);
#pragma unroll
            for (int i = 0; i < 8; ++i) u[i] = tanh_(u[i]);
            aw[ks] = __builtin_bit_cast(bf16x8, pack8(u)); }
#pragma unroll
        for (int ks = 0; ks < 2; ++ks) { lerp8(p, rowa, 1600 + ks * 32 + q * 8, u); aa[ks] = __builtin_bit_cast(bf16x8, pack8(u)); }
#pragma unroll
        for (int ks = 0; ks < 4; ++ks) { lerp8(p, rowa, 1664 + ks * 32 + q * 8, u);
#pragma unroll
            for (int i = 0; i < 8; ++i) u[i] = sigm(u[i]);
            ag[ks] = __builtin_bit_cast(bf16x8, pack8(u)); }
        }
        u32x4 pw, pa, pg[2];
#define PREP_LOAD(hh_) do { const int c_ = tid >> 3, k8_ = (tid & 7) * 8; \
            pw = *(const u32x4*)(WUPT + (size_t)((hh_) * 64 + c_) * 64 + k8_); pa = *(const u32x4*)(AUPT + (size_t)((hh_) * 64 + c_) * 64 + k8_); \
            _Pragma("unroll") for (int i = 0; i < 2; ++i) { const int pc_ = tid + i * 512, c2_ = pc_ >> 4, k82_ = (pc_ & 15) * 8; pg[i] = *(const u32x4*)(GUPT + (size_t)((hh_) * 64 + c2_) * 128 + k82_); } } while (0)
        PREP_LOAD(0);
#pragma unroll 1
        for (int h = 0; h < 8; ++h) {
            __syncthreads();
            { const int c = tid >> 3, k8 = (tid & 7) * 8;
              *(u32x4*)(WU + c * 72 + k8) = pw; *(u32x4*)(AU + c * 72 + k8) = pa;
#pragma unroll
              for (int i = 0; i < 2; ++i) { const int pc = tid + i * 512, c2 = pc >> 4, k82 = (pc & 15) * 8; *(u32x4*)(GU + c2 * 136 + k82) = pg[i]; } }
#pragma unroll
            for (int i = 0; i < 2; ++i) { const int pc = lane + i * 64, rr = pc >> 3, c8 = (pc & 7) * 8, row = item * 16 + rr, col = 512 + h * 64 + c8;
                *(u32x4*)(kcur + rr * 72 + c8) = *(const u32x4*)(PROJ + (size_t)row * PLD + col);
                u32x4 pv = {0u, 0u, 0u, 0u};
                if (row >= MPR) { const float* sp = p.in[2] + (size_t)(row - MPR) * RPJ + col; const f32x4 a = *(const f32x4*)sp, b = *(const f32x4*)(sp + 4); pv.x = pkbf(a[0], a[1]); pv.y = pkbf(a[2], a[3]); pv.z = pkbf(b[0], b[1]); pv.w = pkbf(b[2], b[3]); }
                else if ((row & (SEQ - 1)) != 0) pv = *(const u32x4*)(PROJ + (size_t)(row - 1) * PLD + col);
                *(u32x4*)(kprv + rr * 72 + c8) = pv; }
            if (h + 1 < 8) PREP_LOAD(h + 1);
            __syncthreads();
            float ss[4] = {0.f, 0.f, 0.f, 0.f};
#pragma unroll
            for (int ctl = 0; ctl < 4; ++ctl) { const int cl = ctl * 16 + r, col = h * 64 + cl; const float kkc = p.in[13][col], muc = p.in[7][512 + col];
#pragma unroll
                for (int j = 0; j < 4; ++j) { const float kc = bf2f(kcur[(q * 4 + j) * 72 + cl]), kv = bf2f(kprv[(q * 4 + j) * 72 + cl]); const float kr = (kc + (kv - kc) * muc) * kkc; ss[j] += kr * kr; } }
#pragma unroll
            for (int j = 0; j < 4; ++j) { ss[j] = sum16(ss[j]); ss[j] = rsqrtf(fmaxf(ss[j], 1e-24f)); }
#pragma unroll 1
            for (int ctl = 0; ctl < 4; ++ctl) {
                const int cl = ctl * 16 + r, col = h * 64 + cl;
                f32x4 cw = {0.f, 0.f, 0.f, 0.f}, ca = cw, cgt = cw;
#pragma unroll
                for (int ks = 0; ks < 2; ++ks) { cw = mfma16(aw[ks], *(const bf16x8*)(WU + cl * 72 + ks * 32 + q * 8), cw); ca = mfma16(aa[ks], *(const bf16x8*)(AU + cl * 72 + ks * 32 + q * 8), ca); }
#pragma unroll
                for (int ks = 0; ks < 4; ++ks) cgt = mfma16(ag[ks], *(const bf16x8*)(GU + cl * 136 + ks * 32 + q * 8), cgt);
                const float w0c = p.in[8][col], a0c = p.in[10][col], kkc = p.in[13][col], kac = p.in[14][col], muc = p.in[7][512 + col];
#pragma unroll
                for (int j = 0; j < 4; ++j) {
                    const int row = item * 16 + q * 4 + j; const size_t o = (size_t)row * 512 + col;
                    const float wl = -softplus(-(w0c + cw[j])) - 0.5f;
                    WD[o] = __expf(-__expf(wl));
                    const float a = sigm(a0c + ca[j]);
                    GG[o] = f2bf(cgt[j]);
                    const float kc = bf2f(kcur[(q * 4 + j) * 72 + cl]), kv = bf2f(kprv[(q * 4 + j) * 72 + cl]); const float k = kc + (kv - kc) * muc;
                    KP[o] = f2bf(k * (1.f + (a - 1.f) * kac));
                    const float kk = k * kkc * ss[j];
                    KK[o] = f2bf(kk); KB[o] = f2bf(kk * a);
                }
            }
        }
    }
    __syncthreads();
#undef PREP_LOAD
    bf16* XBC = (bf16*)(p.ws + WS_XBC);
    const int ntl = MTOT / 128, cb = (G > ntl + 32) ? ntl : 0;
    if (bid < cb) return;
    const size_t gt = (size_t)(bid - cb) * 512 + tid, NGT = (size_t)(G - cb) * 512;
    for (size_t idx = gt; idx < (size_t)MPR * 128; idx += NGT) {
        const int row = (int)(idx >> 7), c0 = (int)(idx & 127) * 8, t = row & (SEQ - 1);
        float acc[8], x[8];
        { const f32x4 b0 = *(const f32x4*)(p.in[19] + c0), b1 = *(const f32x4*)(p.in[19] + c0 + 4);
#pragma unroll
          for (int i = 0; i < 4; ++i) { acc[i] = b0[i]; acc[4 + i] = b1[i]; } }
#pragma unroll
        for (int d = 0; d < 4; ++d) { if (t - 3 + d < 0) continue;
            unpack8(*(const u32x4*)(PROJ + (size_t)(row - 3 + d) * PLD + 2304 + c0), x);
            const f32x4 w0 = *(const f32x4*)(p.in[18] + d * 1024 + c0), w1 = *(const f32x4*)(p.in[18] + d * 1024 + c0 + 4);
#pragma unroll
            for (int i = 0; i < 4; ++i) { acc[i] += w0[i] * x[i]; acc[4 + i] += w1[i] * x[4 + i]; } }
#pragma unroll
        for (int i = 0; i < 8; ++i) acc[i] = silu(acc[i]);
        *(u32x4*)(XBC + (size_t)row * 1024 + c0) = pack8(acc);
    }
}

constexpr int TC = 32, SBUF = 5 * TC * 64 + TC * 16 + TC * 2;
struct StageRegs { f32x4 w0, w1; u32x4 kp, kk, kb, rc, rp, vc, vp; };
__device__ __forceinline__ void scan_issue(const P& p, StageRegs& R, int row0, int h, int vq, int st) {
    const float* WD = p.out + OS_WD; const bf16* KP = (const bf16*)(p.ws + WS_KP); const bf16* KK = (const bf16*)(p.ws + WS_KK); const bf16* KB = (const bf16*)(p.ws + WS_KB); const bf16* PROJ = (const bf16*)(p.ws + WS_PROJ);
    const int tt = st >> 3, k8 = (st & 7) * 8, row = row0 + tt, prow = (row & (SEQ - 1)) ? row - 1 : row; const size_t o = (size_t)row * 512 + h * 64 + k8;
    R.w0 = *(const f32x4*)(WD + o); R.w1 = *(const f32x4*)(WD + o + 4); R.kp = *(const u32x4*)(KP + o); R.kk = *(const u32x4*)(KK + o); R.kb = *(const u32x4*)(KB + o);
    R.rc = *(const u32x4*)(PROJ + (size_t)row * PLD + h * 64 + k8); R.rp = *(const u32x4*)(PROJ + (size_t)prow * PLD + h * 64 + k8);
    if (st < 64) { const int t2 = st >> 1, v8 = (st & 1) * 8, row2 = row0 + t2, prow2 = (row2 & (SEQ - 1)) ? row2 - 1 : row2;
        R.vc = *(const u32x4*)(PROJ + (size_t)row2 * PLD + 1024 + h * 64 + vq * 16 + v8); R.vp = *(const u32x4*)(PROJ + (size_t)prow2 * PLD + 1024 + h * 64 + vq * 16 + v8); }
}
__device__ __forceinline__ void scan_commit(const StageRegs& R, float* B, int row0, int st, const float* mur, const float* muv) {
    const int tt = st >> 3, k8 = (st & 7) * 8; float kp[8], kb[8], v[8], rc[8], rp[8];
    *(f32x4*)(B + tt * 64 + k8) = R.w0; *(f32x4*)(B + tt * 64 + k8 + 4) = R.w1;
    unpack8(R.kp, kp); *(f32x4*)(B + TC * 64 + tt * 64 + k8) = (f32x4){kp[0], kp[1], kp[2], kp[3]}; *(f32x4*)(B + TC * 64 + tt * 64 + k8 + 4) = (f32x4){kp[4], kp[5], kp[6], kp[7]};
    unpack8(R.kk, v); *(f32x4*)(B + 2 * TC * 64 + tt * 64 + k8) = (f32x4){-v[0], -v[1], -v[2], -v[3]}; *(f32x4*)(B + 2 * TC * 64 + tt * 64 + k8 + 4) = (f32x4){-v[4], -v[5], -v[6], -v[7]};
    unpack8(R.kb, kb); *(f32x4*)(B + 3 * TC * 64 + tt * 64 + k8) = (f32x4){kb[0], kb[1], kb[2], kb[3]}; *(f32x4*)(B + 3 * TC * 64 + tt * 64 + k8 + 4) = (f32x4){kb[4], kb[5], kb[6], kb[7]};
    unpack8(R.rc, rc); unpack8(R.rp, rp); const float pz = ((row0 + tt) & (SEQ - 1)) ? 1.f : 0.f;
    float c1 = 0.f, c2 = 0.f;
#pragma unroll
    for (int j = 0; j < 8; ++j) { v[j] = rc[j] + (rp[j] * pz - rc[j]) * mur[j]; c1 += kb[j] * v[j]; c2 += kp[j] * v[j]; }
    *(f32x4*)(B + 4 * TC * 64 + tt * 64 + k8) = (f32x4){R.w0[0] * v[0], R.w0[1] * v[1], R.w0[2] * v[2], R.w0[3] * v[3]}; *(f32x4*)(B + 4 * TC * 64 + tt * 64 + k8 + 4) = (f32x4){R.w1[0] * v[4], R.w1[1] * v[5], R.w1[2] * v[6], R.w1[3] * v[7]};
    c1 += __shfl_xor(c1, 1); c2 += __shfl_xor(c2, 1); c1 += __shfl_xor(c1, 2); c2 += __shfl_xor(c2, 2); c1 += __shfl_xor(c1, 4); c2 += __shfl_xor(c2, 4);
    if ((st & 7) == 0) { B[5 * TC * 64 + TC * 16 + tt * 2] = c1; B[5 * TC * 64 + TC * 16 + tt * 2 + 1] = c2; }
    if (st < 64) { const int t2 = st >> 1, v8 = (st & 1) * 8; unpack8(R.vc, rc); unpack8(R.vp, rp); const float pz2 = ((row0 + t2) & (SEQ - 1)) ? 1.f : 0.f;
#pragma unroll
        for (int j = 0; j < 8; ++j) v[j] = rc[j] + (rp[j] * pz2 - rc[j]) * muv[j];
        *(f32x4*)(B + 5 * TC * 64 + t2 * 16 + v8) = (f32x4){v[0], v[1], v[2], v[3]}; *(f32x4*)(B + 5 * TC * 64 + t2 * 16 + v8 + 4) = (f32x4){v[4], v[5], v[6], v[7]}; }
}
struct ScanIn { f32x4 w, kp, ka, kb, wr; float vv, c1, c2; };
__device__ __forceinline__ ScanIn scan_load(const float* B, int tt, int kg, int rloc) {
    ScanIn s; s.w = *(const f32x4*)(B + tt * 64 + kg * 4); s.kp = *(const f32x4*)(B + TC * 64 + tt * 64 + kg * 4); s.ka = *(const f32x4*)(B + 2 * TC * 64 + tt * 64 + kg * 4);
    s.kb = *(const f32x4*)(B + 3 * TC * 64 + tt * 64 + kg * 4); s.wr = *(const f32x4*)(B + 4 * TC * 64 + tt * 64 + kg * 4);
    s.vv = B[5 * TC * 64 + tt * 16 + rloc]; s.c1 = B[5 * TC * 64 + TC * 16 + tt * 2]; s.c2 = B[5 * TC * 64 + TC * 16 + tt * 2 + 1]; return s;
}
__device__ __forceinline__ void phase_scan(const P& p_in, unsigned char* smem) {
    PHASE_PROLOGUE;
    const int lane = tid & 63, wave = tid >> 6;
    float* buf0 = (float*)smem; float* ybuf = buf0 + 2 * SBUF;
    bf16* YR = (bf16*)(p.ws + WS_XB);
    constexpr int NCH = SEQ / TC;
    for (int unit = blockIdx.x; unit < 256; unit += gridDim.x) {
        const int xcd = unit & 7, slot = unit >> 3, bh = xcd * 8 + (slot >> 2), vq = slot & 3, b = bh >> 3, h = bh & 7, rowbase = b * SEQ;
        bf16* yu = YR + (size_t)(bh * 4 + vq) * SEQ * 16;
        const int st = tid - 256;
        StageRegs R; float mur[8], muv[8];
        if (wave >= 4) {
#pragma unroll
            for (int j = 0; j < 8; ++j) { mur[j] = p.in[7][h * 64 + (st & 7) * 8 + j]; muv[j] = p.in[7][1024 + h * 64 + vq * 16 + (st & 1) * 8 + j]; }
            scan_issue(p, R, rowbase, h, vq, st); scan_commit(R, buf0, rowbase, st, mur, muv); scan_issue(p, R, rowbase + TC, h, vq, st);
        }
        __syncthreads();
        float S0 = 0.f, S1 = 0.f, S2 = 0.f, S3 = 0.f;
        const int rl = lane >> 4, kg = lane & 15, rloc = (wave & 3) * 4 + rl;
        for (int c = 0; c < NCH; ++c) {
            if (wave < 4) {
                const float* B = buf0 + (c & 1) * SBUF; float* yb = ybuf + (c & 1) * (TC * 16);
                ScanIn cur = scan_load(B, 0, kg, rloc);
#pragma unroll 4
                for (int tt = 0; tt < TC; ++tt) {
                    const ScanIn nxt = scan_load(B, (tt + 1) & (TC - 1), kg, rloc);
                    float sa = (S0 * cur.ka[0] + S1 * cur.ka[1]) + (S2 * cur.ka[2] + S3 * cur.ka[3]);
                    float y1 = (S0 * cur.wr[0] + S1 * cur.wr[1]) + (S2 * cur.wr[2] + S3 * cur.wr[3]);
                    sa += dppf<0xB1>(sa); y1 += dppf<0xB1>(y1); sa += dppf<0x4E>(sa); y1 += dppf<0x4E>(y1);
                    sa += dppf<0x141>(sa); y1 += dppf<0x141>(y1); sa += dppf<0x140>(sa); y1 += dppf<0x140>(y1);
                    S0 = S0 * cur.w[0] + (sa * cur.kb[0] + cur.vv * cur.kp[0]); S1 = S1 * cur.w[1] + (sa * cur.kb[1] + cur.vv * cur.kp[1]);
                    S2 = S2 * cur.w[2] + (sa * cur.kb[2] + cur.vv * cur.kp[2]); S3 = S3 * cur.w[3] + (sa * cur.kb[3] + cur.vv * cur.kp[3]);
                    if (kg == 0) yb[tt * 16 + rloc] = y1 + sa * cur.c1 + cur.vv * cur.c2;
                    cur = nxt;
                }
            } else {
                if (c + 1 < NCH) scan_commit(R, buf0 + ((c + 1) & 1) * SBUF, rowbase + (c + 1) * TC, st, mur, muv);
                if (c + 2 < NCH) scan_issue(p, R, rowbase + (c + 2) * TC, h, vq, st);
                if (c > 0) { const float* yp = ybuf + ((c - 1) & 1) * (TC * 16); const int i2 = st * 2;
                    *(unsigned*)(yu + (size_t)(c - 1) * TC * 16 + i2) = pkbf(yp[i2], yp[i2 + 1]); }
            }
            __syncthreads();
        }
        if (wave >= 4) { const float* yp = ybuf + ((NCH - 1) & 1) * (TC * 16); const int i2 = st * 2;
            *(unsigned*)(yu + (size_t)(NCH - 1) * TC * 16 + i2) = pkbf(yp[i2], yp[i2 + 1]); }
        else *(f32x4*)(p.out + O_WKVP + ((size_t)(bh * 64 + vq * 16 + rloc)) * 64 + kg * 4) = (f32x4){S0, S1, S2, S3};
        __syncthreads();
    }
}


constexpr int CK = 16, NCHAIN = 2, NHELP = 8 - NCHAIN, SLOTB = 22912, NCHK = SEQ / CK, SCAN_WGS = 256 / NCHAIN;
constexpr int SO_AT = 0, SO_RT = 2304, SO_BT = 4608, SO_KT = 6912, SO_BH = 9216, SO_KH = 12288, SO_NAK = 15360, SO_NBR = 16128, SO_NKR = 16896, SO_TT = 17664, SO_VT = 18432, SO_DC = 21504, SO_NAB = 21760;
constexpr int CR_SB = NHELP * SLOTB, FL_OFF = CR_SB + NCHAIN * 3072;
static_assert(FL_OFF + 256 <= MISC_OFF, "scan LDS map");
struct HelpRegs { f32x4 w0, w1; u32x4 kp, kk, kb, rc, rp, vc, vp; };
__device__ __forceinline__ void help_issue(const P& p, HelpRegs (&R)[2], int row0, int h, int lane) {
    const float* WD = p.out + OS_WD; const bf16* KP = (const bf16*)(p.ws + WS_KP); const bf16* KK = (const bf16*)(p.ws + WS_KK); const bf16* KB = (const bf16*)(p.ws + WS_KB); const bf16* PROJ = (const bf16*)(p.ws + WS_PROJ);
#pragma unroll
    for (int i = 0; i < 2; ++i) { const int pc = lane + i * 64, tt = pc & 15, k8 = (pc >> 4) * 8, row = row0 + tt, prow = (row & (SEQ - 1)) ? row - 1 : row; const size_t o = (size_t)row * 512 + h * 64 + k8;
        R[i].w0 = *(const f32x4*)(WD + o); R[i].w1 = *(const f32x4*)(WD + o + 4); R[i].kp = *(const u32x4*)(KP + o); R[i].kk = *(const u32x4*)(KK + o); R[i].kb = *(const u32x4*)(KB + o);
        R[i].rc = *(const u32x4*)(PROJ + (size_t)row * PLD + h * 64 + k8); R[i].rp = *(const u32x4*)(PROJ + (size_t)prow * PLD + h * 64 + k8);
        R[i].vc = *(const u32x4*)(PROJ + (size_t)row * PLD + 1024 + h * 64 + k8); R[i].vp = *(const u32x4*)(PROJ + (size_t)prow * PLD + 1024 + h * 64 + k8); }
}
__device__ __forceinline__ void phase_scan2(const P& p_in, unsigned char* smem) {
    PHASE_PROLOGUE;
    const int lane = tid & 63, wave = tid >> 6, r = lane & 15, q = lane >> 4;
    bf16* YR = (bf16*)(p.ws + WS_XB);
    volatile unsigned* flags = (volatile unsigned*)(smem + FL_OFF);
    const bf16x8 zero8 = {0, 0, 0, 0, 0, 0, 0, 0};
    for (int unit = blockIdx.x; unit < SCAN_WGS; unit += SCAN_WGS) {
        const int ub = unit / (4 / NCHAIN), part = unit % (4 / NCHAIN), bh = (ub & 7) * 8 + (ub >> 3), vq = part * NCHAIN + (wave % NCHAIN), b = bh >> 3, h = bh & 7, rowbase = b * SEQ;
        if (tid < 64) flags[tid] = 0u;
        __syncthreads();
        if (wave < NCHAIN) {
            __builtin_amdgcn_s_setprio(3);
            bf16* yu = YR + (size_t)(bh * 4 + vq) * SEQ * 16;
            f32x4 ST[4];
#pragma unroll
            for (int mt = 0; mt < 4; ++mt) ST[mt] = (f32x4){0.f, 0.f, 0.f, 0.f};
            for (int c = 0; c < NCHK; ++c) {
                const int slot = c % NHELP; unsigned char* sb = smem + slot * SLOTB;
                const bf16* AT = (const bf16*)(sb + SO_AT); const bf16* RT = (const bf16*)(sb + SO_RT); const bf16* BH = (const bf16*)(sb + SO_BH); const bf16* KH = (const bf16*)(sb + SO_KH);
                const bf16* NAK = (const bf16*)(sb + SO_NAK); const bf16* NBR = (const bf16*)(sb + SO_NBR); const bf16* NKR = (const bf16*)(sb + SO_NKR); const bf16* TT = (const bf16*)(sb + SO_TT);
                const bf16* VT = (const bf16*)(sb + SO_VT) + vq * 16 * 24; const float* DC = (const float*)(sb + SO_DC);
                s16x4 sb4[4];
#pragma unroll
                for (int mt = 0; mt < 4; ++mt) sb4[mt] = cvt4(ST[mt]);
                { unsigned sp = 0; while (flags[slot] != (unsigned)(c + 1)) { __builtin_amdgcn_s_sleep(1); if (++sp > (1u << 22)) break; } }
                asm volatile("" ::: "memory");
                s16x4 fa[4], fr[4], fbh[4], fkh[4]; f32x4 dcv[4];
#pragma unroll
                for (int mt = 0; mt < 4; ++mt) { fa[mt] = *(const s16x4*)(AT + r * 72 + mt * 16 + q * 4); fr[mt] = *(const s16x4*)(RT + r * 72 + mt * 16 + q * 4);
                    fbh[mt] = *(const s16x4*)(BH + (mt * 16 + r) * 24 + q * 4); fkh[mt] = *(const s16x4*)(KH + (mt * 16 + r) * 24 + q * 4); dcv[mt] = *(const f32x4*)(DC + mt * 16 + q * 4); }
                const s16x4 fnak = *(const s16x4*)(NAK + lane * 4), ftt = *(const s16x4*)(TT + lane * 4), fnbr = *(const s16x4*)(NBR + lane * 4), fnkr = *(const s16x4*)(NKR + lane * 4);
                const s16x4 fvt = *(const s16x4*)(VT + r * 24 + q * 4);
                LDS_FENCE();
                if (lane == 0) flags[8 + slot * NCHAIN + wave] = (unsigned)(c + 1);
                f32x4 Wt = {0.f, 0.f, 0.f, 0.f};
#pragma unroll
                for (int mt = 0; mt < 4; ++mt) Wt = mf16(fa[mt], sb4[mt], Wt);
                Wt = mf16(fnak, fvt, Wt);
                f32x4 Ut = {0.f, 0.f, 0.f, 0.f};
                Ut = mf16(ftt, cvt4(Wt), Ut);
                const s16x4 ub = cvt4(Ut);
#pragma unroll
                for (int mt = 0; mt < 4; ++mt) { ST[mt] = ST[mt] * dcv[mt]; ST[mt] = mf16(fbh[mt], ub, ST[mt]); ST[mt] = mf16(fkh[mt], fvt, ST[mt]); }
                f32x4 Yt = {0.f, 0.f, 0.f, 0.f};
#pragma unroll
                for (int mt = 0; mt < 4; ++mt) Yt = mf16(fr[mt], sb4[mt], Yt);
                Yt = mf16(fnbr, ub, Yt); Yt = mf16(fnkr, fvt, Yt);
#pragma unroll
                for (int j = 0; j < 4; ++j) yu[(size_t)(c * CK + q * 4 + j) * 16 + r] = f2bf(Yt[j]);
            }
#pragma unroll
            for (int mt = 0; mt < 4; ++mt) *(f32x4*)(p.out + O_WKVP + ((size_t)(bh * 64 + vq * 16 + r)) * 64 + mt * 16 + q * 4) = ST[mt];
            __builtin_amdgcn_s_setprio(0);
        } else {
            const int hw = wave - NCHAIN; unsigned char* sb = smem + hw * SLOTB;
            bf16* AT = (bf16*)(sb + SO_AT); bf16* RT = (bf16*)(sb + SO_RT); bf16* BT = (bf16*)(sb + SO_BT); bf16* KT = (bf16*)(sb + SO_KT); bf16* BH = (bf16*)(sb + SO_BH); bf16* KH = (bf16*)(sb + SO_KH);
            bf16* NAK = (bf16*)(sb + SO_NAK); bf16* NBR = (bf16*)(sb + SO_NBR); bf16* NKR = (bf16*)(sb + SO_NKR); bf16* TT = (bf16*)(sb + SO_TT); bf16* VT = (bf16*)(sb + SO_VT);
            float* DC = (float*)(sb + SO_DC); float* NAB = (float*)(sb + SO_NAB); float* WR = (float*)(sb + SO_BH);
            float mur[2][8], muv[2][8];
#pragma unroll
            for (int i = 0; i < 2; ++i)
#pragma unroll
                for (int j = 0; j < 8; ++j) { mur[i][j] = p.in[7][h * 64 + ((lane + i * 64) >> 4) * 8 + j]; muv[i][j] = p.in[7][1024 + h * 64 + ((lane + i * 64) >> 4) * 8 + j]; }
            HelpRegs R[2];
            help_issue(p, R, rowbase + hw * CK, h, lane);
            for (int c = hw; c < NCHK; c += NHELP) {
                if (c >= NHELP) { const unsigned want = (unsigned)(c - NHELP + 1); unsigned sp = 0;
                    for (;;) { bool ok = true;
#pragma unroll
                        for (int w = 0; w < NCHAIN; ++w) ok = ok && (flags[8 + hw * NCHAIN + w] == want);
                        if (ok) break; __builtin_amdgcn_s_sleep(2); if (++sp > (1u << 22)) break; } }
                asm volatile("" ::: "memory");
                const int row0 = rowbase + c * CK;
#pragma unroll
                for (int i = 0; i < 2; ++i) { const int k8 = ((lane >> 4) + 4 * i) * 8, tt = lane & 15; float w[8], pre[8], suf[8], x[8], y[8], rc[8], rp[8];
#pragma unroll
                    for (int j = 0; j < 4; ++j) { w[j] = R[i].w0[j]; w[4 + j] = R[i].w1[j]; }
#pragma unroll
                    for (int j = 0; j < 8; ++j) { float a = w[j], z = w[j];
                        a *= dppo<0x111>(a); a *= dppo<0x112>(a); a *= dppo<0x114>(a); a *= dppo<0x118>(a);
                        z *= dppo<0x101>(z); z *= dppo<0x102>(z); z *= dppo<0x104>(z); z *= dppo<0x108>(z);
                        pre[j] = a; suf[j] = z * __builtin_amdgcn_rcpf(w[j]); }
                    if (tt == 15) { *(f32x4*)(DC + k8) = (f32x4){pre[0], pre[1], pre[2], pre[3]}; *(f32x4*)(DC + k8 + 4) = (f32x4){pre[4], pre[5], pre[6], pre[7]}; }
                    unpack8(R[i].kk, x);
#pragma unroll
                    for (int j = 0; j < 8; ++j) y[j] = -x[j] * dppo<0x111>(pre[j]);
                    *(u32x4*)(AT + tt * 72 + k8) = pack8(y);
                    unpack8(R[i].kb, x);
#pragma unroll
                    for (int j = 0; j < 8; ++j) { const float inv = __builtin_amdgcn_rcpf(pre[j]); rp[j] = inv; y[j] = x[j] * inv; x[j] *= suf[j]; }
                    *(u32x4*)(BT + tt * 72 + k8) = pack8(y);
#pragma unroll
                    for (int j = 0; j < 8; ++j) BH[(k8 + j) * 24 + tt] = f2bf(x[j]);
                    unpack8(R[i].kp, x);
#pragma unroll
                    for (int j = 0; j < 8; ++j) { y[j] = x[j] * rp[j]; x[j] *= suf[j]; }
                    *(u32x4*)(KT + tt * 72 + k8) = pack8(y);
#pragma unroll
                    for (int j = 0; j < 8; ++j) KH[(k8 + j) * 24 + tt] = f2bf(x[j]);
                    unpack8(R[i].rc, rc); unpack8(R[i].rp, rp); const float pz = ((row0 + tt) & (SEQ - 1)) ? 1.f : 0.f;
#pragma unroll
                    for (int j = 0; j < 8; ++j) y[j] = (rc[j] + (rp[j] * pz - rc[j]) * mur[i][j]) * pre[j];
                    *(u32x4*)(RT + tt * 72 + k8) = pack8(y);
                    unpack8(R[i].vc, rc); unpack8(R[i].vp, rp);
#pragma unroll
                    for (int j = 0; j < 8; ++j) VT[(k8 + j) * 24 + tt] = f2bf(rc[j] + (rp[j] * pz - rc[j]) * muv[i][j]); }
                if (c + NHELP < NCHK) help_issue(p, R, rowbase + (c + NHELP) * CK, h, lane);
                LDS_FENCE();
                { f32x4 nab = {0.f, 0.f, 0.f, 0.f}, nabT = nab, nak = nab, nbr = nab, nkr = nab;
#pragma unroll
                  for (int ks = 0; ks < 2; ++ks) { const bf16x8 fb = *(const bf16x8*)(BT + r * 72 + ks * 32 + q * 8), fk = *(const bf16x8*)(KT + r * 72 + ks * 32 + q * 8), fa = *(const bf16x8*)(AT + r * 72 + ks * 32 + q * 8), fr = *(const bf16x8*)(RT + r * 72 + ks * 32 + q * 8);
                      nab = mfma16(fb, fa, nab); nabT = mfma16(fa, fb, nabT); nak = mfma16(fk, fa, nak); nbr = mfma16(fb, fr, nbr); nkr = mfma16(fk, fr, nkr); }
#pragma unroll
                  for (int j = 0; j < 4; ++j) { const int i = q * 4 + j, t = r;
                      nab[j] = (i < t) ? nab[j] : 0.f; nabT[j] = (r < i) ? nabT[j] : 0.f; nak[j] = (i < t) ? nak[j] : 0.f; nbr[j] = (i <= t) ? nbr[j] : 0.f; nkr[j] = (i <= t) ? nkr[j] : 0.f; }
                  *(s16x4*)(NAK + lane * 4) = cvt4(nak); *(s16x4*)(NBR + lane * 4) = cvt4(nbr); *(s16x4*)(NKR + lane * 4) = cvt4(nkr);
                  const f32x4 z4 = {0.f, 0.f, 0.f, 0.f};
                  const s16x4 bN = cvt4(nab), bNT = cvt4(nabT);
                  const f32x4 n2 = mf16(bNT, bN, z4), n2T = mf16(bN, bNT, z4);
                  const s16x4 b2 = cvt4(n2), b2T = cvt4(n2T);
                  const f32x4 n4 = mf16(b2T, b2, z4), n4T = mf16(b2, b2T, z4);
                  const s16x4 b4 = cvt4(n4), b4T = cvt4(n4T);
                  f32x4 X = mf16(b4T, b4, z4);
#pragma unroll
                  for (int j = 0; j < 4; ++j) X[j] += (q * 4 + j == r) ? 1.f : 0.f;
                  X = mf16(b4T, cvt4(X), X);
                  X = mf16(b2T, cvt4(X), X);
                  X = mf16(bNT, cvt4(X), X);
                  *(s16x4*)(TT + lane * 4) = cvt4(X); }
                LDS_FENCE();
                if (lane == 0) flags[hw] = (unsigned)(c + 1);
            }
        }
        __syncthreads();
    }
}

__device__ __forceinline__ bf16x8 ldfrag(const bf16* base, int ld, int row0, int k0, int r, int q) { return *(const bf16x8*)(base + (row0 + r) * ld + k0 + q * 8); }
__device__ __forceinline__ void phase_ssd(const P& p_in, unsigned char* smem) {
    PHASE_PROLOGUE;
    const int lane = tid & 63, wave = tid >> 6, r = lane & 15, q = lane >> 4;
    bf16* XT = (bf16*)(smem + 53248); bf16* XdT = (bf16*)(smem + 57856); bf16* Gs = (bf16*)(smem + 62464); bf16* Hb = (bf16*)(smem + 71680); float* xsn = (float*)(smem + 80384);
    const bf16* XBC = (const bf16*)(p.ws + WS_XBC); const float* DT = (const float*)(p.ws + WS_DT); bf16* YM = (bf16*)(p.ws + WS_XB) + (size_t)MPR * 512;
    for (int unit = (int)blockIdx.x - SCAN_WGS; unit >= 0 && unit < 128; unit += 128) {
        const int bg = unit >> 3, e = (unit >> 1) & 3, ph = unit & 1, b = bg >> 1, g = bg & 1, h = g * 4 + e;
        const float A = -__expf(p.in[21][h]), Dh = p.in[22][h];
        f32x4 hacc[2] = {{0.f, 0.f, 0.f, 0.f}, {0.f, 0.f, 0.f, 0.f}};
        for (int i = tid; i < 32 * 136; i += 512) Hb[i] = 0;
        u32x4 rc[2], rb[2]; unsigned rx0, rx1; float rdt = 0.f;
#define SSD_LOAD(c_) do { const int row0_ = b * SEQ + (c_) * 64; \
            _Pragma("unroll") for (int i = 0; i < 2; ++i) { const int pc = tid + i * 512, s_ = pc >> 4, n8 = (pc & 15) * 8; \
                rc[i] = *(const u32x4*)(XBC + (size_t)(row0_ + s_) * 1024 + 768 + g * 128 + n8); rb[i] = *(const u32x4*)(XBC + (size_t)(row0_ + s_) * 1024 + 512 + g * 128 + n8); } \
            { const unsigned* xp_ = (const unsigned*)(XBC + (size_t)(row0_ + (tid >> 3)) * 1024 + h * 64 + ph * 32 + (tid & 7) * 4); rx0 = xp_[0]; rx1 = xp_[1]; } \
            if (tid < 64) rdt = DT[(size_t)(row0_ + tid) * 8 + h]; } while (0)
        SSD_LOAD(0);
        for (int c = 0; c < SEQ / 64; ++c) {
            unsigned char* sb = smem + (c & 1) * 89088; bf16* Cs = (bf16*)sb; bf16* Bs = (bf16*)(sb + 17408); bf16* BT = (bf16*)(sb + 34816);
            float* cs = (float*)(smem + ((c & 1) ? 142336 : 88576)); float* dtv = cs + 64;
#pragma unroll
            for (int i = 0; i < 2; ++i) { const int pc = tid + i * 512, s_ = pc >> 4, n8 = (pc & 15) * 8;
                *(u32x4*)(Cs + s_ * 136 + n8) = rc[i]; *(u32x4*)(Bs + s_ * 136 + n8) = rb[i];
                const unsigned w[4] = {rb[i].x, rb[i].y, rb[i].z, rb[i].w};
                const int sp = ((((s_ >> 3) ^ (pc & 7)) << 3) | (s_ & 7));
#pragma unroll
                for (int j = 0; j < 4; ++j) { BT[(n8 + 2 * j) * 72 + sp] = (bf16)(w[j] & 0xffffu); BT[(n8 + 2 * j + 1) * 72 + sp] = (bf16)(w[j] >> 16); } }
            if (wave == 0) { float v = A * rdt;
                v += dppf<0x111>(v); v += dppf<0x112>(v); v += dppf<0x114>(v); v += dppf<0x118>(v);
                v += __int_as_float(__builtin_amdgcn_update_dpp(0, __float_as_int(v), 0x142, 0xa, 0xf, false));
                v += __int_as_float(__builtin_amdgcn_update_dpp(0, __float_as_int(v), 0x143, 0xc, 0xf, false));
                cs[lane] = v; dtv[lane] = rdt; }
            __syncthreads();
            { const int s_ = tid >> 3, p4 = (tid & 7) * 4; const float dts = dtv[s_], dec = __expf(cs[63] - cs[s_]);
              const float x[4] = {bflo(rx0), bfhi(rx0), bflo(rx1), bfhi(rx1)};
#pragma unroll
              for (int j = 0; j < 4; ++j) { const float X = x[j] * dts; XT[(p4 + j) * 72 + s_] = f2bf(X); XdT[(p4 + j) * 72 + s_] = f2bf(X * dec); }
              *(f32x4*)(xsn + s_ * 32 + p4) = (f32x4){x[0], x[1], x[2], x[3]}; }
            if (c + 1 < SEQ / 64) SSD_LOAD(c + 1);
#pragma unroll
            for (int i = 0; i < 2; ++i) { const int tile = wave * 2 + i, mt = tile >> 2, nt = tile & 3; f32x4 acc = {0.f, 0.f, 0.f, 0.f};
#pragma unroll
                for (int ks = 0; ks < 4; ++ks) acc = mfma16(ldfrag(Cs, 136, mt * 16, ks * 32, r, q), ldfrag(Bs, 136, nt * 16, ks * 32, r, q), acc);
                const int s_ = nt * 16 + r; const float css = cs[s_];
#pragma unroll
                for (int j = 0; j < 4; ++j) { const int l = mt * 16 + q * 4 + j; const float gv = (s_ <= l) ? acc[j] * __expf(cs[l] - css) : 0.f; Gs[l * 72 + s_] = f2bf(gv); } }
            const int mt = wave >> 1, pt = wave & 1;
            f32x4 yacc = {0.f, 0.f, 0.f, 0.f};
#pragma unroll
            for (int ks = 0; ks < 4; ++ks) yacc = mfma16(ldfrag(Cs, 136, mt * 16, ks * 32, r, q), ldfrag(Hb, 136, pt * 16, ks * 32, r, q), yacc);
#pragma unroll
            for (int j = 0; j < 4; ++j) yacc[j] *= __expf(cs[mt * 16 + q * 4 + j]);
            __syncthreads();
#pragma unroll
            for (int ks = 0; ks < 2; ++ks) yacc = mfma16(ldfrag(Gs, 72, mt * 16, ks * 32, r, q), ldfrag(XT, 72, pt * 16, ks * 32, r, q), yacc);
#pragma unroll
            for (int j = 0; j < 4; ++j) { const int l = mt * 16 + q * 4 + j; YM[((size_t)((b * 8 + h) * 4 + ph * 2 + pt) * SEQ + c * 64 + l) * 16 + r] = f2bf(yacc[j] + Dh * xsn[l * 32 + pt * 16 + r]); }
            { const float dl = __expf(cs[63]);
#pragma unroll
              for (int t2 = 0; t2 < 2; ++t2) { hacc[t2] = hacc[t2] * dl;
#pragma unroll
                  for (int ks = 0; ks < 2; ++ks) hacc[t2] = mfma16(ldfrag(XdT, 72, t2 * 16, ks * 32, r, q), *(const bf16x8*)(BT + (wave * 16 + r) * 72 + (((ks * 4 + q) ^ ((wave * 2 + (r >> 3)) & 7)) << 3)), hacc[t2]);
#pragma unroll
                  for (int j = 0; j < 4; ++j) Hb[(t2 * 16 + q * 4 + j) * 136 + wave * 16 + r] = f2bf(hacc[t2][j]); } }
        }
#undef SSD_LOAD
#pragma unroll
        for (int t2 = 0; t2 < 2; ++t2)
#pragma unroll
            for (int j = 0; j < 4; ++j) p.out[O_SSMP + ((size_t)((b * 8 + h) * 64 + ph * 32 + t2 * 16 + q * 4 + j)) * 128 + wave * 16 + r] = hacc[t2][j];
        __syncthreads();
    }
}

__device__ __forceinline__ float conv_act_s(const P& p, int bs, int c) {
    const bf16* PROJ = (const bf16*)(p.ws + WS_PROJ); const float* sc = p.in[4] + (size_t)bs * 3072 + c; const float* cw = p.in[18] + c;
    const float v = p.in[19][c] + cw[0] * sc[0] + cw[1024] * sc[1024] + cw[2048] * sc[2048] + cw[3072] * bf2f(PROJ[(size_t)(MPR + bs) * PLD + 2304 + c]);
    return silu(v);
}
__device__ __forceinline__ void phase_sample_step(const P& p_in, unsigned char* smem) {
    PHASE_PROLOGUE;
    const int lane = tid & 63, wave = tid >> 6, G = gridDim.x, bid = blockIdx.x;
    const int first = SCAN_WGS;
    const int gw = (bid - first) * 8 + wave, NGW = (G - first) * 8;
    if (bid < first) return;
    float* sv = (float*)(smem + wave * 2048);
    const float* WD = p.out + OS_WD; const bf16* KP = (const bf16*)(p.ws + WS_KP); const bf16* KK = (const bf16*)(p.ws + WS_KK); const bf16* KB = (const bf16*)(p.ws + WS_KB);
    bf16* YS = (bf16*)(p.ws + WS_YS); const float* DT = (const float*)(p.ws + WS_DT);
    const int kq = lane & 15, rr = lane >> 4;
    for (int unit = gw; unit < 2048; unit += NGW) {
        const int bs = (unit & 1023) >> 3, h = unit & 7, row = MPR + bs;
        if (unit < 1024) {
            const size_t o = (size_t)row * 512 + h * 64 + lane;
            sv[lane] = WD[o]; sv[64 + lane] = bf2f(KP[o]); sv[128 + lane] = -bf2f(KK[o]); sv[192 + lane] = bf2f(KB[o]); sv[256 + lane] = lerp1(p, row, h * 64 + lane); sv[320 + lane] = lerp1(p, row, 1024 + h * 64 + lane);
            LDS_FENCE();
            const f32x4 w4 = *(const f32x4*)(sv + kq * 4), kp4 = *(const f32x4*)(sv + 64 + kq * 4), ka4 = *(const f32x4*)(sv + 128 + kq * 4), kb4 = *(const f32x4*)(sv + 192 + kq * 4), r4 = *(const f32x4*)(sv + 256 + kq * 4);
            const size_t so = (size_t)(bs * 8 + h) * 4096 + rr * 64 + kq * 4;
            const float* Sb = p.in[3] + so; float* Ob = p.out + O_WKVS + so;
            f32x4 S[16]; float sa[16];
#pragma unroll
            for (int i = 0; i < 16; ++i) S[i] = *(const f32x4*)(Sb + i * 256);
#pragma unroll
            for (int i = 0; i < 16; ++i) sa[i] = sum16((S[i][0] * ka4[0] + S[i][1] * ka4[1]) + (S[i][2] * ka4[2] + S[i][3] * ka4[3]));
#pragma unroll
            for (int i = 0; i < 16; ++i) { const float vv = sv[320 + 4 * i + rr]; f32x4 n;
#pragma unroll
                for (int j = 0; j < 4; ++j) n[j] = S[i][j] * w4[j] + (sa[i] * kb4[j] + vv * kp4[j]);
                *(f32x4*)(Ob + i * 256) = n;
                const float y = sum16((n[0] * r4[0] + n[1] * r4[1]) + (n[2] * r4[2] + n[3] * r4[3]));
                if (kq == 0) YS[(size_t)bs * 1024 + h * 64 + 4 * i + rr] = f2bf(y); }
            LDS_FENCE();
        } else {
            const int g = h >> 2;
            sv[lane] = conv_act_s(p, bs, 512 + g * 128 + lane); sv[64 + lane] = conv_act_s(p, bs, 512 + g * 128 + 64 + lane);
            sv[128 + lane] = conv_act_s(p, bs, 768 + g * 128 + lane); sv[192 + lane] = conv_act_s(p, bs, 768 + g * 128 + 64 + lane);
            sv[256 + lane] = conv_act_s(p, bs, h * 64 + lane);
            LDS_FENCE();
            const float dt = DT[(size_t)row * 8 + h], A = -__expf(p.in[21][h]), dA = __expf(A * dt), Dh = p.in[22][h];
            const f32x4 Bl = *(const f32x4*)(sv + kq * 4), Bh = *(const f32x4*)(sv + 64 + kq * 4), Cl = *(const f32x4*)(sv + 128 + kq * 4), Ch = *(const f32x4*)(sv + 192 + kq * 4);
            const size_t so = (size_t)(bs * 8 + h) * 8192 + rr * 128 + kq * 4;
            const float* Hb_ = p.in[5] + so; float* Ob = p.out + O_SSMS + so;
#pragma unroll
            for (int half = 0; half < 2; ++half) { f32x4 hl[8], hh[8];
#pragma unroll
                for (int i = 0; i < 8; ++i) { hl[i] = *(const f32x4*)(Hb_ + (half * 8 + i) * 512); hh[i] = *(const f32x4*)(Hb_ + (half * 8 + i) * 512 + 64); }
#pragma unroll
                for (int i = 0; i < 8; ++i) { const int pp = 4 * (half * 8 + i) + rr; const float x = sv[256 + pp], dtx = dt * x; f32x4 nl, nh; float y = 0.f;
#pragma unroll
                    for (int j = 0; j < 4; ++j) { nl[j] = hl[i][j] * dA + dtx * Bl[j]; nh[j] = hh[i][j] * dA + dtx * Bh[j]; y += nl[j] * Cl[j] + nh[j] * Ch[j]; }
                    *(f32x4*)(Ob + (half * 8 + i) * 512) = nl; *(f32x4*)(Ob + (half * 8 + i) * 512 + 64) = nh;
                    y = sum16(y) + Dh * x;
                    if (kq == 0) YS[(size_t)bs * 1024 + 512 + h * 64 + pp] = f2bf(y); } }
            LDS_FENCE();
        }
    }
}

__device__ __forceinline__ void phase_post(const P& p_in) {
    PHASE_PROLOGUE;
    const int lane = tid & 63, wave = tid >> 6, G = gridDim.x, bid = blockIdx.x;
    const int gw = bid * 8 + wave, NGW = G * 8;
    bf16* MIX = (bf16*)(p.ws + WS_MIX); const bf16* YR = (const bf16*)(p.ws + WS_XB); const bf16* YM = YR + (size_t)MPR * 512; const bf16* YS = (const bf16*)(p.ws + WS_YS);
    const bf16* PROJ = (const bf16*)(p.ws + WS_PROJ); const bf16* KP = (const bf16*)(p.ws + WS_KP); const bf16* GG = (const bf16*)(p.out + OS_GG);
    const int c0 = lane * 8;
    float rk[8], lw[8], lb[8], gn[8], mur[8], muv[8];
#pragma unroll
    for (int i = 0; i < 8; ++i) { rk[i] = p.in[15][c0 + i]; lw[i] = p.in[16][c0 + i]; lb[i] = p.in[17][c0 + i]; gn[i] = p.in[23][c0 + i]; mur[i] = p.in[7][c0 + i]; muv[i] = p.in[7][1024 + c0 + i]; }
    struct PostRegs { u32x4 yr, ym, rc, rp, vc, vp, kp, gg, z; };
    PostRegs nx;
#define POST_LOAD(R_, row_) do { const int rw_ = (row_); \
        const size_t yo_ = ((size_t)(((rw_ >> 11) * 8 + (lane >> 3)) * 4 + ((lane & 7) >> 1)) * SEQ + (rw_ & (SEQ - 1))) * 16 + (lane & 1) * 8; \
        R_.yr = rw_ < MPR ? *(const u32x4*)(YR + yo_) : *(const u32x4*)(YS + (size_t)(rw_ - MPR) * 1024 + c0); \
        R_.ym = rw_ < MPR ? *(const u32x4*)(YM + yo_) : *(const u32x4*)(YS + (size_t)(rw_ - MPR) * 1024 + 512 + c0); \
        R_.rc = *(const u32x4*)(PROJ + (size_t)rw_ * PLD + c0); R_.vc = *(const u32x4*)(PROJ + (size_t)rw_ * PLD + 1024 + c0); R_.z = *(const u32x4*)(PROJ + (size_t)rw_ * PLD + 1792 + c0); \
        R_.kp = *(const u32x4*)(KP + (size_t)rw_ * 512 + c0); R_.gg = *(const u32x4*)(GG + (size_t)rw_ * 512 + c0); \
        u32x4 pr_ = {0u, 0u, 0u, 0u}, pv_ = pr_; \
        if (rw_ >= MPR) { const float* sp_ = p.in[2] + (size_t)(rw_ - MPR) * RPJ + c0; const f32x4 a_ = *(const f32x4*)sp_, b_ = *(const f32x4*)(sp_ + 4), c_ = *(const f32x4*)(sp_ + 1024), d_ = *(const f32x4*)(sp_ + 1028); \
            pr_.x = pkbf(a_[0], a_[1]); pr_.y = pkbf(a_[2], a_[3]); pr_.z = pkbf(b_[0], b_[1]); pr_.w = pkbf(b_[2], b_[3]); pv_.x = pkbf(c_[0], c_[1]); pv_.y = pkbf(c_[2], c_[3]); pv_.z = pkbf(d_[0], d_[1]); pv_.w = pkbf(d_[2], d_[3]); } \
        else if ((rw_ & (SEQ - 1)) != 0) { pr_ = *(const u32x4*)(PROJ + (size_t)(rw_ - 1) * PLD + c0); pv_ = *(const u32x4*)(PROJ + (size_t)(rw_ - 1) * PLD + 1024 + c0); } \
        R_.rp = pr_; R_.vp = pv_; } while (0)
    if (gw < MTOT) POST_LOAD(nx, gw);
    for (int row = gw; row < MTOT; row += NGW) {
        const PostRegs cu = nx;
        if (row + NGW < MTOT) POST_LOAD(nx, row + NGW);
        {
            float y[8], rr[8], kp[8], vv[8], gg[8], t0[8], t1[8];
            unpack8(cu.yr, y);
            float s = 0.f;
#pragma unroll
            for (int i = 0; i < 8; ++i) s += y[i];
            s = sum8(s);
            const float mean = s * (1.f / 64.f); float s2 = 0.f;
#pragma unroll
            for (int i = 0; i < 8; ++i) { y[i] -= mean; s2 += y[i] * y[i]; }
            s2 = sum8(s2);
            const float rstd = rsqrtf(s2 * (1.f / 64.f) + 64e-5f);
            unpack8(cu.rc, t0); unpack8(cu.rp, t1);
#pragma unroll
            for (int i = 0; i < 8; ++i) rr[i] = t0[i] + (t1[i] - t0[i]) * mur[i];
            unpack8(cu.vc, t0); unpack8(cu.vp, t1);
#pragma unroll
            for (int i = 0; i < 8; ++i) vv[i] = t0[i] + (t1[i] - t0[i]) * muv[i];
            unpack8(cu.kp, kp); unpack8(cu.gg, gg);
            float bo = 0.f;
#pragma unroll
            for (int i = 0; i < 8; ++i) bo += rr[i] * kp[i] * rk[i];
            bo = sum8(bo);
#pragma unroll
            for (int i = 0; i < 8; ++i) y[i] = (y[i] * rstd * lw[i] + lb[i] + bo * vv[i]) * gg[i];
            *(u32x4*)(MIX + (size_t)row * 1024 + c0) = pack8(y);
        }
        {
            float y[8], z[8];
            unpack8(cu.ym, y); unpack8(cu.z, z);
            float ss = 0.f;
#pragma unroll
            for (int i = 0; i < 8; ++i) { y[i] *= silu(z[i]); ss += y[i] * y[i]; }
            ss = sum32(ss, lane >= 32);
            const float sc = rsqrtf(ss * (1.f / 256.f) + 1e-5f);
#pragma unroll
            for (int i = 0; i < 8; ++i) y[i] = y[i] * sc * gn[i];
            *(u32x4*)(MIX + (size_t)row * 1024 + 512 + c0) = pack8(y);
        }
    }
#undef POST_LOAD
}

template <bool TO_BF16> __device__ __forceinline__ void phase_ln(const P& p_in, const float* gam, const float* bet, bf16* ob, size_t src_off, int sld) {
    PHASE_PROLOGUE;
    const int lane = tid & 63, wave = tid >> 6, G = gridDim.x, bid = blockIdx.x;
    const int gw = bid * 8 + wave, NGW = G * 8;
    const bf16* src = (const bf16*)p.out + src_off;
    f32x4 gv[4], bv[4];
#pragma unroll
    for (int j = 0; j < 4; ++j) { gv[j] = *(const f32x4*)(gam + lane * 4 + 256 * j); bv[j] = *(const f32x4*)(bet + lane * 4 + 256 * j); }
    unsigned long long nx[4] = {0ull, 0ull, 0ull, 0ull};
    if (gw < MTOT) {
#pragma unroll
        for (int j = 0; j < 4; ++j) nx[j] = *(const unsigned long long*)(src + (size_t)gw * sld + lane * 4 + 256 * j); }
    for (int row = gw; row < MTOT; row += NGW) {
        float* xr = p.out + (size_t)row * 1024 + lane * 4;
        f32x4 v[4]; float s = 0.f;
#pragma unroll
        for (int j = 0; j < 4; ++j) { const unsigned lo = (unsigned)nx[j], hi = (unsigned)(nx[j] >> 32);
            v[j] = (f32x4){bflo(lo), bfhi(lo), bflo(hi), bfhi(hi)}; s += (v[j][0] + v[j][1]) + (v[j][2] + v[j][3]); }
        if (row + NGW < MTOT) {
#pragma unroll
            for (int j = 0; j < 4; ++j) nx[j] = *(const unsigned long long*)(src + (size_t)(row + NGW) * sld + lane * 4 + 256 * j); }
        s = sum64(s);
        const float mean = s * (1.f / 1024.f); float s2 = 0.f;
#pragma unroll
        for (int j = 0; j < 4; ++j) { v[j] = v[j] - mean; s2 += (v[j][0] * v[j][0] + v[j][1] * v[j][1]) + (v[j][2] * v[j][2] + v[j][3] * v[j][3]); }
        s2 = sum64(s2);
        const float rstd = rsqrtf(s2 * (1.f / 1024.f) + 1e-5f);
#pragma unroll
        for (int j = 0; j < 4; ++j) { const f32x4 o = v[j] * rstd * gv[j] + bv[j];
            if (TO_BF16) { unsigned long long w = (unsigned long long)pkbf(o[0], o[1]) | ((unsigned long long)pkbf(o[2], o[3]) << 32); *(unsigned long long*)(ob + (size_t)row * 1024 + lane * 4 + 256 * j) = w; }
            else *(f32x4*)(xr + 256 * j) = o; }
    }
}

#ifndef USE_CHUNKED
#define USE_CHUNKED 1
#endif
#ifndef REPEAT_SEL
#define REPEAT_SEL 0
#endif
#ifndef DUMP_SEL
#define DUMP_SEL 0
#endif
#ifndef STOP_AFTER
#define STOP_AFTER 99
#endif
__global__ void __launch_bounds__(512, 2) mega(P p) {
    extern __shared__ __attribute__((aligned(16))) unsigned char smem[];
    LAS unsigned char* lds = (LAS unsigned char*)smem;
    volatile LAS unsigned* MISC = (volatile LAS unsigned*)(lds + MISC_OFF);
    if (threadIdx.x < 16) MISC[threadIdx.x] = 0u;
    __syncthreads();
    XcdBarrier bar = xcd_barrier_post((unsigned*)(p.ws + WS_CTL), MISC);
    if (p.never) cg::this_grid().sync();
#define GRID_BAR() xcd_barrier(bar)
    const int G = gridDim.x, bid = blockIdx.x;
    bf16* XB = (bf16*)(p.ws + WS_XB); bf16* PROJ = (bf16*)(p.ws + WS_PROJ); float* DT = (float*)(p.ws + WS_DT); bf16* HID = (bf16*)(p.ws + WS_HID);

#if STOP_AFTER != 99
    { const size_t gt = (size_t)blockIdx.x * 512 + threadIdx.x, NGT = (size_t)gridDim.x * 512; for (size_t i = O_SHP + gt; i < 30939136; i += NGT) p.out[i] = 0.f; }
    GRID_BAR();
#endif
    phase0(p, smem);
    GRID_BAR();
    {
        pg8::Gemm g{XB, (const bf16*)(p.ws + WS_WIN), MPR, 3584, 1024}; pg8::StaticOrder S; S.init(MPR, 3584, G, bid);
        pg8::EpiProj E{PROJ, DT, p.in[20], p.out};
        pg8::gemm_phase<pg8::EpiProj, pg8::StaticOrder, true, true>(lds, g, S, E);
        const float* dtb = p.in[20]; float* out = p.out;
        small_gemm<4, 1024>(XB + (size_t)MPR * 1024, (const bf16*)(p.ws + WS_WIN), PROJN, smem, [=](int rs, int c, float v) {
            if (c < 3328) PROJ[(size_t)(MPR + rs) * PLD + c] = f2bf(v); else DT[(size_t)(MPR + rs) * 8 + (c - 3328)] = softplus(v + dtb[c - 3328]);
            if (c < 1792) out[O_SHS + (size_t)rs * 1792 + c] = v;
            if (c >= 2304 && c < 3328) out[O_CONVS + ((size_t)rs * 3 + 2) * 1024 + (c - 2304)] = v; }, (G == 256) ? 128 : 0);
        phase0_late(p, smem, (G == 256) ? 128 : 0, 0);
    }
    GRID_BAR();
    phase_prep(p, smem);
#if REPEAT_SEL == 2
    phase_prep(p, smem);
#endif
    GRID_BAR();
#if STOP_AFTER == 2
    { const size_t gt = (size_t)blockIdx.x * 512 + threadIdx.x, NGT = (size_t)gridDim.x * 512; const bf16* KPd = (const bf16*)(p.ws + WS_KP); const bf16* XBCd = (const bf16*)(p.ws + WS_XBC);
      for (size_t i = gt; i < 8454144; i += NGT) { p.out[i] = bf2f(KPd[i]); p.out[8454144 + i] = bf2f(XBCd[i]); } }
    return;
#endif
#if USE_CHUNKED
    phase_scan2(p, smem);
#else
    phase_scan(p, smem);
#endif
    phase_ssd(p, smem);
    phase_sample_step(p, smem);
#if REPEAT_SEL == 3
    phase_scan2(p, smem);
    phase_ssd(p, smem);
    phase_sample_step(p, smem);
#endif
#if REPEAT_SEL == 5
    phase_sample_step(p, smem);
    phase_sample_step(p, smem);
#endif
#if REPEAT_SEL == 6
    phase_ssd(p, smem);
#endif
#if REPEAT_SEL == 4
    phase_ssd(p, smem);
    phase_sample_step(p, smem);
#endif
    GRID_BAR();
#if STOP_AFTER == 4
    { const size_t gt = (size_t)blockIdx.x * 512 + threadIdx.x, NGT = (size_t)gridDim.x * 512; const bf16* Yd = (const bf16*)(p.ws + WS_XB);
      for (size_t i = gt; i < 8388608; i += NGT) { p.out[i] = (DUMP_SEL & 1) ? bf2f(Yd[i]) : 0.f; p.out[8388608 + i] = (DUMP_SEL & 2) ? bf2f(Yd[8388608 + i]) : 0.f; }
      for (size_t i = gt; i < 131072; i += NGT) p.out[16777216 + i] = (DUMP_SEL & 4) ? bf2f(((const bf16*)(p.ws + WS_YS))[i]) : 0.f; }
    return;
#endif
    phase_post(p);
    GRID_BAR();
#if STOP_AFTER == 5
    { const size_t gt = (size_t)blockIdx.x * 512 + threadIdx.x, NGT = (size_t)gridDim.x * 512; for (size_t i = gt; i < (size_t)MTOT * 1024; i += NGT) p.out[i] = bf2f(((const bf16*)(p.ws + WS_MIX))[i]); }
    return;
#endif
    {
        pg8::Gemm g{(const bf16*)(p.ws + WS_MIX), (const bf16*)(p.ws + WS_WOUT), MPR, 1024, 1024}; pg8::StaticOrder S; S.init(MPR, 1024, G, bid);
        pg8::EpiResF32 E{p.in[0], nullptr, (bf16*)p.out, 1024, ALPHA};
        pg8::gemm_phase<pg8::EpiResF32, pg8::StaticOrder, true, true>(lds, g, S, E);
        const float* xs = p.in[1]; float* out = p.out;
        small_gemm<2, 1024>((const bf16*)(p.ws + WS_MIX) + (size_t)MPR * 1024, (const bf16*)(p.ws + WS_WOUT), 1024, smem, [=](int rs, int c, float v) { ((bf16*)out)[(size_t)(MPR + rs) * 1024 + c] = f2bf(ALPHA * xs[(size_t)rs * 1024 + c] + v); });
    }
    GRID_BAR();
    phase_ln<true>(p, p.in[25], p.in[26], XB, 0, 1024);
    phase0_late(p, smem, 0, 1);
    GRID_BAR();
    {
        pg8::Gemm g{XB, (const bf16*)(p.ws + WS_WFF1), MPR, 4096, 1024}; pg8::StaticOrder S; S.init(MPR, 4096, G, bid);
        pg8::EpiRelu2 E{HID, 4096};
        pg8::gemm_phase<pg8::EpiRelu2, pg8::StaticOrder, true, true>(lds, g, S, E);
        small_gemm<4, 1024>(XB + (size_t)MPR * 1024, (const bf16*)(p.ws + WS_WFF1), 4096, smem, [=](int rs, int c, float v) { const float a = fmaxf(v, 0.f); HID[(size_t)(MPR + rs) * 4096 + c] = f2bf(a * a); });
    }
    GRID_BAR();
    {
        pg8::Gemm g{HID, (const bf16*)(p.ws + WS_WFF2), MPR, 1024, 4096}; pg8::StaticOrder S; S.init(MPR, 1024, G, bid);
        pg8::EpiResF32 E{nullptr, XB, (bf16*)p.out + 1024, 2048, ALPHA};
        pg8::gemm_phase<pg8::EpiResF32, pg8::StaticOrder, true, true>(lds, g, S, E);
        float* out = p.out;
        small_gemm<2, 4096>(HID + (size_t)MPR * 4096, (const bf16*)(p.ws + WS_WFF2), 1024, smem, [=](int rs, int c, float v) { ((bf16*)out)[(size_t)(MPR + rs) * 2048 + 1024 + c] = f2bf(ALPHA * bf2f(XB[(size_t)(MPR + rs) * 1024 + c]) + v); });
    }
    GRID_BAR();
    phase_ln<false>(p, p.in[29], p.in[30], nullptr, 1024, 2048);
}

extern "C" void kernel_launch(void* const* d_in, const int* in_sizes, int n_in, void* d_out, int out_size, void* d_ws, size_t ws_size, hipStream_t stream) {
    static int grid = 0;
    if (grid == 0) {
        int dev = 0, cus = 0, per_cu = 0;
        (void)hipGetDevice(&dev);
        (void)hipDeviceGetAttribute(&cus, hipDeviceAttributeMultiprocessorCount, dev);
        if (hipFuncSetAttribute((const void*)mega, hipFuncAttributeMaxDynamicSharedMemorySize, LDS_BYTES) != hipSuccess) fprintf(stderr, "kernel_launch: hipFuncSetAttribute failed\n");
        if (hipOccupancyMaxActiveBlocksPerMultiprocessor(&per_cu, (const void*)mega, 512, LDS_BYTES) != hipSuccess || per_cu < 1) { fprintf(stderr, "kernel_launch: occupancy query says %d\n", per_cu); per_cu = 1; }
        (void)hipGetLastError();
        grid = cus * 1;
        if (n_in != 31 || out_size != 30939136 || ws_size < WS_CTL + 16384) fprintf(stderr, "kernel_launch: unexpected sizes n_in %d out %d ws %zu\n", n_in, out_size, ws_size);
    }
    (void)hipMemsetAsync((char*)d_ws + WS_CTL, 0, 16384, stream);
    P a{};
    for (int i = 0; i < 31; ++i) a.in[i] = (const float*)d_in[i];
    a.out = (float*)d_out; a.ws = (unsigned char*)d_ws; a.never = 0; a.pad = 0;
    void* args[] = {&a};
    hipError_t e = hipLaunchCooperativeKernel((const void*)mega, dim3(grid), dim3(512), args, LDS_BYTES, stream);
    if (e != hipSuccess) fprintf(stderr, "kernel_launch: cooperative launch failed: %s (grid %d)\n", hipGetErrorString(e), grid);
}
```
